# Optimizing an MI355X kernel written in HIP

```python
import jax, jax.numpy as jnp
from jax import lax
import numpy as np

D_MODEL = 1024
BATCH = 8
SEQ = 4096
DEPTH = 2

GRID_W = 64
CTX_LEN = 256
EPS = 1e-6
N_MOD = 6

GLA_HEADS = 4
GLA_DK = D_MODEL // (2 * GLA_HEADS)
GLA_DV = D_MODEL // GLA_HEADS
GLA_RANK = 16
GLA_GATE_NORM = 16.0
CHUNK = 64

LRU_WIDTH = D_MODEL
LRU_BLOCKS = 4
LRU_BLOCK = LRU_WIDTH // LRU_BLOCKS
LRU_C = 8.0
CONV_W = 4
CONV_LEFT = 2
CONV_RIGHT = CONV_W - 1 - CONV_LEFT

RET_HEADS = 4
RET_DK = D_MODEL // (2 * RET_HEADS)
RET_DV = D_MODEL // RET_HEADS
ROPE_BASE = 10000.0

N_BRANCH = 3
BRANCH_WIDTH = D_MODEL

N_EXPERTS = 32
TOP_K = 4
D_EXPERT = D_MODEL
SWIGLU_LIMIT = 7.0
SWIGLU_ALPHA = 1.702
MOE_BLOCK = 256

IN_SIZES = (
    GLA_HEADS * GLA_DK, GLA_HEADS * GLA_DK, GLA_HEADS * GLA_DV, GLA_HEADS * GLA_DV,
    GLA_RANK, GLA_RANK,
    LRU_WIDTH, LRU_WIDTH,
    RET_HEADS * RET_DK, RET_HEADS * RET_DK, RET_HEADS * RET_DV, RET_HEADS * RET_DV,
    N_BRANCH * D_MODEL,
)
IN_TOTAL = int(sum(IN_SIZES))
IN_OFFSETS = tuple(int(o) for o in np.cumsum(IN_SIZES)[:-1])

kernel_name = 'hybrid_gla_rglru_retention_moe_dit'


def rms_norm(x, gain):
    xf = x.astype(jnp.float32)
    y = xf * lax.rsqrt(jnp.mean(xf * xf, axis=-1, keepdims=True) + EPS)
    return (y * gain.astype(jnp.float32)).astype(x.dtype)


def modulate(h, shift, scale):
    return h * (1.0 + scale) + shift


def to_heads(a, n):
    b, t, _ = a.shape
    return a.reshape(b, t, n, -1).transpose(0, 2, 1, 3)


def from_heads(a):
    b, n, t, d = a.shape
    return a.transpose(0, 2, 1, 3).reshape(b, t, n * d)


def head_norm(o, gain, center):
    o = o.astype(jnp.float32)
    if center:
        o = o - jnp.mean(o, axis=-1, keepdims=True)
    o = o * lax.rsqrt(jnp.mean(o * o, axis=-1, keepdims=True) + EPS)
    return from_heads(o) * gain.astype(jnp.float32)


def chunked_linear_attn(q, k, v, g, s0, strict):
    b, h, t, _ = q.shape
    dv = v.shape[-1]
    n = t // CHUNK

    def blocks(a):
        return a.reshape(a.shape[0], a.shape[1], n, CHUNK, a.shape[-1])

    qc, kc, vc = blocks(q), blocks(k), blocks(v)
    G = jnp.cumsum(blocks(g).astype(jnp.float32), axis=3)
    G_last = G[:, :, :, -1:, :]
    q_dec = qc * jnp.exp(G)
    k_inv = kc * jnp.exp(-G)
    k_end = kc * jnp.exp(G_last - G)
    mask = jnp.tril(jnp.ones((CHUNK, CHUNK), bool), k=-1 if strict else 0)
    scores = jnp.where(mask, jnp.einsum('bhncd,bhnsd->bhncs', q_dec, k_inv), 0.0)
    o_intra = jnp.einsum('bhncs,bhnse->bhnce', scores, vc)
    kv = jnp.einsum('bhncd,bhnce->bhnde', k_end, vc)
    decay = jnp.exp(G_last[:, :, :, 0, :])

    def step(state, inp):
        kv_n, dec_n = inp
        return dec_n[..., None] * state + kv_n, state

    final, states_in = lax.scan(step, s0, (jnp.moveaxis(kv, 2, 0), jnp.moveaxis(decay, 2, 0)))
    states_in = jnp.moveaxis(states_in, 0, 2)
    o_inter = jnp.einsum('bhncd,bhnde->bhnce', q_dec, states_in)
    return (o_intra + o_inter).reshape(b, h, t, dv), final


def bidir_linear_attn(q, k, v, g_f, g_b, s0_f, s0_b):
    flip = lambda a: jnp.flip(a, axis=2)
    o_f, s_f = chunked_linear_attn(q, k, v, g_f, s0_f, strict=False)
    o_b, s_b = chunked_linear_attn(flip(q), flip(k), flip(v), flip(g_b), s0_b, strict=True)
    return o_f + flip(o_b), s_f, s_b


def gla_inputs(q, k, v, lr_f, lr_b, wa2, ba):
    qh = to_heads(q, GLA_HEADS).astype(jnp.float32) * GLA_DK ** -0.5
    kh = to_heads(k, GLA_HEADS)
    vh = to_heads(v, GLA_HEADS)
    g_f = to_heads(jax.nn.log_sigmoid((lr_f @ wa2[0] + ba[0]).astype(jnp.float32)) / GLA_GATE_NORM, GLA_HEADS)
    g_b = to_heads(jax.nn.log_sigmoid((lr_b @ wa2[1] + ba[1]).astype(jnp.float32)) / GLA_GATE_NORM, GLA_HEADS)
    return qh, kh, vh, g_f, g_b


def axial_rope(rows, head_dim):
    row = jnp.broadcast_to(jnp.arange(rows)[:, None], (rows, GRID_W)).reshape(-1).astype(jnp.float32)
    col = jnp.broadcast_to(jnp.arange(GRID_W)[None, :], (rows, GRID_W)).reshape(-1).astype(jnp.float32)
    n_freq = head_dim // 4
    inv = ROPE_BASE ** (-jnp.arange(n_freq, dtype=jnp.float32) / n_freq)
    ang = jnp.concatenate([row[:, None] * inv, col[:, None] * inv], axis=-1)
    return jnp.cos(ang), jnp.sin(ang)


def apply_rope(x, cos, sin):
    half = x.shape[-1] // 2
    x1, x2 = x[..., :half], x[..., half:]
    return jnp.concatenate([x1 * cos - x2 * sin, x1 * sin + x2 * cos], axis=-1)


def ret_inputs(q, k, v, cos, sin):
    qh = to_heads(q, RET_HEADS).astype(jnp.float32)
    kh = to_heads(k, RET_HEADS).astype(jnp.float32) * RET_DK ** -0.5
    if cos is not None:
        qh = apply_rope(qh, cos, sin)
        kh = apply_rope(kh, cos, sin)
    return qh, kh, to_heads(v, RET_HEADS)


def ret_log_decay(n_tokens):
    gamma = 1.0 - 2.0 ** (-5.0 - jnp.arange(RET_HEADS, dtype=jnp.float32))
    return jnp.broadcast_to(jnp.log(gamma)[None, :, None, None], (1, RET_HEADS, n_tokens, 1))


def depthwise_conv(x, w, b):
    y = lax.conv_general_dilated(x, w[:, None, :].astype(x.dtype), window_strides=(1,),
                                 padding=[(CONV_LEFT, CONV_RIGHT)],
                                 dimension_numbers=('NWC', 'WIO', 'NWC'),
                                 feature_group_count=x.shape[-1])
    return y + b


def block_diag(x, w):
    b, t, c = x.shape
    return jnp.einsum('btgi,gij->btgj', x.reshape(b, t, LRU_BLOCKS, LRU_BLOCK), w).reshape(b, t, c)


def linear_scan(a, b, h0):
    b = b.at[:, 0].add(a[:, 0] * h0)

    def combine(e1, e2):
        a1, b1 = e1
        a2, b2 = e2
        return a1 * a2, a2 * b1 + b2

    _, h = lax.associative_scan(combine, (a, b), axis=1)
    return h


def rglru_scan(xc, wa, ba, wi, bi, lam, h0):
    r = jax.nn.sigmoid((block_diag(xc, wa) + ba).astype(jnp.float32))
    i = jax.nn.sigmoid((block_diag(xc, wi) + bi).astype(jnp.float32))
    log_a = LRU_C * r * jax.nn.log_sigmoid(lam.astype(jnp.float32))
    a = jnp.exp(log_a)
    b = jnp.sqrt(-jnp.expm1(2.0 * log_a)) * (i * xc.astype(jnp.float32))
    h = linear_scan(a, b, h0)
    return h, h[:, -1]


def rglru_bidir(xc, wa, ba, wi, bi, lam, h0_f, h0_b):
    h_f, last_f = rglru_scan(xc, wa[0], ba[0], wi[0], bi[0], lam[0], h0_f)
    h_b, last_b = rglru_scan(jnp.flip(xc, 1), wa[1], ba[1], wi[1], bi[1], lam[1], h0_b)
    return h_f + jnp.flip(h_b, 1), last_f, last_b


def hybrid_mixer(xn, cn, rope_cos, rope_sin, w_in, gla_wa2, gla_ba, gla_norm, lru_conv_w, lru_conv_b,
                 lru_wa, lru_ba, lru_wi, lru_bi, lru_lam, ret_norm, w_branch, w_out, with_ctx_out):
    f32 = jnp.float32
    nb = xn.shape[0]
    px = jnp.split(xn @ w_in, IN_OFFSETS, axis=-1)
    pc = jnp.split(cn @ w_in, IN_OFFSETS, axis=-1)

    zero_gla = jnp.zeros((nb, GLA_HEADS, GLA_DK, GLA_DV), f32)
    o_gla_c, gs_f, gs_b = bidir_linear_attn(*gla_inputs(*pc[0:3], *pc[4:6], gla_wa2, gla_ba), zero_gla, zero_gla)
    o_gla_x, _, _ = bidir_linear_attn(*gla_inputs(*px[0:3], *px[4:6], gla_wa2, gla_ba), gs_f, gs_b)

    lru_p = (lru_wa, lru_ba, lru_wi, lru_bi, lru_lam)
    zero_lru = jnp.zeros((nb, LRU_WIDTH), f32)
    h_c, hs_f, hs_b = rglru_bidir(depthwise_conv(pc[6], lru_conv_w, lru_conv_b), *lru_p, zero_lru, zero_lru)
    h_x, _, _ = rglru_bidir(depthwise_conv(px[6], lru_conv_w, lru_conv_b), *lru_p, hs_f, hs_b)

    zero_ret = jnp.zeros((nb, RET_HEADS, RET_DK, RET_DV), f32)
    g_c = ret_log_decay(cn.shape[1])
    o_ret_c, rs_f, rs_b = bidir_linear_attn(*ret_inputs(*pc[8:11], None, None), g_c, g_c, zero_ret, zero_ret)
    g_x = ret_log_decay(xn.shape[1])
    o_ret_x, _, _ = bidir_linear_attn(*ret_inputs(*px[8:11], rope_cos, rope_sin), g_x, g_x, rs_f, rs_b)

    def finish(p, o_gla, h_lru, o_ret, dtype):
        gla = head_norm(o_gla, gla_norm, False) * jax.nn.silu(p[3].astype(f32))
        lru = h_lru * jax.nn.gelu(p[7].astype(f32))
        ret = head_norm(o_ret, ret_norm, True) * jax.nn.silu(p[11].astype(f32))
        g_gla, g_lru, g_ret = jnp.split(jax.nn.sigmoid(p[12].astype(f32)), N_BRANCH, axis=-1)
        merged = (g_gla * (gla.astype(dtype) @ w_branch[0])
                  + g_lru * (lru.astype(dtype) @ w_branch[1])
                  + g_ret * (ret.astype(dtype) @ w_branch[2]))
        return merged.astype(dtype) @ w_out

    out_x = finish(px, o_gla_x, h_x, o_ret_x, xn.dtype)
    out_c = finish(pc, o_gla_c, h_c, o_ret_c, cn.dtype) if with_ctx_out else None
    return out_x, out_c


def moe_ffn(h, w_router, b_router, w_gu, b_gu, w_down, b_down):
    n_tok, d = h.shape
    n_assign = n_tok * TOP_K
    logits = (h @ w_router).astype(jnp.float32) + b_router.astype(jnp.float32)
    top_logits, top_idx = lax.top_k(logits, TOP_K)
    top_w = jax.nn.softmax(top_logits, axis=-1)
    flat_e = top_idx.reshape(-1)
    order = jnp.argsort(flat_e)
    sorted_e = flat_e[order]
    sorted_tok = (order // TOP_K).astype(jnp.int32)
    sorted_w = top_w.reshape(-1)[order]
    counts = jnp.bincount(flat_e, length=N_EXPERTS)
    padded = (counts + MOE_BLOCK - 1) // MOE_BLOCK * MOE_BLOCK
    pad_end = jnp.cumsum(padded)
    pad_start = pad_end - padded
    grp_start = jnp.cumsum(counts) - counts
    slot = pad_start[sorted_e] + jnp.arange(n_assign) - grp_start[sorted_e]
    n_blocks = -(-n_assign // MOE_BLOCK) + N_EXPERTS
    n_slots = n_blocks * MOE_BLOCK
    slot_tok = jnp.full((n_slots,), n_tok, jnp.int32).at[slot].set(sorted_tok)
    slot_w = jnp.zeros((n_slots,), jnp.float32).at[slot].set(sorted_w)
    block_e = jnp.minimum(jnp.searchsorted(pad_end, jnp.arange(n_blocks) * MOE_BLOCK, side='right'),
                          N_EXPERTS - 1)
    h_pad = jnp.concatenate([h, jnp.zeros((1, d), h.dtype)], axis=0)

    def expert_block(acc, blk):
        tok, wgt, e = blk
        gu = h_pad[tok] @ w_gu[e] + b_gu[e]
        gate = jnp.minimum(gu[:, 0::2], SWIGLU_LIMIT)
        up = jnp.clip(gu[:, 1::2], -SWIGLU_LIMIT, SWIGLU_LIMIT)
        act = gate * jax.nn.sigmoid(SWIGLU_ALPHA * gate) * (up + 1.0)
        y = act @ w_down[e] + b_down[e]
        return acc.at[tok].add(y.astype(jnp.float32) * wgt[:, None]), None

    acc, _ = lax.scan(expert_block, jnp.zeros((n_tok + 1, d), jnp.float32),
                      (slot_tok.reshape(n_blocks, MOE_BLOCK), slot_w.reshape(n_blocks, MOE_BLOCK), block_e))
    return acc[:n_tok].astype(h.dtype)


def setup_inputs(seed: int = 0) -> dict:
    key = jax.random.key(seed)
    ks = jax.random.split(key, 32)
    f32 = jnp.float32
    D = D_MODEL
    L = DEPTH

    def nrm(k, shape, scale):
        return jax.random.normal(k, shape, f32) * scale

    a0 = jax.random.uniform(ks[17], (L, 2, LRU_WIDTH), f32, 0.9, 0.999)
    root = a0 ** (1.0 / LRU_C)
    lru_lam = jnp.log(root) - jnp.log1p(-root)
    return {
        'x': nrm(ks[0], (BATCH, SEQ, D), 1.0),
        'c': nrm(ks[1], (BATCH, D), 1.0),
        'ctx': nrm(ks[2], (BATCH, CTX_LEN, D), 1.0),
        'c_ctx': nrm(ks[3], (D,), 1.0),
        'w_ada': nrm(ks[4], (L, D, N_MOD * D), 0.5 * D ** -0.5),
        'b_ada': nrm(ks[5], (L, N_MOD * D), 0.02),
        'norm1': 1.0 + nrm(ks[6], (L, D), 0.02),
        'norm2': 1.0 + nrm(ks[7], (L, D), 0.02),
        'w_in': nrm(ks[8], (L, D, IN_TOTAL), D ** -0.5),
        'gla_wa2': nrm(ks[9], (L, 2, GLA_RANK, GLA_HEADS * GLA_DK), GLA_RANK ** -0.5),
        'gla_ba': nrm(ks[10], (L, 2, GLA_HEADS * GLA_DK), 0.1),
        'gla_norm': 1.0 + nrm(ks[11], (L, GLA_HEADS * GLA_DV), 0.02),
        'lru_conv_w': nrm(ks[12], (L, CONV_W, LRU_WIDTH), CONV_W ** -0.5),
        'lru_conv_b': nrm(ks[13], (L, LRU_WIDTH), 0.02),
        'lru_wa': nrm(ks[14], (L, 2, LRU_BLOCKS, LRU_BLOCK, LRU_BLOCK), LRU_BLOCK ** -0.5),
        'lru_ba': nrm(ks[15], (L, 2, LRU_WIDTH), 0.02),
        'lru_wi': nrm(ks[16], (L, 2, LRU_BLOCKS, LRU_BLOCK, LRU_BLOCK), LRU_BLOCK ** -0.5),
        'lru_bi': nrm(ks[18], (L, 2, LRU_WIDTH), 0.02),
        'lru_lam': lru_lam,
        'ret_norm': 1.0 + nrm(ks[19], (L, RET_HEADS * RET_DV), 0.02),
        'w_branch': nrm(ks[20], (L, N_BRANCH, BRANCH_WIDTH, D), BRANCH_WIDTH ** -0.5),
        'w_out': nrm(ks[21], (L, D, D), D ** -0.5),
        'w_router': nrm(ks[22], (L, D, N_EXPERTS), D ** -0.5),
        'b_router': nrm(ks[23], (L, N_EXPERTS), 0.01),
        'w_gu': nrm(ks[24], (L, N_EXPERTS, D, 2 * D_EXPERT), D ** -0.5),
        'b_gu': nrm(ks[25], (L, N_EXPERTS, 2 * D_EXPERT), 0.02),
        'w_down': nrm(ks[26], (L, N_EXPERTS, D_EXPERT, D), D_EXPERT ** -0.5),
        'b_down': nrm(ks[27], (L, N_EXPERTS, D), 0.02),
        'final_norm': 1.0 + nrm(ks[28], (D,), 0.02),
    }


def reference(x, c, ctx, c_ctx, w_ada, b_ada, norm1, norm2, w_in, gla_wa2, gla_ba, gla_norm,
              lru_conv_w, lru_conv_b, lru_wa, lru_ba, lru_wi, lru_bi, lru_lam, ret_norm,
              w_branch, w_out, w_router, b_router, w_gu, b_gu, w_down, b_down, final_norm):
    nb, n_lat, d = x.shape
    rows = n_lat // GRID_W
    rope_cos, rope_sin = axial_rope(rows, RET_DK)
    silu_c = jax.nn.silu(c)
    silu_cc = jax.nn.silu(c_ctx)
    for li in range(DEPTH):
        last = li == DEPTH - 1
        mx = (silu_c @ w_ada[li] + b_ada[li]).reshape(nb, N_MOD, 1, d)
        mc = (silu_cc @ w_ada[li] + b_ada[li]).reshape(N_MOD, d)
        xn = modulate(rms_norm(x, norm1[li]), mx[:, 0], mx[:, 1])
        cn = modulate(rms_norm(ctx, norm1[li]), mc[0], mc[1])
        mix_x, mix_c = hybrid_mixer(xn, cn, rope_cos, rope_sin, w_in[li], gla_wa2[li], gla_ba[li], gla_norm[li],
                                    lru_conv_w[li], lru_conv_b[li], lru_wa[li], lru_ba[li], lru_wi[li],
                                    lru_bi[li], lru_lam[li], ret_norm[li], w_branch[li], w_out[li],
                                    not last)
        x = x + mx[:, 2] * mix_x
        xn2 = modulate(rms_norm(x, norm2[li]), mx[:, 3], mx[:, 4])
        moe_p = (w_router[li], b_router[li], w_gu[li], b_gu[li], w_down[li], b_down[li])
        if last:
            x = x + mx[:, 5] * moe_ffn(xn2.reshape(-1, d), *moe_p).reshape(x.shape)
        else:
            ctx = ctx + mc[2] * mix_c
            cn2 = modulate(rms_norm(ctx, norm2[li]), mc[3], mc[4])
            y = moe_ffn(jnp.concatenate([xn2.reshape(-1, d), cn2.reshape(-1, d)], axis=0), *moe_p)
            x = x + mx[:, 5] * y[:nb * n_lat].reshape(x.shape)
            ctx = ctx + mc[5] * y[nb * n_lat:].reshape(ctx.shape)
    return rms_norm(x, final_norm)
```

```cpp
#include <hip/hip_runtime.h>
#include <cstdio>
#include <cstdint>

#define LAS __attribute__((address_space(3)))
typedef unsigned short bf16_t;
typedef short bf16x8 __attribute__((ext_vector_type(8)));
typedef float f32x4 __attribute__((ext_vector_type(4)));
typedef float f32x2 __attribute__((ext_vector_type(2)));
typedef unsigned u32x4 __attribute__((ext_vector_type(4)));
typedef unsigned u32x2 __attribute__((ext_vector_type(2)));

constexpr int D = 1024, NBATCH = 8, SEQ = 4096, CTXL = 256;
constexpr int TLAT = NBATCH * SEQ, TCTX = NBATCH * CTXL, TT = TLAT + TCTX;
constexpr int LDP = 11520;
constexpr int C_GQ = 0, C_GK = 512, C_GV = 1024, C_GG = 2048, C_LX = 3072, C_LG = 4096, C_RQ = 5120, C_RK = 5632, C_RV = 6144, C_RG = 7168, C_MG = 8192, C_LR = 11264;
constexpr int IN_TOTAL = 11296, NE = 32;
constexpr int SLOT_TILES_MAX = 576;
constexpr float EPS = 1e-6f;

constexpr size_t MiB = (size_t)1 << 20;
constexpr size_t WS_CTL = 0, CTL_BYTES = 1 * MiB;
constexpr size_t WS_MODP = 1 * MiB, WS_MODS = 5 * MiB, WS_COS = 6 * MiB, WS_SIN = 7 * MiB, WS_LSL = 8 * MiB, WS_CARA = 9 * MiB, WS_CARH = 11 * MiB;
constexpr size_t WS_TOKE = 13 * MiB, WS_TOKW = WS_TOKE + 768 * 1024, WS_TOKP = WS_TOKW + 768 * 1024, WS_TOKS = WS_TOKP + 768 * 1024;
constexpr size_t WS_WIN = 16 * MiB, WS_WLRU = 39 * MiB, WS_WBR = 41 * MiB, WS_WOUT = 47 * MiB, WS_WGU = 49 * MiB, WS_WDN = 177 * MiB;
constexpr size_t WS_XS = 241 * MiB, WS_P = 377 * MiB, WS_B = 1142 * MiB, WS_C = 1430 * MiB, WS_D = 1702 * MiB, WS_E = 1770 * MiB, WS_END = 1906 * MiB;
constexpr size_t ROWB = (size_t)TT * D * 2;
static_assert(ROWB == 68 * MiB, "row buffer");
constexpr int CW_CNT = 1024, CW_NT = 1024 + 128, CW_TILE = 2048, CW_BAR = 8192;

__device__ __forceinline__ float bflo(unsigned w) { return __uint_as_float(w << 16); }
__device__ __forceinline__ float bfhi(unsigned w) { return __uint_as_float(w & 0xffff0000u); }
__device__ __forceinline__ unsigned f2bf(float f) { unsigned u = __float_as_uint(f); return (u + 0x7fffu + ((u >> 16) & 1u)) >> 16; }
__device__ __forceinline__ unsigned pk2(float lo, float hi) { return f2bf(lo) | (f2bf(hi) << 16); }
__device__ __forceinline__ float sigmoidf_(float x) { return __builtin_amdgcn_rcpf(1.0f + __expf(-x)); }
__device__ __forceinline__ float siluf_(float x) { return x * sigmoidf_(x); }
__device__ __forceinline__ float logsigmoidf_(float z) { return fminf(z, 0.f) - __logf(1.0f + __expf(-fabsf(z))); }
__device__ __forceinline__ float gelu_tanh_(float x) { const float u = 0.7978845608028654f * (x + 0.044715f * x * x * x); const float t = 1.0f - 2.0f * __builtin_amdgcn_rcpf(__expf(2.0f * u) + 1.0f); return 0.5f * x * (1.0f + t); }
__device__ __forceinline__ float wave_sum(float v) {
#pragma unroll
    for (int o = 1; o < 64; o <<= 1) v += __shfl_xor(v, o);
    return v;
}
#define LDS_WAIT() asm volatile("s_waitcnt lgkmcnt(0)" ::: "memory")

namespace pg8 {
#define PG8_LAS __attribute__((address_space(3)))
constexpr int BM = 256, BK = 64, HALF = 128, HTB = HALF * BK * 2, STAGE_BYTES = 8 * HTB, NXCD = 8, WGM = 8;
__host__ __device__ __forceinline__ int lds_byte(int r, int c) { const int st = (r >> 4) * 2 + (c >> 5), rr = r & 15, cc = c & 31, ob = rr * 64 + cc * 2; return st * 1024 + (ob ^ (((ob >> 9) & 1) << 5)); }
__host__ __device__ __forceinline__ void stage_rc(int b, int& R, int& C) { const int st = b / 1024, sb = b % 1024, swz = sb ^ (((sb >> 9) & 1) << 5); R = (st >> 1) * 16 + swz / 64; C = (st & 1) * 32 + (swz % 64) / 2; }
__host__ __device__ __forceinline__ int perm32(int rho) { const int n = rho >> 4, i = rho & 15; return 8 * (i >> 2) + 4 * n + (i & 3); }
struct Unit { int pm, pn, aux; const char* a; const char* b; };
struct Gemm { int lda, ldb, K; };
__device__ __forceinline__ void tile_of(int L, int nM, int nN, int& pm, int& pn) {
    const int nwg = nM * nN; int wgid = L; { const int q = nwg / NXCD, r = nwg % NXCD, xcd = wgid % NXCD, off = wgid / NXCD; wgid = (xcd < r ? xcd * (q + 1) : r * (q + 1) + (xcd - r) * q) + off; }
    const int nig = WGM * nN, gid = wgid / nig, fm = gid * WGM, gsz = (nM - fm) < WGM ? (nM - fm) : WGM;
    pm = fm + ((wgid % nig) % gsz); pn = (wgid % nig) / gsz;
}
__device__ __forceinline__ unsigned cvt_pk_bf16(float lo, float hi) { unsigned r; asm volatile("v_cvt_pk_bf16_f32 %0, %1, %2" : "=v"(r) : "v"(lo), "v"(hi)); return r; }
template <class Epi, class Sched, bool ALIGN_EPI = false, bool SP2 = false>
__device__ __forceinline__ void gemm_phase(PG8_LAS unsigned char* lds, const Gemm g, const Sched& S, const Epi& E) {
    int tid_o = threadIdx.x; asm volatile("" : "+v"(tid_o));
    const int tid = tid_o, wid = __builtin_amdgcn_readfirstlane(tid >> 6), lane = tid & 63, wr = wid >> 2, wc = wid & 3, fr = lane & 15, fq = lane >> 4;
    const int K = g.K, nt = K / BK;
    unsigned voffA[2], voffB[2];
#pragma unroll
    for (int i = 0; i < 2; ++i) { int R, C; stage_rc(tid * 16 + i * 8192, R, C); const int Rb = Epi::PERM ? ((R & ~31) + perm32(R & 31)) : R;
        voffA[i] = (unsigned)(R * g.lda + C) * 2u; voffB[i] = (unsigned)(Rb * g.ldb + C) * 2u; }
    const size_t kstep = (size_t)(BK * 2);
    const size_t hstepA = (size_t)HALF * g.lda * 2, hstepB = (size_t)HALF * g.ldb * 2;
    const unsigned ldsw = (unsigned)wid * 1024u;
    const int aoff = lds_byte(wr * 64 + fr, fq * 8), boff = lds_byte(wc * 32 + fr, fq * 8);
#define PG8_SA(b, h) (((b) * 2 + (h)) * HTB)
#define PG8_SB(b, h) ((4 + (b) * 2 + (h)) * HTB)
#define PG8_STAGE(bufoff, gbase, voff) do { _Pragma("unroll") for (int _i = 0; _i < 2; ++_i) \
        __builtin_amdgcn_global_load_lds((const unsigned*)((const char*)(gbase) + (voff)[_i]), (PG8_LAS unsigned*)(lds + (bufoff) + ldsw + _i * 8192), 16, 0, 0); } while (0)
#define PG8_LDA(dst, b, h) do { _Pragma("unroll") for (int m = 0; m < 4; ++m) _Pragma("unroll") for (int k = 0; k < 2; ++k) dst[m][k] = *(const PG8_LAS bf16x8*)(lds + PG8_SA(b, h) + aoff + m * 2048 + k * 1024); } while (0)
#define PG8_LDB(dst, b, h) do { _Pragma("unroll") for (int n = 0; n < 2; ++n) _Pragma("unroll") for (int k = 0; k < 2; ++k) dst[n][k] = *(const PG8_LAS bf16x8*)(lds + PG8_SB(b, h) + boff + n * 2048 + k * 1024); } while (0)
#define PG8_MMA(ai, bj, At, Bt) do { __builtin_amdgcn_s_setprio(1); _Pragma("unroll") for (int m = 0; m < 4; ++m) _Pragma("unroll") for (int n = 0; n < 2; ++n) _Pragma("unroll") for (int k = 0; k < 2; ++k) \
        acc[ai][bj][m][n] = __builtin_amdgcn_mfma_f32_16x16x32_bf16(Bt[n][k], At[m][k], acc[ai][bj][m][n], 0, 0, 0); __builtin_amdgcn_s_setprio(0); } while (0)
#define PG8_WAIT_V(n) asm volatile("s_waitcnt vmcnt(" #n ")" ::: "memory")
#define PG8_WAIT_L(n) asm volatile("s_waitcnt lgkmcnt(" #n ")" ::: "memory")
#define PG8_BAR __builtin_amdgcn_s_barrier()
#define PG8_SCHED __builtin_amdgcn_sched_barrier(0)
    Unit cur, nxt; int ui = 0;
    if (!S.next(0, cur)) return;
    f32x4 acc[2][2][4][2];
#pragma unroll
    for (int a = 0; a < 2; ++a)
#pragma unroll
        for (int b = 0; b < 2; ++b)
#pragma unroll
            for (int m = 0; m < 4; ++m)
#pragma unroll
                for (int n = 0; n < 2; ++n) acc[a][b][m][n] = (f32x4){0.f, 0.f, 0.f, 0.f};
    bf16x8 At[4][2], B0[2][2], B1[2][2];
    const char* cA = cur.a; const char* cB = cur.b;
    S.a_ready(cur);
    if constexpr (SP2) {
        PG8_STAGE(PG8_SB(0, 0), cB, voffB); PG8_STAGE(PG8_SB(0, 1), cB + hstepB, voffB); PG8_STAGE(PG8_SA(0, 0), cA, voffA); PG8_STAGE(PG8_SA(0, 1), cA + hstepA, voffA);
        if (wr == 1) PG8_BAR;
        PG8_WAIT_V(2); PG8_BAR;
        PG8_STAGE(PG8_SB(1, 0), cB + kstep, voffB); PG8_STAGE(PG8_SA(1, 0), cA + kstep, voffA); PG8_STAGE(PG8_SB(1, 1), cB + hstepB + kstep, voffB);
        PG8_WAIT_V(6); PG8_BAR;
    } else {
        PG8_STAGE(PG8_SB(0, 0), cB, voffB); PG8_STAGE(PG8_SA(0, 0), cA, voffA); PG8_STAGE(PG8_SB(0, 1), cB + hstepB, voffB); PG8_STAGE(PG8_SA(0, 1), cA + hstepA, voffA);
        if (wr == 1) PG8_BAR;
        PG8_WAIT_V(4); PG8_BAR;
        PG8_STAGE(PG8_SB(1, 0), cB + kstep, voffB); PG8_STAGE(PG8_SA(1, 0), cA + kstep, voffA); PG8_STAGE(PG8_SB(1, 1), cB + hstepB + kstep, voffB);
        PG8_WAIT_V(6); PG8_BAR;
    }
    for (;;) {
        const bool has_next = S.next(ui + 1, nxt);
        const char* nA = has_next ? nxt.a : cA; const char* nB = has_next ? nxt.b : cB;
        for (int t = 0; t < nt; t += 2) {
            const bool last = (t == nt - 2);
            const char* a1 = cA + (size_t)(t + 1) * kstep;
            const char* a2 = last ? nA : cA + (size_t)(t + 2) * kstep; const char* b2 = last ? nB : cB + (size_t)(t + 2) * kstep;
            const char* a3 = a2 + kstep; const char* b3 = b2 + kstep;
            if (last && has_next) S.a_ready(nxt);
            if constexpr (SP2) {
            PG8_LDB(B0, 0, 0); PG8_LDB(B1, 0, 1); PG8_SCHED; PG8_LDA(At, 0, 0); PG8_STAGE(PG8_SA(1, 1), a1 + hstepA, voffA);
            PG8_WAIT_V(8); PG8_WAIT_L(0); PG8_BAR; PG8_MMA(0, 0, At, B0); PG8_MMA(0, 1, At, B1); PG8_BAR; PG8_SCHED;
            PG8_LDA(At, 0, 1); PG8_STAGE(PG8_SB(0, 0), b2, voffB); PG8_STAGE(PG8_SB(0, 1), b2 + hstepB, voffB); PG8_STAGE(PG8_SA(0, 0), a2, voffA);
            PG8_WAIT_V(8); PG8_WAIT_L(0); PG8_BAR; PG8_MMA(1, 0, At, B0); PG8_MMA(1, 1, At, B1); PG8_BAR; PG8_SCHED;
            PG8_LDB(B0, 1, 0); PG8_LDB(B1, 1, 1); PG8_SCHED; PG8_LDA(At, 1, 0); PG8_STAGE(PG8_SA(0, 1), a2 + hstepA, voffA);
            PG8_WAIT_V(8); PG8_WAIT_L(0); PG8_BAR; PG8_MMA(0, 0, At, B0); PG8_MMA(0, 1, At, B1); PG8_BAR; PG8_SCHED;
            PG8_LDA(At, 1, 1); PG8_STAGE(PG8_SB(1, 0), b3, voffB); PG8_STAGE(PG8_SB(1, 1), b3 + hstepB, voffB); PG8_STAGE(PG8_SA(1, 0), a3, voffA);
            PG8_WAIT_V(8); PG8_WAIT_L(0); PG8_BAR; PG8_MMA(1, 0, At, B0); PG8_MMA(1, 1, At, B1); PG8_BAR; PG8_SCHED;
            } else {
            PG8_LDB(B0, 0, 0); PG8_SCHED; PG8_LDA(At, 0, 0); PG8_STAGE(PG8_SA(1, 1), a1 + hstepA, voffA);
            PG8_WAIT_L(8); PG8_BAR; PG8_WAIT_L(0); PG8_MMA(0, 0, At, B0); PG8_BAR; PG8_SCHED;
            PG8_LDB(B1, 0, 1); PG8_STAGE(PG8_SB(0, 0), b2, voffB);
            PG8_BAR; PG8_WAIT_L(0); PG8_MMA(0, 1, At, B1); PG8_BAR;
            PG8_LDA(At, 0, 1); PG8_STAGE(PG8_SA(0, 0), a2, voffA);
            PG8_BAR; PG8_WAIT_L(0); PG8_MMA(1, 0, At, B0); PG8_BAR; PG8_SCHED;
            PG8_STAGE(PG8_SB(0, 1), b2 + hstepB, voffB);
            PG8_WAIT_V(6); PG8_BAR; PG8_MMA(1, 1, At, B1); PG8_BAR;
            PG8_LDB(B0, 1, 0); PG8_SCHED; PG8_LDA(At, 1, 0); PG8_STAGE(PG8_SA(0, 1), a2 + hstepA, voffA);
            PG8_WAIT_L(8); PG8_BAR; PG8_WAIT_L(0); PG8_MMA(0, 0, At, B0); PG8_BAR; PG8_SCHED;
            PG8_LDB(B1, 1, 1); PG8_STAGE(PG8_SB(1, 0), b3, voffB);
            PG8_BAR; PG8_WAIT_L(0); PG8_MMA(0, 1, At, B1); PG8_BAR;
            PG8_LDA(At, 1, 1); PG8_STAGE(PG8_SA(1, 0), a3, voffA);
            PG8_BAR; PG8_WAIT_L(0); PG8_MMA(1, 0, At, B0); PG8_BAR; PG8_SCHED;
            PG8_STAGE(PG8_SB(1, 1), b3 + hstepB, voffB);
            PG8_WAIT_V(6); PG8_BAR; PG8_MMA(1, 1, At, B1); PG8_BAR;
            }
        }
        if constexpr (ALIGN_EPI) { if (wr == 0) PG8_BAR; }
        if constexpr (!Epi::AFTER_DRAIN) { E(acc, cur, wr, wc, fr, fq); S.done(cur); }
        if (!has_next) break;
#pragma unroll
        for (int a = 0; a < 2; ++a)
#pragma unroll
            for (int b = 0; b < 2; ++b)
#pragma unroll
                for (int m = 0; m < 4; ++m)
#pragma unroll
                    for (int n = 0; n < 2; ++n) acc[a][b][m][n] = (f32x4){0.f, 0.f, 0.f, 0.f};
        cur = nxt; cA = nA; cB = nB; ++ui;
        if constexpr (ALIGN_EPI) { if (wr == 1) PG8_BAR; }
    }
    PG8_WAIT_V(0);
    if constexpr (!ALIGN_EPI) { if (wr == 0) PG8_BAR; }
    PG8_BAR;
    if constexpr (Epi::AFTER_DRAIN) { E.fused(acc, cur, wr, wc, fr, fq, lds, wid, lane); S.done(cur); }
#undef PG8_SA
#undef PG8_SB
#undef PG8_STAGE
#undef PG8_LDA
#undef PG8_LDB
#undef PG8_MMA
#undef PG8_WAIT_V
#undef PG8_WAIT_L
#undef PG8_BAR
#undef PG8_SCHED
}
}

#define GAS __attribute__((address_space(1)))
typedef GAS unsigned gu32;
#define RLX_AGENT __ATOMIC_RELAXED, __HIP_MEMORY_SCOPE_AGENT
#define XB_TMO      128
#define XB_XCNT(j)  (256  + 64 * (j))
#define XB_XSUB(j)  (1280 + 64 * (j))
#define XB_XGEN(j)  (2304 + 64 * (j))
#define XB_TOP      3328
#define XB_TOPGEN   3392
#define XCD_BAR_WORDS 3456
#define XB_SPIN_CAP (1u << 18)

__device__ __forceinline__ unsigned xb_ld(unsigned* p)              { return __hip_atomic_load(p, __ATOMIC_RELAXED, __HIP_MEMORY_SCOPE_AGENT); }
__device__ __forceinline__ unsigned xb_add(unsigned* p, unsigned v) { return __hip_atomic_fetch_add(p, v, __ATOMIC_RELAXED, __HIP_MEMORY_SCOPE_AGENT); }
__device__ __forceinline__ unsigned xb_xcc_id() { return (unsigned)__builtin_amdgcn_s_getreg((3 << 11) | 20) & 0xFu; }
#define XB_SPIN(cond, bar) do { unsigned _sp = 0; while (cond) { __builtin_amdgcn_s_sleep(1); \
    if ((++_sp & 255u) == 0u) { if (xb_ld(&(bar)[XB_TMO])) break; if (_sp > XB_SPIN_CAP) { atomicAdd(&(bar)[XB_TMO], 1u); break; } } } } while (0)

struct XcdBarrier {
    unsigned* bar; unsigned x;
    volatile LAS unsigned* st;
};

__device__ __forceinline__ XcdBarrier xcd_barrier_post(unsigned* bar, volatile LAS unsigned* st) {
    XcdBarrier b; b.bar = bar; b.x = xb_xcc_id(); b.st = st;
    if (threadIdx.x == 0) (void)xb_add(&bar[XB_XCNT(b.x)], 1u);
    return b;
}
__device__ __forceinline__ void xcd_barrier_complete(unsigned* bar, unsigned x, unsigned& nloc, unsigned& nx) {
    const unsigned G = gridDim.x * gridDim.y * gridDim.z;
    unsigned sum, cnt, mine, sp = 0u;
    for (;;) {
        sum = 0u; cnt = 0u; mine = 0u;
#pragma unroll
        for (unsigned j = 0; j < 16; ++j) { const unsigned c = xb_ld(&bar[XB_XCNT(j)]); sum += c; cnt += (c > 0u) ? 1u : 0u; mine = (j == x) ? c : mine; }
        if (sum == G) break;
        __builtin_amdgcn_s_sleep(1);
        if ((++sp & 255u) == 0u) { if (xb_ld(&bar[XB_TMO])) break; if (sp > XB_SPIN_CAP) { atomicAdd(&bar[XB_TMO], 1u); break; } }
    }
    nloc = mine > 0u ? mine : 1u; nx = cnt > 0u ? cnt : 1u;
}

__device__ __forceinline__ void xcd_barrier(const XcdBarrier& b) {
    asm volatile("s_waitcnt vmcnt(0)" ::: "memory");
    __syncthreads();
    if (threadIdx.x == 0) {
        unsigned* bar = b.bar;
        __builtin_amdgcn_s_waitcnt(0);
        unsigned nloc = b.st[0], nx = b.st[1];
        if (nloc == 0u) { xcd_barrier_complete(bar, b.x, nloc, nx); b.st[0] = nloc; b.st[1] = nx; }
        const unsigned old = xb_add(&bar[XB_XSUB(b.x)], 1u);
        const unsigned gen = old / nloc;
        if (old + 1u == (gen + 1u) * nloc) {
            __builtin_amdgcn_fence(__ATOMIC_RELEASE, "agent");
            asm volatile("s_waitcnt vmcnt(0)" ::: "memory");
            const unsigned og = xb_add(&bar[XB_TOP], 1u);
            const unsigned tg = og / nx;
            if (og + 1u == (tg + 1u) * nx) xb_add(&bar[XB_TOPGEN], 1u);
            else XB_SPIN(xb_ld(&bar[XB_TOPGEN]) == tg, bar);
            __builtin_amdgcn_fence(__ATOMIC_ACQUIRE, "agent");
            xb_add(&bar[XB_XGEN(b.x)], 1u);
            asm volatile("s_waitcnt vmcnt(0)" ::: "memory");
        } else {
            XB_SPIN(xb_ld(&bar[XB_XGEN(b.x)]) == gen, bar);
            __builtin_amdgcn_fence(__ATOMIC_ACQUIRE, "agent");
            asm volatile("s_waitcnt vmcnt(0)" ::: "memory");
        }
    }
    __syncthreads();
}

struct OrderBase {
    __device__ __forceinline__ void a_ready(const pg8::Unit&) const {}
    __device__ __forceinline__ void done(const pg8::Unit&) const {}
};
struct PlainOrder : OrderBase {
    const char* A; const char* B; size_t astep, bstep; int nM, nN, G, c;
    __device__ __forceinline__ bool next(int i, pg8::Unit& u) const {
        const long L = (long)i * G + c; if (L >= (long)nM * nN) return false;
        pg8::tile_of((int)L, nM, nN, u.pm, u.pn); u.aux = 0; u.a = A + (size_t)u.pm * astep; u.b = B + (size_t)u.pn * bstep; return true; }
};
struct LruOrder : OrderBase {
    const char* A; const char* B; int nM, G, c;
    __device__ __forceinline__ bool next(int i, pg8::Unit& u) const {
        const long L = (long)i * G + c; if (L >= (long)nM * 16) return false;
        pg8::tile_of((int)L, nM, 16, u.pm, u.pn); u.aux = 0; u.a = A + (size_t)u.pm * (256 * 1024 * 2) + (size_t)(u.pn >> 2) * 512; u.b = B + (size_t)u.pn * (256 * 256 * 2); return true; }
};
struct BranchOrder : OrderBase {
    const char* A; const char* B; int nM, G, c;
    __device__ __forceinline__ bool next(int i, pg8::Unit& u) const {
        const int j = i / 3, br = i - 3 * j; const long L = (long)j * G + c; if (L >= (long)nM * 4) return false;
        pg8::tile_of((int)L, nM, 4, u.pm, u.pn); u.aux = br; u.a = A + (size_t)br * ROWB + (size_t)u.pm * (256 * 1024 * 2); u.b = B + (size_t)br * (1024 * 1024 * 2) + (size_t)u.pn * (256 * 1024 * 2); return true; }
};
struct MoeOrder : OrderBase {
    const char* A; const char* B; const unsigned* tile_e; size_t estep; int nM, nN, G, c;
    __device__ __forceinline__ bool next(int i, pg8::Unit& u) const {
        const long L = (long)i * G + c; if (L >= (long)nM * nN) return false;
        pg8::tile_of((int)L, nM, nN, u.pm, u.pn); const int e = (int)tile_e[u.pm]; u.aux = e;
        u.a = A + (size_t)u.pm * (256 * 1024 * 2); u.b = B + (size_t)e * estep + (size_t)u.pn * (256 * 1024 * 2); return true; }
};

struct EpiBf16Bias {
    static constexpr bool PERM = true, AFTER_DRAIN = false;
    bf16_t* O; int ldc; const float* bias; int bstride;
    __device__ __forceinline__ void operator()(const f32x4 (&acc)[2][2][4][2], const pg8::Unit& u, int wr, int wc, int fr, int fq) const {
        const int row0 = u.pm * 256 + wr * 64 + fr, col0 = u.pn * 256 + wc * 32 + 8 * fq;
        f32x4 bv[2][2];
#pragma unroll
        for (int bj = 0; bj < 2; ++bj)
#pragma unroll
            for (int n = 0; n < 2; ++n) bv[bj][n] = bias ? *(const f32x4*)(bias + (size_t)u.aux * bstride + col0 + bj * 128 + 4 * n) : (f32x4){0.f, 0.f, 0.f, 0.f};
#pragma unroll
        for (int ai = 0; ai < 2; ++ai)
#pragma unroll
            for (int m = 0; m < 4; ++m) { bf16_t* rowp = O + (size_t)(row0 + ai * 128 + m * 16) * ldc + col0;
#pragma unroll
                for (int bj = 0; bj < 2; ++bj) { const f32x4 v0 = acc[ai][bj][m][0] + bv[bj][0], v1 = acc[ai][bj][m][1] + bv[bj][1];
                    u32x4 w; w.x = pg8::cvt_pk_bf16(v0[0], v0[1]); w.y = pg8::cvt_pk_bf16(v0[2], v0[3]); w.z = pg8::cvt_pk_bf16(v1[0], v1[1]); w.w = pg8::cvt_pk_bf16(v1[2], v1[3]);
                    *(u32x4*)(rowp + bj * 128) = w; } }
    }
};
struct EpiLru {
    static constexpr bool PERM = true, AFTER_DRAIN = false;
    const bf16_t* xc; bf16_t* LA; bf16_t* BB; const float* ba; const float* bi; const float* lsl;
    __device__ __forceinline__ void operator()(const f32x4 (&acc)[2][2][4][2], const pg8::Unit& u, int wr, int wc, int fr, int fq) const {
        const int g = u.pn >> 2, d = (u.pn >> 1) & 1, hh = u.pn & 1;
        const int row0 = u.pm * 256 + wr * 64 + fr, ch0 = 256 * g + 128 * hh + wc * 32 + 8 * fq;
#pragma unroll
        for (int ai = 0; ai < 2; ++ai)
#pragma unroll
            for (int m = 0; m < 4; ++m) { const size_t off = (size_t)(row0 + ai * 128 + m * 16) * 1024 + ch0;
                const u32x4 xw = *(const u32x4*)(xc + off); float la[8], bb[8];
#pragma unroll
                for (int n = 0; n < 2; ++n) { const f32x4 pb = *(const f32x4*)(ba + d * 1024 + ch0 + 4 * n), pi = *(const f32x4*)(bi + d * 1024 + ch0 + 4 * n), pl = *(const f32x4*)(lsl + d * 1024 + ch0 + 4 * n);
#pragma unroll
                    for (int e = 0; e < 4; ++e) { const int idx = 4 * n + e; const unsigned w = xw[idx >> 1]; const float xv = (idx & 1) ? bfhi(w) : bflo(w);
                        const float r = sigmoidf_(acc[ai][0][m][n][e] + pb[e]), ig = sigmoidf_(acc[ai][1][m][n][e] + pi[e]);
                        const float l = 8.0f * r * pl[e]; la[idx] = l; bb[idx] = sqrtf(fmaxf(1.0f - __expf(2.0f * l), 0.f)) * ig * xv; } }
                u32x4 w1, w2; w1.x = pg8::cvt_pk_bf16(la[0], la[1]); w1.y = pg8::cvt_pk_bf16(la[2], la[3]); w1.z = pg8::cvt_pk_bf16(la[4], la[5]); w1.w = pg8::cvt_pk_bf16(la[6], la[7]);
                w2.x = pg8::cvt_pk_bf16(bb[0], bb[1]); w2.y = pg8::cvt_pk_bf16(bb[2], bb[3]); w2.z = pg8::cvt_pk_bf16(bb[4], bb[5]); w2.w = pg8::cvt_pk_bf16(bb[6], bb[7]);
                *(u32x4*)(LA + (size_t)d * TT * 1024 + off) = w1; *(u32x4*)(BB + (size_t)d * TT * 1024 + off) = w2; asm volatile("" ::: "memory"); }
    }
};
struct EpiBranch {
    static constexpr bool PERM = true, AFTER_DRAIN = false;
    const bf16_t* P; float* MF; bf16_t* MG;
    __device__ __forceinline__ void operator()(const f32x4 (&acc)[2][2][4][2], const pg8::Unit& u, int wr, int wc, int fr, int fq) const {
        const int br = u.aux, row0 = u.pm * 256 + wr * 64 + fr, col0 = u.pn * 256 + wc * 32 + 8 * fq;
#pragma unroll
        for (int ai = 0; ai < 2; ++ai)
#pragma unroll
            for (int m = 0; m < 4; ++m) { const size_t row = (size_t)(row0 + ai * 128 + m * 16);
#pragma unroll
                for (int bj = 0; bj < 2; ++bj) { const int c = col0 + bj * 128;
                    const u32x4 gw = *(const u32x4*)(P + row * LDP + C_MG + br * 1024 + c);
                    f32x4 v0, v1;
                    v0[0] = sigmoidf_(bflo(gw.x)) * acc[ai][bj][m][0][0]; v0[1] = sigmoidf_(bfhi(gw.x)) * acc[ai][bj][m][0][1]; v0[2] = sigmoidf_(bflo(gw.y)) * acc[ai][bj][m][0][2]; v0[3] = sigmoidf_(bfhi(gw.y)) * acc[ai][bj][m][0][3];
                    v1[0] = sigmoidf_(bflo(gw.z)) * acc[ai][bj][m][1][0]; v1[1] = sigmoidf_(bfhi(gw.z)) * acc[ai][bj][m][1][1]; v1[2] = sigmoidf_(bflo(gw.w)) * acc[ai][bj][m][1][2]; v1[3] = sigmoidf_(bfhi(gw.w)) * acc[ai][bj][m][1][3];
                    float* mf = MF + row * 1024 + c;
                    if (br != 0) { v0 += *(const f32x4*)mf; v1 += *(const f32x4*)(mf + 4); }
                    if (br != 2) { *(f32x4*)mf = v0; *(f32x4*)(mf + 4) = v1; }
                    else { u32x4 w; w.x = pg8::cvt_pk_bf16(v0[0], v0[1]); w.y = pg8::cvt_pk_bf16(v0[2], v0[3]); w.z = pg8::cvt_pk_bf16(v1[0], v1[1]); w.w = pg8::cvt_pk_bf16(v1[2], v1[3]);
                        *(u32x4*)(MG + row * 1024 + c) = w; } } }
    }
};
struct EpiOut {
    static constexpr bool PERM = false, AFTER_DRAIN = false;
    const float* baseLat; const float* baseCtx; float* xs; const float* gate;
    __device__ __forceinline__ void operator()(const f32x4 (&acc)[2][2][4][2], const pg8::Unit& u, int wr, int wc, int fr, int fq) const {
        const int mrow = u.pm < 128 ? (u.pm >> 4) : 8; const float* gp = gate + mrow * 6144;
        const int row0 = u.pm * 256 + wr * 64 + fr, col0 = u.pn * 256 + wc * 32 + 4 * fq;
        const float* base = u.pm < 128 ? baseLat + (size_t)row0 * 1024 : baseCtx + (size_t)(row0 - TLAT) * 1024;
        f32x4 gv[2][2];
#pragma unroll
        for (int bj = 0; bj < 2; ++bj)
#pragma unroll
            for (int n = 0; n < 2; ++n) gv[bj][n] = *(const f32x4*)(gp + col0 + bj * 128 + n * 16);
#pragma unroll
        for (int ai = 0; ai < 2; ++ai)
#pragma unroll
            for (int m = 0; m < 4; ++m) { const size_t ro = (size_t)(ai * 128 + m * 16) * 1024 + col0; float* op = xs + (size_t)row0 * 1024 + ro;
#pragma unroll
                for (int bj = 0; bj < 2; ++bj)
#pragma unroll
                    for (int n = 0; n < 2; ++n) *(f32x4*)(op + bj * 128 + n * 16) = *(const f32x4*)(base + ro + bj * 128 + n * 16) + gv[bj][n] * acc[ai][bj][m][n]; }
    }
};
struct EpiSwiglu {
    static constexpr bool PERM = true, AFTER_DRAIN = false;
    bf16_t* H; const float* bgu;
    __device__ __forceinline__ void operator()(const f32x4 (&acc)[2][2][4][2], const pg8::Unit& u, int wr, int wc, int fr, int fq) const {
        const int row0 = u.pm * 256 + wr * 64 + fr, f0 = u.pn * 128 + wc * 32 + 8 * fq;
        float bg[8], bu[8];
#pragma unroll
        for (int q = 0; q < 4; ++q) { const f32x4 b = *(const f32x4*)(bgu + (size_t)u.aux * 2048 + 2 * f0 + 4 * q); bg[2 * q] = b[0]; bu[2 * q] = b[1]; bg[2 * q + 1] = b[2]; bu[2 * q + 1] = b[3]; }
#pragma unroll
        for (int ai = 0; ai < 2; ++ai)
#pragma unroll
            for (int m = 0; m < 4; ++m) { float a[8];
#pragma unroll
                for (int n = 0; n < 2; ++n)
#pragma unroll
                    for (int e = 0; e < 4; ++e) { const int idx = 4 * n + e; const float gt = fminf(acc[ai][0][m][n][e] + bg[idx], 7.0f), up = fminf(fmaxf(acc[ai][1][m][n][e] + bu[idx], -7.0f), 7.0f);
                        a[idx] = gt * sigmoidf_(1.702f * gt) * (up + 1.0f); }
                u32x4 w; w.x = pg8::cvt_pk_bf16(a[0], a[1]); w.y = pg8::cvt_pk_bf16(a[2], a[3]); w.z = pg8::cvt_pk_bf16(a[4], a[5]); w.w = pg8::cvt_pk_bf16(a[6], a[7]);
                *(u32x4*)(H + (size_t)(row0 + ai * 128 + m * 16) * 1024 + f0) = w; }
    }
};

constexpr int NWAVES = 8, NTHR = 512;
constexpr int LDS_BYTES = 147456, MISC_OFF = 131072 + 320;
struct Frame {
    LAS unsigned char* lds; unsigned char* ws; const float* const* in; float* out;
    int tid, bx, lane, wave, G, gw, NGW, gtid, NGT;
};
__device__ __forceinline__ int mrow_of(int row) { return row < TLAT ? (row >> 12) : 8; }
__device__ __forceinline__ int seqrow(int d, int b, int p) {
    if (p < CTXL) return TLAT + b * CTXL + (d ? CTXL - 1 - p : p);
    const int q = p - CTXL; return b * SEQ + (d ? SEQ - 1 - q : q);
}
struct RowV { f32x4 v[4]; };
__device__ __forceinline__ RowV load_row(const float* p, int lane) { RowV r;
#pragma unroll
    for (int j = 0; j < 4; ++j) r.v[j] = *(const f32x4*)(p + 4 * lane + 256 * j);
    return r; }
__device__ __forceinline__ float row_sumsq(const RowV& r) { float s = 0.f;
#pragma unroll
    for (int j = 0; j < 4; ++j) s += (r.v[j][0] * r.v[j][0] + r.v[j][1] * r.v[j][1]) + (r.v[j][2] * r.v[j][2] + r.v[j][3] * r.v[j][3]);
    return wave_sum(s); }
__device__ __forceinline__ RowV norm_mod(const RowV& x, const float* gain, const float* shift, const float* scale, int lane) {
    const float rs = rsqrtf(row_sumsq(x) * (1.0f / D) + EPS); RowV y;
#pragma unroll
    for (int j = 0; j < 4; ++j) { const int c = 4 * lane + 256 * j; const f32x4 g = *(const f32x4*)(gain + c), sh = *(const f32x4*)(shift + c), sc = *(const f32x4*)(scale + c);
        y.v[j] = (x.v[j] * rs) * g * (sc + 1.0f) + sh; }
    return y; }
__device__ __forceinline__ void store_row_bf16(bf16_t* p, const RowV& y, int lane) {
#pragma unroll
    for (int j = 0; j < 4; ++j) { u32x2 w; w.x = pk2(y.v[j][0], y.v[j][1]); w.y = pk2(y.v[j][2], y.v[j][3]); *(u32x2*)(p + 4 * lane + 256 * j) = w; } }
__device__ __forceinline__ f32x4 ld4bf(const bf16_t* p) { const u32x2 w = *(const u32x2*)p; return (f32x4){bflo(w.x), bfhi(w.x), bflo(w.y), bfhi(w.y)}; }

__device__ __forceinline__ void phase_proA(const Frame& F) {
    const float* c = F.in[1]; const float* cc = F.in[3]; const float* w_ada = F.in[4];
    float* modp = (float*)(F.ws + WS_MODP);
    for (int it = F.gw; it < 2 * 8 * 96; it += F.NGW) {
        const int cg = it % 96, ks = (it / 96) % 8, l = it / 768, col = cg * 64 + F.lane;
        float acc[9];
#pragma unroll
        for (int r = 0; r < 9; ++r) acc[r] = 0.f;
        for (int k = ks * 128; k < ks * 128 + 128; ++k) {
            const float w = w_ada[((size_t)l * 1024 + k) * 6144 + col];
#pragma unroll
            for (int r = 0; r < 8; ++r) acc[r] += siluf_(c[r * 1024 + k]) * w;
            acc[8] += siluf_(cc[k]) * w;
        }
#pragma unroll
        for (int r = 0; r < 9; ++r) modp[((size_t)(ks * 2 + l) * 9 + r) * 6144 + col] = acc[r];
    }
    float* rc = (float*)(F.ws + WS_COS); float* rsn = (float*)(F.ws + WS_SIN);
    for (int i = F.gtid; i < SEQ * 64; i += F.NGT) {
        const int t = i >> 6, j = i & 63, f = j & 31; const float pos = (float)((j < 32) ? (t >> 6) : (t & 63));
        const float inv = exp2f(-(float)f * (13.287712379549449f / 32.0f)); const float ang = pos * inv;
        const float nn = rintf(ang * 0.15915494309189535f); float r = fmaf(-nn, 6.28125f, ang); r = fmaf(-nn, 1.9353071795864769e-3f, r);
        rc[i] = __cosf(r); rsn[i] = __sinf(r);
    }
}
__device__ __forceinline__ void phase_proB(const Frame& F) {
    const float* modp = (const float*)(F.ws + WS_MODP); float* mods = (float*)(F.ws + WS_MODS); const float* b_ada = F.in[5];
    for (int i = F.gtid; i < 2 * 9 * 6144; i += F.NGT) { const int l = i / (9 * 6144), col = i % 6144; float s = b_ada[l * 6144 + col];
#pragma unroll
        for (int ks = 0; ks < 8; ++ks) s += modp[(size_t)ks * (2 * 9 * 6144) + i];
        mods[i] = s; }
}

template <class RM> __device__ __forceinline__ void tr_item(const float* W, int ldw, int k0, int n0, bf16_t* WT, int ldt, LAS float* scr, int lane, const RM& rm) {
#pragma unroll 8
    for (int i = 0; i < 32; ++i) { const int kk = 2 * i + (lane >> 5); scr[kk * 33 + (lane & 31)] = W[(size_t)(k0 + kk) * ldw + n0 + (lane & 31)]; }
    LDS_WAIT(); asm volatile("" ::: "memory");
    const int c = lane & 7;
#pragma unroll
    for (int j = 0; j < 4; ++j) { const int n = (lane >> 3) + 8 * j; const LAS float* s = scr + (8 * c) * 33 + n; int drow; float sc; rm(n0 + n, drow, sc);
        u32x4 o; o.x = pk2(s[0 * 33] * sc, s[1 * 33] * sc); o.y = pk2(s[2 * 33] * sc, s[3 * 33] * sc); o.z = pk2(s[4 * 33] * sc, s[5 * 33] * sc); o.w = pk2(s[6 * 33] * sc, s[7 * 33] * sc);
        *(u32x4*)(WT + (size_t)drow * ldt + k0 + 8 * c) = o; }
    LDS_WAIT(); asm volatile("" ::: "memory");
}
struct RmIn { __device__ __forceinline__ void operator()(int n, int& drow, float& sc) const {
    drow = n < 3072 ? n : (n < 3104 ? C_LR + (n - 3072) : n - 32); sc = (n < 512 || (n >= 5664 && n < 6176)) ? 0.08838834764831845f : 1.0f; } };
struct RmId { __device__ __forceinline__ void operator()(int n, int& drow, float& sc) const { drow = n; sc = 1.0f; } };
struct RmLru { int base; __device__ __forceinline__ void operator()(int n, int& drow, float& sc) const { drow = base + (n & 127); sc = 1.0f; } };
struct RmGu { __device__ __forceinline__ void operator()(int n, int& drow, float& sc) const { const int f = n >> 1, u = n & 1; drow = 256 * (f >> 7) + 128 * u + (f & 127); sc = 1.0f; } };
__device__ __forceinline__ void phase_W(const Frame& F, int li) {
    LAS float* scr = (LAS float*)(F.lds + F.wave * 8704);
    bf16_t* Win_t = (bf16_t*)(F.ws + WS_WIN); bf16_t* Wlru_t = (bf16_t*)(F.ws + WS_WLRU); bf16_t* Wbr_t = (bf16_t*)(F.ws + WS_WBR);
    bf16_t* Wout_t = (bf16_t*)(F.ws + WS_WOUT); bf16_t* Wgu_t = (bf16_t*)(F.ws + WS_WGU); bf16_t* Wdn_t = (bf16_t*)(F.ws + WS_WDN);
    constexpr int I_IN = 16 * 353, I_LRU = 512, I_BR = 1536, I_OUT = 512, I_GU = 32768, I_DN = 16384, NITEMS = I_IN + I_LRU + I_BR + I_OUT + I_GU + I_DN;
    for (int it0 = F.gw; it0 < NITEMS; it0 += F.NGW) {
        int it = it0;
        if (it < I_IN) { const int kb = it / 353, nb = it % 353; tr_item(F.in[8] + (size_t)li * 1024 * IN_TOTAL, IN_TOTAL, 64 * kb, 32 * nb, Win_t, 1024, scr, F.lane, RmIn{}); continue; } it -= I_IN;
        if (it < I_LRU) { const int mat = it >> 5, r = it & 31, kb = r >> 3, nb = r & 7, ty = mat >> 3, d = (mat >> 2) & 1, g = mat & 3, n0 = 32 * nb, pn = g * 4 + d * 2 + (n0 >> 7);
            const float* src = (ty ? F.in[16] : F.in[14]) + (size_t)((li * 2 + d) * 4 + g) * 65536;
            tr_item(src, 256, 64 * kb, n0, Wlru_t, 256, scr, F.lane, RmLru{pn * 256 + ty * 128}); continue; } it -= I_LRU;
        if (it < I_BR) { const int br = it >> 9, r = it & 511, kb = r >> 5, nb = r & 31; tr_item(F.in[20] + (size_t)(li * 3 + br) * 1048576, 1024, 64 * kb, 32 * nb, Wbr_t + (size_t)br * 1048576, 1024, scr, F.lane, RmId{}); continue; } it -= I_BR;
        if (it < I_OUT) { const int kb = it >> 5, nb = it & 31; tr_item(F.in[21] + (size_t)li * 1048576, 1024, 64 * kb, 32 * nb, Wout_t, 1024, scr, F.lane, RmId{}); continue; } it -= I_OUT;
        if (it < I_GU) { const int e = it >> 10, r = it & 1023, kb = r >> 6, nb = r & 63; tr_item(F.in[24] + (size_t)(li * 32 + e) * 2097152, 2048, 64 * kb, 32 * nb, Wgu_t + (size_t)e * 2097152, 1024, scr, F.lane, RmGu{}); continue; } it -= I_GU;
        { const int e = it >> 9, r = it & 511, kb = r >> 5, nb = r & 31; tr_item(F.in[26] + (size_t)(li * 32 + e) * 1048576, 1024, 64 * kb, 32 * nb, Wdn_t + (size_t)e * 1048576, 1024, scr, F.lane, RmId{}); }
    }
    for (int i = F.gtid; i < (LDP - IN_TOTAL) * 1024 / 8; i += F.NGT) *(u32x4*)(Win_t + (size_t)IN_TOTAL * 1024 + (size_t)i * 8) = (u32x4){0u, 0u, 0u, 0u};
    float* lsl = (float*)(F.ws + WS_LSL);
    for (int i = F.gtid; i < 2048; i += F.NGT) lsl[i] = logsigmoidf_(F.in[18][li * 2048 + i]);
}
__device__ __forceinline__ void phase_norm_in(const Frame& F) {
    const float* mods = (const float*)(F.ws + WS_MODS); bf16_t* xn = (bf16_t*)(F.ws + WS_D);
    for (int row = F.gw; row < TT; row += F.NGW) {
        const float* src = row < TLAT ? F.in[0] + (size_t)row * D : F.in[2] + (size_t)(row - TLAT) * D;
        const float* mp = mods + mrow_of(row) * 6144;
        const RowV y = norm_mod(load_row(src, F.lane), F.in[6], mp, mp + 1024, F.lane);
        store_row_bf16(xn + (size_t)row * D, y, F.lane);
    }
}

__device__ __forceinline__ void phase_conv(const Frame& F, int li) {
    const bf16_t* P = (const bf16_t*)(F.ws + WS_P); bf16_t* xc = (bf16_t*)(F.ws + WS_D);
    const float* cw = F.in[12] + (size_t)li * 4 * 1024; const float* cb = F.in[13] + (size_t)li * 1024;
    for (int i = F.gtid; i < TT * 128; i += F.NGT) {
        const int row = i >> 7, ch = (i & 127) * 8;
        int t, L; if (row < TLAT) { t = row & (SEQ - 1); L = SEQ; } else { t = (row - TLAT) & (CTXL - 1); L = CTXL; }
        float a[8];
        { const f32x4 b0 = *(const f32x4*)(cb + ch), b1 = *(const f32x4*)(cb + ch + 4); a[0] = b0[0]; a[1] = b0[1]; a[2] = b0[2]; a[3] = b0[3]; a[4] = b1[0]; a[5] = b1[1]; a[6] = b1[2]; a[7] = b1[3]; }
#pragma unroll
        for (int j = 0; j < 4; ++j) { const int tt = t - 2 + j; if (tt < 0 || tt >= L) continue;
            const u32x4 xw = *(const u32x4*)(P + (size_t)(row - 2 + j) * LDP + C_LX + ch);
            const f32x4 w0 = *(const f32x4*)(cw + j * 1024 + ch), w1 = *(const f32x4*)(cw + j * 1024 + ch + 4);
            a[0] += w0[0] * bflo(xw.x); a[1] += w0[1] * bfhi(xw.x); a[2] += w0[2] * bflo(xw.y); a[3] += w0[3] * bfhi(xw.y);
            a[4] += w1[0] * bflo(xw.z); a[5] += w1[1] * bfhi(xw.z); a[6] += w1[2] * bflo(xw.w); a[7] += w1[3] * bfhi(xw.w); }
        u32x4 o; o.x = pk2(a[0], a[1]); o.y = pk2(a[2], a[3]); o.z = pk2(a[4], a[5]); o.w = pk2(a[6], a[7]);
        *(u32x4*)(xc + (size_t)row * 1024 + ch) = o;
    }
}
__device__ __forceinline__ int seg_row(int d, int b, int s, int p) {
    const int base = (s == 0) ? TLAT + b * CTXL : b * SEQ + 256 * (d ? 16 - s : s - 1);
    return base + (d ? 255 - p : p);
}
template <bool FINAL> __device__ __forceinline__ void phase_lru_scan(const Frame& F) {
    const bf16_t* LA = (const bf16_t*)(F.ws + WS_C); const bf16_t* BB = (const bf16_t*)(F.ws + WS_C + 2 * ROWB);
    float* carA = (float*)(F.ws + WS_CARA); float* carH = (float*)(F.ws + WS_CARH); bf16_t* HO = (bf16_t*)(F.ws + WS_E);
    for (int i = F.gtid; i < 2 * 8 * 17 * 256; i += F.NGT) {
        const int cq = i & 255, s = (i >> 8) % 17, db = (i >> 8) / 17, b = db & 7, d = db >> 3;
        f32x4 h = (f32x4){0.f, 0.f, 0.f, 0.f}, As = (f32x4){0.f, 0.f, 0.f, 0.f};
        if (FINAL) { for (int s2 = 0; s2 < s; ++s2) { const size_t o = ((size_t)(db * 17 + s2) * 256 + cq) * 4; h = *(const f32x4*)(carA + o) * h + *(const f32x4*)(carH + o); } }
        const size_t dofs = (size_t)d * TT * 1024;
#pragma unroll 8
        for (int p = 0; p < 256; ++p) { const size_t off = (size_t)seg_row(d, b, s, p) * 1024 + cq * 4;
            const f32x4 la = ld4bf(LA + dofs + off), bb = ld4bf(BB + dofs + off);
            f32x4 a; a[0] = __expf(la[0]); a[1] = __expf(la[1]); a[2] = __expf(la[2]); a[3] = __expf(la[3]);
            h = a * h + bb;
            if (FINAL) { u32x2 w; w.x = pk2(h[0], h[1]); w.y = pk2(h[2], h[3]); *(u32x2*)(HO + dofs + off) = w; } else As += la; }
        if (!FINAL) { const size_t o = (size_t)i * 4; f32x4 A; A[0] = __expf(As[0]); A[1] = __expf(As[1]); A[2] = __expf(As[2]); A[3] = __expf(As[3]);
            *(f32x4*)(carA + o) = A; *(f32x4*)(carH + o) = h; }
    }
}

template <bool STRICT> __device__ __forceinline__ void scan_steps(LAS float* sq, LAS float* sk, LAS float* sd, LAS float* sv, LAS float* so, float (&S)[8][4], int wave, int lane) {
    const int rg = lane >> 2, cg = lane & 3, cb = 16 * wave + 4 * cg;
    for (int p = 0; p < 32; ++p) {
        float q[8], k[8], dc[8];
#pragma unroll
        for (int h2 = 0; h2 < 2; ++h2) { const f32x4 a = *(const LAS f32x4*)(sq + p * 128 + rg * 8 + 4 * h2), b = *(const LAS f32x4*)(sk + p * 128 + rg * 8 + 4 * h2), c = *(const LAS f32x4*)(sd + p * 128 + rg * 8 + 4 * h2);
#pragma unroll
            for (int e = 0; e < 4; ++e) { q[4 * h2 + e] = a[e]; k[4 * h2 + e] = b[e]; dc[4 * h2 + e] = c[e]; } }
        const f32x4 v = *(const LAS f32x4*)(sv + p * 128 + cb);
        float o[4] = {0.f, 0.f, 0.f, 0.f};
#pragma unroll
        for (int i = 0; i < 8; ++i)
#pragma unroll
            for (int j = 0; j < 4; ++j) { const float s1 = dc[i] * S[i][j], s2 = s1 + k[i] * v[j]; o[j] += q[i] * (STRICT ? s1 : s2); S[i][j] = s2; }
#pragma unroll
        for (int j = 0; j < 4; ++j) { float x = o[j]; x += __shfl_xor(x, 4); x += __shfl_xor(x, 8); x += __shfl_xor(x, 16); x += __shfl_xor(x, 32); o[j] = x; }
        if (rg == 0) *(LAS f32x4*)(so + p * 128 + cb) = (f32x4){o[0], o[1], o[2], o[3]};
    }
}
__device__ __forceinline__ void phase_scan_ref(const Frame& F, int li) {
    LAS float* sq = (LAS float*)F.lds; LAS float* sk = sq + 4096; LAS float* sd = sk + 4096; LAS float* sv = sd + 4096; LAS float* so = sv + 4096;
    const bf16_t* P = (const bf16_t*)(F.ws + WS_P); bf16_t* OB = (bf16_t*)(F.ws + WS_B);
    const float* rcos = (const float*)(F.ws + WS_COS); const float* rsin = (const float*)(F.ws + WS_SIN);
    const int tt = F.tid >> 4, part = F.tid & 15;
    for (int u = F.bx; u < 256; u += F.G) {
        const int js = u & 1, h = (u >> 1) & 3, b = (u >> 3) & 7, d = (u >> 6) & 1, mx = u >> 7;
        const int CQ = (mx ? C_RQ : C_GQ) + 128 * h, CK = (mx ? C_RK : C_GK) + 128 * h, CV = (mx ? C_RV : C_GV) + 256 * h + 128 * js;
        bf16_t* O = OB + (size_t)(mx * 2 + d) * TT * 1024;
        const float* wa2 = F.in[9] + (size_t)((li * 2 + d) * 16) * 512 + 128 * h; const float* gba = F.in[10] + (size_t)(li * 2 + d) * 512 + 128 * h;
        const float gamma = 1.0f - exp2f(-5.0f - (float)h);
        float S[8][4];
#pragma unroll
        for (int i = 0; i < 8; ++i)
#pragma unroll
            for (int j = 0; j < 4; ++j) S[i][j] = 0.f;
        for (int p0 = 0; p0 < CTXL + SEQ; p0 += 32) {
            const int row = seqrow(d, b, p0 + tt); const bf16_t* pr = P + (size_t)row * LDP;
            {
                const u32x4 qw = *(const u32x4*)(pr + CQ + 8 * part), kw = *(const u32x4*)(pr + CK + 8 * part), vw = *(const u32x4*)(pr + CV + 8 * part);
                float q[8] = {bflo(qw.x), bfhi(qw.x), bflo(qw.y), bfhi(qw.y), bflo(qw.z), bfhi(qw.z), bflo(qw.w), bfhi(qw.w)};
                float k[8] = {bflo(kw.x), bfhi(kw.x), bflo(kw.y), bfhi(kw.y), bflo(kw.z), bfhi(kw.z), bflo(kw.w), bfhi(kw.w)};
                float dc[8];
                if (mx == 0) {
                    const u32x4 l0 = *(const u32x4*)(pr + C_LR + 16 * d), l1 = *(const u32x4*)(pr + C_LR + 16 * d + 8);
                    const float lr[16] = {bflo(l0.x), bfhi(l0.x), bflo(l0.y), bfhi(l0.y), bflo(l0.z), bfhi(l0.z), bflo(l0.w), bfhi(l0.w), bflo(l1.x), bfhi(l1.x), bflo(l1.y), bfhi(l1.y), bflo(l1.z), bfhi(l1.z), bflo(l1.w), bfhi(l1.w)};
                    float z[8];
#pragma unroll
                    for (int e = 0; e < 8; ++e) z[e] = gba[8 * part + e];
#pragma unroll
                    for (int r = 0; r < 16; ++r) { const f32x4 w0 = *(const f32x4*)(wa2 + r * 512 + 8 * part), w1 = *(const f32x4*)(wa2 + r * 512 + 8 * part + 4);
#pragma unroll
                        for (int e = 0; e < 4; ++e) { z[e] += lr[r] * w0[e]; z[4 + e] += lr[r] * w1[e]; } }
#pragma unroll
                    for (int e = 0; e < 8; ++e) dc[e] = __expf(logsigmoidf_(z[e]) * 0.0625f);
                } else {
#pragma unroll
                    for (int e = 0; e < 8; ++e) dc[e] = gamma;
                    if (row < TLAT) {
                        const int t = row & (SEQ - 1), i0 = 8 * (part & 7);
                        const u32x4 qo = *(const u32x4*)(pr + CQ + 8 * (part ^ 8)), ko = *(const u32x4*)(pr + CK + 8 * (part ^ 8));
                        const float q2[8] = {bflo(qo.x), bfhi(qo.x), bflo(qo.y), bfhi(qo.y), bflo(qo.z), bfhi(qo.z), bflo(qo.w), bfhi(qo.w)};
                        const float k2[8] = {bflo(ko.x), bfhi(ko.x), bflo(ko.y), bfhi(ko.y), bflo(ko.z), bfhi(ko.z), bflo(ko.w), bfhi(ko.w)};
#pragma unroll
                        for (int e = 0; e < 8; ++e) { const float cs = rcos[t * 64 + i0 + e], sn = rsin[t * 64 + i0 + e];
                            if (part < 8) { q[e] = q[e] * cs - q2[e] * sn; k[e] = k[e] * cs - k2[e] * sn; }
                            else { q[e] = q2[e] * sn + q[e] * cs; k[e] = k2[e] * sn + k[e] * cs; } }
                    }
                }
                LAS float* dq = sq + tt * 128 + 8 * part; LAS float* dk = sk + tt * 128 + 8 * part; LAS float* dd = sd + tt * 128 + 8 * part; LAS float* dv = sv + tt * 128 + 8 * part;
                *(LAS f32x4*)dq = (f32x4){q[0], q[1], q[2], q[3]}; *(LAS f32x4*)(dq + 4) = (f32x4){q[4], q[5], q[6], q[7]};
                *(LAS f32x4*)dk = (f32x4){k[0], k[1], k[2], k[3]}; *(LAS f32x4*)(dk + 4) = (f32x4){k[4], k[5], k[6], k[7]};
                *(LAS f32x4*)dd = (f32x4){dc[0], dc[1], dc[2], dc[3]}; *(LAS f32x4*)(dd + 4) = (f32x4){dc[4], dc[5], dc[6], dc[7]};
                *(LAS f32x4*)dv = (f32x4){bflo(vw.x), bfhi(vw.x), bflo(vw.y), bfhi(vw.y)}; *(LAS f32x4*)(dv + 4) = (f32x4){bflo(vw.z), bfhi(vw.z), bflo(vw.w), bfhi(vw.w)};
            }
            __syncthreads();
            if (d) scan_steps<true>(sq, sk, sd, sv, so, S, F.wave, F.lane); else scan_steps<false>(sq, sk, sd, sv, so, S, F.wave, F.lane);
            __syncthreads();
            { const f32x4 o0 = *(const LAS f32x4*)(so + tt * 128 + 8 * part), o1 = *(const LAS f32x4*)(so + tt * 128 + 8 * part + 4);
              u32x4 w; w.x = pk2(o0[0], o0[1]); w.y = pk2(o0[2], o0[3]); w.z = pk2(o1[0], o1[1]); w.w = pk2(o1[2], o1[3]);
              *(u32x4*)(O + (size_t)row * 1024 + 256 * h + 128 * js + 8 * part) = w; }
        }
        __syncthreads();
    }
}

__device__ __forceinline__ void phase_finish(const Frame& F, int li, int nrows) {
    const bf16_t* P = (const bf16_t*)(F.ws + WS_P); const bf16_t* OB = (const bf16_t*)(F.ws + WS_B); const bf16_t* HB = (const bf16_t*)(F.ws + WS_E); bf16_t* A3 = (bf16_t*)(F.ws + WS_C);
    const float* gnorm = F.in[11] + (size_t)li * 1024; const float* rnorm = F.in[19] + (size_t)li * 1024;
    const size_t RS = (size_t)TT * 1024;
    for (int row = F.gw; row < nrows; row += F.NGW) {
        const bf16_t* pr = P + (size_t)row * LDP; const size_t ro = (size_t)row * 1024;
#pragma unroll
        for (int j = 0; j < 4; ++j) {
            const int c = 4 * F.lane + 256 * j;
            {
                const f32x4 o = ld4bf(OB + ro + c) + ld4bf(OB + RS + ro + c);
                const float ss = wave_sum((o[0] * o[0] + o[1] * o[1]) + (o[2] * o[2] + o[3] * o[3])); const float rs = rsqrtf(ss * (1.0f / 256.0f) + EPS);
                const f32x4 g = ld4bf(pr + C_GG + c), gn = *(const f32x4*)(gnorm + c); u32x2 w;
                w.x = pk2(o[0] * rs * gn[0] * siluf_(g[0]), o[1] * rs * gn[1] * siluf_(g[1])); w.y = pk2(o[2] * rs * gn[2] * siluf_(g[2]), o[3] * rs * gn[3] * siluf_(g[3]));
                *(u32x2*)(A3 + ro + c) = w; }
            {
                const f32x4 hh = ld4bf(HB + ro + c) + ld4bf(HB + RS + ro + c), g = ld4bf(pr + C_LG + c); u32x2 w;
                w.x = pk2(hh[0] * gelu_tanh_(g[0]), hh[1] * gelu_tanh_(g[1])); w.y = pk2(hh[2] * gelu_tanh_(g[2]), hh[3] * gelu_tanh_(g[3]));
                *(u32x2*)(A3 + RS + ro + c) = w; }
            {
                f32x4 o = ld4bf(OB + 2 * RS + ro + c) + ld4bf(OB + 3 * RS + ro + c);
                const float mean = wave_sum((o[0] + o[1]) + (o[2] + o[3])) * (1.0f / 256.0f); o = o - mean;
                const float ss = wave_sum((o[0] * o[0] + o[1] * o[1]) + (o[2] * o[2] + o[3] * o[3])); const float rs = rsqrtf(ss * (1.0f / 256.0f) + EPS);
                const f32x4 g = ld4bf(pr + C_RG + c), gn = *(const f32x4*)(rnorm + c); u32x2 w;
                w.x = pk2(o[0] * rs * gn[0] * siluf_(g[0]), o[1] * rs * gn[1] * siluf_(g[1])); w.y = pk2(o[2] * rs * gn[2] * siluf_(g[2]), o[3] * rs * gn[3] * siluf_(g[3]));
                *(u32x2*)(A3 + 2 * RS + ro + c) = w; }
        }
    }
}

__device__ __forceinline__ void phase_norm2_router(const Frame& F, int li, int ntok) {
    LAS float* wrT = (LAS float*)F.lds;
    LAS unsigned* hist = (LAS unsigned*)(F.lds + 131072); LAS unsigned* hbase = hist + 32;
    const float* wr = F.in[22] + (size_t)li * 1024 * 32; const float* br = F.in[23] + li * 32;
    for (int i = F.tid; i < 32768; i += NTHR) wrT[(i & 31) * 1024 + (i >> 5)] = wr[i];
    if (F.tid < 32) hist[F.tid] = 0u;
    __syncthreads();
    const float* xs = (const float*)(F.ws + WS_XS); const float* mods = (const float*)(F.ws + WS_MODS) + (size_t)li * 9 * 6144;
    bf16_t* xn2 = (bf16_t*)(F.ws + WS_D); int* tok_e = (int*)(F.ws + WS_TOKE); float* tok_w = (float*)(F.ws + WS_TOKW); int* tok_p = (int*)(F.ws + WS_TOKP);
    unsigned* cnt = (unsigned*)(F.ws + WS_CTL) + CW_CNT + li * 32;
    for (int row = F.gw; row < ntok; row += F.NGW) {
        const float* mp = mods + mrow_of(row) * 6144;
        const RowV y = norm_mod(load_row(xs + (size_t)row * D, F.lane), F.in[7] + (size_t)li * 1024, mp + 3 * 1024, mp + 4 * 1024, F.lane);
        store_row_bf16(xn2 + (size_t)row * D, y, F.lane);
        float lg[32];
#pragma unroll
        for (int e = 0; e < 32; ++e) { float s = 0.f;
#pragma unroll
            for (int j = 0; j < 4; ++j) { const f32x4 w = *(const LAS f32x4*)(wrT + e * 1024 + 4 * F.lane + 256 * j); s += (y.v[j][0] * w[0] + y.v[j][1] * w[1]) + (y.v[j][2] * w[2] + y.v[j][3] * w[3]); }
            lg[e] = wave_sum(s) + br[e]; }
        unsigned taken = 0u; float tl[4]; int te[4];
#pragma unroll
        for (int k = 0; k < 4; ++k) { float best = -3.0e38f; int bi = 0;
#pragma unroll
            for (int e = 0; e < 32; ++e) { const bool ok = !((taken >> e) & 1u) && lg[e] > best; best = ok ? lg[e] : best; bi = ok ? e : bi; }
            taken |= 1u << bi; tl[k] = best; te[k] = bi; }
        const float e1 = __expf(tl[1] - tl[0]), e2 = __expf(tl[2] - tl[0]), e3 = __expf(tl[3] - tl[0]); const float inv = 1.0f / (1.0f + e1 + e2 + e3);
        if (F.lane < 4) { const int k = F.lane; const int ek = k == 0 ? te[0] : k == 1 ? te[1] : k == 2 ? te[2] : te[3]; const float wk = (k == 0 ? 1.0f : k == 1 ? e1 : k == 2 ? e2 : e3) * inv;
            const unsigned lp = atomicAdd((unsigned*)&hist[ek], 1u);
            tok_e[row * 4 + k] = ek; tok_w[row * 4 + k] = wk; tok_p[row * 4 + k] = (int)lp; }
    }
    __syncthreads();
    if (F.tid < 32) hbase[F.tid] = __hip_atomic_fetch_add(cnt + F.tid, hist[F.tid], __ATOMIC_RELAXED, __HIP_MEMORY_SCOPE_AGENT);
    __syncthreads();
    for (int row = F.gw; row < ntok; row += F.NGW) if (F.lane < 4) { const int i = row * 4 + F.lane; tok_p[i] += (int)hbase[tok_e[i]]; }
    __syncthreads();
}
__device__ __forceinline__ void phase_dispatch(const Frame& F, int li, int ntok) {
    LAS unsigned* pstart = (LAS unsigned*)F.lds;
    unsigned* ctl = (unsigned*)(F.ws + WS_CTL); unsigned* cnt = ctl + CW_CNT + li * 32; unsigned* tile_e = ctl + CW_TILE + li * 1024;
    if (F.tid == 0) { unsigned ps = 0;
        for (int e = 0; e < 32; ++e) { const unsigned c = __hip_atomic_load(cnt + e, __ATOMIC_RELAXED, __HIP_MEMORY_SCOPE_AGENT), nt = (c + 255u) >> 8; pstart[e] = ps;
            if (F.bx == 0) for (unsigned j = 0; j < nt; ++j) tile_e[(ps >> 8) + j] = (unsigned)e;
            ps += nt << 8; }
        if (F.bx == 0) ctl[CW_NT + li] = ps >> 8; }
    __syncthreads();
    const bf16_t* xn2 = (const bf16_t*)(F.ws + WS_D); bf16_t* xg = (bf16_t*)(F.ws + WS_P);
    const int* tok_e = (const int*)(F.ws + WS_TOKE); const int* tok_p = (const int*)(F.ws + WS_TOKP); int* tok_s = (int*)(F.ws + WS_TOKS);
    for (int it = F.gw; it < ntok * 4; it += F.NGW) {
        const int tok = it >> 2; const int slot = (int)pstart[tok_e[it]] + tok_p[it];
        if (F.lane == 0) tok_s[it] = slot;
        const u32x4* s = (const u32x4*)(xn2 + (size_t)tok * 1024); u32x4* dst = (u32x4*)(xg + (size_t)slot * 1024);
        dst[F.lane] = s[F.lane]; dst[64 + F.lane] = s[64 + F.lane];
    }
    __syncthreads();
}
__device__ __forceinline__ void phase_combine(const Frame& F, int li, int ntok, bool last) {
    float* xs = (float*)(F.ws + WS_XS); const bf16_t* Y = (const bf16_t*)(F.ws + WS_B); bf16_t* xn = (bf16_t*)(F.ws + WS_D);
    const float* mods = (const float*)(F.ws + WS_MODS); const float* tok_w = (const float*)(F.ws + WS_TOKW); const int* tok_s = (const int*)(F.ws + WS_TOKS);
    for (int row = F.gw; row < ntok; row += F.NGW) {
        const int mr = mrow_of(row); const float* gp = mods + ((size_t)li * 9 + mr) * 6144 + 5 * 1024;
        RowV x = load_row(xs + (size_t)row * D, F.lane);
        const int s0 = tok_s[row * 4], s1 = tok_s[row * 4 + 1], s2 = tok_s[row * 4 + 2], s3 = tok_s[row * 4 + 3];
        const float w0 = tok_w[row * 4], w1 = tok_w[row * 4 + 1], w2 = tok_w[row * 4 + 2], w3 = tok_w[row * 4 + 3];
#pragma unroll
        for (int j = 0; j < 4; ++j) { const int c = 4 * F.lane + 256 * j;
            const f32x4 y = ld4bf(Y + (size_t)s0 * 1024 + c) * w0 + ld4bf(Y + (size_t)s1 * 1024 + c) * w1 + ld4bf(Y + (size_t)s2 * 1024 + c) * w2 + ld4bf(Y + (size_t)s3 * 1024 + c) * w3;
            x.v[j] = x.v[j] + *(const f32x4*)(gp + c) * y; }
        if (!last) {
#pragma unroll
            for (int j = 0; j < 4; ++j) *(f32x4*)(xs + (size_t)row * D + 4 * F.lane + 256 * j) = x.v[j];
            const float* mp = mods + ((size_t)(li + 1) * 9 + mr) * 6144;
            const RowV y = norm_mod(x, F.in[6] + (size_t)(li + 1) * 1024, mp, mp + 1024, F.lane);
            store_row_bf16(xn + (size_t)row * D, y, F.lane);
        } else {
            const float rs = rsqrtf(row_sumsq(x) * (1.0f / D) + EPS);
#pragma unroll
            for (int j = 0; j < 4; ++j) { const int c = 4 * F.lane + 256 * j; *(f32x4*)(F.out + (size_t)row * D + c) = (x.v[j] * rs) * *(const f32x4*)(F.in[28] + c); }
        }
    }
}

#ifndef MK_ONE_LAUNCH
#define MK_ONE_LAUNCH 0
#endif
constexpr int NPH_LAYER = 15, NPHASES = 2 + 2 * NPH_LAYER;
struct Args { const float* in[29]; float* out; unsigned char* ws; int ph_lo, ph_hi, region, pad; };
#ifndef MK_PHMASK
#define MK_PHMASK 0x7fff
#endif
#define IN(k) (lo <= (k) && (k) < hi)
#define EN(j) ((MK_PHMASK >> (j)) & 1)
#define SEAM(k) do { if (IN(k) && IN((k) + 1)) xcd_barrier(bar); } while (0)
#define MKF() Frame F; { unsigned char* ws_ = args.ws; asm volatile("" : "+s"(ws_)); F.ws = ws_; F.lds = (LAS unsigned char*)lds_raw; F.out = args.out; F.in = args.in; \
        int tid_ = threadIdx.x, bx_ = blockIdx.x; asm volatile("" : "+v"(tid_), "+s"(bx_)); F.tid = tid_; F.bx = bx_; F.lane = F.tid & 63; F.wave = __builtin_amdgcn_readfirstlane(F.tid >> 6); F.G = gridDim.x; \
        F.gw = F.bx * NWAVES + F.wave; F.NGW = F.G * NWAVES; F.gtid = F.bx * NTHR + F.tid; F.NGT = F.G * NTHR; }
template <int li> __device__ __forceinline__ void run_layer(const Args& args, unsigned char* lds_raw, const XcdBarrier& bar, const int lo, const int hi) {
        const int pb = 2 + NPH_LAYER * li; const bool last = (li == 1); const int nrows = last ? TLAT : TT, nMt = nrows / 256;
        if (EN(0) && IN(pb + 0)) { MKF(); phase_W(F, li); if (li == 0) phase_norm_in(F); __syncthreads(); }
        SEAM(pb + 0);
        if (EN(1) && IN(pb + 1)) { MKF(); unsigned* ctl = (unsigned*)(F.ws + WS_CTL); (void)ctl;
            pg8::Gemm g{1024, 1024, 1024}; PlainOrder S; S.A = (const char*)(F.ws + WS_D); S.B = (const char*)(F.ws + WS_WIN); S.astep = 256 * 1024 * 2; S.bstep = 256 * 1024 * 2; S.nM = TT / 256; S.nN = LDP / 256; S.G = F.G; S.c = F.bx;
            EpiBf16Bias E{(bf16_t*)(F.ws + WS_P), LDP, nullptr, 0};
            pg8::gemm_phase<EpiBf16Bias, PlainOrder, true, true>(F.lds, g, S, E);
        }
        SEAM(pb + 1);
        if (EN(2) && IN(pb + 2)) { MKF(); phase_conv(F, li); }
        SEAM(pb + 2);
        if (EN(3) && IN(pb + 3)) { MKF(); unsigned* ctl = (unsigned*)(F.ws + WS_CTL); (void)ctl;
            pg8::Gemm g{1024, 256, 256}; LruOrder S; S.A = (const char*)(F.ws + WS_D); S.B = (const char*)(F.ws + WS_WLRU); S.nM = TT / 256; S.G = F.G; S.c = F.bx;
            EpiLru E{(const bf16_t*)(F.ws + WS_D), (bf16_t*)(F.ws + WS_C), (bf16_t*)(F.ws + WS_C + 2 * ROWB), F.in[15] + (size_t)li * 2048, F.in[17] + (size_t)li * 2048, (const float*)(F.ws + WS_LSL)};
            pg8::gemm_phase<EpiLru, LruOrder, true, true>(F.lds, g, S, E);
        }
        SEAM(pb + 3);
        if (EN(4) && IN(pb + 4)) { MKF(); phase_lru_scan<false>(F); }
        SEAM(pb + 4);
        if (EN(5) && IN(pb + 5)) { MKF(); phase_lru_scan<true>(F); }
        SEAM(pb + 5);
        if (EN(6) && IN(pb + 6)) { MKF(); phase_scan_ref(F, li); }
        SEAM(pb + 6);
        if (EN(7) && IN(pb + 7)) { MKF(); phase_finish(F, li, nrows); }
        SEAM(pb + 7);
        if (EN(8) && IN(pb + 8)) { MKF(); unsigned* ctl = (unsigned*)(F.ws + WS_CTL); (void)ctl;
            pg8::Gemm g{1024, 1024, 1024}; BranchOrder S; S.A = (const char*)(F.ws + WS_C); S.B = (const char*)(F.ws + WS_WBR); S.nM = nMt; S.G = F.G; S.c = F.bx;
            EpiBranch E{(const bf16_t*)(F.ws + WS_P), (float*)(F.ws + WS_B), (bf16_t*)(F.ws + WS_B + 2 * ROWB)};
            pg8::gemm_phase<EpiBranch, BranchOrder, true, true>(F.lds, g, S, E);
        }
        SEAM(pb + 8);
        if (EN(9) && IN(pb + 9)) { MKF(); unsigned* ctl = (unsigned*)(F.ws + WS_CTL); (void)ctl;
            pg8::Gemm g{1024, 1024, 1024}; PlainOrder S; S.A = (const char*)(F.ws + WS_B + 2 * ROWB); S.B = (const char*)(F.ws + WS_WOUT); S.astep = 256 * 1024 * 2; S.bstep = 256 * 1024 * 2; S.nM = nMt; S.nN = 4; S.G = F.G; S.c = F.bx;
            float* xs = (float*)(F.ws + WS_XS);
            EpiOut E{li == 0 ? F.in[0] : xs, li == 0 ? F.in[2] : xs + (size_t)TLAT * D, xs, (const float*)(F.ws + WS_MODS) + (size_t)li * 9 * 6144 + 2 * 1024};
            pg8::gemm_phase<EpiOut, PlainOrder, true, true>(F.lds, g, S, E);
        }
        SEAM(pb + 9);
        if (EN(10) && IN(pb + 10)) { MKF(); phase_norm2_router(F, li, nrows); }
        SEAM(pb + 10);
        if (EN(11) && IN(pb + 11)) { MKF(); phase_dispatch(F, li, nrows); }
        SEAM(pb + 11);
        if (EN(12) && IN(pb + 12)) { MKF(); unsigned* ctl = (unsigned*)(F.ws + WS_CTL); (void)ctl;
            pg8::Gemm g{1024, 1024, 1024}; MoeOrder S; S.A = (const char*)(F.ws + WS_P); S.B = (const char*)(F.ws + WS_WGU); S.tile_e = ctl + CW_TILE + li * 1024; S.estep = (size_t)2048 * 1024 * 2;
            S.nM = (int)ctl[CW_NT + li]; S.nN = 8; S.G = F.G; S.c = F.bx;
            EpiSwiglu E{(bf16_t*)(F.ws + WS_P + 288 * MiB), F.in[25] + (size_t)li * 32 * 2048};
            pg8::gemm_phase<EpiSwiglu, MoeOrder, true, true>(F.lds, g, S, E);
        }
        SEAM(pb + 12);
        if (EN(13) && IN(pb + 13)) { MKF(); unsigned* ctl = (unsigned*)(F.ws + WS_CTL); (void)ctl;
            pg8::Gemm g{1024, 1024, 1024}; MoeOrder S; S.A = (const char*)(F.ws + WS_P + 288 * MiB); S.B = (const char*)(F.ws + WS_WDN); S.tile_e = ctl + CW_TILE + li * 1024; S.estep = (size_t)1024 * 1024 * 2;
            S.nM = (int)ctl[CW_NT + li]; S.nN = 4; S.G = F.G; S.c = F.bx;
            EpiBf16Bias E{(bf16_t*)(F.ws + WS_B), 1024, F.in[27] + (size_t)li * 32 * 1024, 1024};
            pg8::gemm_phase<EpiBf16Bias, MoeOrder, true, true>(F.lds, g, S, E);
        }
        SEAM(pb + 13);
        if (EN(14) && IN(pb + 14)) { MKF(); phase_combine(F, li, nrows, last); }
        SEAM(pb + 14);
    }
__global__ void __launch_bounds__(NTHR, 2) mk_fwd(Args args) {
    extern __shared__ __attribute__((aligned(16))) unsigned char lds_raw[];
    const int tid0 = threadIdx.x;
    volatile LAS unsigned* MISC = (volatile LAS unsigned*)((LAS unsigned char*)lds_raw + MISC_OFF);
    if (tid0 < 32) MISC[tid0] = 0u;
    __syncthreads();
    unsigned* ctl0 = (unsigned*)(args.ws + WS_CTL);
    const int lo = args.ph_lo, hi = args.ph_hi;
    XcdBarrier bar; bar.bar = ctl0 + CW_BAR + args.region * 4096; bar.x = 0; bar.st = MISC + 8;
    if (hi - lo > 1) bar = xcd_barrier_post(ctl0 + CW_BAR + args.region * 4096, MISC + 8);

    if (IN(0)) { MKF(); phase_proA(F); }
    SEAM(0);
    if (IN(1)) { MKF(); phase_proB(F); }
    SEAM(1);
    run_layer<0>(args, lds_raw, bar, lo, hi);
    run_layer<1>(args, lds_raw, bar, lo, hi);
}

extern "C" void kernel_launch(void* const* d_in, const int* in_sizes, int n_in, void* d_out, int out_size, void* d_ws, size_t ws_size, hipStream_t stream) {
    static int grid = 0;
    if (grid == 0) {
        if (n_in != 29 || ws_size < WS_END || out_size != TLAT * D) { fprintf(stderr, "kernel_launch: unexpected problem: n_in %d ws %zu out %d\n", n_in, ws_size, out_size); grid = -1; return; }
        int dev = 0, cus = 0;
        if (hipGetDevice(&dev) != hipSuccess || hipDeviceGetAttribute(&cus, hipDeviceAttributeMultiprocessorCount, dev) != hipSuccess) { grid = -1; return; }
        if (hipFuncSetAttribute((const void*)mk_fwd, hipFuncAttributeMaxDynamicSharedMemorySize, LDS_BYTES) != hipSuccess) { fprintf(stderr, "kernel_launch: hipFuncSetAttribute failed\n"); grid = -1; return; }
        int per_cu = 0;
        if (hipOccupancyMaxActiveBlocksPerMultiprocessor(&per_cu, (const void*)mk_fwd, NTHR, LDS_BYTES) != hipSuccess || per_cu < 1) fprintf(stderr, "kernel_launch: occupancy query reports %d\n", per_cu);
        (void)hipGetLastError();
        grid = cus;
    }
    if (grid < 0) return;
    (void)hipMemsetAsync((char*)d_ws + WS_CTL, 0, CTL_BYTES, stream);
    Args a{};
    for (int i = 0; i < 29; ++i) a.in[i] = (const float*)d_in[i];
    a.out = (float*)d_out; a.ws = (unsigned char*)d_ws;
#if MK_ONE_LAUNCH
    a.ph_lo = 0; a.ph_hi = NPHASES; a.region = 0;
    hipLaunchKernelGGL(mk_fwd, dim3(grid), dim3(NTHR), LDS_BYTES, stream, a);
#else
    for (int p = 0; p < NPHASES; ++p) { a.ph_lo = p; a.ph_hi = p + 1; a.region = 0; hipLaunchKernelGGL(mk_fwd, dim3(grid), dim3(NTHR), LDS_BYTES, stream, a); }
#endif
}
```

```cpp
#include <hip/hip_runtime.h>
#include <cstdio>
#include <cstdint>

#define LAS __attribute__((address_space(3)))
typedef unsigned short bf16_t;
typedef short bf16x8 __attribute__((ext_vector_type(8)));
typedef float f32x4 __attribute__((ext_vector_type(4)));
typedef float f32x2 __attribute__((ext_vector_type(2)));
typedef unsigned u32x4 __attribute__((ext_vector_type(4)));
typedef unsigned u32x2 __attribute__((ext_vector_type(2)));

constexpr int D = 1024, NBATCH = 8, SEQ = 4096, CTXL = 256;
constexpr int TLAT = NBATCH * SEQ, TCTX = NBATCH * CTXL, TT = TLAT + TCTX;
constexpr int LDP = 11520;
constexpr int C_GQ = 0, C_GK = 512, C_GV = 1024, C_GG = 2048, C_LX = 3072, C_LG = 4096, C_RQ = 5120, C_RK = 5632, C_RV = 6144, C_RG = 7168, C_MG = 8192, C_LR = 11264;
constexpr int IN_TOTAL = 11296, NE = 32;
constexpr int SLOT_TILES_MAX = 576;
constexpr float EPS = 1e-6f;

constexpr size_t MiB = (size_t)1 << 20;
constexpr size_t WS_CTL = 0, CTL_BYTES = 1 * MiB;
constexpr size_t WS_MODP = 1 * MiB, WS_MODS = 5 * MiB, WS_COS = 6 * MiB, WS_SIN = 7 * MiB, WS_LSL = 8 * MiB, WS_CARA = 9 * MiB, WS_CARH = 11 * MiB;
constexpr size_t WS_TOKE = 13 * MiB, WS_TOKW = WS_TOKE + 768 * 1024, WS_TOKP = WS_TOKW + 768 * 1024, WS_TOKS = WS_TOKP + 768 * 1024;
constexpr size_t WS_WIN = 16 * MiB, WS_WLRU = 39 * MiB, WS_WBR = 41 * MiB, WS_WOUT = 47 * MiB, WS_WGU = 49 * MiB, WS_WDN = 177 * MiB;
constexpr size_t WS_XS = 241 * MiB, WS_P = 377 * MiB, WS_B = 1142 * MiB, WS_C = 1430 * MiB, WS_D = 1702 * MiB, WS_E = 1770 * MiB, WS_END = 1906 * MiB;
constexpr size_t ROWB = (size_t)TT * D * 2;
static_assert(ROWB == 68 * MiB, "row buffer");
constexpr int CW_CNT = 1024, CW_NT = 1024 + 128, CW_TILE = 2048, CW_BAR = 8192;

__device__ __forceinline__ float bflo(unsigned w) { return __uint_as_float(w << 16); }
__device__ __forceinline__ float bfhi(unsigned w) { return __uint_as_float(w & 0xffff0000u); }
__device__ __forceinline__ unsigned f2bf(float f) { unsigned u = __float_as_uint(f); return (u + 0x7fffu + ((u >> 16) & 1u)) >> 16; }
__device__ __forceinline__ unsigned pk2(float lo, float hi) { return f2bf(lo) | (f2bf(hi) << 16); }
__device__ __forceinline__ float sigmoidf_(float x) { return __builtin_amdgcn_rcpf(1.0f + __expf(-x)); }
__device__ __forceinline__ float siluf_(float x) { return x * sigmoidf_(x); }
__device__ __forceinline__ float logsigmoidf_(float z) { return fminf(z, 0.f) - __logf(1.0f + __expf(-fabsf(z))); }
__device__ __forceinline__ float gelu_tanh_(float x) { const float u = 0.7978845608028654f * (x + 0.044715f * x * x * x); const float t = 1.0f - 2.0f * __builtin_amdgcn_rcpf(__expf(2.0f * u) + 1.0f); return 0.5f * x * (1.0f + t); }
__device__ __forceinline__ float wave_sum(float v) {
#pragma unroll
    for (int o = 1; o < 64; o <<= 1) v += __shfl_xor(v, o);
    return v;
}
#define LDS_WAIT() asm volatile("s_waitcnt lgkmcnt(0)" ::: "memory")

namespace pg8 {
#define PG8_LAS __attribute__((address_space(3)))
constexpr int BM = 256, BK = 64, HALF = 128, HTB = HALF * BK * 2, STAGE_BYTES = 8 * HTB, NXCD = 8, WGM = 8;
__host__ __device__ __forceinline__ int lds_byte(int r, int c) { const int st = (r >> 4) * 2 + (c >> 5), rr = r & 15, cc = c & 31, ob = rr * 64 + cc * 2; return st * 1024 + (ob ^ (((ob >> 9) & 1) << 5)); }
__host__ __device__ __forceinline__ void stage_rc(int b, int& R, int& C) { const int st = b / 1024, sb = b % 1024, swz = sb ^ (((sb >> 9) & 1) << 5); R = (st >> 1) * 16 + swz / 64; C = (st & 1) * 32 + (swz % 64) / 2; }
__host__ __device__ __forceinline__ int perm32(int rho) { const int n = rho >> 4, i = rho & 15; return 8 * (i >> 2) + 4 * n + (i & 3); }
struct Unit { int pm, pn, aux; const char* a; const char* b; };
struct Gemm { int lda, ldb, K; };
__device__ __forceinline__ void tile_of(int L, int nM, int nN, int& pm, int& pn) {
    const int nwg = nM * nN; int wgid = L; { const int q = nwg / NXCD, r = nwg % NXCD, xcd = wgid % NXCD, off = wgid / NXCD; wgid = (xcd < r ? xcd * (q + 1) : r * (q + 1) + (xcd - r) * q) + off; }
    const int nig = WGM * nN, gid = wgid / nig, fm = gid * WGM, gsz = (nM - fm) < WGM ? (nM - fm) : WGM;
    pm = fm + ((wgid % nig) % gsz); pn = (wgid % nig) / gsz;
}
__device__ __forceinline__ unsigned cvt_pk_bf16(float lo, float hi) { unsigned r; asm volatile("v_cvt_pk_bf16_f32 %0, %1, %2" : "=v"(r) : "v"(lo), "v"(hi)); return r; }
template <class Epi, class Sched, bool ALIGN_EPI = false, bool SP2 = false>
__device__ __forceinline__ void gemm_phase(PG8_LAS unsigned char* lds, const Gemm g, const Sched& S, const Epi& E) {
    int tid_o = threadIdx.x; asm volatile("" : "+v"(tid_o));
    const int tid = tid_o, wid = __builtin_amdgcn_readfirstlane(tid >> 6), lane = tid & 63, wr = wid >> 2, wc = wid & 3, fr = lane & 15, fq = lane >> 4;
    const int K = g.K, nt = K / BK;
    unsigned voffA[2], voffB[2];
#pragma unroll
    for (int i = 0; i < 2; ++i) { int R, C; stage_rc(tid * 16 + i * 8192, R, C); const int Rb = Epi::PERM ? ((R & ~31) + perm32(R & 31)) : R;
        voffA[i] = (unsigned)(R * g.lda + C) * 2u; voffB[i] = (unsigned)(Rb * g.ldb + C) * 2u; }
    const size_t kstep = (size_t)(BK * 2);
    const size_t hstepA = (size_t)HALF * g.lda * 2, hstepB = (size_t)HALF * g.ldb * 2;
    const unsigned ldsw = (unsigned)wid * 1024u;
    const int aoff = lds_byte(wr * 64 + fr, fq * 8), boff = lds_byte(wc * 32 + fr, fq * 8);
#define PG8_SA(b, h) (((b) * 2 + (h)) * HTB)
#define PG8_SB(b, h) ((4 + (b) * 2 + (h)) * HTB)
#define PG8_STAGE(bufoff, gbase, voff) do { _Pragma("unroll") for (int _i = 0; _i < 2; ++_i) \
        __builtin_amdgcn_global_load_lds((const unsigned*)((const char*)(gbase) + (voff)[_i]), (PG8_LAS unsigned*)(lds + (bufoff) + ldsw + _i * 8192), 16, 0, 0); } while (0)
#define PG8_LDA(dst, b, h) do { _Pragma("unroll") for (int m = 0; m < 4; ++m) _Pragma("unroll") for (int k = 0; k < 2; ++k) dst[m][k] = *(const PG8_LAS bf16x8*)(lds + PG8_SA(b, h) + aoff + m * 2048 + k * 1024); } while (0)
#define PG8_LDB(dst, b, h) do { _Pragma("unroll") for (int n = 0; n < 2; ++n) _Pragma("unroll") for (int k = 0; k < 2; ++k) dst[n][k] = *(const PG8_LAS bf16x8*)(lds + PG8_SB(b, h) + boff + n * 2048 + k * 1024); } while (0)
#define PG8_MMA(ai, bj, At, Bt) do { __builtin_amdgcn_s_setprio(1); _Pragma("unroll") for (int m = 0; m < 4; ++m) _Pragma("unroll") for (int n = 0; n < 2; ++n) _Pragma("unroll") for (int k = 0; k < 2; ++k) \
        acc[ai][bj][m][n] = __builtin_amdgcn_mfma_f32_16x16x32_bf16(Bt[n][k], At[m][k], acc[ai][bj][m][n], 0, 0, 0); __builtin_amdgcn_s_setprio(0); } while (0)
#define PG8_WAIT_V(n) asm volatile("s_waitcnt vmcnt(" #n ")" ::: "memory")
#define PG8_WAIT_L(n) asm volatile("s_waitcnt lgkmcnt(" #n ")" ::: "memory")
#define PG8_BAR __builtin_amdgcn_s_barrier()
#define PG8_SCHED __builtin_amdgcn_sched_barrier(0)
    Unit cur, nxt; int ui = 0;
    if (!S.next(0, cur)) return;
    f32x4 acc[2][2][4][2];
#pragma unroll
    for (int a = 0; a < 2; ++a)
#pragma unroll
        for (int b = 0; b < 2; ++b)
#pragma unroll
            for (int m = 0; m < 4; ++m)
#pragma unroll
                for (int n = 0; n < 2; ++n) acc[a][b][m][n] = (f32x4){0.f, 0.f, 0.f, 0.f};
    bf16x8 At[4][2], B0[2][2], B1[2][2];
    const char* cA = cur.a; const char* cB = cur.b;
    S.a_ready(cur);
    if constexpr (SP2) {
        PG8_STAGE(PG8_SB(0, 0), cB, voffB); PG8_STAGE(PG8_SB(0, 1), cB + hstepB, voffB); PG8_STAGE(PG8_SA(0, 0), cA, voffA); PG8_STAGE(PG8_SA(0, 1), cA + hstepA, voffA);
        if (wr == 1) PG8_BAR;
        PG8_WAIT_V(2); PG8_BAR;
        PG8_STAGE(PG8_SB(1, 0), cB + kstep, voffB); PG8_STAGE(PG8_SA(1, 0), cA + kstep, voffA); PG8_STAGE(PG8_SB(1, 1), cB + hstepB + kstep, voffB);
        PG8_WAIT_V(6); PG8_BAR;
    } else {
        PG8_STAGE(PG8_SB(0, 0), cB, voffB); PG8_STAGE(PG8_SA(0, 0), cA, voffA); PG8_STAGE(PG8_SB(0, 1), cB + hstepB, voffB); PG8_STAGE(PG8_SA(0, 1), cA + hstepA, voffA);
        if (wr == 1) PG8_BAR;
        PG8_WAIT_V(4); PG8_BAR;
        PG8_STAGE(PG8_SB(1, 0), cB + kstep, voffB); PG8_STAGE(PG8_SA(1, 0), cA + kstep, voffA); PG8_STAGE(PG8_SB(1, 1), cB + hstepB + kstep, voffB);
        PG8_WAIT_V(6); PG8_BAR;
    }
    for (;;) {
        const bool has_next = S.next(ui + 1, nxt);
        const char* nA = has_next ? nxt.a : cA; const char* nB = has_next ? nxt.b : cB;
        for (int t = 0; t < nt; t += 2) {
            const bool last = (t == nt - 2);
            const char* a1 = cA + (size_t)(t + 1) * kstep;
            const char* a2 = last ? nA : cA + (size_t)(t + 2) * kstep; const char* b2 = last ? nB : cB + (size_t)(t + 2) * kstep;
            const char* a3 = a2 + kstep; const char* b3 = b2 + kstep;
            if (last && has_next) S.a_ready(nxt);
            if constexpr (SP2) {
            PG8_LDB(B0, 0, 0); PG8_LDB(B1, 0, 1); PG8_SCHED; PG8_LDA(At, 0, 0); PG8_STAGE(PG8_SA(1, 1), a1 + hstepA, voffA);
            PG8_WAIT_V(8); PG8_WAIT_L(0); PG8_BAR; PG8_MMA(0, 0, At, B0); PG8_MMA(0, 1, At, B1); PG8_BAR; PG8_SCHED;
            PG8_LDA(At, 0, 1); PG8_STAGE(PG8_SB(0, 0), b2, voffB); PG8_STAGE(PG8_SB(0, 1), b2 + hstepB, voffB); PG8_STAGE(PG8_SA(0, 0), a2, voffA);
            PG8_WAIT_V(8); PG8_WAIT_L(0); PG8_BAR; PG8_MMA(1, 0, At, B0); PG8_MMA(1, 1, At, B1); PG8_BAR; PG8_SCHED;
            PG8_LDB(B0, 1, 0); PG8_LDB(B1, 1, 1); PG8_SCHED; PG8_LDA(At, 1, 0); PG8_STAGE(PG8_SA(0, 1), a2 + hstepA, voffA);
            PG8_WAIT_V(8); PG8_WAIT_L(0); PG8_BAR; PG8_MMA(0, 0, At, B0); PG8_MMA(0, 1, At, B1); PG8_BAR; PG8_SCHED;
            PG8_LDA(At, 1, 1); PG8_STAGE(PG8_SB(1, 0), b3, voffB); PG8_STAGE(PG8_SB(1, 1), b3 + hstepB, voffB); PG8_STAGE(PG8_SA(1, 0), a3, voffA);
            PG8_WAIT_V(8); PG8_WAIT_L(0); PG8_BAR; PG8_MMA(1, 0, At, B0); PG8_MMA(1, 1, At, B1); PG8_BAR; PG8_SCHED;
            } else {
            PG8_LDB(B0, 0, 0); PG8_SCHED; PG8_LDA(At, 0, 0); PG8_STAGE(PG8_SA(1, 1), a1 + hstepA, voffA);
            PG8_WAIT_L(8); PG8_BAR; PG8_WAIT_L(0); PG8_MMA(0, 0, At, B0); PG8_BAR; PG8_SCHED;
            PG8_LDB(B1, 0, 1); PG8_STAGE(PG8_SB(0, 0), b2, voffB);
            PG8_BAR; PG8_WAIT_L(0); PG8_MMA(0, 1, At, B1); PG8_BAR;
            PG8_LDA(At, 0, 1); PG8_STAGE(PG8_SA(0, 0), a2, voffA);
            PG8_BAR; PG8_WAIT_L(0); PG8_MMA(1, 0, At, B0); PG8_BAR; PG8_SCHED;
            PG8_STAGE(PG8_SB(0, 1), b2 + hstepB, voffB);
            PG8_WAIT_V(6); PG8_BAR; PG8_MMA(1, 1, At, B1); PG8_BAR;
            PG8_LDB(B0, 1, 0); PG8_SCHED; PG8_LDA(At, 1, 0); PG8_STAGE(PG8_SA(0, 1), a2 + hstepA, voffA);
            PG8_WAIT_L(8); PG8_BAR; PG8_WAIT_L(0); PG8_MMA(0, 0, At, B0); PG8_BAR; PG8_SCHED;
            PG8_LDB(B1, 1, 1); PG8_STAGE(PG8_SB(1, 0), b3, voffB);
            PG8_BAR; PG8_WAIT_L(0); PG8_MMA(0, 1, At, B1); PG8_BAR;
            PG8_LDA(At, 1, 1); PG8_STAGE(PG8_SA(1, 0), a3, voffA);
            PG8_BAR; PG8_WAIT_L(0); PG8_MMA(1, 0, At, B0); PG8_BAR; PG8_SCHED;
            PG8_STAGE(PG8_SB(1, 1), b3 + hstepB, voffB);
            PG8_WAIT_V(6); PG8_BAR; PG8_MMA(1, 1, At, B1); PG8_BAR;
            }
        }
        if constexpr (ALIGN_EPI) { if (wr == 0) PG8_BAR; }
        if constexpr (!Epi::AFTER_DRAIN) { E(acc, cur, wr, wc, fr, fq); S.done(cur); }
        if (!has_next) break;
#pragma unroll
        for (int a = 0; a < 2; ++a)
#pragma unroll
            for (int b = 0; b < 2; ++b)
#pragma unroll
                for (int m = 0; m < 4; ++m)
#pragma unroll
                    for (int n = 0; n < 2; ++n) acc[a][b][m][n] = (f32x4){0.f, 0.f, 0.f, 0.f};
        cur = nxt; cA = nA; cB = nB; ++ui;
        if constexpr (ALIGN_EPI) { if (wr == 1) PG8_BAR; }
    }
    PG8_WAIT_V(0);
    if constexpr (!ALIGN_EPI) { if (wr == 0) PG8_BAR; }
    PG8_BAR;
    if constexpr (Epi::AFTER_DRAIN) { E.fused(acc, cur, wr, wc, fr, fq, lds, wid, lane); S.done(cur); }
#undef PG8_SA
#undef PG8_SB
#undef PG8_STAGE
#undef PG8_LDA
#undef PG8_LDB
#undef PG8_MMA
#undef PG8_WAIT_V
#undef PG8_WAIT_L
#undef PG8_BAR
#undef PG8_SCHED
}
}

#define GAS __attribute__((address_space(1)))
typedef GAS unsigned gu32;
#define RLX_AGENT __ATOMIC_RELAXED, __HIP_MEMORY_SCOPE_AGENT
#define XB_TMO      128
#define XB_XCNT(j)  (256  + 64 * (j))
#define XB_XSUB(j)  (1280 + 64 * (j))
#define XB_XGEN(j)  (2304 + 64 * (j))
#define XB_TOP      3328
#define XB_TOPGEN   3392
#define XCD_BAR_WORDS 3456
#define XB_SPIN_CAP (1u << 18)

__device__ __forceinline__ unsigned xb_ld(unsigned* p)              { return __hip_atomic_load(p, __ATOMIC_RELAXED, __HIP_MEMORY_SCOPE_AGENT); }
__device__ __forceinline__ unsigned xb_add(unsigned* p, unsigned v) { return __hip_atomic_fetch_add(p, v, __ATOMIC_RELAXED, __HIP_MEMORY_SCOPE_AGENT); }
__device__ __forceinline__ unsigned xb_xcc_id() { return (unsigned)__builtin_amdgcn_s_getreg((3 << 11) | 20) & 0xFu; }
#define XB_SPIN(cond, bar) do { unsigned _sp = 0; while (cond) { __builtin_amdgcn_s_sleep(1); \
    if ((++_sp & 255u) == 0u) { if (xb_ld(&(bar)[XB_TMO])) break; if (_sp > XB_SPIN_CAP) { atomicAdd(&(bar)[XB_TMO], 1u); break; } } } } while (0)

struct XcdBarrier {
    unsigned* bar; unsigned x;
    volatile LAS unsigned* st;
};

__device__ __forceinline__ XcdBarrier xcd_barrier_post(unsigned* bar, volatile LAS unsigned* st) {
    XcdBarrier b; b.bar = bar; b.x = xb_xcc_id(); b.st = st;
    if (threadIdx.x == 0) (void)xb_add(&bar[XB_XCNT(b.x)], 1u);
    return b;
}
__device__ __forceinline__ void xcd_barrier_complete(unsigned* bar, unsigned x, unsigned& nloc, unsigned& nx) {
    const unsigned G = gridDim.x * gridDim.y * gridDim.z;
    unsigned sum, cnt, mine, sp = 0u;
    for (;;) {
        sum = 0u; cnt = 0u; mine = 0u;
#pragma unroll
        for (unsigned j = 0; j < 16; ++j) { const unsigned c = xb_ld(&bar[XB_XCNT(j)]); sum += c; cnt += (c > 0u) ? 1u : 0u; mine = (j == x) ? c : mine; }
        if (sum == G) break;
        __builtin_amdgcn_s_sleep(1);
        if ((++sp & 255u) == 0u) { if (xb_ld(&bar[XB_TMO])) break; if (sp > XB_SPIN_CAP) { atomicAdd(&bar[XB_TMO], 1u); break; } }
    }
    nloc = mine > 0u ? mine : 1u; nx = cnt > 0u ? cnt : 1u;
}

__device__ __forceinline__ void xcd_barrier(const XcdBarrier& b) {
    asm volatile("s_waitcnt vmcnt(0)" ::: "memory");
    __syncthreads();
    if (threadIdx.x == 0) {
        unsigned* bar = b.bar;
        __builtin_amdgcn_s_waitcnt(0);
        unsigned nloc = b.st[0], nx = b.st[1];
        if (nloc == 0u) { xcd_barrier_complete(bar, b.x, nloc, nx); b.st[0] = nloc; b.st[1] = nx; }
        const unsigned old = xb_add(&bar[XB_XSUB(b.x)], 1u);
        const unsigned gen = old / nloc;
        if (old + 1u == (gen + 1u) * nloc) {
            __builtin_amdgcn_fence(__ATOMIC_RELEASE, "agent");
            asm volatile("s_waitcnt vmcnt(0)" ::: "memory");
            const unsigned og = xb_add(&bar[XB_TOP], 1u);
            const unsigned tg = og / nx;
            if (og + 1u == (tg + 1u) * nx) xb_add(&bar[XB_TOPGEN], 1u);
            else XB_SPIN(xb_ld(&bar[XB_TOPGEN]) == tg, bar);
            __builtin_amdgcn_fence(__ATOMIC_ACQUIRE, "agent");
            xb_add(&bar[XB_XGEN(b.x)], 1u);
            asm volatile("s_waitcnt vmcnt(0)" ::: "memory");
        } else {
            XB_SPIN(xb_ld(&bar[XB_XGEN(b.x)]) == gen, bar);
            __builtin_amdgcn_fence(__ATOMIC_ACQUIRE, "agent");
            asm volatile("s_waitcnt vmcnt(0)" ::: "memory");
        }
    }
    __syncthreads();
}

struct OrderBase {
    __device__ __forceinline__ void a_ready(const pg8::Unit&) const {}
    __device__ __forceinline__ void done(const pg8::Unit&) const {}
};
struct PlainOrder : OrderBase {
    const char* A; const char* B; size_t astep, bstep; int nM, nN, G, c;
    __device__ __forceinline__ bool next(int i, pg8::Unit& u) const {
        const long L = (long)i * G + c; if (L >= (long)nM * nN) return false;
        pg8::tile_of((int)L, nM, nN, u.pm, u.pn); u.aux = 0; u.a = A + (size_t)u.pm * astep; u.b = B + (size_t)u.pn * bstep; return true; }
};
struct LruOrder : OrderBase {
    const char* A; const char* B; int nM, G, c;
    __device__ __forceinline__ bool next(int i, pg8::Unit& u) const {
        const long L = (long)i * G + c; if (L >= (long)nM * 16) return false;
        pg8::tile_of((int)L, nM, 16, u.pm, u.pn); u.aux = 0; u.a = A + (size_t)u.pm * (256 * 1024 * 2) + (size_t)(u.pn >> 2) * 512; u.b = B + (size_t)u.pn * (256 * 256 * 2); return true; }
};
struct BranchOrder : OrderBase {
    const char* A; const char* B; int nM, G, c;
    __device__ __forceinline__ bool next(int i, pg8::Unit& u) const {
        const int j = i / 3, br = i - 3 * j; const long L = (long)j * G + c; if (L >= (long)nM * 4) return false;
        pg8::tile_of((int)L, nM, 4, u.pm, u.pn); u.aux = br; u.a = A + (size_t)br * ROWB + (size_t)u.pm * (256 * 1024 * 2); u.b = B + (size_t)br * (1024 * 1024 * 2) + (size_t)u.pn * (256 * 1024 * 2); return true; }
};
struct MoeOrder : OrderBase {
    const char* A; const char* B; const unsigned* tile_e; size_t estep; int nM, nN, G, c;
    __device__ __forceinline__ bool next(int i, pg8::Unit& u) const {
        const long L = (long)i * G + c; if (L >= (long)nM * nN) return false;
        pg8::tile_of((int)L, nM, nN, u.pm, u.pn); const int e = (int)tile_e[u.pm]; u.aux = e;
        u.a = A + (size_t)u.pm * (256 * 1024 * 2); u.b = B + (size_t)e * estep + (size_t)u.pn * (256 * 1024 * 2); return true; }
};

struct EpiBf16Bias {
    static constexpr bool PERM = true, AFTER_DRAIN = false;
    bf16_t* O; int ldc; const float* bias; int bstride;
    __device__ __forceinline__ void operator()(const f32x4 (&acc)[2][2][4][2], const pg8::Unit& u, int wr, int wc, int fr, int fq) const {
        const int row0 = u.pm * 256 + wr * 64 + fr, col0 = u.pn * 256 + wc * 32 + 8 * fq;
        f32x4 bv[2][2];
#pragma unroll
        for (int bj = 0; bj < 2; ++bj)
#pragma unroll
            for (int n = 0; n < 2; ++n) bv[bj][n] = bias ? *(const f32x4*)(bias + (size_t)u.aux * bstride + col0 + bj * 128 + 4 * n) : (f32x4){0.f, 0.f, 0.f, 0.f};
#pragma unroll
        for (int ai = 0; ai < 2; ++ai)
#pragma unroll
            for (int m = 0; m < 4; ++m) { bf16_t* rowp = O + (size_t)(row0 + ai * 128 + m * 16) * ldc + col0;
#pragma unroll
                for (int bj = 0; bj < 2; ++bj) { const f32x4 v0 = acc[ai][bj][m][0] + bv[bj][0], v1 = acc[ai][bj][m][1] + bv[bj][1];
                    u32x4 w; w.x = pg8::cvt_pk_bf16(v0[0], v0[1]); w.y = pg8::cvt_pk_bf16(v0[2], v0[3]); w.z = pg8::cvt_pk_bf16(v1[0], v1[1]); w.w = pg8::cvt_pk_bf16(v1[2], v1[3]);
                    *(u32x4*)(rowp + bj * 128) = w; } }
    }
};
struct EpiLru {
    static constexpr bool PERM = true, AFTER_DRAIN = false;
    const bf16_t* xc; bf16_t* LA; bf16_t* BB; const float* ba; const float* bi; const float* lsl;
    __device__ __forceinline__ void operator()(const f32x4 (&acc)[2][2][4][2], const pg8::Unit& u, int wr, int wc, int fr, int fq) const {
        const int g = u.pn >> 2, d = (u.pn >> 1) & 1, hh = u.pn & 1;
        const int row0 = u.pm * 256 + wr * 64 + fr, ch0 = 256 * g + 128 * hh + wc * 32 + 8 * fq;
#pragma unroll
        for (int ai = 0; ai < 2; ++ai)
#pragma unroll
            for (int m = 0; m < 4; ++m) { const size_t off = (size_t)(row0 + ai * 128 + m * 16) * 1024 + ch0;
                const u32x4 xw = *(const u32x4*)(xc + off); float la[8], bb[8];
#pragma unroll
                for (int n = 0; n < 2; ++n) { const f32x4 pb = *(const f32x4*)(ba + d * 1024 + ch0 + 4 * n), pi = *(const f32x4*)(bi + d * 1024 + ch0 + 4 * n), pl = *(const f32x4*)(lsl + d * 1024 + ch0 + 4 * n);
#pragma unroll
                    for (int e = 0; e < 4; ++e) { const int idx = 4 * n + e; const unsigned w = xw[idx >> 1]; const float xv = (idx & 1) ? bfhi(w) : bflo(w);
                        const float r = sigmoidf_(acc[ai][0][m][n][e] + pb[e]), ig = sigmoidf_(acc[ai][1][m][n][e] + pi[e]);
                        const float l = 8.0f * r * pl[e]; la[idx] = l; bb[idx] = sqrtf(fmaxf(1.0f - __expf(2.0f * l), 0.f)) * ig * xv; } }
                u32x4 w1, w2; w1.x = pg8::cvt_pk_bf16(la[0], la[1]); w1.y = pg8::cvt_pk_bf16(la[2], la[3]); w1.z = pg8::cvt_pk_bf16(la[4], la[5]); w1.w = pg8::cvt_pk_bf16(la[6], la[7]);
                w2.x = pg8::cvt_pk_bf16(bb[0], bb[1]); w2.y = pg8::cvt_pk_bf16(bb[2], bb[3]); w2.z = pg8::cvt_pk_bf16(bb[4], bb[5]); w2.w = pg8::cvt_pk_bf16(bb[6], bb[7]);
                *(u32x4*)(LA + (size_t)d * TT * 1024 + off) = w1; *(u32x4*)(BB + (size_t)d * TT * 1024 + off) = w2; asm volatile("" ::: "memory"); }
    }
};
struct EpiBranch {
    static constexpr bool PERM = true, AFTER_DRAIN = false;
    const bf16_t* P; float* MF; bf16_t* MG;
    __device__ __forceinline__ void operator()(const f32x4 (&acc)[2][2][4][2], const pg8::Unit& u, int wr, int wc, int fr, int fq) const {
        const int br = u.aux, row0 = u.pm * 256 + wr * 64 + fr, col0 = u.pn * 256 + wc * 32 + 8 * fq;
#pragma unroll
        for (int ai = 0; ai < 2; ++ai)
#pragma unroll
            for (int m = 0; m < 4; ++m) { const size_t row = (size_t)(row0 + ai * 128 + m * 16);
#pragma unroll
                for (int bj = 0; bj < 2; ++bj) { const int c = col0 + bj * 128;
                    const u32x4 gw = *(const u32x4*)(P + row * LDP + C_MG + br * 1024 + c);
                    f32x4 v0, v1;
                    v0[0] = sigmoidf_(bflo(gw.x)) * acc[ai][bj][m][0][0]; v0[1] = sigmoidf_(bfhi(gw.x)) * acc[ai][bj][m][0][1]; v0[2] = sigmoidf_(bflo(gw.y)) * acc[ai][bj][m][0][2]; v0[3] = sigmoidf_(bfhi(gw.y)) * acc[ai][bj][m][0][3];
                    v1[0] = sigmoidf_(bflo(gw.z)) * acc[ai][bj][m][1][0]; v1[1] = sigmoidf_(bfhi(gw.z)) * acc[ai][bj][m][1][1]; v1[2] = sigmoidf_(bflo(gw.w)) * acc[ai][bj][m][1][2]; v1[3] = sigmoidf_(bfhi(gw.w)) * acc[ai][bj][m][1][3];
                    float* mf = MF + row * 1024 + c;
                    if (br != 0) { v0 += *(const f32x4*)mf; v1 += *(const f32x4*)(mf + 4); }
                    if (br != 2) { *(f32x4*)mf = v0; *(f32x4*)(mf + 4) = v1; }
                    else { u32x4 w; w.x = pg8::cvt_pk_bf16(v0[0], v0[1]); w.y = pg8::cvt_pk_bf16(v0[2], v0[3]); w.z = pg8::cvt_pk_bf16(v1[0], v1[1]); w.w = pg8::cvt_pk_bf16(v1[2], v1[3]);
                        *(u32x4*)(MG + row * 1024 + c) = w; } } }
    }
};
struct EpiOut {
    static constexpr bool PERM = false, AFTER_DRAIN = false;
    const float* baseLat; const float* baseCtx; float* xs; const float* gate;
    __device__ __forceinline__ void operator()(const f32x4 (&acc)[2][2][4][2], const pg8::Unit& u, int wr, int wc, int fr, int fq) const {
        const int mrow = u.pm < 128 ? (u.pm >> 4) : 8; const float* gp = gate + mrow * 6144;
        const int row0 = u.pm * 256 + wr * 64 + fr, col0 = u.pn * 256 + wc * 32 + 4 * fq;
        const float* base = u.pm < 128 ? baseLat + (size_t)row0 * 1024 : baseCtx + (size_t)(row0 - TLAT) * 1024;
        f32x4 gv[2][2];
#pragma unroll
        for (int bj = 0; bj < 2; ++bj)
#pragma unroll
            for (int n = 0; n < 2; ++n) gv[bj][n] = *(const f32x4*)(gp + col0 + bj * 128 + n * 16);
#pragma unroll
        for (int ai = 0; ai < 2; ++ai)
#pragma unroll
            for (int m = 0; m < 4; ++m) { const size_t ro = (size_t)(ai * 128 + m * 16) * 1024 + col0; float* op = xs + (size_t)row0 * 1024 + ro;
#pragma unroll
                for (int bj = 0; bj < 2; ++bj)
#pragma unroll
                    for (int n = 0; n < 2; ++n) *(f32x4*)(op + bj * 128 + n * 16) = *(const f32x4*)(base + ro + bj * 128 + n * 16) + gv[bj][n] * acc[ai][bj][m][n]; }
    }
};
struct EpiSwiglu {
    static constexpr bool PERM = true, AFTER_DRAIN = false;
    bf16_t* H; const float* bgu;
    __device__ __forceinline__ void operator()(const f32x4 (&acc)[2][2][4][2], const pg8::Unit& u, int wr, int wc, int fr, int fq) const {
        const int row0 = u.pm * 256 + wr * 64 + fr, f0 = u.pn * 128 + wc * 32 + 8 * fq;
        float bg[8], bu[8];
#pragma unroll
        for (int q = 0; q < 4; ++q) { const f32x4 b = *(const f32x4*)(bgu + (size_t)u.aux * 2048 + 2 * f0 + 4 * q); bg[2 * q] = b[0]; bu[2 * q] = b[1]; bg[2 * q + 1] = b[2]; bu[2 * q + 1] = b[3]; }
#pragma unroll
        for (int ai = 0; ai < 2; ++ai)
#pragma unroll
            for (int m = 0; m < 4; ++m) { float a[8];
#pragma unroll
                for (int n = 0; n < 2; ++n)
#pragma unroll
                    for (int e = 0; e < 4; ++e) { const int idx = 4 * n + e; const float gt = fminf(acc[ai][0][m][n][e] + bg[idx], 7.0f), up = fminf(fmaxf(acc[ai][1][m][n][e] + bu[idx], -7.0f), 7.0f);
                        a[idx] = gt * sigmoidf_(1.702f * gt) * (up + 1.0f); }
                u32x4 w; w.x = pg8::cvt_pk_bf16(a[0], a[1]); w.y = pg8::cvt_pk_bf16(a[2], a[3]); w.z = pg8::cvt_pk_bf16(a[4], a[5]); w.w = pg8::cvt_pk_bf16(a[6], a[7]);
                *(u32x4*)(H + (size_t)(row0 + ai * 128 + m * 16) * 1024 + f0) = w; }
    }
};

constexpr int NWAVES = 8, NTHR = 512;
constexpr int LDS_BYTES = 147456, MISC_OFF = 131072 + 320;
struct Frame {
    LAS unsigned char* lds; unsigned char* ws; const float* const* in; float* out;
    int tid, bx, lane, wave, G, gw, NGW, gtid, NGT;
};
__device__ __forceinline__ int mrow_of(int row) { return row < TLAT ? (row >> 12) : 8; }
__device__ __forceinline__ int seqrow(int d, int b, int p) {
    if (p < CTXL) return TLAT + b * CTXL + (d ? CTXL - 1 - p : p);
    const int q = p - CTXL; return b * SEQ + (d ? SEQ - 1 - q : q);
}
struct RowV { f32x4 v[4]; };
__device__ __forceinline__ RowV load_row(const float* p, int lane) { RowV r;
#pragma unroll
    for (int j = 0; j < 4; ++j) r.v[j] = *(const f32x4*)(p + 4 * lane + 256 * j);
    return r; }
__device__ __forceinline__ float row_sumsq(const RowV& r) { float s = 0.f;
#pragma unroll
    for (int j = 0; j < 4; ++j) s += (r.v[j][0] * r.v[j][0] + r.v[j][1] * r.v[j][1]) + (r.v[j][2] * r.v[j][2] + r.v[j][3] * r.v[j][3]);
    return wave_sum(s); }
__device__ __forceinline__ RowV norm_mod(const RowV& x, const float* gain, const float* shift, const float* scale, int lane) {
    const float rs = rsqrtf(row_sumsq(x) * (1.0f / D) + EPS); RowV y;
#pragma unroll
    for (int j = 0; j < 4; ++j) { const int c = 4 * lane + 256 * j; const f32x4 g = *(const f32x4*)(gain + c), sh = *(const f32x4*)(shift + c), sc = *(const f32x4*)(scale + c);
        y.v[j] = (x.v[j] * rs) * g * (sc + 1.0f) + sh; }
    return y; }
__device__ __forceinline__ void store_row_bf16(bf16_t* p, const RowV& y, int lane) {
#pragma unroll
    for (int j = 0; j < 4; ++j) { u32x2 w; w.x = pk2(y.v[j][0], y.v[j][1]); w.y = pk2(y.v[j][2], y.v[j][3]); *(u32x2*)(p + 4 * lane + 256 * j) = w; } }
__device__ __forceinline__ f32x4 ld4bf(const bf16_t* p) { const u32x2 w = *(const u32x2*)p; return (f32x4){bflo(w.x), bfhi(w.x), bflo(w.y), bfhi(w.y)}; }

__device__ __forceinline__ void phase_proA(const Frame& F) {
    const float* c = F.in[1]; const float* cc = F.in[3]; const float* w_ada = F.in[4];
    float* modp = (float*)(F.ws + WS_MODP);
    for (int it = F.gw; it < 2 * 8 * 96; it += F.NGW) {
        const int cg = it % 96, ks = (it / 96) % 8, l = it / 768, col = cg * 64 + F.lane;
        float acc[9];
#pragma unroll
        for (int r = 0; r < 9; ++r) acc[r] = 0.f;
        for (int k = ks * 128; k < ks * 128 + 128; ++k) {
            const float w = w_ada[((size_t)l * 1024 + k) * 6144 + col];
#pragma unroll
            for (int r = 0; r < 8; ++r) acc[r] += siluf_(c[r * 1024 + k]) * w;
            acc[8] += siluf_(cc[k]) * w;
        }
#pragma unroll
        for (int r = 0; r < 9; ++r) modp[((size_t)(ks * 2 + l) * 9 + r) * 6144 + col] = acc[r];
    }
    float* rc = (float*)(F.ws + WS_COS); float* rsn = (float*)(F.ws + WS_SIN);
    for (int i = F.gtid; i < SEQ * 64; i += F.NGT) {
        const int t = i >> 6, j = i & 63, f = j & 31; const float pos = (float)((j < 32) ? (t >> 6) : (t & 63));
        const float inv = exp2f(-(float)f * (13.287712379549449f / 32.0f)); const float ang = pos * inv;
        const float nn = rintf(ang * 0.15915494309189535f); float r = fmaf(-nn, 6.28125f, ang); r = fmaf(-nn, 1.9353071795864769e-3f, r);
        rc[i] = __cosf(r); rsn[i] = __sinf(r);
    }
}
__device__ __forceinline__ void phase_proB(const Frame& F) {
    const float* modp = (const float*)(F.ws + WS_MODP); float* mods = (float*)(F.ws + WS_MODS); const float* b_ada = F.in[5];
    for (int i = F.gtid; i < 2 * 9 * 6144; i += F.NGT) { const int l = i / (9 * 6144), col = i % 6144; float s = b_ada[l * 6144 + col];
#pragma unroll
        for (int ks = 0; ks < 8; ++ks) s += modp[(size_t)ks * (2 * 9 * 6144) + i];
        mods[i] = s; }
}

template <class RM> __device__ __forceinline__ void tr_item(const float* W, int ldw, int k0, int n0, bf16_t* WT, int ldt, LAS float* scr, int lane, const RM& rm) {
#pragma unroll 8
    for (int i = 0; i < 32; ++i) { const int kk = 2 * i + (lane >> 5); scr[kk * 33 + (lane & 31)] = W[(size_t)(k0 + kk) * ldw + n0 + (lane & 31)]; }
    LDS_WAIT(); asm volatile("" ::: "memory");
    const int c = lane & 7;
#pragma unroll
    for (int j = 0; j < 4; ++j) { const int n = (lane >> 3) + 8 * j; const LAS float* s = scr + (8 * c) * 33 + n; int drow; float sc; rm(n0 + n, drow, sc);
        u32x4 o; o.x = pk2(s[0 * 33] * sc, s[1 * 33] * sc); o.y = pk2(s[2 * 33] * sc, s[3 * 33] * sc); o.z = pk2(s[4 * 33] * sc, s[5 * 33] * sc); o.w = pk2(s[6 * 33] * sc, s[7 * 33] * sc);
        *(u32x4*)(WT + (size_t)drow * ldt + k0 + 8 * c) = o; }
    LDS_WAIT(); asm volatile("" ::: "memory");
}
struct RmIn { __device__ __forceinline__ void operator()(int n, int& drow, float& sc) const {
    drow = n < 3072 ? n : (n < 3104 ? C_LR + (n - 3072) : n - 32); sc = (n < 512 || (n >= 5664 && n < 6176)) ? 0.08838834764831845f : 1.0f; } };
struct RmId { __device__ __forceinline__ void operator()(int n, int& drow, float& sc) const { drow = n; sc = 1.0f; } };
struct RmLru { int base; __device__ __forceinline__ void operator()(int n, int& drow, float& sc) const { drow = base + (n & 127); sc = 1.0f; } };
struct RmGu { __device__ __forceinline__ void operator()(int n, int& drow, float& sc) const { const int f = n >> 1, u = n & 1; drow = 256 * (f >> 7) + 128 * u + (f & 127); sc = 1.0f; } };
__device__ __forceinline__ void phase_W(const Frame& F, int li) {
    LAS float* scr = (LAS float*)(F.lds + F.wave * 8704);
    bf16_t* Win_t = (bf16_t*)(F.ws + WS_WIN); bf16_t* Wlru_t = (bf16_t*)(F.ws + WS_WLRU); bf16_t* Wbr_t = (bf16_t*)(F.ws + WS_WBR);
    bf16_t* Wout_t = (bf16_t*)(F.ws + WS_WOUT); bf16_t* Wgu_t = (bf16_t*)(F.ws + WS_WGU); bf16_t* Wdn_t = (bf16_t*)(F.ws + WS_WDN);
    constexpr int I_IN = 16 * 353, I_LRU = 512, I_BR = 1536, I_OUT = 512, I_GU = 32768, I_DN = 16384, NITEMS = I_IN + I_LRU + I_BR + I_OUT + I_GU + I_DN;
    for (int it0 = F.gw; it0 < NITEMS; it0 += F.NGW) {
        int it = it0;
        if (it < I_IN) { const int kb = it / 353, nb = it % 353; tr_item(F.in[8] + (size_t)li * 1024 * IN_TOTAL, IN_TOTAL, 64 * kb, 32 * nb, Win_t, 1024, scr, F.lane, RmIn{}); continue; } it -= I_IN;
        if (it < I_LRU) { const int mat = it >> 5, r = it & 31, kb = r >> 3, nb = r & 7, ty = mat >> 3, d = (mat >> 2) & 1, g = mat & 3, n0 = 32 * nb, pn = g * 4 + d * 2 + (n0 >> 7);
            const float* src = (ty ? F.in[16] : F.in[14]) + (size_t)((li * 2 + d) * 4 + g) * 65536;
            tr_item(src, 256, 64 * kb, n0, Wlru_t, 256, scr, F.lane, RmLru{pn * 256 + ty * 128}); continue; } it -= I_LRU;
        if (it < I_BR) { const int br = it >> 9, r = it & 511, kb = r >> 5, nb = r & 31; tr_item(F.in[20] + (size_t)(li * 3 + br) * 1048576, 1024, 64 * kb, 32 * nb, Wbr_t + (size_t)br * 1048576, 1024, scr, F.lane, RmId{}); continue; } it -= I_BR;
        if (it < I_OUT) { const int kb = it >> 5, nb = it & 31; tr_item(F.in[21] + (size_t)li * 1048576, 1024, 64 * kb, 32 * nb, Wout_t, 1024, scr, F.lane, RmId{}); continue; } it -= I_OUT;
        if (it < I_GU) { const int e = it >> 10, r = it & 1023, kb = r >> 6, nb = r & 63; tr_item(F.in[24] + (size_t)(li * 32 + e) * 2097152, 2048, 64 * kb, 32 * nb, Wgu_t + (size_t)e * 2097152, 1024, scr, F.lane, RmGu{}); continue; } it -= I_GU;
        { const int e = it >> 9, r = it & 511, kb = r >> 5, nb = r & 31; tr_item(F.in[26] + (size_t)(li * 32 + e) * 1048576, 1024, 64 * kb, 32 * nb, Wdn_t + (size_t)e * 1048576, 1024, scr, F.lane, RmId{}); }
    }
    for (int i = F.gtid; i < (LDP - IN_TOTAL) * 1024 / 8; i += F.NGT) *(u32x4*)(Win_t + (size_t)IN_TOTAL * 1024 + (size_t)i * 8) = (u32x4){0u, 0u, 0u, 0u};
    float* lsl = (float*)(F.ws + WS_LSL);
    for (int i = F.gtid; i < 2048; i += F.NGT) lsl[i] = logsigmoidf_(F.in[18][li * 2048 + i]);
}
__device__ __forceinline__ void phase_norm_in(const Frame& F) {
    const float* mods = (const float*)(F.ws + WS_MODS); bf16_t* xn = (bf16_t*)(F.ws + WS_D);
    for (int row = F.gw; row < TT; row += F.NGW) {
        const float* src = row < TLAT ? F.in[0] + (size_t)row * D : F.in[2] + (size_t)(row - TLAT) * D;
        const float* mp = mods + mrow_of(row) * 6144;
        const RowV y = norm_mod(load_row(src, F.lane), F.in[6], mp, mp + 1024, F.lane);
        store_row_bf16(xn + (size_t)row * D, y, F.lane);
    }
}

__device__ __forceinline__ void phase_conv(const Frame& F, int li) {
    const bf16_t* P = (const bf16_t*)(F.ws + WS_P); bf16_t* xc = (bf16_t*)(F.ws + WS_D);
    const float* cw = F.in[12] + (size_t)li * 4 * 1024; const float* cb = F.in[13] + (size_t)li * 1024;
    for (int i = F.gtid; i < TT * 128; i += F.NGT) {
        const int row = i >> 7, ch = (i & 127) * 8;
        int t, L; if (row < TLAT) { t = row & (SEQ - 1); L = SEQ; } else { t = (row - TLAT) & (CTXL - 1); L = CTXL; }
        float a[8];
        { const f32x4 b0 = *(const f32x4*)(cb + ch), b1 = *(const f32x4*)(cb + ch + 4); a[0] = b0[0]; a[1] = b0[1]; a[2] = b0[2]; a[3] = b0[3]; a[4] = b1[0]; a[5] = b1[1]; a[6] = b1[2]; a[7] = b1[3]; }
#pragma unroll
        for (int j = 0; j < 4; ++j) { const int tt = t - 2 + j; if (tt < 0 || tt >= L) continue;
            const u32x4 xw = *(const u32x4*)(P + (size_t)(row - 2 + j) * LDP + C_LX + ch);
            const f32x4 w0 = *(const f32x4*)(cw + j * 1024 + ch), w1 = *(const f32x4*)(cw + j * 1024 + ch + 4);
            a[0] += w0[0] * bflo(xw.x); a[1] += w0[1] * bfhi(xw.x); a[2] += w0[2] * bflo(xw.y); a[3] += w0[3] * bfhi(xw.y);
            a[4] += w1[0] * bflo(xw.z); a[5] += w1[1] * bfhi(xw.z); a[6] += w1[2] * bflo(xw.w); a[7] += w1[3] * bfhi(xw.w); }
        u32x4 o; o.x = pk2(a[0], a[1]); o.y = pk2(a[2], a[3]); o.z = pk2(a[4], a[5]); o.w = pk2(a[6], a[7]);
        *(u32x4*)(xc + (size_t)row * 1024 + ch) = o;
    }
}
__device__ __forceinline__ int seg_row(int d, int b, int s, int p) {
    const int base = (s == 0) ? TLAT + b * CTXL : b * SEQ + 256 * (d ? 16 - s : s - 1);
    return base + (d ? 255 - p : p);
}
template <bool FINAL> __device__ __forceinline__ void phase_lru_scan(const Frame& F) {
    const bf16_t* LA = (const bf16_t*)(F.ws + WS_C); const bf16_t* BB = (const bf16_t*)(F.ws + WS_C + 2 * ROWB);
    float* carA = (float*)(F.ws + WS_CARA); float* carH = (float*)(F.ws + WS_CARH); bf16_t* HO = (bf16_t*)(F.ws + WS_E);
    for (int i = F.gtid; i < 2 * 8 * 17 * 256; i += F.NGT) {
        const int cq = i & 255, s = (i >> 8) % 17, db = (i >> 8) / 17, b = db & 7, d = db >> 3;
        f32x4 h = (f32x4){0.f, 0.f, 0.f, 0.f}, As = (f32x4){0.f, 0.f, 0.f, 0.f};
        if (FINAL) { for (int s2 = 0; s2 < s; ++s2) { const size_t o = ((size_t)(db * 17 + s2) * 256 + cq) * 4; h = *(const f32x4*)(carA + o) * h + *(const f32x4*)(carH + o); } }
        const size_t dofs = (size_t)d * TT * 1024;
#pragma unroll 8
        for (int p = 0; p < 256; ++p) { const size_t off = (size_t)seg_row(d, b, s, p) * 1024 + cq * 4;
            const f32x4 la = ld4bf(LA + dofs + off), bb = ld4bf(BB + dofs + off);
            f32x4 a; a[0] = __expf(la[0]); a[1] = __expf(la[1]); a[2] = __expf(la[2]); a[3] = __expf(la[3]);
            h = a * h + bb;
            if (FINAL) { u32x2 w; w.x = pk2(h[0], h[1]); w.y = pk2(h[2], h[3]); *(u32x2*)(HO + dofs + off) = w; } else As += la; }
        if (!FINAL) { const size_t o = (size_t)i * 4; f32x4 A; A[0] = __expf(As[0]); A[1] = __expf(As[1]); A[2] = __expf(As[2]); A[3] = __expf(As[3]);
            *(f32x4*)(carA + o) = A; *(f32x4*)(carH + o) = h; }
    }
}

template <bool STRICT> __device__ __forceinline__ void scan_steps(LAS float* sq, LAS float* sk, LAS float* sd, LAS float* sv, LAS float* so, float (&S)[8][4], int wave, int lane) {
    const int rg = lane >> 2, cg = lane & 3, cb = 16 * wave + 4 * cg;
    for (int p = 0; p < 32; ++p) {
        float q[8], k[8], dc[8];
#pragma unroll
        for (int h2 = 0; h2 < 2; ++h2) { const f32x4 a = *(const LAS f32x4*)(sq + p * 128 + rg * 8 + 4 * h2), b = *(const LAS f32x4*)(sk + p * 128 + rg * 8 + 4 * h2), c = *(const LAS f32x4*)(sd + p * 128 + rg * 8 + 4 * h2);
#pragma unroll
            for (int e = 0; e < 4; ++e) { q[4 * h2 + e] = a[e]; k[4 * h2 + e] = b[e]; dc[4 * h2 + e] = c[e]; } }
        const f32x4 v = *(const LAS f32x4*)(sv + p * 128 + cb);
        float o[4] = {0.f, 0.f, 0.f, 0.f};
#pragma unroll
        for (int i = 0; i < 8; ++i)
#pragma unroll
            for (int j = 0; j < 4; ++j) { const float s1 = dc[i] * S[i][j], s2 = s1 + k[i] * v[j]; o[j] += q[i] * (STRICT ? s1 : s2); S[i][j] = s2; }
#pragma unroll
        for (int j = 0; j < 4; ++j) { float x = o[j]; x += __shfl_xor(x, 4); x += __shfl_xor(x, 8); x += __shfl_xor(x, 16); x += __shfl_xor(x, 32); o[j] = x; }
        if (rg == 0) *(LAS f32x4*)(so + p * 128 + cb) = (f32x4){o[0], o[1], o[2], o[3]};
    }
}
__device__ __forceinline__ void phase_scan_ref(const Frame& F, int li) {
    LAS float* sq = (LAS float*)F.lds; LAS float* sk = sq + 4096; LAS float* sd = sk + 4096; LAS float* sv = sd + 4096; LAS float* so = sv + 4096;
    const bf16_t* P = (const bf16_t*)(F.ws + WS_P); bf16_t* OB = (bf16_t*)(F.ws + WS_B);
    const float* rcos = (const float*)(F.ws + WS_COS); const float* rsin = (const float*)(F.ws + WS_SIN);
    const int tt = F.tid >> 4, part = F.tid & 15;
    for (int u = F.bx; u < 256; u += F.G) {
        const int js = u & 1, h = (u >> 1) & 3, b = (u >> 3) & 7, d = (u >> 6) & 1, mx = u >> 7;
        const int CQ = (mx ? C_RQ : C_GQ) + 128 * h, CK = (mx ? C_RK : C_GK) + 128 * h, CV = (mx ? C_RV : C_GV) + 256 * h + 128 * js;
        bf16_t* O = OB + (size_t)(mx * 2 + d) * TT * 1024;
        const float* wa2 = F.in[9] + (size_t)((li * 2 + d) * 16) * 512 + 128 * h; const float* gba = F.in[10] + (size_t)(li * 2 + d) * 512 + 128 * h;
        const float gamma = 1.0f - exp2f(-5.0f - (float)h);
        float S[8][4];
#pragma unroll
        for (int i = 0; i < 8; ++i)
#pragma unroll
            for (int j = 0; j < 4; ++j) S[i][j] = 0.f;
        for (int p0 = 0; p0 < CTXL + SEQ; p0 += 32) {
            const int row = seqrow(d, b, p0 + tt); const bf16_t* pr = P + (size_t)row * LDP;
            {
                const u32x4 qw = *(const u32x4*)(pr + CQ + 8 * part), kw = *(const u32x4*)(pr + CK + 8 * part), vw = *(const u32x4*)(pr + CV + 8 * part);
                float q[8] = {bflo(qw.x), bfhi(qw.x), bflo(qw.y), bfhi(qw.y), bflo(qw.z), bfhi(qw.z), bflo(qw.w), bfhi(qw.w)};
                float k[8] = {bflo(kw.x), bfhi(kw.x), bflo(kw.y), bfhi(kw.y), bflo(kw.z), bfhi(kw.z), bflo(kw.w), bfhi(kw.w)};
                float dc[8];
                if (mx == 0) {
                    const u32x4 l0 = *(const u32x4*)(pr + C_LR + 16 * d), l1 = *(const u32x4*)(pr + C_LR + 16 * d + 8);
                    const float lr[16] = {bflo(l0.x), bfhi(l0.x), bflo(l0.y), bfhi(l0.y), bflo(l0.z), bfhi(l0.z), bflo(l0.w), bfhi(l0.w), bflo(l1.x), bfhi(l1.x), bflo(l1.y), bfhi(l1.y), bflo(l1.z), bfhi(l1.z), bflo(l1.w), bfhi(l1.w)};
                    float z[8];
#pragma unroll
                    for (int e = 0; e < 8; ++e) z[e] = gba[8 * part + e];
#pragma unroll
                    for (int r = 0; r < 16; ++r) { const f32x4 w0 = *(const f32x4*)(wa2 + r * 512 + 8 * part), w1 = *(const f32x4*)(wa2 + r * 512 + 8 * part + 4);
#pragma unroll
                        for (int e = 0; e < 4; ++e) { z[e] += lr[r] * w0[e]; z[4 + e] += lr[r] * w1[e]; } }
#pragma unroll
                    for (int e = 0; e < 8; ++e) dc[e] = __expf(logsigmoidf_(z[e]) * 0.0625f);
                } else {
#pragma unroll
                    for (int e = 0; e < 8; ++e) dc[e] = gamma;
                    if (row < TLAT) {
                        const int t = row & (SEQ - 1), i0 = 8 * (part & 7);
                        const u32x4 qo = *(const u32x4*)(pr + CQ + 8 * (part ^ 8)), ko = *(const u32x4*)(pr + CK + 8 * (part ^ 8));
                        const float q2[8] = {bflo(qo.x), bfhi(qo.x), bflo(qo.y), bfhi(qo.y), bflo(qo.z), bfhi(qo.z), bflo(qo.w), bfhi(qo.w)};
                        const float k2[8] = {bflo(ko.x), bfhi(ko.x), bflo(ko.y), bfhi(ko.y), bflo(ko.z), bfhi(ko.z), bflo(ko.w), bfhi(ko.w)};
#pragma unroll
                        for (int e = 0; e < 8; ++e) { const float cs = rcos[t * 64 + i0 + e], sn = rsin[t * 64 + i0 + e];
                            if (part < 8) { q[e] = q[e] * cs - q2[e] * sn; k[e] = k[e] * cs - k2[e] * sn; }
                            else { q[e] = q2[e] * sn + q[e] * cs; k[e] = k2[e] * sn + k[e] * cs; } }
                    }
                }
                LAS float* dq = sq + tt * 128 + 8 * part; LAS float* dk = sk + tt * 128 + 8 * part; LAS float* dd = sd + tt * 128 + 8 * part; LAS float* dv = sv + tt * 128 + 8 * part;
                *(LAS f32x4*)dq = (f32x4){q[0], q[1], q[2], q[3]}; *(LAS f32x4*)(dq + 4) = (f32x4){q[4], q[5], q[6], q[7]};
                *(LAS f32x4*)dk = (f32x4){k[0], k[1], k[2], k[3]}; *(LAS f32x4*)(dk + 4) = (f32x4){k[4], k[5], k[6], k[7]};
                *(LAS f32x4*)dd = (f32x4){dc[0], dc[1], dc[2], dc[3]}; *(LAS f32x4*)(dd + 4) = (f32x4){dc[4], dc[5], dc[6], dc[7]};
                *(LAS f32x4*)dv = (f32x4){bflo(vw.x), bfhi(vw.x), bflo(vw.y), bfhi(vw.y)}; *(LAS f32x4*)(dv + 4) = (f32x4){bflo(vw.z), bfhi(vw.z), bflo(vw.w), bfhi(vw.w)};
            }
            __syncthreads();
            if (d) scan_steps<true>(sq, sk, sd, sv, so, S, F.wave, F.lane); else scan_steps<false>(sq, sk, sd, sv, so, S, F.wave, F.lane);
            __syncthreads();
            { const f32x4 o0 = *(const LAS f32x4*)(so + tt * 128 + 8 * part), o1 = *(const LAS f32x4*)(so + tt * 128 + 8 * part + 4);
              u32x4 w; w.x = pk2(o0[0], o0[1]); w.y = pk2(o0[2], o0[3]); w.z = pk2(o1[0], o1[1]); w.w = pk2(o1[2], o1[3]);
              *(u32x4*)(O + (size_t)row * 1024 + 256 * h + 128 * js + 8 * part) = w; }
        }
        __syncthreads();
    }
}

__device__ __forceinline__ void phase_finish(const Frame& F, int li, int nrows) {
    const bf16_t* P = (const bf16_t*)(F.ws + WS_P); const bf16_t* OB = (const bf16_t*)(F.ws + WS_B); const bf16_t* HB = (const bf16_t*)(F.ws + WS_E); bf16_t* A3 = (bf16_t*)(F.ws + WS_C);
    const float* gnorm = F.in[11] + (size_t)li * 1024; const float* rnorm = F.in[19] + (size_t)li * 1024;
    const size_t RS = (size_t)TT * 1024;
    for (int row = F.gw; row < nrows; row += F.NGW) {
        const bf16_t* pr = P + (size_t)row * LDP; const size_t ro = (size_t)row * 1024;
#pragma unroll
        for (int j = 0; j < 4; ++j) {
            const int c = 4 * F.lane + 256 * j;
            {
                const f32x4 o = ld4bf(OB + ro + c) + ld4bf(OB + RS + ro + c);
                const float ss = wave_sum((o[0] * o[0] + o[1] * o[1]) + (o[2] * o[2] + o[3] * o[3])); const float rs = rsqrtf(ss * (1.0f / 256.0f) + EPS);
                const f32x4 g = ld4bf(pr + C_GG + c), gn = *(const f32x4*)(gnorm + c); u32x2 w;
                w.x = pk2(o[0] * rs * gn[0] * siluf_(g[0]), o[1] * rs * gn[1] * siluf_(g[1])); w.y = pk2(o[2] * rs * gn[2] * siluf_(g[2]), o[3] * rs * gn[3] * siluf_(g[3]));
                *(u32x2*)(A3 + ro + c) = w; }
            {
                const f32x4 hh = ld4bf(HB + ro + c) + ld4bf(HB + RS + ro + c), g = ld4bf(pr + C_LG + c); u32x2 w;
                w.x = pk2(hh[0] * gelu_tanh_(g[0]), hh[1] * gelu_tanh_(g[1])); w.y = pk2(hh[2] * gelu_tanh_(g[2]), hh[3] * gelu_tanh_(g[3]));
                *(u32x2*)(A3 + RS + ro + c) = w; }
            {
                f32x4 o = ld4bf(OB + 2 * RS + ro + c) + ld4bf(OB + 3 * RS + ro + c);
                const float mean = wave_sum((o[0] + o[1]) + (o[2] + o[3])) * (1.0f / 256.0f); o = o - mean;
                const float ss = wave_sum((o[0] * o[0] + o[1] * o[1]) + (o[2] * o[2] + o[3] * o[3])); const float rs = rsqrtf(ss * (1.0f / 256.0f) + EPS);
                const f32x4 g = ld4bf(pr + C_RG + c), gn = *(const f32x4*)(rnorm + c); u32x2 w;
                w.x = pk2(o[0] * rs * gn[0] * siluf_(g[0]), o[1] * rs * gn[1] * siluf_(g[1])); w.y = pk2(o[2] * rs * gn[2] * siluf_(g[2]), o[3] * rs * gn[3] * siluf_(g[3]));
                *(u32x2*)(A3 + 2 * RS + ro + c) = w; }
        }
    }
}

__device__ __forceinline__ void phase_norm2_router(const Frame& F, int li, int ntok) {
    LAS float* wrT = (LAS float*)F.lds;
    LAS unsigned* hist = (LAS unsigned*)(F.lds + 131072); LAS unsigned* hbase = hist + 32;
    const float* wr = F.in[22] + (size_t)li * 1024 * 32; const float* br = F.in[23] + li * 32;
    for (int i = F.tid; i < 32768; i += NTHR) wrT[(i & 31) * 1024 + (i >> 5)] = wr[i];
    if (F.tid < 32) hist[F.tid] = 0u;
    __syncthreads();
    const float* xs = (const float*)(F.ws + WS_XS); const float* mods = (const float*)(F.ws + WS_MODS) + (size_t)li * 9 * 6144;
    bf16_t* xn2 = (bf16_t*)(F.ws + WS_D); int* tok_e = (int*)(F.ws + WS_TOKE); float* tok_w = (float*)(F.ws + WS_TOKW); int* tok_p = (int*)(F.ws + WS_TOKP);
    unsigned* cnt = (unsigned*)(F.ws + WS_CTL) + CW_CNT + li * 32;
    for (int row = F.gw; row < ntok; row += F.NGW) {
        const float* mp = mods + mrow_of(row) * 6144;
        const RowV y = norm_mod(load_row(xs + (size_t)row * D, F.lane), F.in[7] + (size_t)li * 1024, mp + 3 * 1024, mp + 4 * 1024, F.lane);
        store_row_bf16(xn2 + (size_t)row * D, y, F.lane);
        float lg[32];
#pragma unroll
        for (int e = 0; e < 32; ++e) { float s = 0.f;
#pragma unroll
            for (int j = 0; j < 4; ++j) { const f32x4 w = *(const LAS f32x4*)(wrT + e * 1024 + 4 * F.lane + 256 * j); s += (y.v[j][0] * w[0] + y.v[j][1] * w[1]) + (y.v[j][2] * w[2] + y.v[j][3] * w[3]); }
            lg[e] = wave_sum(s) + br[e]; }
        unsigned taken = 0u; float tl[4]; int te[4];
#pragma unroll
        for (int k = 0; k < 4; ++k) { float best = -3.0e38f; int bi = 0;
#pragma unroll
            for (int e = 0; e < 32; ++e) { const bool ok = !((taken >> e) & 1u) && lg[e] > best; best = ok ? lg[e] : best; bi = ok ? e : bi; }
            taken |= 1u << bi; tl[k] = best; te[k] = bi; }
        const float e1 = __expf(tl[1] - tl[0]), e2 = __expf(tl[2] - tl[0]), e3 = __expf(tl[3] - tl[0]); const float inv = 1.0f / (1.0f + e1 + e2 + e3);
        if (F.lane < 4) { const int k = F.lane; const int ek = k == 0 ? te[0] : k == 1 ? te[1] : k == 2 ? te[2] : te[3]; const float wk = (k == 0 ? 1.0f : k == 1 ? e1 : k == 2 ? e2 : e3) * inv;
            const unsigned lp = atomicAdd((unsigned*)&hist[ek], 1u);
            tok_e[row * 4 + k] = ek; tok_w[row * 4 + k] = wk; tok_p[row * 4 + k] = (int)lp; }
    }
    __syncthreads();
    if (F.tid < 32) hbase[F.tid] = __hip_atomic_fetch_add(cnt + F.tid, hist[F.tid], __ATOMIC_RELAXED, __HIP_MEMORY_SCOPE_AGENT);
    __syncthreads();
    for (int row = F.gw; row < ntok; row += F.NGW) if (F.lane < 4) { const int i = row * 4 + F.lane; tok_p[i] += (int)hbase[tok_e[i]]; }
    __syncthreads();
}
__device__ __forceinline__ void phase_dispatch(const Frame& F, int li, int ntok) {
    LAS unsigned* pstart = (LAS unsigned*)F.lds;
    unsigned* ctl = (unsigned*)(F.ws + WS_CTL); unsigned* cnt = ctl + CW_CNT + li * 32; unsigned* tile_e = ctl + CW_TILE + li * 1024;
    if (F.tid == 0) { unsigned ps = 0;
        for (int e = 0; e < 32; ++e) { const unsigned c = __hip_atomic_load(cnt + e, __ATOMIC_RELAXED, __HIP_MEMORY_SCOPE_AGENT), nt = (c + 255u) >> 8; pstart[e] = ps;
            if (F.bx == 0) for (unsigned j = 0; j < nt; ++j) tile_e[(ps >> 8) + j] = (unsigned)e;
            ps += nt << 8; }
        if (F.bx == 0) ctl[CW_NT + li] = ps >> 8; }
    __syncthreads();
    const bf16_t* xn2 = (const bf16_t*)(F.ws + WS_D); bf16_t* xg = (bf16_t*)(F.ws + WS_P);
    const int* tok_e = (const int*)(F.ws + WS_TOKE); const int* tok_p = (const int*)(F.ws + WS_TOKP); int* tok_s = (int*)(F.ws + WS_TOKS);
    for (int it = F.gw; it < ntok * 4; it += F.NGW) {
        const int tok = it >> 2; const int slot = (int)pstart[tok_e[it]] + tok_p[it];
        if (F.lane == 0) tok_s[it] = slot;
        const u32x4* s = (const u32x4*)(xn2 + (size_t)tok * 1024); u32x4* dst = (u32x4*)(xg + (size_t)slot * 1024);
        dst[F.lane] = s[F.lane]; dst[64 + F.lane] = s[64 + F.lane];
    }
    __syncthreads();
}
__device__ __forceinline__ void phase_combine(const Frame& F, int li, int ntok, bool last) {
    float* xs = (float*)(F.ws + WS_XS); const bf16_t* Y = (const bf16_t*)(F.ws + WS_B); bf16_t* xn = (bf16_t*)(F.ws + WS_D);
    const float* mods = (const float*)(F.ws + WS_MODS); const float* tok_w = (const float*)(F.ws + WS_TOKW); const int* tok_s = (const int*)(F.ws + WS_TOKS);
    for (int row = F.gw; row < ntok; row += F.NGW) {
        const int mr = mrow_of(row); const float* gp = mods + ((size_t)li * 9 + mr) * 6144 + 5 * 1024;
        RowV x = load_row(xs + (size_t)row * D, F.lane);
        const int s0 = tok_s[row * 4], s1 = tok_s[row * 4 + 1], s2 = tok_s[row * 4 + 2], s3 = tok_s[row * 4 + 3];
        const float w0 = tok_w[row * 4], w1 = tok_w[row * 4 + 1], w2 = tok_w[row * 4 + 2], w3 = tok_w[row * 4 + 3];
#pragma unroll
        for (int j = 0; j < 4; ++j) { const int c = 4 * F.lane + 256 * j;
            const f32x4 y = ld4bf(Y + (size_t)s0 * 1024 + c) * w0 + ld4bf(Y + (size_t)s1 * 1024 + c) * w1 + ld4bf(Y + (size_t)s2 * 1024 + c) * w2 + ld4bf(Y + (size_t)s3 * 1024 + c) * w3;
            x.v[j] = x.v[j] + *(const f32x4*)(gp + c) * y; }
        if (!last) {
#pragma unroll
            for (int j = 0; j < 4; ++j) *(f32x4*)(xs + (size_t)row * D + 4 * F.lane + 256 * j) = x.v[j];
            const float* mp = mods + ((size_t)(li + 1) * 9 + mr) * 6144;
            const RowV y = norm_mod(x, F.in[6] + (size_t)(li + 1) * 1024, mp, mp + 1024, F.lane);
            store_row_bf16(xn + (size_t)row * D, y, F.lane);
        } else {
            const float rs = rsqrtf(row_sumsq(x) * (1.0f / D) + EPS);
#pragma unroll
            for (int j = 0; j < 4; ++j) { const int c = 4 * F.lane + 256 * j; *(f32x4*)(F.out + (size_t)row * D + c) = (x.v[j] * rs) * *(const f32x4*)(F.in[28] + c); }
        }
    }
}

#ifndef MK_ONE_LAUNCH
#define MK_ONE_LAUNCH 1
#endif
constexpr int NPH_LAYER = 15, NPHASES = 2 + 2 * NPH_LAYER;
struct Args { const float* in[29]; float* out; unsigned char* ws; int ph_lo, ph_hi, region, pad; };
#ifndef MK_PHMASK
#define MK_PHMASK 0x7fff
#endif
#define IN(k) (lo <= (k) && (k) < hi)
#define EN(j) ((MK_PHMASK >> (j)) & 1)
#define SEAM(k) do { if (IN(k) && IN((k) + 1)) xcd_barrier(bar); } while (0)
#define MKF() Frame F; { unsigned char* ws_ = args.ws; asm volatile("" : "+s"(ws_)); F.ws = ws_; F.lds = (LAS unsigned char*)lds_raw; F.out = args.out; F.in = args.in; \
        int tid_ = threadIdx.x, bx_ = blockIdx.x; asm volatile("" : "+v"(tid_), "+s"(bx_)); F.tid = tid_; F.bx = bx_; F.lane = F.tid & 63; F.wave = __builtin_amdgcn_readfirstlane(F.tid >> 6); F.G = gridDim.x; \
        F.gw = F.bx * NWAVES + F.wave; F.NGW = F.G * NWAVES; F.gtid = F.bx * NTHR + F.tid; F.NGT = F.G * NTHR; }
template <int li> __device__ __forceinline__ void run_layer(const Args& args, unsigned char* lds_raw, const XcdBarrier& bar, const int lo, const int hi) {
        const int pb = 2 + NPH_LAYER * li; const bool last = (li == 1); const int nrows = last ? TLAT : TT, nMt = nrows / 256;
        if (EN(0) && IN(pb + 0)) { MKF(); phase_W(F, li); if (li == 0) phase_norm_in(F); __syncthreads(); }
        SEAM(pb + 0);
        if (EN(1) && IN(pb + 1)) { MKF(); unsigned* ctl = (unsigned*)(F.ws + WS_CTL); (void)ctl;
            pg8::Gemm g{1024, 1024, 1024}; PlainOrder S; S.A = (const char*)(F.ws + WS_D); S.B = (const char*)(F.ws + WS_WIN); S.astep = 256 * 1024 * 2; S.bstep = 256 * 1024 * 2; S.nM = TT / 256; S.nN = LDP / 256; S.G = F.G; S.c = F.bx;
            EpiBf16Bias E{(bf16_t*)(F.ws + WS_P), LDP, nullptr, 0};
            pg8::gemm_phase<EpiBf16Bias, PlainOrder, true, true>(F.lds, g, S, E);
        }
        SEAM(pb + 1);
        if (EN(2) && IN(pb + 2)) { MKF(); phase_conv(F, li); }
        SEAM(pb + 2);
        if (EN(3) && IN(pb + 3)) { MKF(); unsigned* ctl = (unsigned*)(F.ws + WS_CTL); (void)ctl;
            pg8::Gemm g{1024, 256, 256}; LruOrder S; S.A = (const char*)(F.ws + WS_D); S.B = (const char*)(F.ws + WS_WLRU); S.nM = TT / 256; S.G = F.G; S.c = F.bx;
            EpiLru E{(const bf16_t*)(F.ws + WS_D), (bf16_t*)(F.ws + WS_C), (bf16_t*)(F.ws + WS_C + 2 * ROWB), F.in[15] + (size_t)li * 2048, F.in[17] + (size_t)li * 2048, (const float*)(F.ws + WS_LSL)};
            pg8::gemm_phase<EpiLru, LruOrder, true, true>(F.lds, g, S, E);
        }
        SEAM(pb + 3);
        if (EN(4) && IN(pb + 4)) { MKF(); phase_lru_scan<false>(F); }
        SEAM(pb + 4);
        if (EN(5) && IN(pb + 5)) { MKF(); phase_lru_scan<true>(F); }
        SEAM(pb + 5);
        if (EN(6) && IN(pb + 6)) { MKF(); phase_scan_ref(F, li); }
        SEAM(pb + 6);
        if (EN(7) && IN(pb + 7)) { MKF(); phase_finish(F, li, nrows); }
        SEAM(pb + 7);
        if (EN(8) && IN(pb + 8)) { MKF(); unsigned* ctl = (unsigned*)(F.ws + WS_CTL); (void)ctl;
            pg8::Gemm g{1024, 1024, 1024}; BranchOrder S; S.A = (const char*)(F.ws + WS_C); S.B = (const char*)(F.ws + WS_WBR); S.nM = nMt; S.G = F.G; S.c = F.bx;
            EpiBranch E{(const bf16_t*)(F.ws + WS_P), (float*)(F.ws + WS_B), (bf16_t*)(F.ws + WS_B + 2 * ROWB)};
            pg8::gemm_phase<EpiBranch, BranchOrder, true, true>(F.lds, g, S, E);
        }
        SEAM(pb + 8);
        if (EN(9) && IN(pb + 9)) { MKF(); unsigned* ctl = (unsigned*)(F.ws + WS_CTL); (void)ctl;
            pg8::Gemm g{1024, 1024, 1024}; PlainOrder S; S.A = (const char*)(F.ws + WS_B + 2 * ROWB); S.B = (const char*)(F.ws + WS_WOUT); S.astep = 256 * 1024 * 2; S.bstep = 256 * 1024 * 2; S.nM = nMt; S.nN = 4; S.G = F.G; S.c = F.bx;
            float* xs = (float*)(F.ws + WS_XS);
            EpiOut E{li == 0 ? F.in[0] : xs, li == 0 ? F.in[2] : xs + (size_t)TLAT * D, xs, (const float*)(F.ws + WS_MODS) + (size_t)li * 9 * 6144 + 2 * 1024};
            pg8::gemm_phase<EpiOut, PlainOrder, true, true>(F.lds, g, S, E);
        }
        SEAM(pb + 9);
        if (EN(10) && IN(pb + 10)) { MKF(); phase_norm2_router(F, li, nrows); }
        SEAM(pb + 10);
        if (EN(11) && IN(pb + 11)) { MKF(); phase_dispatch(F, li, nrows); }
        SEAM(pb + 11);
        if (EN(12) && IN(pb + 12)) { MKF(); unsigned* ctl = (unsigned*)(F.ws + WS_CTL); (void)ctl;
            pg8::Gemm g{1024, 1024, 1024}; MoeOrder S; S.A = (const char*)(F.ws + WS_P); S.B = (const char*)(F.ws + WS_WGU); S.tile_e = ctl + CW_TILE + li * 1024; S.estep = (size_t)2048 * 1024 * 2;
            S.nM = (int)ctl[CW_NT + li]; S.nN = 8; S.G = F.G; S.c = F.bx;
            EpiSwiglu E{(bf16_t*)(F.ws + WS_P + 288 * MiB), F.in[25] + (size_t)li * 32 * 2048};
            pg8::gemm_phase<EpiSwiglu, MoeOrder, true, true>(F.lds, g, S, E);
        }
        SEAM(pb + 12);
        if (EN(13) && IN(pb + 13)) { MKF(); unsigned* ctl = (unsigned*)(F.ws + WS_CTL); (void)ctl;
            pg8::Gemm g{1024, 1024, 1024}; MoeOrder S; S.A = (const char*)(F.ws + WS_P + 288 * MiB); S.B = (const char*)(F.ws + WS_WDN); S.tile_e = ctl + CW_TILE + li * 1024; S.estep = (size_t)1024 * 1024 * 2;
            S.nM = (int)ctl[CW_NT + li]; S.nN = 4; S.G = F.G; S.c = F.bx;
            EpiBf16Bias E{(bf16_t*)(F.ws + WS_B), 1024, F.in[27] + (size_t)li * 32 * 1024, 1024};
            pg8::gemm_phase<EpiBf16Bias, MoeOrder, true, true>(F.lds, g, S, E);
        }
        SEAM(pb + 13);
        if (EN(14) && IN(pb + 14)) { MKF(); phase_combine(F, li, nrows, last); }
        SEAM(pb + 14);
    }
__global__ void __launch_bounds__(NTHR, 2) mk_fwd(Args args) {
    extern __shared__ __attribute__((aligned(16))) unsigned char lds_raw[];
    const int tid0 = threadIdx.x;
    volatile LAS unsigned* MISC = (volatile LAS unsigned*)((LAS unsigned char*)lds_raw + MISC_OFF);
    if (tid0 < 32) MISC[tid0] = 0u;
    __syncthreads();
    unsigned* ctl0 = (unsigned*)(args.ws + WS_CTL);
    const int lo = args.ph_lo, hi = args.ph_hi;
    XcdBarrier bar; bar.bar = ctl0 + CW_BAR + args.region * 4096; bar.x = 0; bar.st = MISC + 8;
    if (hi - lo > 1) bar = xcd_barrier_post(ctl0 + CW_BAR + args.region * 4096, MISC + 8);

    if (IN(0)) { MKF(); phase_proA(F); }
    SEAM(0);
    if (IN(1)) { MKF(); phase_proB(F); }
    SEAM(1);
    run_layer<0>(args, lds_raw, bar, lo, hi);
    run_layer<1>(args, lds_raw, bar, lo, hi);
}

extern "C" void kernel_launch(void* const* d_in, const int* in_sizes, int n_in, void* d_out, int out_size, void* d_ws, size_t ws_size, hipStream_t stream) {
    static int grid = 0;
    if (grid == 0) {
        if (n_in != 29 || ws_size < WS_END || out_size != TLAT * D) { fprintf(stderr, "kernel_launch: unexpected problem: n_in %d ws %zu out %d\n", n_in, ws_size, out_size); grid = -1; return; }
        int dev = 0, cus = 0;
        if (hipGetDevice(&dev) != hipSuccess || hipDeviceGetAttribute(&cus, hipDeviceAttributeMultiprocessorCount, dev) != hipSuccess) { grid = -1; return; }
        if (hipFuncSetAttribute((const void*)mk_fwd, hipFuncAttributeMaxDynamicSharedMemorySize, LDS_BYTES) != hipSuccess) { fprintf(stderr, "kernel_launch: hipFuncSetAttribute failed\n"); grid = -1; return; }
        int per_cu = 0;
        if (hipOccupancyMaxActiveBlocksPerMultiprocessor(&per_cu, (const void*)mk_fwd, NTHR, LDS_BYTES) != hipSuccess || per_cu < 1) fprintf(stderr, "kernel_launch: occupancy query reports %d\n", per_cu);
        (void)hipGetLastError();
        grid = cus;
    }
    if (grid < 0) return;
    (void)hipMemsetAsync((char*)d_ws + WS_CTL, 0, CTL_BYTES, stream);
    Args a{};
    for (int i = 0; i < 29; ++i) a.in[i] = (const float*)d_in[i];
    a.out = (float*)d_out; a.ws = (unsigned char*)d_ws;
#if MK_ONE_LAUNCH
    a.ph_lo = 0; a.ph_hi = NPHASES; a.region = 0;
    hipLaunchKernelGGL(mk_fwd, dim3(grid), dim3(NTHR), LDS_BYTES, stream, a);
#else
    for (int p = 0; p < NPHASES; ++p) { a.ph_lo = p; a.ph_hi = p + 1; a.region = 0; hipLaunchKernelGGL(mk_fwd, dim3(grid), dim3(NTHR), LDS_BYTES, stream, a); }
#endif
}
```

```cpp
#include <hip/hip_runtime.h>
#include <cstdio>
#include <cstdint>

#define LAS __attribute__((address_space(3)))
typedef unsigned short bf16_t;
typedef short bf16x8 __attribute__((ext_vector_type(8)));
typedef float f32x4 __attribute__((ext_vector_type(4)));
typedef float f32x2 __attribute__((ext_vector_type(2)));
typedef unsigned u32x4 __attribute__((ext_vector_type(4)));
typedef unsigned u32x2 __attribute__((ext_vector_type(2)));

constexpr int D = 1024, NBATCH = 8, SEQ = 4096, CTXL = 256;
constexpr int TLAT = NBATCH * SEQ, TCTX = NBATCH * CTXL, TT = TLAT + TCTX;
constexpr int LDP = 11520;
constexpr int C_GQ = 0, C_GK = 512, C_GV = 1024, C_GG = 2048, C_LX = 3072, C_LG = 4096, C_RQ = 5120, C_RK = 5632, C_RV = 6144, C_RG = 7168, C_MG = 8192, C_LR = 11264;
constexpr int IN_TOTAL = 11296, NE = 32;
constexpr int SLOT_TILES_MAX = 576;
constexpr float EPS = 1e-6f;

constexpr size_t MiB = (size_t)1 << 20;
constexpr size_t WS_CTL = 0, CTL_BYTES = 1 * MiB;
constexpr size_t WS_MODP = 1 * MiB, WS_MODS = 5 * MiB, WS_COS = 6 * MiB, WS_SIN = 7 * MiB, WS_LSL = 8 * MiB, WS_CARA = 9 * MiB, WS_CARH = 11 * MiB;
constexpr size_t WS_TOKE = 13 * MiB, WS_TOKW = WS_TOKE + 768 * 1024, WS_TOKP = WS_TOKW + 768 * 1024, WS_TOKS = WS_TOKP + 768 * 1024;
constexpr size_t WS_WIN = 16 * MiB, WS_WLRU = 39 * MiB, WS_WBR = 41 * MiB, WS_WOUT = 47 * MiB, WS_WGU = 49 * MiB, WS_WDN = 177 * MiB;
constexpr size_t WS_XS = 241 * MiB, WS_P = 377 * MiB, WS_B = 1142 * MiB, WS_C = 1430 * MiB, WS_D = 1702 * MiB, WS_E = 1770 * MiB, WS_END = 1906 * MiB;
constexpr size_t ROWB = (size_t)TT * D * 2;
static_assert(ROWB == 68 * MiB, "row buffer");
constexpr int CW_CNT = 1024, CW_NT = 1024 + 128, CW_TILE = 2048, CW_BAR = 8192;

__device__ __forceinline__ float bflo(unsigned w) { return __uint_as_float(w << 16); }
__device__ __forceinline__ float bfhi(unsigned w) { return __uint_as_float(w & 0xffff0000u); }
__device__ __forceinline__ unsigned f2bf(float f) { unsigned u = __float_as_uint(f); return (u + 0x7fffu + ((u >> 16) & 1u)) >> 16; }
__device__ __forceinline__ unsigned pk2(float lo, float hi) { return f2bf(lo) | (f2bf(hi) << 16); }
__device__ __forceinline__ float sigmoidf_(float x) { return __builtin_amdgcn_rcpf(1.0f + __expf(-x)); }
__device__ __forceinline__ float siluf_(float x) { return x * sigmoidf_(x); }
__device__ __forceinline__ float logsigmoidf_(float z) { return fminf(z, 0.f) - __logf(1.0f + __expf(-fabsf(z))); }
__device__ __forceinline__ float gelu_tanh_(float x) { const float u = 0.7978845608028654f * (x + 0.044715f * x * x * x); const float t = 1.0f - 2.0f * __builtin_amdgcn_rcpf(__expf(2.0f * u) + 1.0f); return 0.5f * x * (1.0f + t); }
__device__ __forceinline__ float wave_sum(float v) {
#pragma unroll
    for (int o = 1; o < 64; o <<= 1) v += __shfl_xor(v, o);
    return v;
}
#define LDS_WAIT() asm volatile("s_waitcnt lgkmcnt(0)" ::: "memory")

namespace pg8 {
#define PG8_LAS __attribute__((address_space(3)))
constexpr int BM = 256, BK = 64, HALF = 128, HTB = HALF * BK * 2, STAGE_BYTES = 8 * HTB, NXCD = 8, WGM = 8;
__host__ __device__ __forceinline__ int lds_byte(int r, int c) { const int st = (r >> 4) * 2 + (c >> 5), rr = r & 15, cc = c & 31, ob = rr * 64 + cc * 2; return st * 1024 + (ob ^ (((ob >> 9) & 1) << 5)); }
__host__ __device__ __forceinline__ void stage_rc(int b, int& R, int& C) { const int st = b / 1024, sb = b % 1024, swz = sb ^ (((sb >> 9) & 1) << 5); R = (st >> 1) * 16 + swz / 64; C = (st & 1) * 32 + (swz % 64) / 2; }
__host__ __device__ __forceinline__ int perm32(int rho) { const int n = rho >> 4, i = rho & 15; return 8 * (i >> 2) + 4 * n + (i & 3); }
struct Unit { int pm, pn, aux; const char* a; const char* b; };
struct Gemm { int lda, ldb, K; };
__device__ __forceinline__ void tile_of(int L, int nM, int nN, int& pm, int& pn) {
    const int nwg = nM * nN; int wgid = L; { const int q = nwg / NXCD, r = nwg % NXCD, xcd = wgid % NXCD, off = wgid / NXCD; wgid = (xcd < r ? xcd * (q + 1) : r * (q + 1) + (xcd - r) * q) + off; }
    const int nig = WGM * nN, gid = wgid / nig, fm = gid * WGM, gsz = (nM - fm) < WGM ? (nM - fm) : WGM;
    pm = fm + ((wgid % nig) % gsz); pn = (wgid % nig) / gsz;
}
__device__ __forceinline__ unsigned cvt_pk_bf16(float lo, float hi) { unsigned r; asm volatile("v_cvt_pk_bf16_f32 %0, %1, %2" : "=v"(r) : "v"(lo), "v"(hi)); return r; }
template <class Epi, class Sched, bool ALIGN_EPI = false, bool SP2 = false>
__device__ __forceinline__ void gemm_phase(PG8_LAS unsigned char* lds, const Gemm g, const Sched& S, const Epi& E) {
    int tid_o = threadIdx.x; asm volatile("" : "+v"(tid_o));
    const int tid = tid_o, wid = __builtin_amdgcn_readfirstlane(tid >> 6), lane = tid & 63, wr = wid >> 2, wc = wid & 3, fr = lane & 15, fq = lane >> 4;
    const int K = g.K, nt = K / BK;
    unsigned voffA[2], voffB[2];
#pragma unroll
    for (int i = 0; i < 2; ++i) { int R, C; stage_rc(tid * 16 + i * 8192, R, C); const int Rb = Epi::PERM ? ((R & ~31) + perm32(R & 31)) : R;
        voffA[i] = (unsigned)(R * g.lda + C) * 2u; voffB[i] = (unsigned)(Rb * g.ldb + C) * 2u; }
    const size_t kstep = (size_t)(BK * 2);
    const size_t hstepA = (size_t)HALF * g.lda * 2, hstepB = (size_t)HALF * g.ldb * 2;
    const unsigned ldsw = (unsigned)wid * 1024u;
    const int aoff = lds_byte(wr * 64 + fr, fq * 8), boff = lds_byte(wc * 32 + fr, fq * 8);
#define PG8_SA(b, h) (((b) * 2 + (h)) * HTB)
#define PG8_SB(b, h) ((4 + (b) * 2 + (h)) * HTB)
#define PG8_STAGE(bufoff, gbase, voff) do { _Pragma("unroll") for (int _i = 0; _i < 2; ++_i) \
        __builtin_amdgcn_global_load_lds((const unsigned*)((const char*)(gbase) + (voff)[_i]), (PG8_LAS unsigned*)(lds + (bufoff) + ldsw + _i * 8192), 16, 0, 0); } while (0)
#define PG8_LDA(dst, b, h) do { _Pragma("unroll") for (int m = 0; m < 4; ++m) _Pragma("unroll") for (int k = 0; k < 2; ++k) dst[m][k] = *(const PG8_LAS bf16x8*)(lds + PG8_SA(b, h) + aoff + m * 2048 + k * 1024); } while (0)
#define PG8_LDB(dst, b, h) do { _Pragma("unroll") for (int n = 0; n < 2; ++n) _Pragma("unroll") for (int k = 0; k < 2; ++k) dst[n][k] = *(const PG8_LAS bf16x8*)(lds + PG8_SB(b, h) + boff + n * 2048 + k * 1024); } while (0)
#define PG8_MMA(ai, bj, At, Bt) do { __builtin_amdgcn_s_setprio(1); _Pragma("unroll") for (int m = 0; m < 4; ++m) _Pragma("unroll") for (int n = 0; n < 2; ++n) _Pragma("unroll") for (int k = 0; k < 2; ++k) \
        acc[ai][bj][m][n] = __builtin_amdgcn_mfma_f32_16x16x32_bf16(Bt[n][k], At[m][k], acc[ai][bj][m][n], 0, 0, 0); __builtin_amdgcn_s_setprio(0); } while (0)
#define PG8_WAIT_V(n) asm volatile("s_waitcnt vmcnt(" #n ")" ::: "memory")
#define PG8_WAIT_L(n) asm volatile("s_waitcnt lgkmcnt(" #n ")" ::: "memory")
#define PG8_BAR __builtin_amdgcn_s_barrier()
#define PG8_SCHED __builtin_amdgcn_sched_barrier(0)
    Unit cur, nxt; int ui = 0;
    if (!S.next(0, cur)) return;
    f32x4 acc[2][2][4][2];
#pragma unroll
    for (int a = 0; a < 2; ++a)
#pragma unroll
        for (int b = 0; b < 2; ++b)
#pragma unroll
            for (int m = 0; m < 4; ++m)
#pragma unroll
                for (int n = 0; n < 2; ++n) acc[a][b][m][n] = (f32x4){0.f, 0.f, 0.f, 0.f};
    bf16x8 At[4][2], B0[2][2], B1[2][2];
    const char* cA = cur.a; const char* cB = cur.b;
    S.a_ready(cur);
    if constexpr (SP2) {
        PG8_STAGE(PG8_SB(0, 0), cB, voffB); PG8_STAGE(PG8_SB(0, 1), cB + hstepB, voffB); PG8_STAGE(PG8_SA(0, 0), cA, voffA); PG8_STAGE(PG8_SA(0, 1), cA + hstepA, voffA);
        if (wr == 1) PG8_BAR;
        PG8_WAIT_V(2); PG8_BAR;
        PG8_STAGE(PG8_SB(1, 0), cB + kstep, voffB); PG8_STAGE(PG8_SA(1, 0), cA + kstep, voffA); PG8_STAGE(PG8_SB(1, 1), cB + hstepB + kstep, voffB);
        PG8_WAIT_V(6); PG8_BAR;
    } else {
        PG8_STAGE(PG8_SB(0, 0), cB, voffB); PG8_STAGE(PG8_SA(0, 0), cA, voffA); PG8_STAGE(PG8_SB(0, 1), cB + hstepB, voffB); PG8_STAGE(PG8_SA(0, 1), cA + hstepA, voffA);
        if (wr == 1) PG8_BAR;
        PG8_WAIT_V(4); PG8_BAR;
        PG8_STAGE(PG8_SB(1, 0), cB + kstep, voffB); PG8_STAGE(PG8_SA(1, 0), cA + kstep, voffA); PG8_STAGE(PG8_SB(1, 1), cB + hstepB + kstep, voffB);
        PG8_WAIT_V(6); PG8_BAR;
    }
    for (;;) {
        const bool has_next = S.next(ui + 1, nxt);
        const char* nA = has_next ? nxt.a : cA; const char* nB = has_next ? nxt.b : cB;
        for (int t = 0; t < nt; t += 2) {
            const bool last = (t == nt - 2);
            const char* a1 = cA + (size_t)(t + 1) * kstep;
            const char* a2 = last ? nA : cA + (size_t)(t + 2) * kstep; const char* b2 = last ? nB : cB + (size_t)(t + 2) * kstep;
            const char* a3 = a2 + kstep; const char* b3 = b2 + kstep;
            if (last && has_next) S.a_ready(nxt);
            if constexpr (SP2) {
            PG8_LDB(B0, 0, 0); PG8_LDB(B1, 0, 1); PG8_SCHED; PG8_LDA(At, 0, 0); PG8_STAGE(PG8_SA(1, 1), a1 + hstepA, voffA);
            PG8_WAIT_V(8); PG8_WAIT_L(0); PG8_BAR; PG8_MMA(0, 0, At, B0); PG8_MMA(0, 1, At, B1); PG8_BAR; PG8_SCHED;
            PG8_LDA(At, 0, 1); PG8_STAGE(PG8_SB(0, 0), b2, voffB); PG8_STAGE(PG8_SB(0, 1), b2 + hstepB, voffB); PG8_STAGE(PG8_SA(0, 0), a2, voffA);
            PG8_WAIT_V(8); PG8_WAIT_L(0); PG8_BAR; PG8_MMA(1, 0, At, B0); PG8_MMA(1, 1, At, B1); PG8_BAR; PG8_SCHED;
            PG8_LDB(B0, 1, 0); PG8_LDB(B1, 1, 1); PG8_SCHED; PG8_LDA(At, 1, 0); PG8_STAGE(PG8_SA(0, 1), a2 + hstepA, voffA);
            PG8_WAIT_V(8); PG8_WAIT_L(0); PG8_BAR; PG8_MMA(0, 0, At, B0); PG8_MMA(0, 1, At, B1); PG8_BAR; PG8_SCHED;
            PG8_LDA(At, 1, 1); PG8_STAGE(PG8_SB(1, 0), b3, voffB); PG8_STAGE(PG8_SB(1, 1), b3 + hstepB, voffB); PG8_STAGE(PG8_SA(1, 0), a3, voffA);
            PG8_WAIT_V(8); PG8_WAIT_L(0); PG8_BAR; PG8_MMA(1, 0, At, B0); PG8_MMA(1, 1, At, B1); PG8_BAR; PG8_SCHED;
            } else {
            PG8_LDB(B0, 0, 0); PG8_SCHED; PG8_LDA(At, 0, 0); PG8_STAGE(PG8_SA(1, 1), a1 + hstepA, voffA);
            PG8_WAIT_L(8); PG8_BAR; PG8_WAIT_L(0); PG8_MMA(0, 0, At, B0); PG8_BAR; PG8_SCHED;
            PG8_LDB(B1, 0, 1); PG8_STAGE(PG8_SB(0, 0), b2, voffB);
            PG8_BAR; PG8_WAIT_L(0); PG8_MMA(0, 1, At, B1); PG8_BAR;
            PG8_LDA(At, 0, 1); PG8_STAGE(PG8_SA(0, 0), a2, voffA);
            PG8_BAR; PG8_WAIT_L(0); PG8_MMA(1, 0, At, B0); PG8_BAR; PG8_SCHED;
            PG8_STAGE(PG8_SB(0, 1), b2 + hstepB, voffB);
            PG8_WAIT_V(6); PG8_BAR; PG8_MMA(1, 1, At, B1); PG8_BAR;
            PG8_LDB(B0, 1, 0); PG8_SCHED; PG8_LDA(At, 1, 0); PG8_STAGE(PG8_SA(0, 1), a2 + hstepA, voffA);
            PG8_WAIT_L(8); PG8_BAR; PG8_WAIT_L(0); PG8_MMA(0, 0, At, B0); PG8_BAR; PG8_SCHED;
            PG8_LDB(B1, 1, 1); PG8_STAGE(PG8_SB(1, 0), b3, voffB);
            PG8_BAR; PG8_WAIT_L(0); PG8_MMA(0, 1, At, B1); PG8_BAR;
            PG8_LDA(At, 1, 1); PG8_STAGE(PG8_SA(1, 0), a3, voffA);
            PG8_BAR; PG8_WAIT_L(0); PG8_MMA(1, 0, At, B0); PG8_BAR; PG8_SCHED;
            PG8_STAGE(PG8_SB(1, 1), b3 + hstepB, voffB);
            PG8_WAIT_V(6); PG8_BAR; PG8_MMA(1, 1, At, B1); PG8_BAR;
            }
        }
        if constexpr (ALIGN_EPI) { if (wr == 0) PG8_BAR; }
        if constexpr (!Epi::AFTER_DRAIN) { E(acc, cur, wr, wc, fr, fq); S.done(cur); }
        if (!has_next) break;
#pragma unroll
        for (int a = 0; a < 2; ++a)
#pragma unroll
            for (int b = 0; b < 2; ++b)
#pragma unroll
                for (int m = 0; m < 4; ++m)
#pragma unroll
                    for (int n = 0; n < 2; ++n) acc[a][b][m][n] = (f32x4){0.f, 0.f, 0.f, 0.f};
        cur = nxt; cA = nA; cB = nB; ++ui;
        if constexpr (ALIGN_EPI) { if (wr == 1) PG8_BAR; }
    }
    PG8_WAIT_V(0);
    if constexpr (!ALIGN_EPI) { if (wr == 0) PG8_BAR; }
    PG8_BAR;
    if constexpr (Epi::AFTER_DRAIN) { E.fused(acc, cur, wr, wc, fr, fq, lds, wid, lane); S.done(cur); }
#undef PG8_SA
#undef PG8_SB
#undef PG8_STAGE
#undef PG8_LDA
#undef PG8_LDB
#undef PG8_MMA
#undef PG8_WAIT_V
#undef PG8_WAIT_L
#undef PG8_BAR
#undef PG8_SCHED
}
}

#define GAS __attribute__((address_space(1)))
typedef GAS unsigned gu32;
#define RLX_AGENT __ATOMIC_RELAXED, __HIP_MEMORY_SCOPE_AGENT
#define XB_TMO      128
#define XB_XCNT(j)  (256  + 64 * (j))
#define XB_XSUB(j)  (1280 + 64 * (j))
#define XB_XGEN(j)  (2304 + 64 * (j))
#define XB_TOP      3328
#define XB_TOPGEN   3392
#define XCD_BAR_WORDS 3456
#define XB_SPIN_CAP (1u << 18)

__device__ __forceinline__ unsigned xb_ld(unsigned* p)              { return __hip_atomic_load(p, __ATOMIC_RELAXED, __HIP_MEMORY_SCOPE_AGENT); }
__device__ __forceinline__ unsigned xb_add(unsigned* p, unsigned v) { return __hip_atomic_fetch_add(p, v, __ATOMIC_RELAXED, __HIP_MEMORY_SCOPE_AGENT); }
__device__ __forceinline__ unsigned xb_xcc_id() { return (unsigned)__builtin_amdgcn_s_getreg((3 << 11) | 20) & 0xFu; }
#define XB_SPIN(cond, bar) do { unsigned _sp = 0; while (cond) { __builtin_amdgcn_s_sleep(1); \
    if ((++_sp & 255u) == 0u) { if (xb_ld(&(bar)[XB_TMO])) break; if (_sp > XB_SPIN_CAP) { atomicAdd(&(bar)[XB_TMO], 1u); break; } } } } while (0)

struct XcdBarrier {
    unsigned* bar; unsigned x;
    volatile LAS unsigned* st;
};

__device__ __forceinline__ XcdBarrier xcd_barrier_post(unsigned* bar, volatile LAS unsigned* st) {
    XcdBarrier b; b.bar = bar; b.x = xb_xcc_id(); b.st = st;
    if (threadIdx.x == 0) (void)xb_add(&bar[XB_XCNT(b.x)], 1u);
    return b;
}
__device__ __forceinline__ void xcd_barrier_complete(unsigned* bar, unsigned x, unsigned& nloc, unsigned& nx) {
    const unsigned G = gridDim.x * gridDim.y * gridDim.z;
    unsigned sum, cnt, mine, sp = 0u;
    for (;;) {
        sum = 0u; cnt = 0u; mine = 0u;
#pragma unroll
        for (unsigned j = 0; j < 16; ++j) { const unsigned c = xb_ld(&bar[XB_XCNT(j)]); sum += c; cnt += (c > 0u) ? 1u : 0u; mine = (j == x) ? c : mine; }
        if (sum == G) break;
        __builtin_amdgcn_s_sleep(1);
        if ((++sp & 255u) == 0u) { if (xb_ld(&bar[XB_TMO])) break; if (sp > XB_SPIN_CAP) { atomicAdd(&bar[XB_TMO], 1u); break; } }
    }
    nloc = mine > 0u ? mine : 1u; nx = cnt > 0u ? cnt : 1u;
}

__device__ __forceinline__ void xcd_barrier(const XcdBarrier& b) {
    asm volatile("s_waitcnt vmcnt(0)" ::: "memory");
    __syncthreads();
    if (threadIdx.x == 0) {
        unsigned* bar = b.bar;
        __builtin_amdgcn_s_waitcnt(0);
        unsigned nloc = b.st[0], nx = b.st[1];
        if (nloc == 0u) { xcd_barrier_complete(bar, b.x, nloc, nx); b.st[0] = nloc; b.st[1] = nx; }
        const unsigned old = xb_add(&bar[XB_XSUB(b.x)], 1u);
        const unsigned gen = old / nloc;
        if (old + 1u == (gen + 1u) * nloc) {
            __builtin_amdgcn_fence(__ATOMIC_RELEASE, "agent");
            asm volatile("s_waitcnt vmcnt(0)" ::: "memory");
            const unsigned og = xb_add(&bar[XB_TOP], 1u);
            const unsigned tg = og / nx;
            if (og + 1u == (tg + 1u) * nx) xb_add(&bar[XB_TOPGEN], 1u);
            else XB_SPIN(xb_ld(&bar[XB_TOPGEN]) == tg, bar);
            __builtin_amdgcn_fence(__ATOMIC_ACQUIRE, "agent");
            xb_add(&bar[XB_XGEN(b.x)], 1u);
            asm volatile("s_waitcnt vmcnt(0)" ::: "memory");
        } else {
            XB_SPIN(xb_ld(&bar[XB_XGEN(b.x)]) == gen, bar);
            __builtin_amdgcn_fence(__ATOMIC_ACQUIRE, "agent");
            asm volatile("s_waitcnt vmcnt(0)" ::: "memory");
        }
    }
    __syncthreads();
}

struct OrderBase {
    __device__ __forceinline__ void a_ready(const pg8::Unit&) const {}
    __device__ __forceinline__ void done(const pg8::Unit&) const {}
};
struct PlainOrder : OrderBase {
    const char* A; const char* B; size_t astep, bstep; int nM, nN, G, c;
    __device__ __forceinline__ bool next(int i, pg8::Unit& u) const {
        const long L = (long)i * G + c; if (L >= (long)nM * nN) return false;
        pg8::tile_of((int)L, nM, nN, u.pm, u.pn); u.aux = 0; u.a = A + (size_t)u.pm * astep; u.b = B + (size_t)u.pn * bstep; return true; }
};
struct LruOrder : OrderBase {
    const char* A; const char* B; int nM, G, c;
    __device__ __forceinline__ bool next(int i, pg8::Unit& u) const {
        const long L = (long)i * G + c; if (L >= (long)nM * 16) return false;
        pg8::tile_of((int)L, nM, 16, u.pm, u.pn); u.aux = 0; u.a = A + (size_t)u.pm * (256 * 1024 * 2) + (size_t)(u.pn >> 2) * 512; u.b = B + (size_t)u.pn * (256 * 256 * 2); return true; }
};
struct BranchOrder : OrderBase {
    const char* A; const char* B; int nM, G, c;
    __device__ __forceinline__ bool next(int i, pg8::Unit& u) const {
        const int j = i / 3, br = i - 3 * j; const long L = (long)j * G + c; if (L >= (long)nM * 4) return false;
        pg8::tile_of((int)L, nM, 4, u.pm, u.pn); u.aux = br; u.a = A + (size_t)br * ROWB + (size_t)u.pm * (256 * 1024 * 2); u.b = B + (size_t)br * (1024 * 1024 * 2) + (size_t)u.pn * (256 * 1024 * 2); return true; }
};
struct MoeOrder : OrderBase {
    const char* A; const char* B; const unsigned* tile_e; size_t estep; int nM, nN, G, c;
    __device__ __forceinline__ bool next(int i, pg8::Unit& u) const {
        const long L = (long)i * G + c; if (L >= (long)nM * nN) return false;
        pg8::tile_of((int)L, nM, nN, u.pm, u.pn); const int e = (int)tile_e[u.pm]; u.aux = e;
        u.a = A + (size_t)u.pm * (256 * 1024 * 2); u.b = B + (size_t)e * estep + (size_t)u.pn * (256 * 1024 * 2); return true; }
};

struct EpiBf16Bias {
    static constexpr bool PERM = true, AFTER_DRAIN = false;
    bf16_t* O; int ldc; const float* bias; int bstride;
    __device__ __forceinline__ void operator()(const f32x4 (&acc)[2][2][4][2], const pg8::Unit& u, int wr, int wc, int fr, int fq) const {
        const int row0 = u.pm * 256 + wr * 64 + fr, col0 = u.pn * 256 + wc * 32 + 8 * fq;
        f32x4 bv[2][2];
#pragma unroll
        for (int bj = 0; bj < 2; ++bj)
#pragma unroll
            for (int n = 0; n < 2; ++n) bv[bj][n] = bias ? *(const f32x4*)(bias + (size_t)u.aux * bstride + col0 + bj * 128 + 4 * n) : (f32x4){0.f, 0.f, 0.f, 0.f};
#pragma unroll
        for (int ai = 0; ai < 2; ++ai)
#pragma unroll
            for (int m = 0; m < 4; ++m) { bf16_t* rowp = O + (size_t)(row0 + ai * 128 + m * 16) * ldc + col0;
#pragma unroll
                for (int bj = 0; bj < 2; ++bj) { const f32x4 v0 = acc[ai][bj][m][0] + bv[bj][0], v1 = acc[ai][bj][m][1] + bv[bj][1];
                    u32x4 w; w.x = pg8::cvt_pk_bf16(v0[0], v0[1]); w.y = pg8::cvt_pk_bf16(v0[2], v0[3]); w.z = pg8::cvt_pk_bf16(v1[0], v1[1]); w.w = pg8::cvt_pk_bf16(v1[2], v1[3]);
                    *(u32x4*)(rowp + bj * 128) = w; } }
    }
};
struct EpiLru {
    static constexpr bool PERM = true, AFTER_DRAIN = false;
    const bf16_t* xc; bf16_t* LA; bf16_t* BB; const float* ba; const float* bi; const float* lsl;
    __device__ __forceinline__ void operator()(const f32x4 (&acc)[2][2][4][2], const pg8::Unit& u, int wr, int wc, int fr, int fq) const {
        const int g = u.pn >> 2, d = (u.pn >> 1) & 1, hh = u.pn & 1;
        const int row0 = u.pm * 256 + wr * 64 + fr, ch0 = 256 * g + 128 * hh + wc * 32 + 8 * fq;
#pragma unroll
        for (int ai = 0; ai < 2; ++ai)
#pragma unroll
            for (int m = 0; m < 4; ++m) { const size_t off = (size_t)(row0 + ai * 128 + m * 16) * 1024 + ch0;
                const u32x4 xw = *(const u32x4*)(xc + off); float la[8], bb[8];
#pragma unroll
                for (int n = 0; n < 2; ++n) { const f32x4 pb = *(const f32x4*)(ba + d * 1024 + ch0 + 4 * n), pi = *(const f32x4*)(bi + d * 1024 + ch0 + 4 * n), pl = *(const f32x4*)(lsl + d * 1024 + ch0 + 4 * n);
#pragma unroll
                    for (int e = 0; e < 4; ++e) { const int idx = 4 * n + e; const unsigned w = xw[idx >> 1]; const float xv = (idx & 1) ? bfhi(w) : bflo(w);
                        const float r = sigmoidf_(acc[ai][0][m][n][e] + pb[e]), ig = sigmoidf_(acc[ai][1][m][n][e] + pi[e]);
                        const float l = 8.0f * r * pl[e]; la[idx] = l; bb[idx] = sqrtf(fmaxf(1.0f - __expf(2.0f * l), 0.f)) * ig * xv; } }
                u32x4 w1, w2; w1.x = pg8::cvt_pk_bf16(la[0], la[1]); w1.y = pg8::cvt_pk_bf16(la[2], la[3]); w1.z = pg8::cvt_pk_bf16(la[4], la[5]); w1.w = pg8::cvt_pk_bf16(la[6], la[7]);
                w2.x = pg8::cvt_pk_bf16(bb[0], bb[1]); w2.y = pg8::cvt_pk_bf16(bb[2], bb[3]); w2.z = pg8::cvt_pk_bf16(bb[4], bb[5]); w2.w = pg8::cvt_pk_bf16(bb[6], bb[7]);
                *(u32x4*)(LA + (size_t)d * TT * 1024 + off) = w1; *(u32x4*)(BB + (size_t)d * TT * 1024 + off) = w2; asm volatile("" ::: "memory"); }
    }
};
struct EpiBranch {
    static constexpr bool PERM = true, AFTER_DRAIN = false;
    const bf16_t* P; float* MF; bf16_t* MG;
    __device__ __forceinline__ void operator()(const f32x4 (&acc)[2][2][4][2], const pg8::Unit& u, int wr, int wc, int fr, int fq) const {
        const int br = u.aux, row0 = u.pm * 256 + wr * 64 + fr, col0 = u.pn * 256 + wc * 32 + 8 * fq;
#pragma unroll
        for (int ai = 0; ai < 2; ++ai)
#pragma unroll
            for (int m = 0; m < 4; ++m) { const size_t row = (size_t)(row0 + ai * 128 + m * 16);
#pragma unroll
                for (int bj = 0; bj < 2; ++bj) { const int c = col0 + bj * 128;
                    const u32x4 gw = *(const u32x4*)(P + row * LDP + C_MG + br * 1024 + c);
                    f32x4 v0, v1;
                    v0[0] = sigmoidf_(bflo(gw.x)) * acc[ai][bj][m][0][0]; v0[1] = sigmoidf_(bfhi(gw.x)) * acc[ai][bj][m][0][1]; v0[2] = sigmoidf_(bflo(gw.y)) * acc[ai][bj][m][0][2]; v0[3] = sigmoidf_(bfhi(gw.y)) * acc[ai][bj][m][0][3];
                    v1[0] = sigmoidf_(bflo(gw.z)) * acc[ai][bj][m][1][0]; v1[1] = sigmoidf_(bfhi(gw.z)) * acc[ai][bj][m][1][1]; v1[2] = sigmoidf_(bflo(gw.w)) * acc[ai][bj][m][1][2]; v1[3] = sigmoidf_(bfhi(gw.w)) * acc[ai][bj][m][1][3];
                    float* mf = MF + row * 1024 + c;
                    if (br != 0) { v0 += *(const f32x4*)mf; v1 += *(const f32x4*)(mf + 4); }
                    if (br != 2) { *(f32x4*)mf = v0; *(f32x4*)(mf + 4) = v1; }
                    else { u32x4 w; w.x = pg8::cvt_pk_bf16(v0[0], v0[1]); w.y = pg8::cvt_pk_bf16(v0[2], v0[3]); w.z = pg8::cvt_pk_bf16(v1[0], v1[1]); w.w = pg8::cvt_pk_bf16(v1[2], v1[3]);
                        *(u32x4*)(MG + row * 1024 + c) = w; } } }
    }
};
struct EpiOut {
    static constexpr bool PERM = false, AFTER_DRAIN = false;
    const float* baseLat; const float* baseCtx; float* xs; const float* gate;
    __device__ __forceinline__ void operator()(const f32x4 (&acc)[2][2][4][2], const pg8::Unit& u, int wr, int wc, int fr, int fq) const {
        const int mrow = u.pm < 128 ? (u.pm >> 4) : 8; const float* gp = gate + mrow * 6144;
        const int row0 = u.pm * 256 + wr * 64 + fr, col0 = u.pn * 256 + wc * 32 + 4 * fq;
        const float* base = u.pm < 128 ? baseLat + (size_t)row0 * 1024 : baseCtx + (size_t)(row0 - TLAT) * 1024;
        f32x4 gv[2][2];
#pragma unroll
        for (int bj = 0; bj < 2; ++bj)
#pragma unroll
            for (int n = 0; n < 2; ++n) gv[bj][n] = *(const f32x4*)(gp + col0 + bj * 128 + n * 16);
#pragma unroll
        for (int ai = 0; ai < 2; ++ai)
#pragma unroll
            for (int m = 0; m < 4; ++m) { const size_t ro = (size_t)(ai * 128 + m * 16) * 1024 + col0; float* op = xs + (size_t)row0 * 1024 + ro;
#pragma unroll
                for (int bj = 0; bj < 2; ++bj)
#pragma unroll
                    for (int n = 0; n < 2; ++n) *(f32x4*)(op + bj * 128 + n * 16) = *(const f32x4*)(base + ro + bj * 128 + n * 16) + gv[bj][n] * acc[ai][bj][m][n]; }
    }
};
struct EpiSwiglu {
    static constexpr bool PERM = true, AFTER_DRAIN = false;
    bf16_t* H; const float* bgu;
    __device__ __forceinline__ void operator()(const f32x4 (&acc)[2][2][4][2], const pg8::Unit& u, int wr, int wc, int fr, int fq) const {
        const int row0 = u.pm * 256 + wr * 64 + fr, f0 = u.pn * 128 + wc * 32 + 8 * fq;
        float bg[8], bu[8];
#pragma unroll
        for (int q = 0; q < 4; ++q) { const f32x4 b = *(const f32x4*)(bgu + (size_t)u.aux * 2048 + 2 * f0 + 4 * q); bg[2 * q] = b[0]; bu[2 * q] = b[1]; bg[2 * q + 1] = b[2]; bu[2 * q + 1] = b[3]; }
#pragma unroll
        for (int ai = 0; ai < 2; ++ai)
#pragma unroll
            for (int m = 0; m < 4; ++m) { float a[8];
#pragma unroll
                for (int n = 0; n < 2; ++n)
#pragma unroll
                    for (int e = 0; e < 4; ++e) { const int idx = 4 * n + e; const float gt = fminf(acc[ai][0][m][n][e] + bg[idx], 7.0f), up = fminf(fmaxf(acc[ai][1][m][n][e] + bu[idx], -7.0f), 7.0f);
                        a[idx] = gt * sigmoidf_(1.702f * gt) * (up + 1.0f); }
                u32x4 w; w.x = pg8::cvt_pk_bf16(a[0], a[1]); w.y = pg8::cvt_pk_bf16(a[2], a[3]); w.z = pg8::cvt_pk_bf16(a[4], a[5]); w.w = pg8::cvt_pk_bf16(a[6], a[7]);
                *(u32x4*)(H + (size_t)(row0 + ai * 128 + m * 16) * 1024 + f0) = w; }
    }
};

constexpr int NWAVES = 8, NTHR = 512;
constexpr int LDS_BYTES = 147456, MISC_OFF = 131072 + 320;
struct Frame {
    LAS unsigned char* lds; unsigned char* ws; const float* const* in; float* out;
    int tid, bx, lane, wave, G, gw, NGW, gtid, NGT;
};
__device__ __forceinline__ int mrow_of(int row) { return row < TLAT ? (row >> 12) : 8; }
__device__ __forceinline__ int seqrow(int d, int b, int p) {
    if (p < CTXL) return TLAT + b * CTXL + (d ? CTXL - 1 - p : p);
    const int q = p - CTXL; return b * SEQ + (d ? SEQ - 1 - q : q);
}
struct RowV { f32x4 v[4]; };
__device__ __forceinline__ RowV load_row(const float* p, int lane) { RowV r;
#pragma unroll
    for (int j = 0; j < 4; ++j) r.v[j] = *(const f32x4*)(p + 4 * lane + 256 * j);
    return r; }
__device__ __forceinline__ float row_sumsq(const RowV& r) { float s = 0.f;
#pragma unroll
    for (int j = 0; j < 4; ++j) s += (r.v[j][0] * r.v[j][0] + r.v[j][1] * r.v[j][1]) + (r.v[j][2] * r.v[j][2] + r.v[j][3] * r.v[j][3]);
    return wave_sum(s); }
__device__ __forceinline__ RowV norm_mod(const RowV& x, const float* gain, const float* shift, const float* scale, int lane) {
    const float rs = rsqrtf(row_sumsq(x) * (1.0f / D) + EPS); RowV y;
#pragma unroll
    for (int j = 0; j < 4; ++j) { const int c = 4 * lane + 256 * j; const f32x4 g = *(const f32x4*)(gain + c), sh = *(const f32x4*)(shift + c), sc = *(const f32x4*)(scale + c);
        y.v[j] = (x.v[j] * rs) * g * (sc + 1.0f) + sh; }
    return y; }
__device__ __forceinline__ void store_row_bf16(bf16_t* p, const RowV& y, int lane) {
#pragma unroll
    for (int j = 0; j < 4; ++j) { u32x2 w; w.x = pk2(y.v[j][0], y.v[j][1]); w.y = pk2(y.v[j][2], y.v[j][3]); *(u32x2*)(p + 4 * lane + 256 * j) = w; } }
__device__ __forceinline__ f32x4 ld4bf(const bf16_t* p) { const u32x2 w = *(const u32x2*)p; return (f32x4){bflo(w.x), bfhi(w.x), bflo(w.y), bfhi(w.y)}; }

__device__ __forceinline__ void phase_proA(const Frame& F) {
    const float* c = F.in[1]; const float* cc = F.in[3]; const float* w_ada = F.in[4];
    float* modp = (float*)(F.ws + WS_MODP);
    for (int it = F.gw; it < 2 * 8 * 96; it += F.NGW) {
        const int cg = it % 96, ks = (it / 96) % 8, l = it / 768, col = cg * 64 + F.lane;
        float acc[9];
#pragma unroll
        for (int r = 0; r < 9; ++r) acc[r] = 0.f;
        for (int k = ks * 128; k < ks * 128 + 128; ++k) {
            const float w = w_ada[((size_t)l * 1024 + k) * 6144 + col];
#pragma unroll
            for (int r = 0; r < 8; ++r) acc[r] += siluf_(c[r * 1024 + k]) * w;
            acc[8] += siluf_(cc[k]) * w;
        }
#pragma unroll
        for (int r = 0; r < 9; ++r) modp[((size_t)(ks * 2 + l) * 9 + r) * 6144 + col] = acc[r];
    }
    float* rc = (float*)(F.ws + WS_COS); float* rsn = (float*)(F.ws + WS_SIN);
    for (int i = F.gtid; i < SEQ * 64; i += F.NGT) {
        const int t = i >> 6, j = i & 63, f = j & 31; const float pos = (float)((j < 32) ? (t >> 6) : (t & 63));
        const float inv = exp2f(-(float)f * (13.287712379549449f / 32.0f)); const float ang = pos * inv;
        const float nn = rintf(ang * 0.15915494309189535f); float r = fmaf(-nn, 6.28125f, ang); r = fmaf(-nn, 1.9353071795864769e-3f, r);
        rc[i] = __cosf(r); rsn[i] = __sinf(r);
    }
}
__device__ __forceinline__ void phase_proB(const Frame& F) {
    const float* modp = (const float*)(F.ws + WS_MODP); float* mods = (float*)(F.ws + WS_MODS); const float* b_ada = F.in[5];
    for (int i = F.gtid; i < 2 * 9 * 6144; i += F.NGT) { const int l = i / (9 * 6144), col = i % 6144; float s = b_ada[l * 6144 + col];
#pragma unroll
        for (int ks = 0; ks < 8; ++ks) s += modp[(size_t)ks * (2 * 9 * 6144) + i];
        mods[i] = s; }
}

template <class RM> __device__ __forceinline__ void tr_item(const float* W, int ldw, int k0, int n0, bf16_t* WT, int ldt, LAS float* scr, int lane, const RM& rm) {
#pragma unroll 8
    for (int i = 0; i < 32; ++i) { const int kk = 2 * i + (lane >> 5); scr[kk * 33 + (lane & 31)] = W[(size_t)(k0 + kk) * ldw + n0 + (lane & 31)]; }
    LDS_WAIT(); asm volatile("" ::: "memory");
    const int c = lane & 7;
#pragma unroll
    for (int j = 0; j < 4; ++j) { const int n = (lane >> 3) + 8 * j; const LAS float* s = scr + (8 * c) * 33 + n; int drow; float sc; rm(n0 + n, drow, sc);
        u32x4 o; o.x = pk2(s[0 * 33] * sc, s[1 * 33] * sc); o.y = pk2(s[2 * 33] * sc, s[3 * 33] * sc); o.z = pk2(s[4 * 33] * sc, s[5 * 33] * sc); o.w = pk2(s[6 * 33] * sc, s[7 * 33] * sc);
        *(u32x4*)(WT + (size_t)drow * ldt + k0 + 8 * c) = o; }
    LDS_WAIT(); asm volatile("" ::: "memory");
}
struct RmIn { __device__ __forceinline__ void operator()(int n, int& drow, float& sc) const {
    drow = n < 3072 ? n : (n < 3104 ? C_LR + (n - 3072) : n - 32); sc = (n < 512 || (n >= 5664 && n < 6176)) ? 0.08838834764831845f : 1.0f; } };
struct RmId { __device__ __forceinline__ void operator()(int n, int& drow, float& sc) const { drow = n; sc = 1.0f; } };
struct RmLru { int base; __device__ __forceinline__ void operator()(int n, int& drow, float& sc) const { drow = base + (n & 127); sc = 1.0f; } };
struct RmGu { __device__ __forceinline__ void operator()(int n, int& drow, float& sc) const { const int f = n >> 1, u = n & 1; drow = 256 * (f >> 7) + 128 * u + (f & 127); sc = 1.0f; } };
__device__ __forceinline__ void phase_W(const Frame& F, int li) {
    LAS float* scr = (LAS float*)(F.lds + F.wave * 8704);
    bf16_t* Win_t = (bf16_t*)(F.ws + WS_WIN); bf16_t* Wlru_t = (bf16_t*)(F.ws + WS_WLRU); bf16_t* Wbr_t = (bf16_t*)(F.ws + WS_WBR);
    bf16_t* Wout_t = (bf16_t*)(F.ws + WS_WOUT); bf16_t* Wgu_t = (bf16_t*)(F.ws + WS_WGU); bf16_t* Wdn_t = (bf16_t*)(F.ws + WS_WDN);
    constexpr int I_IN = 16 * 353, I_LRU = 512, I_BR = 1536, I_OUT = 512, I_GU = 32768, I_DN = 16384, NITEMS = I_IN + I_LRU + I_BR + I_OUT + I_GU + I_DN;
    for (int it0 = F.gw; it0 < NITEMS; it0 += F.NGW) {
        int it = it0;
        if (it < I_IN) { const int kb = it / 353, nb = it % 353; tr_item(F.in[8] + (size_t)li * 1024 * IN_TOTAL, IN_TOTAL, 64 * kb, 32 * nb, Win_t, 1024, scr, F.lane, RmIn{}); continue; } it -= I_IN;
        if (it < I_LRU) { const int mat = it >> 5, r = it & 31, kb = r >> 3, nb = r & 7, ty = mat >> 3, d = (mat >> 2) & 1, g = mat & 3, n0 = 32 * nb, pn = g * 4 + d * 2 + (n0 >> 7);
            const float* src = (ty ? F.in[16] : F.in[14]) + (size_t)((li * 2 + d) * 4 + g) * 65536;
            tr_item(src, 256, 64 * kb, n0, Wlru_t, 256, scr, F.lane, RmLru{pn * 256 + ty * 128}); continue; } it -= I_LRU;
        if (it < I_BR) { const int br = it >> 9, r = it & 511, kb = r >> 5, nb = r & 31; tr_item(F.in[20] + (size_t)(li * 3 + br) * 1048576, 1024, 64 * kb, 32 * nb, Wbr_t + (size_t)br * 1048576, 1024, scr, F.lane, RmId{}); continue; } it -= I_BR;
        if (it < I_OUT) { const int kb = it >> 5, nb = it & 31; tr_item(F.in[21] + (size_t)li * 1048576, 1024, 64 * kb, 32 * nb, Wout_t, 1024, scr, F.lane, RmId{}); continue; } it -= I_OUT;
        if (it < I_GU) { const int e = it >> 10, r = it & 1023, kb = r >> 6, nb = r & 63; tr_item(F.in[24] + (size_t)(li * 32 + e) * 2097152, 2048, 64 * kb, 32 * nb, Wgu_t + (size_t)e * 2097152, 1024, scr, F.lane, RmGu{}); continue; } it -= I_GU;
        { const int e = it >> 9, r = it & 511, kb = r >> 5, nb = r & 31; tr_item(F.in[26] + (size_t)(li * 32 + e) * 1048576, 1024, 64 * kb, 32 * nb, Wdn_t + (size_t)e * 1048576, 1024, scr, F.lane, RmId{}); }
    }
    for (int i = F.gtid; i < (LDP - IN_TOTAL) * 1024 / 8; i += F.NGT) *(u32x4*)(Win_t + (size_t)IN_TOTAL * 1024 + (size_t)i * 8) = (u32x4){0u, 0u, 0u, 0u};
    float* lsl = (float*)(F.ws + WS_LSL);
    for (int i = F.gtid; i < 2048; i += F.NGT) lsl[i] = logsigmoidf_(F.in[18][li * 2048 + i]);
}
__device__ __forceinline__ void phase_norm_in(const Frame& F) {
    const float* mods = (const float*)(F.ws + WS_MODS); bf16_t* xn = (bf16_t*)(F.ws + WS_D);
    for (int row = F.gw; row < TT; row += F.NGW) {
        const float* src = row < TLAT ? F.in[0] + (size_t)row * D : F.in[2] + (size_t)(row - TLAT) * D;
        const float* mp = mods + mrow_of(row) * 6144;
        const RowV y = norm_mod(load_row(src, F.lane), F.in[6], mp, mp + 1024, F.lane);
        store_row_bf16(xn + (size_t)row * D, y, F.lane);
    }
}

__device__ __forceinline__ void phase_conv(const Frame& F, int li) {
    const bf16_t* P = (const bf16_t*)(F.ws + WS_P); bf16_t* xc = (bf16_t*)(F.ws + WS_D);
    const float* cw = F.in[12] + (size_t)li * 4 * 1024; const float* cb = F.in[13] + (size_t)li * 1024;
    for (int i = F.gtid; i < TT * 128; i += F.NGT) {
        const int row = i >> 7, ch = (i & 127) * 8;
        int t, L; if (row < TLAT) { t = row & (SEQ - 1); L = SEQ; } else { t = (row - TLAT) & (CTXL - 1); L = CTXL; }
        float a[8];
        { const f32x4 b0 = *(const f32x4*)(cb + ch), b1 = *(const f32x4*)(cb + ch + 4); a[0] = b0[0]; a[1] = b0[1]; a[2] = b0[2]; a[3] = b0[3]; a[4] = b1[0]; a[5] = b1[1]; a[6] = b1[2]; a[7] = b1[3]; }
#pragma unroll
        for (int j = 0; j < 4; ++j) { const int tt = t - 2 + j; if (tt < 0 || tt >= L) continue;
            const u32x4 xw = *(const u32x4*)(P + (size_t)(row - 2 + j) * LDP + C_LX + ch);
            const f32x4 w0 = *(const f32x4*)(cw + j * 1024 + ch), w1 = *(const f32x4*)(cw + j * 1024 + ch + 4);
            a[0] += w0[0] * bflo(xw.x); a[1] += w0[1] * bfhi(xw.x); a[2] += w0[2] * bflo(xw.y); a[3] += w0[3] * bfhi(xw.y);
            a[4] += w1[0] * bflo(xw.z); a[5] += w1[1] * bfhi(xw.z); a[6] += w1[2] * bflo(xw.w); a[7] += w1[3] * bfhi(xw.w); }
        u32x4 o; o.x = pk2(a[0], a[1]); o.y = pk2(a[2], a[3]); o.z = pk2(a[4], a[5]); o.w = pk2(a[6], a[7]);
        *(u32x4*)(xc + (size_t)row * 1024 + ch) = o;
    }
    bf16_t* Pw = (bf16_t*)(F.ws + WS_P); const float* rcos = (const float*)(F.ws + WS_COS); const float* rsin = (const float*)(F.ws + WS_SIN);
    for (int i = F.gtid; i < TLAT * 64; i += F.NGT) {
        const int g8 = i & 7, qk = (i >> 3) & 1, h = (i >> 4) & 3, row = i >> 6, t = row & (SEQ - 1);
        bf16_t* p1 = Pw + (size_t)row * LDP + (qk ? C_RK : C_RQ) + 128 * h + 8 * g8; bf16_t* p2 = p1 + 64;
        const u32x4 a = *(const u32x4*)p1, b = *(const u32x4*)p2;
        const f32x4 c0 = *(const f32x4*)(rcos + t * 64 + 8 * g8), c1 = *(const f32x4*)(rcos + t * 64 + 8 * g8 + 4), s0 = *(const f32x4*)(rsin + t * 64 + 8 * g8), s1 = *(const f32x4*)(rsin + t * 64 + 8 * g8 + 4);
        const float cs[8] = {c0[0], c0[1], c0[2], c0[3], c1[0], c1[1], c1[2], c1[3]}, sn[8] = {s0[0], s0[1], s0[2], s0[3], s1[0], s1[1], s1[2], s1[3]};
        const unsigned aw[4] = {a.x, a.y, a.z, a.w}, bw[4] = {b.x, b.y, b.z, b.w}; u32x4 o1, o2;
#pragma unroll
        for (int e = 0; e < 4; ++e) { const float x1a = bflo(aw[e]), x1b = bfhi(aw[e]), x2a = bflo(bw[e]), x2b = bfhi(bw[e]);
            o1[e] = pk2(x1a * cs[2 * e] - x2a * sn[2 * e], x1b * cs[2 * e + 1] - x2b * sn[2 * e + 1]);
            o2[e] = pk2(x1a * sn[2 * e] + x2a * cs[2 * e], x1b * sn[2 * e + 1] + x2b * cs[2 * e + 1]); }
        *(u32x4*)p1 = o1; *(u32x4*)p2 = o2;
    }
}
__device__ __forceinline__ int seg_row(int d, int b, int s, int p) {
    const int base = (s == 0) ? TLAT + b * CTXL : b * SEQ + 256 * (d ? 16 - s : s - 1);
    return base + (d ? 255 - p : p);
}
template <bool FINAL> __device__ __forceinline__ void phase_lru_scan(const Frame& F) {
    const bf16_t* LA = (const bf16_t*)(F.ws + WS_C); const bf16_t* BB = (const bf16_t*)(F.ws + WS_C + 2 * ROWB);
    float* carA = (float*)(F.ws + WS_CARA); float* carH = (float*)(F.ws + WS_CARH); bf16_t* HO = (bf16_t*)(F.ws + WS_E);
    for (int i = F.gtid; i < 2 * 8 * 17 * 256; i += F.NGT) {
        const int cq = i & 255, s = (i >> 8) % 17, db = (i >> 8) / 17, b = db & 7, d = db >> 3;
        f32x4 h = (f32x4){0.f, 0.f, 0.f, 0.f}, As = (f32x4){0.f, 0.f, 0.f, 0.f};
        if (FINAL) { for (int s2 = 0; s2 < s; ++s2) { const size_t o = ((size_t)(db * 17 + s2) * 256 + cq) * 4; h = *(const f32x4*)(carA + o) * h + *(const f32x4*)(carH + o); } }
        const size_t dofs = (size_t)d * TT * 1024;
#pragma unroll 8
        for (int p = 0; p < 256; ++p) { const size_t off = (size_t)seg_row(d, b, s, p) * 1024 + cq * 4;
            const f32x4 la = ld4bf(LA + dofs + off), bb = ld4bf(BB + dofs + off);
            f32x4 a; a[0] = __expf(la[0]); a[1] = __expf(la[1]); a[2] = __expf(la[2]); a[3] = __expf(la[3]);
            h = a * h + bb;
            if (FINAL) { u32x2 w; w.x = pk2(h[0], h[1]); w.y = pk2(h[2], h[3]); *(u32x2*)(HO + dofs + off) = w; } else As += la; }
        if (!FINAL) { const size_t o = (size_t)i * 4; f32x4 A; A[0] = __expf(As[0]); A[1] = __expf(As[1]); A[2] = __expf(As[2]); A[3] = __expf(As[3]);
            *(f32x4*)(carA + o) = A; *(f32x4*)(carH + o) = h; }
    }
}

template <bool STRICT> __device__ __forceinline__ void scan_steps(LAS float* sq, LAS float* sk, LAS float* sd, LAS float* sv, LAS float* so, float (&S)[8][4], int wave, int lane) {
    const int rg = lane >> 2, cg = lane & 3, cb = 16 * wave + 4 * cg;
    for (int p = 0; p < 32; ++p) {
        float q[8], k[8], dc[8];
#pragma unroll
        for (int h2 = 0; h2 < 2; ++h2) { const f32x4 a = *(const LAS f32x4*)(sq + p * 128 + rg * 8 + 4 * h2), b = *(const LAS f32x4*)(sk + p * 128 + rg * 8 + 4 * h2), c = *(const LAS f32x4*)(sd + p * 128 + rg * 8 + 4 * h2);
#pragma unroll
            for (int e = 0; e < 4; ++e) { q[4 * h2 + e] = a[e]; k[4 * h2 + e] = b[e]; dc[4 * h2 + e] = c[e]; } }
        const f32x4 v = *(const LAS f32x4*)(sv + p * 128 + cb);
        float o[4] = {0.f, 0.f, 0.f, 0.f};
#pragma unroll
        for (int i = 0; i < 8; ++i)
#pragma unroll
            for (int j = 0; j < 4; ++j) { const float s1 = dc[i] * S[i][j], s2 = s1 + k[i] * v[j]; o[j] += q[i] * (STRICT ? s1 : s2); S[i][j] = s2; }
#pragma unroll
        for (int j = 0; j < 4; ++j) { float x = o[j]; x += __shfl_xor(x, 4); x += __shfl_xor(x, 8); x += __shfl_xor(x, 16); x += __shfl_xor(x, 32); o[j] = x; }
        if (rg == 0) *(LAS f32x4*)(so + p * 128 + cb) = (f32x4){o[0], o[1], o[2], o[3]};
    }
}
__device__ __forceinline__ void phase_scan_ref(const Frame& F, int li) {
    LAS float* sq = (LAS float*)F.lds; LAS float* sk = sq + 4096; LAS float* sd = sk + 4096; LAS float* sv = sd + 4096; LAS float* so = sv + 4096;
    const bf16_t* P = (const bf16_t*)(F.ws + WS_P); bf16_t* OB = (bf16_t*)(F.ws + WS_B);
    const float* rcos = (const float*)(F.ws + WS_COS); const float* rsin = (const float*)(F.ws + WS_SIN);
    const int tt = F.tid >> 4, part = F.tid & 15;
    for (int u = F.bx; u < 256; u += F.G) {
        const int js = u & 1, h = (u >> 1) & 3, b = (u >> 3) & 7, d = (u >> 6) & 1, mx = u >> 7;
        const int CQ = (mx ? C_RQ : C_GQ) + 128 * h, CK = (mx ? C_RK : C_GK) + 128 * h, CV = (mx ? C_RV : C_GV) + 256 * h + 128 * js;
        bf16_t* O = OB + (size_t)(mx * 2 + d) * TT * 1024;
        const float* wa2 = F.in[9] + (size_t)((li * 2 + d) * 16) * 512 + 128 * h; const float* gba = F.in[10] + (size_t)(li * 2 + d) * 512 + 128 * h;
        const float gamma = 1.0f - exp2f(-5.0f - (float)h);
        float S[8][4];
#pragma unroll
        for (int i = 0; i < 8; ++i)
#pragma unroll
            for (int j = 0; j < 4; ++j) S[i][j] = 0.f;
        for (int p0 = 0; p0 < CTXL + SEQ; p0 += 32) {
            const int row = seqrow(d, b, p0 + tt); const bf16_t* pr = P + (size_t)row * LDP;
            {
                const u32x4 qw = *(const u32x4*)(pr + CQ + 8 * part), kw = *(const u32x4*)(pr + CK + 8 * part), vw = *(const u32x4*)(pr + CV + 8 * part);
                float q[8] = {bflo(qw.x), bfhi(qw.x), bflo(qw.y), bfhi(qw.y), bflo(qw.z), bfhi(qw.z), bflo(qw.w), bfhi(qw.w)};
                float k[8] = {bflo(kw.x), bfhi(kw.x), bflo(kw.y), bfhi(kw.y), bflo(kw.z), bfhi(kw.z), bflo(kw.w), bfhi(kw.w)};
                float dc[8];
                if (mx == 0) {
                    const u32x4 l0 = *(const u32x4*)(pr + C_LR + 16 * d), l1 = *(const u32x4*)(pr + C_LR + 16 * d + 8);
                    const float lr[16] = {bflo(l0.x), bfhi(l0.x), bflo(l0.y), bfhi(l0.y), bflo(l0.z), bfhi(l0.z), bflo(l0.w), bfhi(l0.w), bflo(l1.x), bfhi(l1.x), bflo(l1.y), bfhi(l1.y), bflo(l1.z), bfhi(l1.z), bflo(l1.w), bfhi(l1.w)};
                    float z[8];
#pragma unroll
                    for (int e = 0; e < 8; ++e) z[e] = gba[8 * part + e];
#pragma unroll
                    for (int r = 0; r < 16; ++r) { const f32x4 w0 = *(const f32x4*)(wa2 + r * 512 + 8 * part), w1 = *(const f32x4*)(wa2 + r * 512 + 8 * part + 4);
#pragma unroll
                        for (int e = 0; e < 4; ++e) { z[e] += lr[r] * w0[e]; z[4 + e] += lr[r] * w1[e]; } }
#pragma unroll
                    for (int e = 0; e < 8; ++e) dc[e] = __expf(logsigmoidf_(z[e]) * 0.0625f);
                } else {
#pragma unroll
                    for (int e = 0; e < 8; ++e) dc[e] = gamma;
                }
                LAS float* dq = sq + tt * 128 + 8 * part; LAS float* dk = sk + tt * 128 + 8 * part; LAS float* dd = sd + tt * 128 + 8 * part; LAS float* dv = sv + tt * 128 + 8 * part;
                *(LAS f32x4*)dq = (f32x4){q[0], q[1], q[2], q[3]}; *(LAS f32x4*)(dq + 4) = (f32x4){q[4], q[5], q[6], q[7]};
                *(LAS f32x4*)dk = (f32x4){k[0], k[1], k[2], k[3]}; *(LAS f32x4*)(dk + 4) = (f32x4){k[4], k[5], k[6], k[7]};
                *(LAS f32x4*)dd = (f32x4){dc[0], dc[1], dc[2], dc[3]}; *(LAS f32x4*)(dd + 4) = (f32x4){dc[4], dc[5], dc[6], dc[7]};
                *(LAS f32x4*)dv = (f32x4){bflo(vw.x), bfhi(vw.x), bflo(vw.y), bfhi(vw.y)}; *(LAS f32x4*)(dv + 4) = (f32x4){bflo(vw.z), bfhi(vw.z), bflo(vw.w), bfhi(vw.w)};
            }
            __syncthreads();
            if (d) scan_steps<true>(sq, sk, sd, sv, so, S, F.wave, F.lane); else scan_steps<false>(sq, sk, sd, sv, so, S, F.wave, F.lane);
            __syncthreads();
            { const f32x4 o0 = *(const LAS f32x4*)(so + tt * 128 + 8 * part), o1 = *(const LAS f32x4*)(so + tt * 128 + 8 * part + 4);
              u32x4 w; w.x = pk2(o0[0], o0[1]); w.y = pk2(o0[2], o0[3]); w.z = pk2(o1[0], o1[1]); w.w = pk2(o1[2], o1[3]);
              *(u32x4*)(O + (size_t)row * 1024 + 256 * h + 128 * js + 8 * part) = w; }
        }
        __syncthreads();
    }
}

typedef short s16x4 __attribute__((ext_vector_type(4)));
constexpr int SC_PITCH = 272, SC_QS = 0, SC_KS = 17408, SC_VS = 34816, SC_SB = 52224, SC_GS = 87040, SC_GPITCH = 528, SC_AS = SC_GS, SC_APITCH = 144, SC_OS = SC_GS + 9216,
              SC_LR = 120832, SC_LRPITCH = 80, SC_GQ = 125952, SC_EGL = 128000;
__device__ __forceinline__ bf16x8 tr_frag(LAS unsigned char* base, int pitch, int k0, int c0, int lane) {
    const int q = (lane & 15) >> 2, p = lane & 3;
    LAS unsigned char* a = base + (k0 + q) * pitch + (c0 + 4 * p) * 2;
    const s16x4 lo = __builtin_amdgcn_ds_read_tr16_b64_v4i16((LAS s16x4*)a);
    const s16x4 hi = __builtin_amdgcn_ds_read_tr16_b64_v4i16((LAS s16x4*)(a + 4 * pitch));
    return (bf16x8){lo[0], lo[1], lo[2], lo[3], hi[0], hi[1], hi[2], hi[3]};
}
#define MFMA16(a, b, c) __builtin_amdgcn_mfma_f32_16x16x32_bf16((a), (b), (c), 0, 0, 0)
template <int MX> __device__ __forceinline__ void scan_unit(const Frame& F, int li, int u) {
    LAS unsigned char* L = F.lds;
    const int tid = F.tid, lane = F.lane, w = F.wave, fr = lane & 15, fq = lane >> 4, tt = tid >> 4, part = tid & 15;
    const int js = u & 1, h = (u >> 1) & 3, b = (u >> 3) & 7, d = (u >> 6) & 1;
    const bf16_t* P = (const bf16_t*)(F.ws + WS_P); bf16_t* O = (bf16_t*)(F.ws + WS_B) + (size_t)(MX * 2 + d) * TT * 1024 + 256 * h + 128 * js;
    const int CQ = (MX ? C_RQ : C_GQ) + 128 * h, CK = (MX ? C_RK : C_GK) + 128 * h, CV = (MX ? C_RV : C_GV) + 256 * h + 128 * js;
    bf16x8 wfrag = (bf16x8){0, 0, 0, 0, 0, 0, 0, 0}; f32x4 bav = (f32x4){0.f, 0.f, 0.f, 0.f}; float lg = 0.f;
    if (MX == 0) {
        const float* wa2 = F.in[9] + (size_t)((li * 2 + d) * 16) * 512 + 128 * h + 16 * w + fr;
        float t8[8];
#pragma unroll
        for (int i = 0; i < 8; ++i) t8[i] = (fq < 2) ? wa2[(size_t)(8 * fq + i) * 512] : 0.f;
        const unsigned w0 = pk2(t8[0], t8[1]), w1 = pk2(t8[2], t8[3]), w2 = pk2(t8[4], t8[5]), w3 = pk2(t8[6], t8[7]);
        wfrag = __builtin_bit_cast(bf16x8, (u32x4){w0, w1, w2, w3});
        bav = *(const f32x4*)(F.in[10] + (size_t)(li * 2 + d) * 512 + 128 * h + 16 * w + 4 * fq);
    } else { const float x = exp2f(-5.0f - (float)h); lg = -(x + x * x * 0.5f + x * x * x * (1.0f / 3.0f) + x * x * x * x * 0.25f); }
    f32x4 S[2][4];
#pragma unroll
    for (int i = 0; i < 2; ++i)
#pragma unroll
        for (int j = 0; j < 4; ++j) S[i][j] = (f32x4){0.f, 0.f, 0.f, 0.f};
    for (int i = tid; i < (128 * SC_PITCH) / 16; i += NTHR) *(LAS u32x4*)(L + SC_SB + i * 16) = (u32x4){0u, 0u, 0u, 0u};
    if (MX == 0) for (int i = tid; i < (64 * SC_LRPITCH) / 16; i += NTHR) *(LAS u32x4*)(L + SC_LR + i * 16) = (u32x4){0u, 0u, 0u, 0u};
    __syncthreads();
    u32x4 rq[2], rk[2], rv[2], rl[2];
    rl[0] = rl[1] = (u32x4){0u, 0u, 0u, 0u};
#define SC_LOAD(chn) do { _Pragma("unroll") for (int ps = 0; ps < 2; ++ps) { const bf16_t* pr = P + (size_t)seqrow(d, b, (chn) * 64 + tt + 32 * ps) * LDP; \
        rq[ps] = *(const u32x4*)(pr + CQ + 8 * part); rk[ps] = *(const u32x4*)(pr + CK + 8 * part); rv[ps] = *(const u32x4*)(pr + CV + 8 * part); \
        if (MX == 0 && part < 2) rl[ps] = *(const u32x4*)(pr + C_LR + 16 * d + 8 * part); } } while (0)
    SC_LOAD(0);
    const int tmA = w >> 1, tnA = 2 * (w & 1), tmB = w & 1, tnB = w >> 1, tmS = w & 3, tnS = w >> 2;
    for (int ch = 0; ch < (CTXL + SEQ) / 64; ++ch) {
#pragma unroll
        for (int ps = 0; ps < 2; ++ps) { const int tok = tt + 32 * ps; *(LAS u32x4*)(L + SC_VS + tok * SC_PITCH + part * 16) = rv[ps];
            if (MX == 0 && part < 2) *(LAS u32x4*)(L + SC_LR + tok * SC_LRPITCH + part * 16) = rl[ps]; }
        if (MX == 0) {
            __syncthreads();
#pragma unroll
            for (int tm = 0; tm < 4; ++tm) { const bf16x8 lrf = *(const LAS bf16x8*)(L + SC_LR + (16 * tm + fr) * SC_LRPITCH + fq * 16);
                const f32x4 z = MFMA16(wfrag, lrf, ((f32x4){0.f, 0.f, 0.f, 0.f})); f32x4 g;
#pragma unroll
                for (int j = 0; j < 4; ++j) g[j] = logsigmoidf_(z[j] + bav[j]) * 0.0625f;
                *(LAS f32x4*)(L + SC_GS + (16 * tm + fr) * SC_GPITCH + (16 * w + 4 * fq) * 4) = g; }
            __syncthreads();
            { const int c = tid & 127, pq_ = tid >> 7; LAS float* gp = (LAS float*)(L + SC_GS) + (16 * pq_) * (SC_GPITCH / 4) + c; float run = 0.f;
#pragma unroll
                for (int i = 0; i < 16; ++i) { run += gp[i * (SC_GPITCH / 4)]; gp[i * (SC_GPITCH / 4)] = run; }
                ((LAS float*)(L + SC_GQ))[pq_ * 128 + c] = run; }
            __syncthreads();
            const LAS float* GQ = (const LAS float*)(L + SC_GQ);
            if (tid < 128) ((LAS float*)(L + SC_EGL))[tid] = __expf((GQ[tid] + GQ[128 + tid]) + (GQ[256 + tid] + GQ[384 + tid]));
#pragma unroll
            for (int ps = 0; ps < 2; ++ps) { const int tok = tt + 32 * ps, qd = tok >> 4;
                f32x4 g0 = *(const LAS f32x4*)(L + SC_GS + tok * SC_GPITCH + part * 32), g1 = *(const LAS f32x4*)(L + SC_GS + tok * SC_GPITCH + part * 32 + 16);
#pragma unroll
                for (int q2 = 0; q2 < 3; ++q2) if (q2 < qd) { g0 += *(const LAS f32x4*)(GQ + q2 * 128 + 8 * part); g1 += *(const LAS f32x4*)(GQ + q2 * 128 + 8 * part + 4); }
                const float G[8] = {g0[0], g0[1], g0[2], g0[3], g1[0], g1[1], g1[2], g1[3]};
                const unsigned qw[4] = {rq[ps].x, rq[ps].y, rq[ps].z, rq[ps].w}, kw[4] = {rk[ps].x, rk[ps].y, rk[ps].z, rk[ps].w}; u32x4 qo, ko;
#pragma unroll
                for (int e2 = 0; e2 < 4; ++e2) { const float ea = __expf(G[2 * e2]), eb = __expf(G[2 * e2 + 1]), na = __expf(-G[2 * e2]), nb = __expf(-G[2 * e2 + 1]);
                    qo[e2] = pk2(bflo(qw[e2]) * ea, bfhi(qw[e2]) * eb); ko[e2] = pk2(bflo(kw[e2]) * na, bfhi(kw[e2]) * nb); }
                *(LAS u32x4*)(L + SC_QS + tok * SC_PITCH + part * 16) = qo; *(LAS u32x4*)(L + SC_KS + tok * SC_PITCH + part * 16) = ko; }
        } else {
#pragma unroll
            for (int ps = 0; ps < 2; ++ps) { const int tok = tt + 32 * ps; const float Gt = (float)(tok + 1) * lg, ea = __expf(Gt), na = __expf(-Gt);
                const unsigned qw[4] = {rq[ps].x, rq[ps].y, rq[ps].z, rq[ps].w}, kw[4] = {rk[ps].x, rk[ps].y, rk[ps].z, rk[ps].w}; u32x4 qo, ko;
#pragma unroll
                for (int e2 = 0; e2 < 4; ++e2) { qo[e2] = pk2(bflo(qw[e2]) * ea, bfhi(qw[e2]) * ea); ko[e2] = pk2(bflo(kw[e2]) * na, bfhi(kw[e2]) * na); }
                *(LAS u32x4*)(L + SC_QS + tok * SC_PITCH + part * 16) = qo; *(LAS u32x4*)(L + SC_KS + tok * SC_PITCH + part * 16) = ko; }
        }
        if (ch + 1 < (CTXL + SEQ) / 64) SC_LOAD(ch + 1);
        __syncthreads();
        {   f32x4 a[2] = {(f32x4){0.f, 0.f, 0.f, 0.f}, (f32x4){0.f, 0.f, 0.f, 0.f}};
#pragma unroll
            for (int ks = 0; ks < 4; ++ks) { const bf16x8 xq = *(const LAS bf16x8*)(L + SC_QS + (16 * tmA + fr) * SC_PITCH + (32 * ks + 8 * fq) * 2);
#pragma unroll
                for (int j = 0; j < 2; ++j) { const bf16x8 yk = *(const LAS bf16x8*)(L + SC_KS + (16 * (tnA + j) + fr) * SC_PITCH + (32 * ks + 8 * fq) * 2); a[j] = MFMA16(yk, xq, a[j]); } }
            const int c = 16 * tmA + fr;
#pragma unroll
            for (int j = 0; j < 2; ++j) { const int s0 = 16 * (tnA + j) + 4 * fq; float m[4];
#pragma unroll
                for (int e = 0; e < 4; ++e) { const int s = s0 + e; const bool keep = d ? (s < c) : (s <= c); m[e] = keep ? a[j][e] : 0.f; }
                u32x2 wv; wv.x = pk2(m[0], m[1]); wv.y = pk2(m[2], m[3]); *(LAS u32x2*)(L + SC_AS + c * SC_APITCH + s0 * 2) = wv; } }
        __syncthreads();
        f32x4 o[2][2];
#pragma unroll
        for (int i = 0; i < 2; ++i)
#pragma unroll
            for (int j = 0; j < 2; ++j) o[i][j] = (f32x4){0.f, 0.f, 0.f, 0.f};
#pragma unroll
        for (int ks = 0; ks < 2; ++ks) { bf16x8 xa[2], yv[2];
#pragma unroll
            for (int i = 0; i < 2; ++i) xa[i] = *(const LAS bf16x8*)(L + SC_AS + (32 * tmB + 16 * i + fr) * SC_APITCH + (32 * ks + 8 * fq) * 2);
#pragma unroll
            for (int j = 0; j < 2; ++j) yv[j] = tr_frag(L + SC_VS, SC_PITCH, 32 * ks + 8 * fq, 32 * tnB + 16 * j, lane);
#pragma unroll
            for (int i = 0; i < 2; ++i)
#pragma unroll
                for (int j = 0; j < 2; ++j) o[i][j] = MFMA16(yv[j], xa[i], o[i][j]); }
#pragma unroll
        for (int ks = 0; ks < 4; ++ks) { bf16x8 xq[2], ys[2];
#pragma unroll
            for (int i = 0; i < 2; ++i) xq[i] = *(const LAS bf16x8*)(L + SC_QS + (32 * tmB + 16 * i + fr) * SC_PITCH + (32 * ks + 8 * fq) * 2);
#pragma unroll
            for (int j = 0; j < 2; ++j) ys[j] = tr_frag(L + SC_SB, SC_PITCH, 32 * ks + 8 * fq, 32 * tnB + 16 * j, lane);
#pragma unroll
            for (int i = 0; i < 2; ++i)
#pragma unroll
                for (int j = 0; j < 2; ++j) o[i][j] = MFMA16(ys[j], xq[i], o[i][j]); }
#pragma unroll
        for (int ks = 0; ks < 2; ++ks) { bf16x8 xk[2], yv[4];
#pragma unroll
            for (int i = 0; i < 2; ++i) xk[i] = tr_frag(L + SC_KS, SC_PITCH, 32 * ks + 8 * fq, 32 * tmS + 16 * i, lane);
#pragma unroll
            for (int j = 0; j < 4; ++j) yv[j] = tr_frag(L + SC_VS, SC_PITCH, 32 * ks + 8 * fq, 64 * tnS + 16 * j, lane);
#pragma unroll
            for (int i = 0; i < 2; ++i)
#pragma unroll
                for (int j = 0; j < 4; ++j) S[i][j] = MFMA16(yv[j], xk[i], S[i][j]); }
        __syncthreads();
#pragma unroll
        for (int i = 0; i < 2; ++i)
#pragma unroll
            for (int j = 0; j < 2; ++j) { u32x2 wv; wv.x = pk2(o[i][j][0], o[i][j][1]); wv.y = pk2(o[i][j][2], o[i][j][3]);
                *(LAS u32x2*)(L + SC_OS + (32 * tmB + 16 * i + fr) * SC_PITCH + (32 * tnB + 16 * j + 4 * fq) * 2) = wv; }
#pragma unroll
        for (int i = 0; i < 2; ++i) { const int row = 32 * tmS + 16 * i + fr; const float eg = (MX == 0) ? ((const LAS float*)(L + SC_EGL))[row] : __expf(64.0f * lg);
#pragma unroll
            for (int j = 0; j < 4; ++j) { S[i][j] = S[i][j] * eg; u32x2 wv; wv.x = pk2(S[i][j][0], S[i][j][1]); wv.y = pk2(S[i][j][2], S[i][j][3]);
                *(LAS u32x2*)(L + SC_SB + row * SC_PITCH + (64 * tnS + 16 * j + 4 * fq) * 2) = wv; } }
        __syncthreads();
#pragma unroll
        for (int ps = 0; ps < 2; ++ps) { const int tok = tt + 32 * ps; const u32x4 v = *(const LAS u32x4*)(L + SC_OS + tok * SC_PITCH + part * 16);
            *(u32x4*)(O + (size_t)seqrow(d, b, ch * 64 + tok) * 1024 + 8 * part) = v; }
    }
#undef SC_LOAD
    __syncthreads();
}
__device__ __forceinline__ void phase_scan_mfma(const Frame& F, int li) {
    for (int u = F.bx; u < 256; u += F.G) { if (u < 128) scan_unit<0>(F, li, u); else scan_unit<1>(F, li, u - 128); }
}

__device__ __forceinline__ void phase_finish(const Frame& F, int li, int nrows) {
    const bf16_t* P = (const bf16_t*)(F.ws + WS_P); const bf16_t* OB = (const bf16_t*)(F.ws + WS_B); const bf16_t* HB = (const bf16_t*)(F.ws + WS_E); bf16_t* A3 = (bf16_t*)(F.ws + WS_C);
    const float* gnorm = F.in[11] + (size_t)li * 1024; const float* rnorm = F.in[19] + (size_t)li * 1024;
    const size_t RS = (size_t)TT * 1024;
    for (int row = F.gw; row < nrows; row += F.NGW) {
        const bf16_t* pr = P + (size_t)row * LDP; const size_t ro = (size_t)row * 1024;
#pragma unroll
        for (int j = 0; j < 4; ++j) {
            const int c = 4 * F.lane + 256 * j;
            {
                const f32x4 o = ld4bf(OB + ro + c) + ld4bf(OB + RS + ro + c);
                const float ss = wave_sum((o[0] * o[0] + o[1] * o[1]) + (o[2] * o[2] + o[3] * o[3])); const float rs = rsqrtf(ss * (1.0f / 256.0f) + EPS);
                const f32x4 g = ld4bf(pr + C_GG + c), gn = *(const f32x4*)(gnorm + c); u32x2 w;
                w.x = pk2(o[0] * rs * gn[0] * siluf_(g[0]), o[1] * rs * gn[1] * siluf_(g[1])); w.y = pk2(o[2] * rs * gn[2] * siluf_(g[2]), o[3] * rs * gn[3] * siluf_(g[3]));
                *(u32x2*)(A3 + ro + c) = w; }
            {
                const f32x4 hh = ld4bf(HB + ro + c) + ld4bf(HB + RS + ro + c), g = ld4bf(pr + C_LG + c); u32x2 w;
                w.x = pk2(hh[0] * gelu_tanh_(g[0]), hh[1] * gelu_tanh_(g[1])); w.y = pk2(hh[2] * gelu_tanh_(g[2]), hh[3] * gelu_tanh_(g[3]));
                *(u32x2*)(A3 + RS + ro + c) = w; }
            {
                f32x4 o = ld4bf(OB + 2 * RS + ro + c) + ld4bf(OB + 3 * RS + ro + c);
                const float mean = wave_sum((o[0] + o[1]) + (o[2] + o[3])) * (1.0f / 256.0f); o = o - mean;
                const float ss = wave_sum((o[0] * o[0] + o[1] * o[1]) + (o[2] * o[2] + o[3] * o[3])); const float rs = rsqrtf(ss * (1.0f / 256.0f) + EPS);
                const f32x4 g = ld4bf(pr + C_RG + c), gn = *(const f32x4*)(rnorm + c); u32x2 w;
                w.x = pk2(o[0] * rs * gn[0] * siluf_(g[0]), o[1] * rs * gn[1] * siluf_(g[1])); w.y = pk2(o[2] * rs * gn[2] * siluf_(g[2]), o[3] * rs * gn[3] * siluf_(g[3]));
                *(u32x2*)(A3 + 2 * RS + ro + c) = w; }
        }
    }
}

__device__ __forceinline__ void phase_norm2_router(const Frame& F, int li, int ntok) {
    LAS float* wrT = (LAS float*)F.lds;
    LAS unsigned* hist = (LAS unsigned*)(F.lds + 131072); LAS unsigned* hbase = hist + 32;
    const float* wr = F.in[22] + (size_t)li * 1024 * 32; const float* br = F.in[23] + li * 32;
    for (int i = F.tid; i < 32768; i += NTHR) wrT[(i & 31) * 1024 + (i >> 5)] = wr[i];
    if (F.tid < 32) hist[F.tid] = 0u;
    __syncthreads();
    const float* xs = (const float*)(F.ws + WS_XS); const float* mods = (const float*)(F.ws + WS_MODS) + (size_t)li * 9 * 6144;
    bf16_t* xn2 = (bf16_t*)(F.ws + WS_D); int* tok_e = (int*)(F.ws + WS_TOKE); float* tok_w = (float*)(F.ws + WS_TOKW); int* tok_p = (int*)(F.ws + WS_TOKP);
    unsigned* cnt = (unsigned*)(F.ws + WS_CTL) + CW_CNT + li * 32;
    for (int row = F.gw; row < ntok; row += F.NGW) {
        const float* mp = mods + mrow_of(row) * 6144;
        const RowV y = norm_mod(load_row(xs + (size_t)row * D, F.lane), F.in[7] + (size_t)li * 1024, mp + 3 * 1024, mp + 4 * 1024, F.lane);
        store_row_bf16(xn2 + (size_t)row * D, y, F.lane);
        float lg[32];
#pragma unroll
        for (int e = 0; e < 32; ++e) { float s = 0.f;
#pragma unroll
            for (int j = 0; j < 4; ++j) { const f32x4 w = *(const LAS f32x4*)(wrT + e * 1024 + 4 * F.lane + 256 * j); s += (y.v[j][0] * w[0] + y.v[j][1] * w[1]) + (y.v[j][2] * w[2] + y.v[j][3] * w[3]); }
            lg[e] = wave_sum(s) + br[e]; }
        unsigned taken = 0u; float tl[4]; int te[4];
#pragma unroll
        for (int k = 0; k < 4; ++k) { float best = -3.0e38f; int bi = 0;
#pragma unroll
            for (int e = 0; e < 32; ++e) { const bool ok = !((taken >> e) & 1u) && lg[e] > best; best = ok ? lg[e] : best; bi = ok ? e : bi; }
            taken |= 1u << bi; tl[k] = best; te[k] = bi; }
        const float e1 = __expf(tl[1] - tl[0]), e2 = __expf(tl[2] - tl[0]), e3 = __expf(tl[3] - tl[0]); const float inv = 1.0f / (1.0f + e1 + e2 + e3);
        if (F.lane < 4) { const int k = F.lane; const int ek = k == 0 ? te[0] : k == 1 ? te[1] : k == 2 ? te[2] : te[3]; const float wk = (k == 0 ? 1.0f : k == 1 ? e1 : k == 2 ? e2 : e3) * inv;
            const unsigned lp = atomicAdd((unsigned*)&hist[ek], 1u);
            tok_e[row * 4 + k] = ek; tok_w[row * 4 + k] = wk; tok_p[row * 4 + k] = (int)lp; }
    }
    __syncthreads();
    if (F.tid < 32) hbase[F.tid] = __hip_atomic_fetch_add(cnt + F.tid, hist[F.tid], __ATOMIC_RELAXED, __HIP_MEMORY_SCOPE_AGENT);
    __syncthreads();
    for (int row = F.gw; row < ntok; row += F.NGW) if (F.lane < 4) { const int i = row * 4 + F.lane; tok_p[i] += (int)hbase[tok_e[i]]; }
    __syncthreads();
}
__device__ __forceinline__ void phase_dispatch(const Frame& F, int li, int ntok) {
    LAS unsigned* pstart = (LAS unsigned*)F.lds;
    unsigned* ctl = (unsigned*)(F.ws + WS_CTL); unsigned* cnt = ctl + CW_CNT + li * 32; unsigned* tile_e = ctl + CW_TILE + li * 1024;
    if (F.tid == 0) { unsigned ps = 0;
        for (int e = 0; e < 32; ++e) { const unsigned c = __hip_atomic_load(cnt + e, __ATOMIC_RELAXED, __HIP_MEMORY_SCOPE_AGENT), nt = (c + 255u) >> 8; pstart[e] = ps;
            if (F.bx == 0) for (unsigned j = 0; j < nt; ++j) tile_e[(ps >> 8) + j] = (unsigned)e;
            ps += nt << 8; }
        if (F.bx == 0) ctl[CW_NT + li] = ps >> 8; }
    __syncthreads();
    const bf16_t* xn2 = (const bf16_t*)(F.ws + WS_D); bf16_t* xg = (bf16_t*)(F.ws + WS_P);
    const int* tok_e = (const int*)(F.ws + WS_TOKE); const int* tok_p = (const int*)(F.ws + WS_TOKP); int* tok_s = (int*)(F.ws + WS_TOKS);
    for (int it = F.gw; it < ntok * 4; it += F.NGW) {
        const int tok = it >> 2; const int slot = (int)pstart[tok_e[it]] + tok_p[it];
        if (F.lane == 0) tok_s[it] = slot;
        const u32x4* s = (const u32x4*)(xn2 + (size_t)tok * 1024); u32x4* dst = (u32x4*)(xg + (size_t)slot * 1024);
        dst[F.lane] = s[F.lane]; dst[64 + F.lane] = s[64 + F.lane];
    }
    __syncthreads();
}
__device__ __forceinline__ void phase_combine(const Frame& F, int li, int ntok, bool last) {
    float* xs = (float*)(F.ws + WS_XS); const bf16_t* Y = (const bf16_t*)(F.ws + WS_B); bf16_t* xn = (bf16_t*)(F.ws + WS_D);
    const float* mods = (const float*)(F.ws + WS_MODS); const float* tok_w = (const float*)(F.ws + WS_TOKW); const int* tok_s = (const int*)(F.ws + WS_TOKS);
    for (int row = F.gw; row < ntok; row += F.NGW) {
        const int mr = mrow_of(row); const float* gp = mods + ((size_t)li * 9 + mr) * 6144 + 5 * 1024;
        RowV x = load_row(xs + (size_t)row * D, F.lane);
        const int s0 = tok_s[row * 4], s1 = tok_s[row * 4 + 1], s2 = tok_s[row * 4 + 2], s3 = tok_s[row * 4 + 3];
        const float w0 = tok_w[row * 4], w1 = tok_w[row * 4 + 1], w2 = tok_w[row * 4 + 2], w3 = tok_w[row * 4 + 3];
#pragma unroll
        for (int j = 0; j < 4; ++j) { const int c = 4 * F.lane + 256 * j;
            const f32x4 y = ld4bf(Y + (size_t)s0 * 1024 + c) * w0 + ld4bf(Y + (size_t)s1 * 1024 + c) * w1 + ld4bf(Y + (size_t)s2 * 1024 + c) * w2 + ld4bf(Y + (size_t)s3 * 1024 + c) * w3;
            x.v[j] = x.v[j] + *(const f32x4*)(gp + c) * y; }
        if (!last) {
#pragma unroll
            for (int j = 0; j < 4; ++j) *(f32x4*)(xs + (size_t)row * D + 4 * F.lane + 256 * j) = x.v[j];
            const float* mp = mods + ((size_t)(li + 1) * 9 + mr) * 6144;
            const RowV y = norm_mod(x, F.in[6] + (size_t)(li + 1) * 1024, mp, mp + 1024, F.lane);
            store_row_bf16(xn + (size_t)row * D, y, F.lane);
        } else {
            const float rs = rsqrtf(row_sumsq(x) * (1.0f / D) + EPS);
#pragma unroll
            for (int j = 0; j < 4; ++j) { const int c = 4 * F.lane + 256 * j; *(f32x4*)(F.out + (size_t)row * D + c) = (x.v[j] * rs) * *(const f32x4*)(F.in[28] + c); }
        }
    }
}

#ifndef MK_SCAN_REF
#define MK_SCAN_REF 0
#endif
#ifndef MK_ONE_LAUNCH
#define MK_ONE_LAUNCH 1
#endif
constexpr int NPH_LAYER = 15, NPHASES = 2 + 2 * NPH_LAYER;
struct Args { const float* in[29]; float* out; unsigned char* ws; int ph_lo, ph_hi, region, pad; };
#ifndef MK_PHMASK
#define MK_PHMASK 0x7fff
#endif
#define IN(k) (lo <= (k) && (k) < hi)
#define EN(j) ((MK_PHMASK >> (j)) & 1)
#define SEAM(k) do { if (IN(k) && IN((k) + 1)) xcd_barrier(bar); } while (0)
#define MKF() Frame F; { unsigned char* ws_ = args.ws; asm volatile("" : "+s"(ws_)); F.ws = ws_; F.lds = (LAS unsigned char*)lds_raw; F.out = args.out; F.in = args.in; \
        int tid_ = threadIdx.x, bx_ = blockIdx.x; asm volatile("" : "+v"(tid_), "+s"(bx_)); F.tid = tid_; F.bx = bx_; F.lane = F.tid & 63; F.wave = __builtin_amdgcn_readfirstlane(F.tid >> 6); F.G = gridDim.x; \
        F.gw = F.bx * NWAVES + F.wave; F.NGW = F.G * NWAVES; F.gtid = F.bx * NTHR + F.tid; F.NGT = F.G * NTHR; }
template <int li> __device__ __forceinline__ void run_layer(const Args& args, unsigned char* lds_raw, const XcdBarrier& bar, const int lo, const int hi) {
        const int pb = 2 + NPH_LAYER * li; const bool last = (li == 1); const int nrows = last ? TLAT : TT, nMt = nrows / 256;
        if (EN(0) && IN(pb + 0)) { MKF(); phase_W(F, li); if (li == 0) phase_norm_in(F); __syncthreads(); }
        SEAM(pb + 0);
        if (EN(1) && IN(pb + 1)) { MKF(); unsigned* ctl = (unsigned*)(F.ws + WS_CTL); (void)ctl;
            pg8::Gemm g{1024, 1024, 1024}; PlainOrder S; S.A = (const char*)(F.ws + WS_D); S.B = (const char*)(F.ws + WS_WIN); S.astep = 256 * 1024 * 2; S.bstep = 256 * 1024 * 2; S.nM = TT / 256; S.nN = LDP / 256; S.G = F.G; S.c = F.bx;
            EpiBf16Bias E{(bf16_t*)(F.ws + WS_P), LDP, nullptr, 0};
            pg8::gemm_phase<EpiBf16Bias, PlainOrder, true, true>(F.lds, g, S, E);
        }
        SEAM(pb + 1);
        if (EN(2) && IN(pb + 2)) { MKF(); phase_conv(F, li); }
        SEAM(pb + 2);
        if (EN(3) && IN(pb + 3)) { MKF(); unsigned* ctl = (unsigned*)(F.ws + WS_CTL); (void)ctl;
            pg8::Gemm g{1024, 256, 256}; LruOrder S; S.A = (const char*)(F.ws + WS_D); S.B = (const char*)(F.ws + WS_WLRU); S.nM = TT / 256; S.G = F.G; S.c = F.bx;
            EpiLru E{(const bf16_t*)(F.ws + WS_D), (bf16_t*)(F.ws + WS_C), (bf16_t*)(F.ws + WS_C + 2 * ROWB), F.in[15] + (size_t)li * 2048, F.in[17] + (size_t)li * 2048, (const float*)(F.ws + WS_LSL)};
            pg8::gemm_phase<EpiLru, LruOrder, true, true>(F.lds, g, S, E);
        }
        SEAM(pb + 3);
        if (EN(4) && IN(pb + 4)) { MKF(); phase_lru_scan<false>(F); }
        SEAM(pb + 4);
        if (EN(5) && IN(pb + 5)) { MKF(); phase_lru_scan<true>(F); }
        SEAM(pb + 5);
        if (EN(6) && IN(pb + 6)) { MKF(); if (MK_SCAN_REF) phase_scan_ref(F, li); else phase_scan_mfma(F, li); }
        SEAM(pb + 6);
        if (EN(7) && IN(pb + 7)) { MKF(); phase_finish(F, li, nrows); }
        SEAM(pb + 7);
        if (EN(8) && IN(pb + 8)) { MKF(); unsigned* ctl = (unsigned*)(F.ws + WS_CTL); (void)ctl;
            pg8::Gemm g{1024, 1024, 1024}; BranchOrder S; S.A = (const char*)(F.ws + WS_C); S.B = (const char*)(F.ws + WS_WBR); S.nM = nMt; S.G = F.G; S.c = F.bx;
            EpiBranch E{(const bf16_t*)(F.ws + WS_P), (float*)(F.ws + WS_B), (bf16_t*)(F.ws + WS_B + 2 * ROWB)};
            pg8::gemm_phase<EpiBranch, BranchOrder, true, true>(F.lds, g, S, E);
        }
        SEAM(pb + 8);
        if (EN(9) && IN(pb + 9)) { MKF(); unsigned* ctl = (unsigned*)(F.ws + WS_CTL); (void)ctl;
            pg8::Gemm g{1024, 1024, 1024}; PlainOrder S; S.A = (const char*)(F.ws + WS_B + 2 * ROWB); S.B = (const char*)(F.ws + WS_WOUT); S.astep = 256 * 1024 * 2; S.bstep = 256 * 1024 * 2; S.nM = nMt; S.nN = 4; S.G = F.G; S.c = F.bx;
            float* xs = (float*)(F.ws + WS_XS);
            EpiOut E{li == 0 ? F.in[0] : xs, li == 0 ? F.in[2] : xs + (size_t)TLAT * D, xs, (const float*)(F.ws + WS_MODS) + (size_t)li * 9 * 6144 + 2 * 1024};
            pg8::gemm_phase<EpiOut, PlainOrder, true, true>(F.lds, g, S, E);
        }
        SEAM(pb + 9);
        if (EN(10) && IN(pb + 10)) { MKF(); phase_norm2_router(F, li, nrows); }
        SEAM(pb + 10);
        if (EN(11) && IN(pb + 11)) { MKF(); phase_dispatch(F, li, nrows); }
        SEAM(pb + 11);
        if (EN(12) && IN(pb + 12)) { MKF(); unsigned* ctl = (unsigned*)(F.ws + WS_CTL); (void)ctl;
            pg8::Gemm g{1024, 1024, 1024}; MoeOrder S; S.A = (const char*)(F.ws + WS_P); S.B = (const char*)(F.ws + WS_WGU); S.tile_e = ctl + CW_TILE + li * 1024; S.estep = (size_t)2048 * 1024 * 2;
            S.nM = (int)ctl[CW_NT + li]; S.nN = 8; S.G = F.G; S.c = F.bx;
            EpiSwiglu E{(bf16_t*)(F.ws + WS_P + 288 * MiB), F.in[25] + (size_t)li * 32 * 2048};
            pg8::gemm_phase<EpiSwiglu, MoeOrder, true, true>(F.lds, g, S, E);
        }
        SEAM(pb + 12);
        if (EN(13) && IN(pb + 13)) { MKF(); unsigned* ctl = (unsigned*)(F.ws + WS_CTL); (void)ctl;
            pg8::Gemm g{1024, 1024, 1024}; MoeOrder S; S.A = (const char*)(F.ws + WS_P + 288 * MiB); S.B = (const char*)(F.ws + WS_WDN); S.tile_e = ctl + CW_TILE + li * 1024; S.estep = (size_t)1024 * 1024 * 2;
            S.nM = (int)ctl[CW_NT + li]; S.nN = 4; S.G = F.G; S.c = F.bx;
            EpiBf16Bias E{(bf16_t*)(F.ws + WS_B), 1024, F.in[27] + (size_t)li * 32 * 1024, 1024};
            pg8::gemm_phase<EpiBf16Bias, MoeOrder, true, true>(F.lds, g, S, E);
        }
        SEAM(pb + 13);
        if (EN(14) && IN(pb + 14)) { MKF(); phase_combine(F, li, nrows, last); }
        SEAM(pb + 14);
    }
__global__ void __launch_bounds__(NTHR, 2) mk_fwd(Args args) {
    extern __shared__ __attribute__((aligned(16))) unsigned char lds_raw[];
    const int tid0 = threadIdx.x;
    volatile LAS unsigned* MISC = (volatile LAS unsigned*)((LAS unsigned char*)lds_raw + MISC_OFF);
    if (tid0 < 32) MISC[tid0] = 0u;
    __syncthreads();
    unsigned* ctl0 = (unsigned*)(args.ws + WS_CTL);
    const int lo = args.ph_lo, hi = args.ph_hi;
    XcdBarrier bar; bar.bar = ctl0 + CW_BAR + args.region * 4096; bar.x = 0; bar.st = MISC + 8;
    if (hi - lo > 1) bar = xcd_barrier_post(ctl0 + CW_BAR + args.region * 4096, MISC + 8);

    if (IN(0)) { MKF(); phase_proA(F); }
    SEAM(0);
    if (IN(1)) { MKF(); phase_proB(F); }
    SEAM(1);
    run_layer<0>(args, lds_raw, bar, lo, hi);
    run_layer<1>(args, lds_raw, bar, lo, hi);
}

extern "C" void kernel_launch(void* const* d_in, const int* in_sizes, int n_in, void* d_out, int out_size, void* d_ws, size_t ws_size, hipStream_t stream) {
    static int grid = 0;
    if (grid == 0) {
        if (n_in != 29 || ws_size < WS_END || out_size != TLAT * D) { fprintf(stderr, "kernel_launch: unexpected problem: n_in %d ws %zu out %d\n", n_in, ws_size, out_size); grid = -1; return; }
        int dev = 0, cus = 0;
        if (hipGetDevice(&dev) != hipSuccess || hipDeviceGetAttribute(&cus, hipDeviceAttributeMultiprocessorCount, dev) != hipSuccess) { grid = -1; return; }
        if (hipFuncSetAttribute((const void*)mk_fwd, hipFuncAttributeMaxDynamicSharedMemorySize, LDS_BYTES) != hipSuccess) { fprintf(stderr, "kernel_launch: hipFuncSetAttribute failed\n"); grid = -1; return; }
        int per_cu = 0;
        if (hipOccupancyMaxActiveBlocksPerMultiprocessor(&per_cu, (const void*)mk_fwd, NTHR, LDS_BYTES) != hipSuccess || per_cu < 1) fprintf(stderr, "kernel_launch: occupancy query reports %d\n", per_cu);
        (void)hipGetLastError();
        grid = cus;
    }
    if (grid < 0) return;
    (void)hipMemsetAsync((char*)d_ws + WS_CTL, 0, CTL_BYTES, stream);
    Args a{};
    for (int i = 0; i < 29; ++i) a.in[i] = (const float*)d_in[i];
    a.out = (float*)d_out; a.ws = (unsigned char*)d_ws;
#if MK_ONE_LAUNCH
    a.ph_lo = 0; a.ph_hi = NPHASES; a.region = 0;
    hipLaunchKernelGGL(mk_fwd, dim3(grid), dim3(NTHR), LDS_BYTES, stream, a);
#else
    for (int p = 0; p < NPHASES; ++p) { a.ph_lo = p; a.ph_hi = p + 1; a.region = 0; hipLaunchKernelGGL(mk_fwd, dim3(grid), dim3(NTHR), LDS_BYTES, stream, a); }
#endif
}
```

```cpp
#include <hip/hip_runtime.h>
#include <cstdio>
#include <cstdint>

#define LAS __attribute__((address_space(3)))
typedef unsigned short bf16_t;
typedef short bf16x8 __attribute__((ext_vector_type(8)));
typedef float f32x4 __attribute__((ext_vector_type(4)));
typedef float f32x2 __attribute__((ext_vector_type(2)));
typedef unsigned u32x4 __attribute__((ext_vector_type(4)));
typedef unsigned u32x2 __attribute__((ext_vector_type(2)));

constexpr int D = 1024, NBATCH = 8, SEQ = 4096, CTXL = 256;
constexpr int TLAT = NBATCH * SEQ, TCTX = NBATCH * CTXL, TT = TLAT + TCTX;
constexpr int LDP = 11520;
constexpr int C_GQ = 0, C_GK = 512, C_GV = 1024, C_GG = 2048, C_LX = 3072, C_LG = 4096, C_RQ = 5120, C_RK = 5632, C_RV = 6144, C_RG = 7168, C_MG = 8192, C_LR = 11264;
constexpr int IN_TOTAL = 11296, NE = 32;
constexpr int SLOT_TILES_MAX = 576;
constexpr float EPS = 1e-6f;

constexpr size_t MiB = (size_t)1 << 20;
constexpr size_t WS_CTL = 0, CTL_BYTES = 1 * MiB;
constexpr size_t WS_MODP = 1 * MiB, WS_MODS = 5 * MiB, WS_COS = 6 * MiB, WS_SIN = 7 * MiB, WS_LSL = 8 * MiB, WS_CARA = 9 * MiB, WS_CARH = 11 * MiB;
constexpr size_t WS_TOKE = 13 * MiB, WS_TOKW = WS_TOKE + 768 * 1024, WS_TOKP = WS_TOKW + 768 * 1024, WS_TOKS = WS_TOKP + 768 * 1024;
constexpr size_t WS_WIN = 16 * MiB, WS_WLRU = 39 * MiB, WS_WBR = 41 * MiB, WS_WOUT = 47 * MiB, WS_WGU = 49 * MiB, WS_WDN = 177 * MiB;
constexpr size_t WS_XS = 241 * MiB, WS_P = 377 * MiB, WS_B = 1142 * MiB, WS_C = 1430 * MiB, WS_D = 1702 * MiB, WS_E = 1770 * MiB, WS_END = 1906 * MiB;
constexpr size_t ROWB = (size_t)TT * D * 2;
static_assert(ROWB == 68 * MiB, "row buffer");
constexpr int CW_CNT = 1024, CW_NT = 1024 + 128, CW_TILE = 2048, CW_BAR = 8192;

__device__ __forceinline__ float bflo(unsigned w) { return __uint_as_float(w << 16); }
__device__ __forceinline__ float bfhi(unsigned w) { return __uint_as_float(w & 0xffff0000u); }
__device__ __forceinline__ unsigned f2bf(float f) { unsigned u = __float_as_uint(f); return (u + 0x7fffu + ((u >> 16) & 1u)) >> 16; }
__device__ __forceinline__ unsigned pk2(float lo, float hi) { return f2bf(lo) | (f2bf(hi) << 16); }
__device__ __forceinline__ float sigmoidf_(float x) { return __builtin_amdgcn_rcpf(1.0f + __expf(-x)); }
__device__ __forceinline__ float siluf_(float x) { return x * sigmoidf_(x); }
__device__ __forceinline__ float logsigmoidf_(float z) { return fminf(z, 0.f) - __logf(1.0f + __expf(-fabsf(z))); }
__device__ __forceinline__ float gelu_tanh_(float x) { const float u = 0.7978845608028654f * (x + 0.044715f * x * x * x); const float t = 1.0f - 2.0f * __builtin_amdgcn_rcpf(__expf(2.0f * u) + 1.0f); return 0.5f * x * (1.0f + t); }
__device__ __forceinline__ float wave_sum(float v) {
#pragma unroll
    for (int o = 1; o < 64; o <<= 1) v += __shfl_xor(v, o);
    return v;
}
#define LDS_WAIT() asm volatile("s_waitcnt lgkmcnt(0)" ::: "memory")

namespace pg8 {
#define PG8_LAS __attribute__((address_space(3)))
constexpr int BM = 256, BK = 64, HALF = 128, HTB = HALF * BK * 2, STAGE_BYTES = 8 * HTB, NXCD = 8, WGM = 8;
__host__ __device__ __forceinline__ int lds_byte(int r, int c) { const int st = (r >> 4) * 2 + (c >> 5), rr = r & 15, cc = c & 31, ob = rr * 64 + cc * 2; return st * 1024 + (ob ^ (((ob >> 9) & 1) << 5)); }
__host__ __device__ __forceinline__ void stage_rc(int b, int& R, int& C) { const int st = b / 1024, sb = b % 1024, swz = sb ^ (((sb >> 9) & 1) << 5); R = (st >> 1) * 16 + swz / 64; C = (st & 1) * 32 + (swz % 64) / 2; }
__host__ __device__ __forceinline__ int perm32(int rho) { const int n = rho >> 4, i = rho & 15; return 8 * (i >> 2) + 4 * n + (i & 3); }
struct Unit { int pm, pn, aux; const char* a; const char* b; };
struct Gemm { int lda, ldb, K; };
__device__ __forceinline__ void tile_of(int L, int nM, int nN, int& pm, int& pn) {
    const int nwg = nM * nN; int wgid = L; { const int q = nwg / NXCD, r = nwg % NXCD, xcd = wgid % NXCD, off = wgid / NXCD; wgid = (xcd < r ? xcd * (q + 1) : r * (q + 1) + (xcd - r) * q) + off; }
    const int nig = WGM * nN, gid = wgid / nig, fm = gid * WGM, gsz = (nM - fm) < WGM ? (nM - fm) : WGM;
    pm = fm + ((wgid % nig) % gsz); pn = (wgid % nig) / gsz;
}
__device__ __forceinline__ unsigned cvt_pk_bf16(float lo, float hi) { unsigned r; asm volatile("v_cvt_pk_bf16_f32 %0, %1, %2" : "=v"(r) : "v"(lo), "v"(hi)); return r; }
template <class Epi, class Sched, bool ALIGN_EPI = false, bool SP2 = false>
__device__ __forceinline__ void gemm_phase(PG8_LAS unsigned char* lds, const Gemm g, const Sched& S, const Epi& E) {
    int tid_o = threadIdx.x; asm volatile("" : "+v"(tid_o));
    const int tid = tid_o, wid = __builtin_amdgcn_readfirstlane(tid >> 6), lane = tid & 63, wr = wid >> 2, wc = wid & 3, fr = lane & 15, fq = lane >> 4;
    const int K = g.K, nt = K / BK;
    unsigned voffA[2], voffB[2];
#pragma unroll
    for (int i = 0; i < 2; ++i) { int R, C; stage_rc(tid * 16 + i * 8192, R, C); const int Rb = Epi::PERM ? ((R & ~31) + perm32(R & 31)) : R;
        voffA[i] = (unsigned)(R * g.lda + C) * 2u; voffB[i] = (unsigned)(Rb * g.ldb + C) * 2u; }
    const size_t kstep = (size_t)(BK * 2);
    const size_t hstepA = (size_t)HALF * g.lda * 2, hstepB = (size_t)HALF * g.ldb * 2;
    const unsigned ldsw = (unsigned)wid * 1024u;
    const int aoff = lds_byte(wr * 64 + fr, fq * 8), boff = lds_byte(wc * 32 + fr, fq * 8);
#define PG8_SA(b, h) (((b) * 2 + (h)) * HTB)
#define PG8_SB(b, h) ((4 + (b) * 2 + (h)) * HTB)
#define PG8_STAGE(bufoff, gbase, voff) do { _Pragma("unroll") for (int _i = 0; _i < 2; ++_i) \
        __builtin_amdgcn_global_load_lds((const unsigned*)((const char*)(gbase) + (voff)[_i]), (PG8_LAS unsigned*)(lds + (bufoff) + ldsw + _i * 8192), 16, 0, 0); } while (0)
#define PG8_LDA(dst, b, h) do { _Pragma("unroll") for (int m = 0; m < 4; ++m) _Pragma("unroll") for (int k = 0; k < 2; ++k) dst[m][k] = *(const PG8_LAS bf16x8*)(lds + PG8_SA(b, h) + aoff + m * 2048 + k * 1024); } while (0)
#define PG8_LDB(dst, b, h) do { _Pragma("unroll") for (int n = 0; n < 2; ++n) _Pragma("unroll") for (int k = 0; k < 2; ++k) dst[n][k] = *(const PG8_LAS bf16x8*)(lds + PG8_SB(b, h) + boff + n * 2048 + k * 1024); } while (0)
#define PG8_MMA(ai, bj, At, Bt) do { __builtin_amdgcn_s_setprio(1); _Pragma("unroll") for (int m = 0; m < 4; ++m) _Pragma("unroll") for (int n = 0; n < 2; ++n) _Pragma("unroll") for (int k = 0; k < 2; ++k) \
        acc[ai][bj][m][n] = __builtin_amdgcn_mfma_f32_16x16x32_bf16(Bt[n][k], At[m][k], acc[ai][bj][m][n], 0, 0, 0); __builtin_amdgcn_s_setprio(0); } while (0)
#define PG8_WAIT_V(n) asm volatile("s_waitcnt vmcnt(" #n ")" ::: "memory")
#define PG8_WAIT_L(n) asm volatile("s_waitcnt lgkmcnt(" #n ")" ::: "memory")
#define PG8_BAR __builtin_amdgcn_s_barrier()
#define PG8_SCHED __builtin_amdgcn_sched_barrier(0)
    Unit cur, nxt; int ui = 0;
    if (!S.next(0, cur)) return;
    f32x4 acc[2][2][4][2];
#pragma unroll
    for (int a = 0; a < 2; ++a)
#pragma unroll
        for (int b = 0; b < 2; ++b)
#pragma unroll
            for (int m = 0; m < 4; ++m)
#pragma unroll
                for (int n = 0; n < 2; ++n) acc[a][b][m][n] = (f32x4){0.f, 0.f, 0.f, 0.f};
    bf16x8 At[4][2], B0[2][2], B1[2][2];
    const char* cA = cur.a; const char* cB = cur.b;
    S.a_ready(cur);
    if constexpr (SP2) {
        PG8_STAGE(PG8_SB(0, 0), cB, voffB); PG8_STAGE(PG8_SB(0, 1), cB + hstepB, voffB); PG8_STAGE(PG8_SA(0, 0), cA, voffA); PG8_STAGE(PG8_SA(0, 1), cA + hstepA, voffA);
        if (wr == 1) PG8_BAR;
        PG8_WAIT_V(2); PG8_BAR;
        PG8_STAGE(PG8_SB(1, 0), cB + kstep, voffB); PG8_STAGE(PG8_SA(1, 0), cA + kstep, voffA); PG8_STAGE(PG8_SB(1, 1), cB + hstepB + kstep, voffB);
        PG8_WAIT_V(6); PG8_BAR;
    } else {
        PG8_STAGE(PG8_SB(0, 0), cB, voffB); PG8_STAGE(PG8_SA(0, 0), cA, voffA); PG8_STAGE(PG8_SB(0, 1), cB + hstepB, voffB); PG8_STAGE(PG8_SA(0, 1), cA + hstepA, voffA);
        if (wr == 1) PG8_BAR;
        PG8_WAIT_V(4); PG8_BAR;
        PG8_STAGE(PG8_SB(1, 0), cB + kstep, voffB); PG8_STAGE(PG8_SA(1, 0), cA + kstep, voffA); PG8_STAGE(PG8_SB(1, 1), cB + hstepB + kstep, voffB);
        PG8_WAIT_V(6); PG8_BAR;
    }
    for (;;) {
        const bool has_next = S.next(ui + 1, nxt);
        const char* nA = has_next ? nxt.a : cA; const char* nB = has_next ? nxt.b : cB;
        for (int t = 0; t < nt; t += 2) {
            const bool last = (t == nt - 2);
            const char* a1 = cA + (size_t)(t + 1) * kstep;
            const char* a2 = last ? nA : cA + (size_t)(t + 2) * kstep; const char* b2 = last ? nB : cB + (size_t)(t + 2) * kstep;
            const char* a3 = a2 + kstep; const char* b3 = b2 + kstep;
            if (last && has_next) S.a_ready(nxt);
            if constexpr (SP2) {
            PG8_LDB(B0, 0, 0); PG8_LDB(B1, 0, 1); PG8_SCHED; PG8_LDA(At, 0, 0); PG8_STAGE(PG8_SA(1, 1), a1 + hstepA, voffA);
            PG8_WAIT_V(8); PG8_WAIT_L(0); PG8_BAR; PG8_MMA(0, 0, At, B0); PG8_MMA(0, 1, At, B1); PG8_BAR; PG8_SCHED;
            PG8_LDA(At, 0, 1); PG8_STAGE(PG8_SB(0, 0), b2, voffB); PG8_STAGE(PG8_SB(0, 1), b2 + hstepB, voffB); PG8_STAGE(PG8_SA(0, 0), a2, voffA);
            PG8_WAIT_V(8); PG8_WAIT_L(0); PG8_BAR; PG8_MMA(1, 0, At, B0); PG8_MMA(1, 1, At, B1); PG8_BAR; PG8_SCHED;
            PG8_LDB(B0, 1, 0); PG8_LDB(B1, 1, 1); PG8_SCHED; PG8_LDA(At, 1, 0); PG8_STAGE(PG8_SA(0, 1), a2 + hstepA, voffA);
            PG8_WAIT_V(8); PG8_WAIT_L(0); PG8_BAR; PG8_MMA(0, 0, At, B0); PG8_MMA(0, 1, At, B1); PG8_BAR; PG8_SCHED;
            PG8_LDA(At, 1, 1); PG8_STAGE(PG8_SB(1, 0), b3, voffB); PG8_STAGE(PG8_SB(1, 1), b3 + hstepB, voffB); PG8_STAGE(PG8_SA(1, 0), a3, voffA);
            PG8_WAIT_V(8); PG8_WAIT_L(0); PG8_BAR; PG8_MMA(1, 0, At, B0); PG8_MMA(1, 1, At, B1); PG8_BAR; PG8_SCHED;
            } else {
            PG8_LDB(B0, 0, 0); PG8_SCHED; PG8_LDA(At, 0, 0); PG8_STAGE(PG8_SA(1, 1), a1 + hstepA, voffA);
            PG8_WAIT_L(8); PG8_BAR; PG8_WAIT_L(0); PG8_MMA(0, 0, At, B0); PG8_BAR; PG8_SCHED;
            PG8_LDB(B1, 0, 1); PG8_STAGE(PG8_SB(0, 0), b2, voffB);
            PG8_BAR; PG8_WAIT_L(0); PG8_MMA(0, 1, At, B1); PG8_BAR;
            PG8_LDA(At, 0, 1); PG8_STAGE(PG8_SA(0, 0), a2, voffA);
            PG8_BAR; PG8_WAIT_L(0); PG8_MMA(1, 0, At, B0); PG8_BAR; PG8_SCHED;
            PG8_STAGE(PG8_SB(0, 1), b2 + hstepB, voffB);
            PG8_WAIT_V(6); PG8_BAR; PG8_MMA(1, 1, At, B1); PG8_BAR;
            PG8_LDB(B0, 1, 0); PG8_SCHED; PG8_LDA(At, 1, 0); PG8_STAGE(PG8_SA(0, 1), a2 + hstepA, voffA);
            PG8_WAIT_L(8); PG8_BAR; PG8_WAIT_L(0); PG8_MMA(0, 0, At, B0); PG8_BAR; PG8_SCHED;
            PG8_LDB(B1, 1, 1); PG8_STAGE(PG8_SB(1, 0), b3, voffB);
            PG8_BAR; PG8_WAIT_L(0); PG8_MMA(0, 1, At, B1); PG8_BAR;
            PG8_LDA(At, 1, 1); PG8_STAGE(PG8_SA(1, 0), a3, voffA);
            PG8_BAR; PG8_WAIT_L(0); PG8_MMA(1, 0, At, B0); PG8_BAR; PG8_SCHED;
            PG8_STAGE(PG8_SB(1, 1), b3 + hstepB, voffB);
            PG8_WAIT_V(6); PG8_BAR; PG8_MMA(1, 1, At, B1); PG8_BAR;
            }
        }
        if constexpr (ALIGN_EPI) { if (wr == 0) PG8_BAR; }
        if constexpr (!Epi::AFTER_DRAIN) { E(acc, cur, wr, wc, fr, fq); S.done(cur); }
        if (!has_next) break;
#pragma unroll
        for (int a = 0; a < 2; ++a)
#pragma unroll
            for (int b = 0; b < 2; ++b)
#pragma unroll
                for (int m = 0; m < 4; ++m)
#pragma unroll
                    for (int n = 0; n < 2; ++n) acc[a][b][m][n] = (f32x4){0.f, 0.f, 0.f, 0.f};
        cur = nxt; cA = nA; cB = nB; ++ui;
        if constexpr (ALIGN_EPI) { if (wr == 1) PG8_BAR; }
    }
    PG8_WAIT_V(0);
    if constexpr (!ALIGN_EPI) { if (wr == 0) PG8_BAR; }
    PG8_BAR;
    if constexpr (Epi::AFTER_DRAIN) { E.fused(acc, cur, wr, wc, fr, fq, lds, wid, lane); S.done(cur); }
#undef PG8_SA
#undef PG8_SB
#undef PG8_STAGE
#undef PG8_LDA
#undef PG8_LDB
#undef PG8_MMA
#undef PG8_WAIT_V
#undef PG8_WAIT_L
#undef PG8_BAR
#undef PG8_SCHED
}
}

#define GAS __attribute__((address_space(1)))
typedef GAS unsigned gu32;
#define RLX_AGENT __ATOMIC_RELAXED, __HIP_MEMORY_SCOPE_AGENT
#define XB_TMO      128
#define XB_XCNT(j)  (256  + 64 * (j))
#define XB_XSUB(j)  (1280 + 64 * (j))
#define XB_XGEN(j)  (2304 + 64 * (j))
#define XB_TOP      3328
#define XB_TOPGEN   3392
#define XCD_BAR_WORDS 3456
#define XB_SPIN_CAP (1u << 18)

__device__ __forceinline__ unsigned xb_ld(unsigned* p)              { return __hip_atomic_load(p, __ATOMIC_RELAXED, __HIP_MEMORY_SCOPE_AGENT); }
__device__ __forceinline__ unsigned xb_add(unsigned* p, unsigned v) { return __hip_atomic_fetch_add(p, v, __ATOMIC_RELAXED, __HIP_MEMORY_SCOPE_AGENT); }
__device__ __forceinline__ unsigned xb_xcc_id() { return (unsigned)__builtin_amdgcn_s_getreg((3 << 11) | 20) & 0xFu; }
#define XB_SPIN(cond, bar) do { unsigned _sp = 0; while (cond) { __builtin_amdgcn_s_sleep(1); \
    if ((++_sp & 255u) == 0u) { if (xb_ld(&(bar)[XB_TMO])) break; if (_sp > XB_SPIN_CAP) { atomicAdd(&(bar)[XB_TMO], 1u); break; } } } } while (0)

struct XcdBarrier {
    unsigned* bar; unsigned x;
    volatile LAS unsigned* st;
};

__device__ __forceinline__ XcdBarrier xcd_barrier_post(unsigned* bar, volatile LAS unsigned* st) {
    XcdBarrier b; b.bar = bar; b.x = xb_xcc_id(); b.st = st;
    if (threadIdx.x == 0) (void)xb_add(&bar[XB_XCNT(b.x)], 1u);
    return b;
}
__device__ __forceinline__ void xcd_barrier_complete(unsigned* bar, unsigned x, unsigned& nloc, unsigned& nx) {
    const unsigned G = gridDim.x * gridDim.y * gridDim.z;
    unsigned sum, cnt, mine, sp = 0u;
    for (;;) {
        sum = 0u; cnt = 0u; mine = 0u;
#pragma unroll
        for (unsigned j = 0; j < 16; ++j) { const unsigned c = xb_ld(&bar[XB_XCNT(j)]); sum += c; cnt += (c > 0u) ? 1u : 0u; mine = (j == x) ? c : mine; }
        if (sum == G) break;
        __builtin_amdgcn_s_sleep(1);
        if ((++sp & 255u) == 0u) { if (xb_ld(&bar[XB_TMO])) break; if (sp > XB_SPIN_CAP) { atomicAdd(&bar[XB_TMO], 1u); break; } }
    }
    nloc = mine > 0u ? mine : 1u; nx = cnt > 0u ? cnt : 1u;
}

__device__ __forceinline__ void xcd_barrier(const XcdBarrier& b) {
    asm volatile("s_waitcnt vmcnt(0)" ::: "memory");
    __syncthreads();
    if (threadIdx.x == 0) {
        unsigned* bar = b.bar;
        __builtin_amdgcn_s_waitcnt(0);
        unsigned nloc = b.st[0], nx = b.st[1];
        if (nloc == 0u) { xcd_barrier_complete(bar, b.x, nloc, nx); b.st[0] = nloc; b.st[1] = nx; }
        const unsigned old = xb_add(&bar[XB_XSUB(b.x)], 1u);
        const unsigned gen = old / nloc;
        if (old + 1u == (gen + 1u) * nloc) {
            __builtin_amdgcn_fence(__ATOMIC_RELEASE, "agent");
            asm volatile("s_waitcnt vmcnt(0)" ::: "memory");
            const unsigned og = xb_add(&bar[XB_TOP], 1u);
            const unsigned tg = og / nx;
            if (og + 1u == (tg + 1u) * nx) xb_add(&bar[XB_TOPGEN], 1u);
            else XB_SPIN(xb_ld(&bar[XB_TOPGEN]) == tg, bar);
            __builtin_amdgcn_fence(__ATOMIC_ACQUIRE, "agent");
            xb_add(&bar[XB_XGEN(b.x)], 1u);
            asm volatile("s_waitcnt vmcnt(0)" ::: "memory");
        } else {
            XB_SPIN(xb_ld(&bar[XB_XGEN(b.x)]) == gen, bar);
            __builtin_amdgcn_fence(__ATOMIC_ACQUIRE, "agent");
            asm volatile("s_waitcnt vmcnt(0)" ::: "memory");
        }
    }
    __syncthreads();
}

struct OrderBase {
    __device__ __forceinline__ void a_ready(const pg8::Unit&) const {}
    __device__ __forceinline__ void done(const pg8::Unit&) const {}
};
struct PlainOrder : OrderBase {
    const char* A; const char* B; size_t astep, bstep; int nM, nN, G, c;
    __device__ __forceinline__ bool next(int i, pg8::Unit& u) const {
        const long L = (long)i * G + c; if (L >= (long)nM * nN) return false;
        pg8::tile_of((int)L, nM, nN, u.pm, u.pn); u.aux = 0; u.a = A + (size_t)u.pm * astep; u.b = B + (size_t)u.pn * bstep; return true; }
};
struct LruOrder : OrderBase {
    const char* A; const char* B; int nM, G, c;
    __device__ __forceinline__ bool next(int i, pg8::Unit& u) const {
        const long L = (long)i * G + c; if (L >= (long)nM * 16) return false;
        pg8::tile_of((int)L, nM, 16, u.pm, u.pn); u.aux = 0; u.a = A + (size_t)u.pm * (256 * 1024 * 2) + (size_t)(u.pn >> 2) * 512; u.b = B + (size_t)u.pn * (256 * 256 * 2); return true; }
};
struct BranchOrder : OrderBase {
    const char* A; const char* B; int nM, G, c;
    __device__ __forceinline__ bool next(int i, pg8::Unit& u) const {
        const int j = i / 3, br = i - 3 * j; const long L = (long)j * G + c; if (L >= (long)nM * 4) return false;
        pg8::tile_of((int)L, nM, 4, u.pm, u.pn); u.aux = br; u.a = A + (size_t)br * ROWB + (size_t)u.pm * (256 * 1024 * 2); u.b = B + (size_t)br * (1024 * 1024 * 2) + (size_t)u.pn * (256 * 1024 * 2); return true; }
};
struct MoeOrder : OrderBase {
    const char* A; const char* B; const unsigned* tile_e; size_t estep; int nM, nN, G, c;
    __device__ __forceinline__ bool next(int i, pg8::Unit& u) const {
        const long L = (long)i * G + c; if (L >= (long)nM * nN) return false;
        pg8::tile_of((int)L, nM, nN, u.pm, u.pn); const int e = (int)tile_e[u.pm]; u.aux = e;
        u.a = A + (size_t)u.pm * (256 * 1024 * 2); u.b = B + (size_t)e * estep + (size_t)u.pn * (256 * 1024 * 2); return true; }
};

struct EpiBf16Bias {
    static constexpr bool PERM = true, AFTER_DRAIN = false;
    bf16_t* O; int ldc; const float* bias; int bstride;
    __device__ __forceinline__ void operator()(const f32x4 (&acc)[2][2][4][2], const pg8::Unit& u, int wr, int wc, int fr, int fq) const {
        const int row0 = u.pm * 256 + wr * 64 + fr, col0 = u.pn * 256 + wc * 32 + 8 * fq;
        f32x4 bv[2][2];
#pragma unroll
        for (int bj = 0; bj < 2; ++bj)
#pragma unroll
            for (int n = 0; n < 2; ++n) bv[bj][n] = bias ? *(const f32x4*)(bias + (size_t)u.aux * bstride + col0 + bj * 128 + 4 * n) : (f32x4){0.f, 0.f, 0.f, 0.f};
#pragma unroll
        for (int ai = 0; ai < 2; ++ai)
#pragma unroll
            for (int m = 0; m < 4; ++m) { bf16_t* rowp = O + (size_t)(row0 + ai * 128 + m * 16) * ldc + col0;
#pragma unroll
                for (int bj = 0; bj < 2; ++bj) { const f32x4 v0 = acc[ai][bj][m][0] + bv[bj][0], v1 = acc[ai][bj][m][1] + bv[bj][1];
                    u32x4 w; w.x = pg8::cvt_pk_bf16(v0[0], v0[1]); w.y = pg8::cvt_pk_bf16(v0[2], v0[3]); w.z = pg8::cvt_pk_bf16(v1[0], v1[1]); w.w = pg8::cvt_pk_bf16(v1[2], v1[3]);
                    *(u32x4*)(rowp + bj * 128) = w; } }
    }
};
struct EpiLru {
    static constexpr bool PERM = true, AFTER_DRAIN = false;
    const bf16_t* xc; bf16_t* LA; bf16_t* BB; const float* ba; const float* bi; const float* lsl;
    __device__ __forceinline__ void operator()(const f32x4 (&acc)[2][2][4][2], const pg8::Unit& u, int wr, int wc, int fr, int fq) const {
        const int g = u.pn >> 2, d = (u.pn >> 1) & 1, hh = u.pn & 1;
        const int row0 = u.pm * 256 + wr * 64 + fr, ch0 = 256 * g + 128 * hh + wc * 32 + 8 * fq;
#pragma unroll
        for (int ai = 0; ai < 2; ++ai)
#pragma unroll
            for (int m = 0; m < 4; ++m) { const size_t off = (size_t)(row0 + ai * 128 + m * 16) * 1024 + ch0;
                const u32x4 xw = *(const u32x4*)(xc + off); float la[8], bb[8];
#pragma unroll
                for (int n = 0; n < 2; ++n) { const f32x4 pb = *(const f32x4*)(ba + d * 1024 + ch0 + 4 * n), pi = *(const f32x4*)(bi + d * 1024 + ch0 + 4 * n), pl = *(const f32x4*)(lsl + d * 1024 + ch0 + 4 * n);
#pragma unroll
                    for (int e = 0; e < 4; ++e) { const int idx = 4 * n + e; const unsigned w = xw[idx >> 1]; const float xv = (idx & 1) ? bfhi(w) : bflo(w);
                        const float r = sigmoidf_(acc[ai][0][m][n][e] + pb[e]), ig = sigmoidf_(acc[ai][1][m][n][e] + pi[e]);
                        const float l = 8.0f * r * pl[e]; la[idx] = l; bb[idx] = sqrtf(fmaxf(1.0f - __expf(2.0f * l), 0.f)) * ig * xv; } }
                u32x4 w1, w2; w1.x = pg8::cvt_pk_bf16(la[0], la[1]); w1.y = pg8::cvt_pk_bf16(la[2], la[3]); w1.z = pg8::cvt_pk_bf16(la[4], la[5]); w1.w = pg8::cvt_pk_bf16(la[6], la[7]);
                w2.x = pg8::cvt_pk_bf16(bb[0], bb[1]); w2.y = pg8::cvt_pk_bf16(bb[2], bb[3]); w2.z = pg8::cvt_pk_bf16(bb[4], bb[5]); w2.w = pg8::cvt_pk_bf16(bb[6], bb[7]);
                *(u32x4*)(LA + (size_t)d * TT * 1024 + off) = w1; *(u32x4*)(BB + (size_t)d * TT * 1024 + off) = w2; asm volatile("" ::: "memory"); }
    }
};
struct EpiBranch {
    static constexpr bool PERM = true, AFTER_DRAIN = false;
    const bf16_t* P; float* MF; bf16_t* MG;
    __device__ __forceinline__ void operator()(const f32x4 (&acc)[2][2][4][2], const pg8::Unit& u, int wr, int wc, int fr, int fq) const {
        const int br = u.aux, row0 = u.pm * 256 + wr * 64 + fr, col0 = u.pn * 256 + wc * 32 + 8 * fq;
#pragma unroll
        for (int ai = 0; ai < 2; ++ai)
#pragma unroll
            for (int m = 0; m < 4; ++m) { const size_t row = (size_t)(row0 + ai * 128 + m * 16);
#pragma unroll
                for (int bj = 0; bj < 2; ++bj) { const int c = col0 + bj * 128;
                    const u32x4 gw = *(const u32x4*)(P + row * LDP + C_MG + br * 1024 + c);
                    f32x4 v0, v1;
                    v0[0] = sigmoidf_(bflo(gw.x)) * acc[ai][bj][m][0][0]; v0[1] = sigmoidf_(bfhi(gw.x)) * acc[ai][bj][m][0][1]; v0[2] = sigmoidf_(bflo(gw.y)) * acc[ai][bj][m][0][2]; v0[3] = sigmoidf_(bfhi(gw.y)) * acc[ai][bj][m][0][3];
                    v1[0] = sigmoidf_(bflo(gw.z)) * acc[ai][bj][m][1][0]; v1[1] = sigmoidf_(bfhi(gw.z)) * acc[ai][bj][m][1][1]; v1[2] = sigmoidf_(bflo(gw.w)) * acc[ai][bj][m][1][2]; v1[3] = sigmoidf_(bfhi(gw.w)) * acc[ai][bj][m][1][3];
                    float* mf = MF + row * 1024 + c;
                    if (br != 0) { v0 += *(const f32x4*)mf; v1 += *(const f32x4*)(mf + 4); }
                    if (br != 2) { *(f32x4*)mf = v0; *(f32x4*)(mf + 4) = v1; }
                    else { u32x4 w; w.x = pg8::cvt_pk_bf16(v0[0], v0[1]); w.y = pg8::cvt_pk_bf16(v0[2], v0[3]); w.z = pg8::cvt_pk_bf16(v1[0], v1[1]); w.w = pg8::cvt_pk_bf16(v1[2], v1[3]);
                        *(u32x4*)(MG + row * 1024 + c) = w; } } }
    }
};
struct EpiOut {
    static constexpr bool PERM = false, AFTER_DRAIN = false;
    const float* baseLat; const float* baseCtx; float* xs; const float* gate;
    __device__ __forceinline__ void operator()(const f32x4 (&acc)[2][2][4][2], const pg8::Unit& u, int wr, int wc, int fr, int fq) const {
        const int mrow = u.pm < 128 ? (u.pm >> 4) : 8; const float* gp = gate + mrow * 6144;
        const int row0 = u.pm * 256 + wr * 64 + fr, col0 = u.pn * 256 + wc * 32 + 4 * fq;
        const float* base = u.pm < 128 ? baseLat + (size_t)row0 * 1024 : baseCtx + (size_t)(row0 - TLAT) * 1024;
        f32x4 gv[2][2];
#pragma unroll
        for (int bj = 0; bj < 2; ++bj)
#pragma unroll
            for (int n = 0; n < 2; ++n) gv[bj][n] = *(const f32x4*)(gp + col0 + bj * 128 + n * 16);
#pragma unroll
        for (int ai = 0; ai < 2; ++ai)
#pragma unroll
            for (int m = 0; m < 4; ++m) { const size_t ro = (size_t)(ai * 128 + m * 16) * 1024 + col0; float* op = xs + (size_t)row0 * 1024 + ro;
#pragma unroll
                for (int bj = 0; bj < 2; ++bj)
#pragma unroll
                    for (int n = 0; n < 2; ++n) *(f32x4*)(op + bj * 128 + n * 16) = *(const f32x4*)(base + ro + bj * 128 + n * 16) + gv[bj][n] * acc[ai][bj][m][n]; }
    }
};
struct EpiSwiglu {
    static constexpr bool PERM = true, AFTER_DRAIN = false;
    bf16_t* H; const float* bgu;
    __device__ __forceinline__ void operator()(const f32x4 (&acc)[2][2][4][2], const pg8::Unit& u, int wr, int wc, int fr, int fq) const {
        const int row0 = u.pm * 256 + wr * 64 + fr, f0 = u.pn * 128 + wc * 32 + 8 * fq;
        float bg[8], bu[8];
#pragma unroll
        for (int q = 0; q < 4; ++q) { const f32x4 b = *(const f32x4*)(bgu + (size_t)u.aux * 2048 + 2 * f0 + 4 * q); bg[2 * q] = b[0]; bu[2 * q] = b[1]; bg[2 * q + 1] = b[2]; bu[2 * q + 1] = b[3]; }
#pragma unroll
        for (int ai = 0; ai < 2; ++ai)
#pragma unroll
            for (int m = 0; m < 4; ++m) { float a[8];
#pragma unroll
                for (int n = 0; n < 2; ++n)
#pragma unroll
                    for (int e = 0; e < 4; ++e) { const int idx = 4 * n + e; const float gt = fminf(acc[ai][0][m][n][e] + bg[idx], 7.0f), up = fminf(fmaxf(acc[ai][1][m][n][e] + bu[idx], -7.0f), 7.0f);
                        a[idx] = gt * sigmoidf_(1.702f * gt) * (up + 1.0f); }
                u32x4 w; w.x = pg8::cvt_pk_bf16(a[0], a[1]); w.y = pg8::cvt_pk_bf16(a[2], a[3]); w.z = pg8::cvt_pk_bf16(a[4], a[5]); w.w = pg8::cvt_pk_bf16(a[6], a[7]);
                *(u32x4*)(H + (size_t)(row0 + ai * 128 + m * 16) * 1024 + f0) = w; }
    }
};

constexpr int NWAVES = 8, NTHR = 512;
constexpr int LDS_BYTES = 163840, MISC_OFF = 163840 - 512;
struct Frame {
    LAS unsigned char* lds; GAS unsigned char* ws; const float* const* in; float* out;
    int tid, bx, lane, wave, G, gw, NGW, gtid, NGT;
};
__device__ __forceinline__ int mrow_of(int row) { return row < TLAT ? (row >> 12) : 8; }
__device__ __forceinline__ int seqrow(int d, int b, int p) {
    if (p < CTXL) return TLAT + b * CTXL + (d ? CTXL - 1 - p : p);
    const int q = p - CTXL; return b * SEQ + (d ? SEQ - 1 - q : q);
}
struct RowV { f32x4 v[4]; };
__device__ __forceinline__ RowV load_row(const float* p, int lane) { RowV r;
#pragma unroll
    for (int j = 0; j < 4; ++j) r.v[j] = *(const f32x4*)(p + 4 * lane + 256 * j);
    return r; }
__device__ __forceinline__ float row_sumsq(const RowV& r) { float s = 0.f;
#pragma unroll
    for (int j = 0; j < 4; ++j) s += (r.v[j][0] * r.v[j][0] + r.v[j][1] * r.v[j][1]) + (r.v[j][2] * r.v[j][2] + r.v[j][3] * r.v[j][3]);
    return wave_sum(s); }
__device__ __forceinline__ RowV norm_mod(const RowV& x, const float* gain, const float* shift, const float* scale, int lane) {
    const float rs = rsqrtf(row_sumsq(x) * (1.0f / D) + EPS); RowV y;
#pragma unroll
    for (int j = 0; j < 4; ++j) { const int c = 4 * lane + 256 * j; const f32x4 g = *(const f32x4*)(gain + c), sh = *(const f32x4*)(shift + c), sc = *(const f32x4*)(scale + c);
        y.v[j] = (x.v[j] * rs) * g * (sc + 1.0f) + sh; }
    return y; }
__device__ __forceinline__ void store_row_bf16(bf16_t* p, const RowV& y, int lane) {
#pragma unroll
    for (int j = 0; j < 4; ++j) { u32x2 w; w.x = pk2(y.v[j][0], y.v[j][1]); w.y = pk2(y.v[j][2], y.v[j][3]); *(u32x2*)(p + 4 * lane + 256 * j) = w; } }
__device__ __forceinline__ f32x4 ld4bf(const bf16_t* p) { const u32x2 w = *(const u32x2*)p; return (f32x4){bflo(w.x), bfhi(w.x), bflo(w.y), bfhi(w.y)}; }

__device__ __forceinline__ void phase_proA(const Frame& F) {
    const float* c = F.in[1]; const float* cc = F.in[3]; const float* w_ada = F.in[4];
    float* modp = (float*)(F.ws + WS_MODP);
    for (int it = F.gw; it < 2 * 8 * 96; it += F.NGW) {
        const int cg = it % 96, ks = (it / 96) % 8, l = it / 768, col = cg * 64 + F.lane;
        float acc[9];
#pragma unroll
        for (int r = 0; r < 9; ++r) acc[r] = 0.f;
        for (int k = ks * 128; k < ks * 128 + 128; ++k) {
            const float w = w_ada[((size_t)l * 1024 + k) * 6144 + col];
#pragma unroll
            for (int r = 0; r < 8; ++r) acc[r] += siluf_(c[r * 1024 + k]) * w;
            acc[8] += siluf_(cc[k]) * w;
        }
#pragma unroll
        for (int r = 0; r < 9; ++r) modp[((size_t)(ks * 2 + l) * 9 + r) * 6144 + col] = acc[r];
    }
    float* rc = (float*)(F.ws + WS_COS); float* rsn = (float*)(F.ws + WS_SIN);
    for (int i = F.gtid; i < SEQ * 64; i += F.NGT) {
        const int t = i >> 6, j = i & 63, f = j & 31; const float pos = (float)((j < 32) ? (t >> 6) : (t & 63));
        const float inv = exp2f(-(float)f * (13.287712379549449f / 32.0f)); const float ang = pos * inv;
        const float nn = rintf(ang * 0.15915494309189535f); float r = fmaf(-nn, 6.28125f, ang); r = fmaf(-nn, 1.9353071795864769e-3f, r);
        rc[i] = __cosf(r); rsn[i] = __sinf(r);
    }
}
__device__ __forceinline__ void phase_proB(const Frame& F) {
    const float* modp = (const float*)(F.ws + WS_MODP); float* mods = (float*)(F.ws + WS_MODS); const float* b_ada = F.in[5];
    for (int i = F.gtid; i < 2 * 9 * 6144; i += F.NGT) { const int l = i / (9 * 6144), col = i % 6144; float s = b_ada[l * 6144 + col];
#pragma unroll
        for (int ks = 0; ks < 8; ++ks) s += modp[(size_t)ks * (2 * 9 * 6144) + i];
        mods[i] = s; }
}

template <class RM> __device__ __forceinline__ void tr_item(const float* W, int ldw, int k0, int n0, bf16_t* WT, int ldt, LAS float* scr, int lane, const RM& rm) {
#pragma unroll 8
    for (int i = 0; i < 32; ++i) { const int kk = 2 * i + (lane >> 5); scr[kk * 33 + (lane & 31)] = W[(size_t)(k0 + kk) * ldw + n0 + (lane & 31)]; }
    LDS_WAIT(); asm volatile("" ::: "memory");
    const int c = lane & 7;
#pragma unroll
    for (int j = 0; j < 4; ++j) { const int n = (lane >> 3) + 8 * j; const LAS float* s = scr + (8 * c) * 33 + n; int drow; float sc; rm(n0 + n, drow, sc);
        u32x4 o; o.x = pk2(s[0 * 33] * sc, s[1 * 33] * sc); o.y = pk2(s[2 * 33] * sc, s[3 * 33] * sc); o.z = pk2(s[4 * 33] * sc, s[5 * 33] * sc); o.w = pk2(s[6 * 33] * sc, s[7 * 33] * sc);
        *(u32x4*)(WT + (size_t)drow * ldt + k0 + 8 * c) = o; }
    LDS_WAIT(); asm volatile("" ::: "memory");
}
struct RmIn { __device__ __forceinline__ void operator()(int n, int& drow, float& sc) const {
    drow = n < 3072 ? n : (n < 3104 ? C_LR + (n - 3072) : n - 32); sc = (n < 512 || (n >= 5664 && n < 6176)) ? 0.08838834764831845f : 1.0f; } };
struct RmId { __device__ __forceinline__ void operator()(int n, int& drow, float& sc) const { drow = n; sc = 1.0f; } };
struct RmLru { int base; __device__ __forceinline__ void operator()(int n, int& drow, float& sc) const { drow = base + (n & 127); sc = 1.0f; } };
struct RmGu { __device__ __forceinline__ void operator()(int n, int& drow, float& sc) const { const int f = n >> 1, u = n & 1; drow = 256 * (f >> 7) + 128 * u + (f & 127); sc = 1.0f; } };
__device__ __forceinline__ void phase_W(const Frame& F, int li) {
    LAS float* scr = (LAS float*)(F.lds + F.wave * 8704);
    bf16_t* Win_t = (bf16_t*)(F.ws + WS_WIN); bf16_t* Wlru_t = (bf16_t*)(F.ws + WS_WLRU); bf16_t* Wbr_t = (bf16_t*)(F.ws + WS_WBR);
    bf16_t* Wout_t = (bf16_t*)(F.ws + WS_WOUT); bf16_t* Wgu_t = (bf16_t*)(F.ws + WS_WGU); bf16_t* Wdn_t = (bf16_t*)(F.ws + WS_WDN);
    constexpr int I_IN = 16 * 353, I_LRU = 512, I_BR = 1536, I_OUT = 512, I_GU = 32768, I_DN = 16384, NITEMS = I_IN + I_LRU + I_BR + I_OUT + I_GU + I_DN;
    for (int it0 = F.gw; it0 < NITEMS; it0 += F.NGW) {
        int it = it0;
        if (it < I_IN) { const int kb = it / 353, nb = it % 353; tr_item(F.in[8] + (size_t)li * 1024 * IN_TOTAL, IN_TOTAL, 64 * kb, 32 * nb, Win_t, 1024, scr, F.lane, RmIn{}); continue; } it -= I_IN;
        if (it < I_LRU) { const int mat = it >> 5, r = it & 31, kb = r >> 3, nb = r & 7, ty = mat >> 3, d = (mat >> 2) & 1, g = mat & 3, n0 = 32 * nb, pn = g * 4 + d * 2 + (n0 >> 7);
            const float* src = (ty ? F.in[16] : F.in[14]) + (size_t)((li * 2 + d) * 4 + g) * 65536;
            tr_item(src, 256, 64 * kb, n0, Wlru_t, 256, scr, F.lane, RmLru{pn * 256 + ty * 128}); continue; } it -= I_LRU;
        if (it < I_BR) { const int br = it >> 9, r = it & 511, kb = r >> 5, nb = r & 31; tr_item(F.in[20] + (size_t)(li * 3 + br) * 1048576, 1024, 64 * kb, 32 * nb, Wbr_t + (size_t)br * 1048576, 1024, scr, F.lane, RmId{}); continue; } it -= I_BR;
        if (it < I_OUT) { const int kb = it >> 5, nb = it & 31; tr_item(F.in[21] + (size_t)li * 1048576, 1024, 64 * kb, 32 * nb, Wout_t, 1024, scr, F.lane, RmId{}); continue; } it -= I_OUT;
        if (it < I_GU) { const int e = it >> 10, r = it & 1023, kb = r >> 6, nb = r & 63; tr_item(F.in[24] + (size_t)(li * 32 + e) * 2097152, 2048, 64 * kb, 32 * nb, Wgu_t + (size_t)e * 2097152, 1024, scr, F.lane, RmGu{}); continue; } it -= I_GU;
        { const int e = it >> 9, r = it & 511, kb = r >> 5, nb = r & 31; tr_item(F.in[26] + (size_t)(li * 32 + e) * 1048576, 1024, 64 * kb, 32 * nb, Wdn_t + (size_t)e * 1048576, 1024, scr, F.lane, RmId{}); }
    }
    for (int i = F.gtid; i < (LDP - IN_TOTAL) * 1024 / 8; i += F.NGT) *(u32x4*)(Win_t + (size_t)IN_TOTAL * 1024 + (size_t)i * 8) = (u32x4){0u, 0u, 0u, 0u};
    float* lsl = (float*)(F.ws + WS_LSL);
    for (int i = F.gtid; i < 2048; i += F.NGT) lsl[i] = logsigmoidf_(F.in[18][li * 2048 + i]);
}
__device__ __forceinline__ void phase_norm_in(const Frame& F) {
    const float* mods = (const float*)(F.ws + WS_MODS); bf16_t* xn = (bf16_t*)(F.ws + WS_D);
    for (int row = F.gw; row < TT; row += F.NGW) {
        const float* src = row < TLAT ? F.in[0] + (size_t)row * D : F.in[2] + (size_t)(row - TLAT) * D;
        const float* mp = mods + mrow_of(row) * 6144;
        const RowV y = norm_mod(load_row(src, F.lane), F.in[6], mp, mp + 1024, F.lane);
        store_row_bf16(xn + (size_t)row * D, y, F.lane);
    }
}

__device__ __forceinline__ void phase_conv(const Frame& F, int li) {
    const bf16_t* P = (const bf16_t*)(F.ws + WS_P); bf16_t* xc = (bf16_t*)(F.ws + WS_D);
    const float* cw = F.in[12] + (size_t)li * 4 * 1024; const float* cb = F.in[13] + (size_t)li * 1024;
    for (int i = F.gtid; i < TT * 128; i += F.NGT) {
        const int row = i >> 7, ch = (i & 127) * 8;
        int t, L; if (row < TLAT) { t = row & (SEQ - 1); L = SEQ; } else { t = (row - TLAT) & (CTXL - 1); L = CTXL; }
        float a[8];
        { const f32x4 b0 = *(const f32x4*)(cb + ch), b1 = *(const f32x4*)(cb + ch + 4); a[0] = b0[0]; a[1] = b0[1]; a[2] = b0[2]; a[3] = b0[3]; a[4] = b1[0]; a[5] = b1[1]; a[6] = b1[2]; a[7] = b1[3]; }
#pragma unroll
        for (int j = 0; j < 4; ++j) { const int tt = t - 2 + j; if (tt < 0 || tt >= L) continue;
            const u32x4 xw = *(const u32x4*)(P + (size_t)(row - 2 + j) * LDP + C_LX + ch);
            const f32x4 w0 = *(const f32x4*)(cw + j * 1024 + ch), w1 = *(const f32x4*)(cw + j * 1024 + ch + 4);
            a[0] += w0[0] * bflo(xw.x); a[1] += w0[1] * bfhi(xw.x); a[2] += w0[2] * bflo(xw.y); a[3] += w0[3] * bfhi(xw.y);
            a[4] += w1[0] * bflo(xw.z); a[5] += w1[1] * bfhi(xw.z); a[6] += w1[2] * bflo(xw.w); a[7] += w1[3] * bfhi(xw.w); }
        u32x4 o; o.x = pk2(a[0], a[1]); o.y = pk2(a[2], a[3]); o.z = pk2(a[4], a[5]); o.w = pk2(a[6], a[7]);
        *(u32x4*)(xc + (size_t)row * 1024 + ch) = o;
    }
    bf16_t* Pw = (bf16_t*)(F.ws + WS_P); const float* rcos = (const float*)(F.ws + WS_COS); const float* rsin = (const float*)(F.ws + WS_SIN);
    for (int i = F.gtid; i < TLAT * 64; i += F.NGT) {
        const int g8 = i & 7, qk = (i >> 3) & 1, h = (i >> 4) & 3, row = i >> 6, t = row & (SEQ - 1);
        bf16_t* p1 = Pw + (size_t)row * LDP + (qk ? C_RK : C_RQ) + 128 * h + 8 * g8; bf16_t* p2 = p1 + 64;
        const u32x4 a = *(const u32x4*)p1, b = *(const u32x4*)p2;
        const f32x4 c0 = *(const f32x4*)(rcos + t * 64 + 8 * g8), c1 = *(const f32x4*)(rcos + t * 64 + 8 * g8 + 4), s0 = *(const f32x4*)(rsin + t * 64 + 8 * g8), s1 = *(const f32x4*)(rsin + t * 64 + 8 * g8 + 4);
        const float cs[8] = {c0[0], c0[1], c0[2], c0[3], c1[0], c1[1], c1[2], c1[3]}, sn[8] = {s0[0], s0[1], s0[2], s0[3], s1[0], s1[1], s1[2], s1[3]};
        const unsigned aw[4] = {a.x, a.y, a.z, a.w}, bw[4] = {b.x, b.y, b.z, b.w}; u32x4 o1, o2;
#pragma unroll
        for (int e = 0; e < 4; ++e) { const float x1a = bflo(aw[e]), x1b = bfhi(aw[e]), x2a = bflo(bw[e]), x2b = bfhi(bw[e]);
            o1[e] = pk2(x1a * cs[2 * e] - x2a * sn[2 * e], x1b * cs[2 * e + 1] - x2b * sn[2 * e + 1]);
            o2[e] = pk2(x1a * sn[2 * e] + x2a * cs[2 * e], x1b * sn[2 * e + 1] + x2b * cs[2 * e + 1]); }
        *(u32x4*)p1 = o1; *(u32x4*)p2 = o2;
    }
}
__device__ __forceinline__ int seg_row(int d, int b, int s, int p) {
    const int base = (s == 0) ? TLAT + b * CTXL : b * SEQ + 256 * (d ? 16 - s : s - 1);
    return base + (d ? 255 - p : p);
}
template <bool FINAL> __device__ __forceinline__ void phase_lru_scan(const Frame& F) {
    const bf16_t* LA = (const bf16_t*)(F.ws + WS_C); const bf16_t* BB = (const bf16_t*)(F.ws + WS_C + 2 * ROWB);
    float* carA = (float*)(F.ws + WS_CARA); float* carH = (float*)(F.ws + WS_CARH); bf16_t* HO = (bf16_t*)(F.ws + WS_E);
    for (int i = F.gtid; i < 2 * 8 * 17 * 256; i += F.NGT) {
        const int cq = i & 255, s = (i >> 8) % 17, db = (i >> 8) / 17, b = db & 7, d = db >> 3;
        f32x4 h = (f32x4){0.f, 0.f, 0.f, 0.f}, As = (f32x4){0.f, 0.f, 0.f, 0.f};
        if (FINAL) { for (int s2 = 0; s2 < s; ++s2) { const size_t o = ((size_t)(db * 17 + s2) * 256 + cq) * 4; h = *(const f32x4*)(carA + o) * h + *(const f32x4*)(carH + o); } }
        const size_t dofs = (size_t)d * TT * 1024;
#pragma unroll 8
        for (int p = 0; p < 256; ++p) { const size_t off = (size_t)seg_row(d, b, s, p) * 1024 + cq * 4;
            const f32x4 la = ld4bf(LA + dofs + off), bb = ld4bf(BB + dofs + off);
            f32x4 a; a[0] = __expf(la[0]); a[1] = __expf(la[1]); a[2] = __expf(la[2]); a[3] = __expf(la[3]);
            h = a * h + bb;
            if (FINAL) { u32x2 w; w.x = pk2(h[0], h[1]); w.y = pk2(h[2], h[3]); *(u32x2*)(HO + dofs + off) = w; } else As += la; }
        if (!FINAL) { const size_t o = (size_t)i * 4; f32x4 A; A[0] = __expf(As[0]); A[1] = __expf(As[1]); A[2] = __expf(As[2]); A[3] = __expf(As[3]);
            *(f32x4*)(carA + o) = A; *(f32x4*)(carH + o) = h; }
    }
}


constexpr size_t QKB = (size_t)TT * 512 * 2;
__device__ __forceinline__ void phase_scanprep(const Frame& F, int li) {
    LAS float* lrs = (LAS float*)F.lds;
    LAS float* qtot = lrs + 64 * 32;
    LAS float* gcs = qtot + 4 * 512;
    bf16_t* Pm = (bf16_t*)(F.ws + WS_P); bf16_t* QK = (bf16_t*)(F.ws + WS_C); float* EGL = (float*)(F.ws + WS_MODP);
    const int qtr = F.tid >> 7, c4 = F.tid & 127, ch0 = 4 * c4;
    for (int rc = F.bx; rc < TT / 64; rc += F.G) {
        if (F.tid < 256) { const int tok = F.tid >> 2, q8 = F.tid & 3; const u32x4 v = *(const u32x4*)(Pm + (size_t)(64 * rc + tok) * LDP + C_LR + 8 * q8);
            LAS float* dst = lrs + tok * 32 + 8 * q8; *(LAS f32x4*)dst = (f32x4){bflo(v.x), bfhi(v.x), bflo(v.y), bfhi(v.y)}; *(LAS f32x4*)(dst + 4) = (f32x4){bflo(v.z), bfhi(v.z), bflo(v.w), bfhi(v.w)}; }
        __syncthreads();
        for (int d = 0; d < 2; ++d) {
            f32x4 wv[16];
#pragma unroll
            for (int r = 0; r < 16; ++r) wv[r] = *(const f32x4*)(F.in[9] + (size_t)((li * 2 + d) * 16 + r) * 512 + ch0);
            const f32x4 bav = *(const f32x4*)(F.in[10] + (size_t)(li * 2 + d) * 512 + ch0);
            f32x4 run = (f32x4){0.f, 0.f, 0.f, 0.f};
#pragma unroll 2
            for (int i = 0; i < 16; ++i) { const int p = 16 * qtr + i, tok = d ? 63 - p : p; f32x4 z = bav;
#pragma unroll
                for (int r4 = 0; r4 < 4; ++r4) { const f32x4 l = *(const LAS f32x4*)(lrs + tok * 32 + 16 * d + 4 * r4);
#pragma unroll
                    for (int e = 0; e < 4; ++e) z += wv[4 * r4 + e] * l[e]; }
#pragma unroll
                for (int e = 0; e < 4; ++e) run[e] += logsigmoidf_(z[e]) * 0.0625f;
                *(LAS f32x4*)(gcs + p * 512 + ch0) = run; }
            *(LAS f32x4*)(qtot + qtr * 512 + ch0) = run;
            __syncthreads();
            f32x4 off = (f32x4){0.f, 0.f, 0.f, 0.f}, tot = (f32x4){0.f, 0.f, 0.f, 0.f};
#pragma unroll
            for (int q2 = 0; q2 < 4; ++q2) { const f32x4 t = *(const LAS f32x4*)(qtot + q2 * 512 + ch0); tot += t; if (q2 < qtr) off += t; }
            if (qtr == 0) { f32x4 e4; e4[0] = __expf(tot[0]); e4[1] = __expf(tot[1]); e4[2] = __expf(tot[2]); e4[3] = __expf(tot[3]); *(f32x4*)(EGL + ((size_t)d * (TT / 64) + rc) * 512 + ch0) = e4; }
            bf16_t* EGd = QK + (size_t)d * TT * 512;
#pragma unroll 4
            for (int i = 0; i < 16; ++i) { const int p = 16 * qtr + i, tok = d ? 63 - p : p; const size_t row = (size_t)(64 * rc + tok);
                const f32x4 G = *(const LAS f32x4*)(gcs + p * 512 + ch0) + off;
                u32x2 we; we.x = pk2(__expf(G[0]), __expf(G[1])); we.y = pk2(__expf(G[2]), __expf(G[3]));
                *(u32x2*)(EGd + row * 512 + ch0) = we; }
            __syncthreads();
        }
    }
}
typedef short s16x4 __attribute__((ext_vector_type(4)));
constexpr int SC_PITCH = 272, SC_QS = 0, SC_KS = 17408, SC_VS = 34816, SC_SB = 52224, SC_AS = 87040, SC_APITCH = 144, SC_OS = SC_AS + 9216;
__device__ __forceinline__ bf16x8 tr_frag(LAS unsigned char* base, int pitch, int k0, int c0, int lane) {
    const int q = (lane & 15) >> 2, p = lane & 3;
    LAS unsigned char* a = base + (k0 + q) * pitch + (c0 + 4 * p) * 2;
    const s16x4 lo = __builtin_amdgcn_ds_read_tr16_b64_v4i16((LAS s16x4*)a);
    const s16x4 hi = __builtin_amdgcn_ds_read_tr16_b64_v4i16((LAS s16x4*)(a + 4 * pitch));
    return (bf16x8){lo[0], lo[1], lo[2], lo[3], hi[0], hi[1], hi[2], hi[3]};
}
#define MFMA16(a, b, c) __builtin_amdgcn_mfma_f32_16x16x32_bf16((a), (b), (c), 0, 0, 0)
__device__ __forceinline__ int chunk_rc(int d, int b, int chn) { return chn < 4 ? (TLAT / 64) + 4 * b + (d ? 3 - chn : chn) : 64 * b + (d ? 63 - (chn - 4) : (chn - 4)); }
struct ScanSet { u32x4 q[2], k[2], v[2], e[2]; float gl[2]; };
#define GST16(ptr, val) asm volatile("global_store_dwordx4 %0, %1, off\n\ts_nop 1" :: "v"(ptr), "v"(val) : "memory")
template <int MX> __device__ __forceinline__ void scan_unit(const Frame& F, int u) {
    LAS unsigned char* L = F.lds;
    const int tid = F.tid, lane = F.lane, w = F.wave, fr = lane & 15, fq = lane >> 4, tt = tid >> 4, part = tid & 15;
    const int js = u & 1, h = (u >> 1) & 3, b = (u >> 3) & 7, d = (u >> 6) & 1;
    const bf16_t* Pq = (const bf16_t*)(F.ws + WS_P) + (MX ? C_RQ : C_GQ) + 128 * h + 8 * part; const bf16_t* Pk = Pq + 512;
    const bf16_t* Pv = (const bf16_t*)(F.ws + WS_P) + (MX ? C_RV : C_GV) + 256 * h + 128 * js + 8 * part;
    const bf16_t* EGp = (const bf16_t*)(F.ws + WS_C) + (size_t)d * TT * 512 + 128 * h + 8 * part;
    const int tmA = w >> 1, tnA = 2 * (w & 1), tmB = w & 1, tnB = w >> 1, tmS = w & 3, tnS = w >> 2;
    const float* EGLp = (const float*)(F.ws + WS_MODP) + (size_t)d * (TT / 64) * 512 + 128 * h + 32 * tmS + fr;
    bf16_t* O = (bf16_t*)(F.ws + WS_B) + (size_t)(MX * 2 + d) * TT * 1024 + 256 * h + 128 * js + 8 * part;
    float er[2] = {1.f, 1.f}, nr[2] = {1.f, 1.f}, egr = 1.0f;
    if (MX == 1) { const float x = exp2f(-5.0f - (float)h), lg = -(x + x * x * 0.5f + x * x * x * (1.0f / 3.0f) + x * x * x * x * 0.25f);
        egr = __expf(64.0f * lg); er[0] = __expf((float)(tt + 1) * lg); nr[0] = __expf(-(float)(tt + 1) * lg); er[1] = __expf((float)(tt + 33) * lg); nr[1] = __expf(-(float)(tt + 33) * lg); }
    f32x4 S[2][4];
#pragma unroll
    for (int i = 0; i < 2; ++i)
#pragma unroll
        for (int j = 0; j < 4; ++j) S[i][j] = (f32x4){0.f, 0.f, 0.f, 0.f};
    for (int i = tid; i < (128 * SC_PITCH) / 16; i += NTHR) *(LAS u32x4*)(L + SC_SB + i * 16) = (u32x4){0u, 0u, 0u, 0u};
    constexpr int NCH = (CTXL + SEQ) / 64;
    ScanSet sA, sB;
#define SC_LOAD(chn, st) do { const int rc_ = chunk_rc(d, b, (chn)); _Pragma("unroll") for (int ps = 0; ps < 2; ++ps) { const int c_ = tt + 32 * ps; const size_t row_ = (size_t)(64 * rc_ + (d ? 63 - c_ : c_)); \
        st.q[ps] = *(const u32x4*)(Pq + row_ * LDP); st.k[ps] = *(const u32x4*)(Pk + row_ * LDP); st.v[ps] = *(const u32x4*)(Pv + row_ * LDP); if (MX == 0) st.e[ps] = *(const u32x4*)(EGp + row_ * 512); } \
        if (MX == 0) { st.gl[0] = EGLp[(size_t)rc_ * 512]; st.gl[1] = EGLp[(size_t)rc_ * 512 + 16]; } } while (0)
#define SC_PUT(st) do { _Pragma("unroll") for (int ps = 0; ps < 2; ++ps) { const int c_ = tt + 32 * ps; u32x4 qo, ko; \
        _Pragma("unroll") for (int e2 = 0; e2 < 4; ++e2) { float ea, eb, na, nb; \
            if (MX == 0) { ea = bflo(st.e[ps][e2]); eb = bfhi(st.e[ps][e2]); na = __builtin_amdgcn_rcpf(ea); nb = __builtin_amdgcn_rcpf(eb); } else { ea = eb = er[ps]; na = nb = nr[ps]; } \
            qo[e2] = pk2(bflo(st.q[ps][e2]) * ea, bfhi(st.q[ps][e2]) * eb); ko[e2] = pk2(bflo(st.k[ps][e2]) * na, bfhi(st.k[ps][e2]) * nb); } \
        *(LAS u32x4*)(L + SC_QS + c_ * SC_PITCH + part * 16) = qo; *(LAS u32x4*)(L + SC_KS + c_ * SC_PITCH + part * 16) = ko; *(LAS u32x4*)(L + SC_VS + c_ * SC_PITCH + part * 16) = st.v[ps]; } } while (0)
    float eg[2] = {egr, egr}, egn[2] = {egr, egr};
    SC_LOAD(0, sA); SC_PUT(sA); if (MX == 0) { eg[0] = sA.gl[0]; eg[1] = sA.gl[1]; }
    SC_LOAD(1, sA);
    __syncthreads();
#define SC_CHUNK(ch, LS, PS) do { \
        const int rc = chunk_rc(d, b, ch); \
        SC_LOAD(((ch) + 2 < NCH ? (ch) + 2 : NCH - 1), LS); \
        {   f32x4 a[2] = {(f32x4){0.f, 0.f, 0.f, 0.f}, (f32x4){0.f, 0.f, 0.f, 0.f}}; \
        _Pragma("unroll") \
            for (int ks = 0; ks < 4; ++ks) { const bf16x8 xq = *(const LAS bf16x8*)(L + SC_QS + (16 * tmA + fr) * SC_PITCH + (32 * ks + 8 * fq) * 2); \
        _Pragma("unroll") \
                for (int j = 0; j < 2; ++j) { const bf16x8 yk = *(const LAS bf16x8*)(L + SC_KS + (16 * (tnA + j) + fr) * SC_PITCH + (32 * ks + 8 * fq) * 2); a[j] = MFMA16(yk, xq, a[j]); } } \
            const int c = 16 * tmA + fr; \
        _Pragma("unroll") \
            for (int j = 0; j < 2; ++j) { const int s0 = 16 * (tnA + j) + 4 * fq; float m[4]; \
        _Pragma("unroll") \
                for (int e = 0; e < 4; ++e) { const int s = s0 + e; const bool keep = d ? (s < c) : (s <= c); m[e] = keep ? a[j][e] : 0.f; } \
                u32x2 wv; wv.x = pk2(m[0], m[1]); wv.y = pk2(m[2], m[3]); *(LAS u32x2*)(L + SC_AS + c * SC_APITCH + s0 * 2) = wv; } } \
        __syncthreads(); \
        f32x4 o[2][2]; \
        _Pragma("unroll") \
        for (int i = 0; i < 2; ++i) \
        _Pragma("unroll") \
            for (int j = 0; j < 2; ++j) o[i][j] = (f32x4){0.f, 0.f, 0.f, 0.f}; \
        _Pragma("unroll") \
        for (int ks = 0; ks < 2; ++ks) { bf16x8 xa[2], yv[2]; \
        _Pragma("unroll") \
            for (int i = 0; i < 2; ++i) xa[i] = *(const LAS bf16x8*)(L + SC_AS + (32 * tmB + 16 * i + fr) * SC_APITCH + (32 * ks + 8 * fq) * 2); \
        _Pragma("unroll") \
            for (int j = 0; j < 2; ++j) yv[j] = tr_frag(L + SC_VS, SC_PITCH, 32 * ks + 8 * fq, 32 * tnB + 16 * j, lane); \
        _Pragma("unroll") \
            for (int i = 0; i < 2; ++i) \
        _Pragma("unroll") \
                for (int j = 0; j < 2; ++j) o[i][j] = MFMA16(yv[j], xa[i], o[i][j]); } \
        _Pragma("unroll") \
        for (int ks = 0; ks < 4; ++ks) { bf16x8 xq[2], ys[2]; \
        _Pragma("unroll") \
            for (int i = 0; i < 2; ++i) xq[i] = *(const LAS bf16x8*)(L + SC_QS + (32 * tmB + 16 * i + fr) * SC_PITCH + (32 * ks + 8 * fq) * 2); \
        _Pragma("unroll") \
            for (int j = 0; j < 2; ++j) ys[j] = tr_frag(L + SC_SB, SC_PITCH, 32 * ks + 8 * fq, 32 * tnB + 16 * j, lane); \
        _Pragma("unroll") \
            for (int i = 0; i < 2; ++i) \
        _Pragma("unroll") \
                for (int j = 0; j < 2; ++j) o[i][j] = MFMA16(ys[j], xq[i], o[i][j]); } \
        _Pragma("unroll") \
        for (int ks = 0; ks < 2; ++ks) { bf16x8 xk[2], yv[4]; \
        _Pragma("unroll") \
            for (int i = 0; i < 2; ++i) xk[i] = tr_frag(L + SC_KS, SC_PITCH, 32 * ks + 8 * fq, 32 * tmS + 16 * i, lane); \
        _Pragma("unroll") \
            for (int j = 0; j < 4; ++j) yv[j] = tr_frag(L + SC_VS, SC_PITCH, 32 * ks + 8 * fq, 64 * tnS + 16 * j, lane); \
        _Pragma("unroll") \
            for (int i = 0; i < 2; ++i) \
        _Pragma("unroll") \
                for (int j = 0; j < 4; ++j) S[i][j] = MFMA16(yv[j], xk[i], S[i][j]); } \
        __syncthreads(); \
        _Pragma("unroll") \
        for (int i = 0; i < 2; ++i) \
        _Pragma("unroll") \
            for (int j = 0; j < 2; ++j) { u32x2 wv; wv.x = pk2(o[i][j][0], o[i][j][1]); wv.y = pk2(o[i][j][2], o[i][j][3]); \
                *(LAS u32x2*)(L + SC_OS + (32 * tmB + 16 * i + fr) * SC_PITCH + (32 * tnB + 16 * j + 4 * fq) * 2) = wv; } \
        _Pragma("unroll") \
        for (int i = 0; i < 2; ++i) { const int row = 32 * tmS + 16 * i + fr; \
            _Pragma("unroll") \
            for (int j = 0; j < 4; ++j) { S[i][j] = S[i][j] * eg[i]; u32x2 wv; wv.x = pk2(S[i][j][0], S[i][j][1]); wv.y = pk2(S[i][j][2], S[i][j][3]); \
                *(LAS u32x2*)(L + SC_SB + row * SC_PITCH + (64 * tnS + 16 * j + 4 * fq) * 2) = wv; } } \
        SC_PUT(PS); if (MX == 0) { eg[0] = PS.gl[0]; eg[1] = PS.gl[1]; } \
        __syncthreads(); \
        _Pragma("unroll") \
        for (int ps = 0; ps < 2; ++ps) { const int c = tt + 32 * ps; const u32x4 v = *(const LAS u32x4*)(L + SC_OS + c * SC_PITCH + part * 16); \
            GST16(O + (size_t)(64 * rc + (d ? 63 - c : c)) * 1024, v); } \
    } while (0)
    for (int ch2 = 0; ch2 < NCH; ch2 += 2) { SC_CHUNK(ch2, sB, sA); SC_CHUNK(ch2 + 1, sA, sB); }
    (void)egn;
#undef SC_CHUNK
#undef SC_LOAD
#undef SC_PUT
    __syncthreads();
}
__device__ __forceinline__ void phase_scan_mfma(const Frame& F, int li) {
    for (int u = F.bx; u < 256; u += F.G) { if (u < 128) scan_unit<0>(F, u); else scan_unit<1>(F, u - 128); }
}

__device__ __forceinline__ void phase_finish(const Frame& F, int li, int nrows) {
    const bf16_t* P = (const bf16_t*)(F.ws + WS_P); const bf16_t* OB = (const bf16_t*)(F.ws + WS_B); const bf16_t* HB = (const bf16_t*)(F.ws + WS_E); bf16_t* A3 = (bf16_t*)(F.ws + WS_C);
    const float* gnorm = F.in[11] + (size_t)li * 1024; const float* rnorm = F.in[19] + (size_t)li * 1024;
    const size_t RS = (size_t)TT * 1024;
    for (int row = F.gw; row < nrows; row += F.NGW) {
        const bf16_t* pr = P + (size_t)row * LDP; const size_t ro = (size_t)row * 1024;
#pragma unroll
        for (int j = 0; j < 4; ++j) {
            const int c = 4 * F.lane + 256 * j;
            {
                const f32x4 o = ld4bf(OB + ro + c) + ld4bf(OB + RS + ro + c);
                const float ss = wave_sum((o[0] * o[0] + o[1] * o[1]) + (o[2] * o[2] + o[3] * o[3])); const float rs = rsqrtf(ss * (1.0f / 256.0f) + EPS);
                const f32x4 g = ld4bf(pr + C_GG + c), gn = *(const f32x4*)(gnorm + c); u32x2 w;
                w.x = pk2(o[0] * rs * gn[0] * siluf_(g[0]), o[1] * rs * gn[1] * siluf_(g[1])); w.y = pk2(o[2] * rs * gn[2] * siluf_(g[2]), o[3] * rs * gn[3] * siluf_(g[3]));
                *(u32x2*)(A3 + ro + c) = w; }
            {
                const f32x4 hh = ld4bf(HB + ro + c) + ld4bf(HB + RS + ro + c), g = ld4bf(pr + C_LG + c); u32x2 w;
                w.x = pk2(hh[0] * gelu_tanh_(g[0]), hh[1] * gelu_tanh_(g[1])); w.y = pk2(hh[2] * gelu_tanh_(g[2]), hh[3] * gelu_tanh_(g[3]));
                *(u32x2*)(A3 + RS + ro + c) = w; }
            {
                f32x4 o = ld4bf(OB + 2 * RS + ro + c) + ld4bf(OB + 3 * RS + ro + c);
                const float mean = wave_sum((o[0] + o[1]) + (o[2] + o[3])) * (1.0f / 256.0f); o = o - mean;
                const float ss = wave_sum((o[0] * o[0] + o[1] * o[1]) + (o[2] * o[2] + o[3] * o[3])); const float rs = rsqrtf(ss * (1.0f / 256.0f) + EPS);
                const f32x4 g = ld4bf(pr + C_RG + c), gn = *(const f32x4*)(rnorm + c); u32x2 w;
                w.x = pk2(o[0] * rs * gn[0] * siluf_(g[0]), o[1] * rs * gn[1] * siluf_(g[1])); w.y = pk2(o[2] * rs * gn[2] * siluf_(g[2]), o[3] * rs * gn[3] * siluf_(g[3]));
                *(u32x2*)(A3 + 2 * RS + ro + c) = w; }
        }
    }
}

__device__ __forceinline__ void phase_norm2_router(const Frame& F, int li, int ntok) {
    LAS float* wrT = (LAS float*)F.lds;
    LAS unsigned* hist = (LAS unsigned*)(F.lds + 131072); LAS unsigned* hbase = hist + 32;
    const float* wr = F.in[22] + (size_t)li * 1024 * 32; const float* br = F.in[23] + li * 32;
    for (int i = F.tid; i < 32768; i += NTHR) wrT[(i & 31) * 1024 + (i >> 5)] = wr[i];
    if (F.tid < 32) hist[F.tid] = 0u;
    __syncthreads();
    const float* xs = (const float*)(F.ws + WS_XS); const float* mods = (const float*)(F.ws + WS_MODS) + (size_t)li * 9 * 6144;
    bf16_t* xn2 = (bf16_t*)(F.ws + WS_D); int* tok_e = (int*)(F.ws + WS_TOKE); float* tok_w = (float*)(F.ws + WS_TOKW); int* tok_p = (int*)(F.ws + WS_TOKP);
    unsigned* cnt = (unsigned*)(F.ws + WS_CTL) + CW_CNT + li * 32;
    for (int row = F.gw; row < ntok; row += F.NGW) {
        const float* mp = mods + mrow_of(row) * 6144;
        const RowV y = norm_mod(load_row(xs + (size_t)row * D, F.lane), F.in[7] + (size_t)li * 1024, mp + 3 * 1024, mp + 4 * 1024, F.lane);
        store_row_bf16(xn2 + (size_t)row * D, y, F.lane);
        float lg[32];
#pragma unroll
        for (int e = 0; e < 32; ++e) { float s = 0.f;
#pragma unroll
            for (int j = 0; j < 4; ++j) { const f32x4 w = *(const LAS f32x4*)(wrT + e * 1024 + 4 * F.lane + 256 * j); s += (y.v[j][0] * w[0] + y.v[j][1] * w[1]) + (y.v[j][2] * w[2] + y.v[j][3] * w[3]); }
            lg[e] = wave_sum(s) + br[e]; }
        unsigned taken = 0u; float tl[4]; int te[4];
#pragma unroll
        for (int k = 0; k < 4; ++k) { float best = -3.0e38f; int bi = 0;
#pragma unroll
            for (int e = 0; e < 32; ++e) { const bool ok = !((taken >> e) & 1u) && lg[e] > best; best = ok ? lg[e] : best; bi = ok ? e : bi; }
            taken |= 1u << bi; tl[k] = best; te[k] = bi; }
        const float e1 = __expf(tl[1] - tl[0]), e2 = __expf(tl[2] - tl[0]), e3 = __expf(tl[3] - tl[0]); const float inv = 1.0f / (1.0f + e1 + e2 + e3);
        if (F.lane < 4) { const int k = F.lane; const int ek = k == 0 ? te[0] : k == 1 ? te[1] : k == 2 ? te[2] : te[3]; const float wk = (k == 0 ? 1.0f : k == 1 ? e1 : k == 2 ? e2 : e3) * inv;
            const unsigned lp = atomicAdd((unsigned*)&hist[ek], 1u);
            tok_e[row * 4 + k] = ek; tok_w[row * 4 + k] = wk; tok_p[row * 4 + k] = (int)lp; }
    }
    __syncthreads();
    if (F.tid < 32) hbase[F.tid] = __hip_atomic_fetch_add(cnt + F.tid, hist[F.tid], __ATOMIC_RELAXED, __HIP_MEMORY_SCOPE_AGENT);
    __syncthreads();
    for (int row = F.gw; row < ntok; row += F.NGW) if (F.lane < 4) { const int i = row * 4 + F.lane; tok_p[i] += (int)hbase[tok_e[i]]; }
    __syncthreads();
}
__device__ __forceinline__ void phase_dispatch(const Frame& F, int li, int ntok) {
    LAS unsigned* pstart = (LAS unsigned*)F.lds;
    unsigned* ctl = (unsigned*)(F.ws + WS_CTL); unsigned* cnt = ctl + CW_CNT + li * 32; unsigned* tile_e = ctl + CW_TILE + li * 1024;
    if (F.tid == 0) { unsigned ps = 0;
        for (int e = 0; e < 32; ++e) { const unsigned c = __hip_atomic_load(cnt + e, __ATOMIC_RELAXED, __HIP_MEMORY_SCOPE_AGENT), nt = (c + 255u) >> 8; pstart[e] = ps;
            if (F.bx == 0) for (unsigned j = 0; j < nt; ++j) tile_e[(ps >> 8) + j] = (unsigned)e;
            ps += nt << 8; }
        if (F.bx == 0) ctl[CW_NT + li] = ps >> 8; }
    __syncthreads();
    const bf16_t* xn2 = (const bf16_t*)(F.ws + WS_D); bf16_t* xg = (bf16_t*)(F.ws + WS_P);
    const int* tok_e = (const int*)(F.ws + WS_TOKE); const int* tok_p = (const int*)(F.ws + WS_TOKP); int* tok_s = (int*)(F.ws + WS_TOKS);
    for (int it = F.gw; it < ntok * 4; it += F.NGW) {
        const int tok = it >> 2; const int slot = (int)pstart[tok_e[it]] + tok_p[it];
        if (F.lane == 0) tok_s[it] = slot;
        const u32x4* s = (const u32x4*)(xn2 + (size_t)tok * 1024); u32x4* dst = (u32x4*)(xg + (size_t)slot * 1024);
        dst[F.lane] = s[F.lane]; dst[64 + F.lane] = s[64 + F.lane];
    }
    __syncthreads();
}
__device__ __forceinline__ void phase_combine(const Frame& F, int li, int ntok, bool last) {
    float* xs = (float*)(F.ws + WS_XS); const bf16_t* Y = (const bf16_t*)(F.ws + WS_B); bf16_t* xn = (bf16_t*)(F.ws + WS_D);
    const float* mods = (const float*)(F.ws + WS_MODS); const float* tok_w = (const float*)(F.ws + WS_TOKW); const int* tok_s = (const int*)(F.ws + WS_TOKS);
    for (int row = F.gw; row < ntok; row += F.NGW) {
        const int mr = mrow_of(row); const float* gp = mods + ((size_t)li * 9 + mr) * 6144 + 5 * 1024;
        RowV x = load_row(xs + (size_t)row * D, F.lane);
        const int s0 = tok_s[row * 4], s1 = tok_s[row * 4 + 1], s2 = tok_s[row * 4 + 2], s3 = tok_s[row * 4 + 3];
        const float w0 = tok_w[row * 4], w1 = tok_w[row * 4 + 1], w2 = tok_w[row * 4 + 2], w3 = tok_w[row * 4 + 3];
#pragma unroll
        for (int j = 0; j < 4; ++j) { const int c = 4 * F.lane + 256 * j;
            const f32x4 y = ld4bf(Y + (size_t)s0 * 1024 + c) * w0 + ld4bf(Y + (size_t)s1 * 1024 + c) * w1 + ld4bf(Y + (size_t)s2 * 1024 + c) * w2 + ld4bf(Y + (size_t)s3 * 1024 + c) * w3;
            x.v[j] = x.v[j] + *(const f32x4*)(gp + c) * y; }
        if (!last) {
#pragma unroll
            for (int j = 0; j < 4; ++j) *(f32x4*)(xs + (size_t)row * D + 4 * F.lane + 256 * j) = x.v[j];
            const float* mp = mods + ((size_t)(li + 1) * 9 + mr) * 6144;
            const RowV y = norm_mod(x, F.in[6] + (size_t)(li + 1) * 1024, mp, mp + 1024, F.lane);
            store_row_bf16(xn + (size_t)row * D, y, F.lane);
        } else {
            const float rs = rsqrtf(row_sumsq(x) * (1.0f / D) + EPS);
#pragma unroll
            for (int j = 0; j < 4; ++j) { const int c = 4 * F.lane + 256 * j; *(f32x4*)(F.out + (size_t)row * D + c) = (x.v[j] * rs) * *(const f32x4*)(F.in[28] + c); }
        }
    }
}

#ifndef MK_SCAN_REF
#define MK_SCAN_REF 0
#endif
#ifndef MK_ONE_LAUNCH
#define MK_ONE_LAUNCH 1
#endif
constexpr int NPH_LAYER = 16, NPHASES = 2 + 2 * NPH_LAYER;
struct Args { const float* in[29]; float* out; unsigned char* ws; int ph_lo, ph_hi, region, pad; };
#ifndef MK_PHMASK
#define MK_PHMASK 0xffff
#endif
#define IN(k) (lo <= (k) && (k) < hi)
#define EN(j) ((MK_PHMASK >> (j)) & 1)
#define SEAM(k) do { if (IN(k) && IN((k) + 1)) xcd_barrier(bar); } while (0)
#define MKF() Frame F; { GAS unsigned char* ws_ = (GAS unsigned char*)args.ws; asm volatile("" : "+s"(ws_)); F.ws = ws_; F.lds = (LAS unsigned char*)lds_raw; F.out = args.out; F.in = args.in; \
        int tid_ = threadIdx.x, bx_ = blockIdx.x; asm volatile("" : "+v"(tid_), "+s"(bx_)); F.tid = tid_; F.bx = bx_; F.lane = F.tid & 63; F.wave = __builtin_amdgcn_readfirstlane(F.tid >> 6); F.G = gridDim.x; \
        F.gw = F.bx * NWAVES + F.wave; F.NGW = F.G * NWAVES; F.gtid = F.bx * NTHR + F.tid; F.NGT = F.G * NTHR; }
template <int li> __device__ __forceinline__ void run_layer(const Args& args, unsigned char* lds_raw, const XcdBarrier& bar, const int lo, const int hi) {
        const int pb = 2 + NPH_LAYER * li; const bool last = (li == 1); const int nrows = last ? TLAT : TT, nMt = nrows / 256;
        if (EN(0) && IN(pb + 0)) { MKF(); phase_W(F, li); if (li == 0) phase_norm_in(F); __syncthreads(); }
        SEAM(pb + 0);
        if (EN(1) && IN(pb + 1)) { MKF(); unsigned* ctl = (unsigned*)(F.ws + WS_CTL); (void)ctl;
            pg8::Gemm g{1024, 1024, 1024}; PlainOrder S; S.A = (const char*)(F.ws + WS_D); S.B = (const char*)(F.ws + WS_WIN); S.astep = 256 * 1024 * 2; S.bstep = 256 * 1024 * 2; S.nM = TT / 256; S.nN = LDP / 256; S.G = F.G; S.c = F.bx;
            EpiBf16Bias E{(bf16_t*)(F.ws + WS_P), LDP, nullptr, 0};
            pg8::gemm_phase<EpiBf16Bias, PlainOrder, true, true>(F.lds, g, S, E);
        }
        SEAM(pb + 1);
        if (EN(2) && IN(pb + 2)) { MKF(); phase_conv(F, li); }
        SEAM(pb + 2);
        if (EN(3) && IN(pb + 3)) { MKF(); unsigned* ctl = (unsigned*)(F.ws + WS_CTL); (void)ctl;
            pg8::Gemm g{1024, 256, 256}; LruOrder S; S.A = (const char*)(F.ws + WS_D); S.B = (const char*)(F.ws + WS_WLRU); S.nM = TT / 256; S.G = F.G; S.c = F.bx;
            EpiLru E{(const bf16_t*)(F.ws + WS_D), (bf16_t*)(F.ws + WS_C), (bf16_t*)(F.ws + WS_C + 2 * ROWB), F.in[15] + (size_t)li * 2048, F.in[17] + (size_t)li * 2048, (const float*)(F.ws + WS_LSL)};
            pg8::gemm_phase<EpiLru, LruOrder, true, true>(F.lds, g, S, E);
        }
        SEAM(pb + 3);
        if (EN(4) && IN(pb + 4)) { MKF(); phase_lru_scan<false>(F); }
        SEAM(pb + 4);
        if (EN(5) && IN(pb + 5)) { MKF(); phase_lru_scan<true>(F); }
        SEAM(pb + 5);
        if (EN(6) && IN(pb + 6)) { MKF(); phase_scanprep(F, li); }
        SEAM(pb + 6);
        if (EN(7) && IN(pb + 7)) { MKF(); phase_scan_mfma(F, li); }
        SEAM(pb + 7);
        if (EN(8) && IN(pb + 8)) { MKF(); phase_finish(F, li, nrows); }
        SEAM(pb + 8);
        if (EN(9) && IN(pb + 9)) { MKF(); unsigned* ctl = (unsigned*)(F.ws + WS_CTL); (void)ctl;
            pg8::Gemm g{1024, 1024, 1024}; BranchOrder S; S.A = (const char*)(F.ws + WS_C); S.B = (const char*)(F.ws + WS_WBR); S.nM = nMt; S.G = F.G; S.c = F.bx;
            EpiBranch E{(const bf16_t*)(F.ws + WS_P), (float*)(F.ws + WS_B), (bf16_t*)(F.ws + WS_B + 2 * ROWB)};
            pg8::gemm_phase<EpiBranch, BranchOrder, true, true>(F.lds, g, S, E);
        }
        SEAM(pb + 9);
        if (EN(10) && IN(pb + 10)) { MKF(); unsigned* ctl = (unsigned*)(F.ws + WS_CTL); (void)ctl;
            pg8::Gemm g{1024, 1024, 1024}; PlainOrder S; S.A = (const char*)(F.ws + WS_B + 2 * ROWB); S.B = (const char*)(F.ws + WS_WOUT); S.astep = 256 * 1024 * 2; S.bstep = 256 * 1024 * 2; S.nM = nMt; S.nN = 4; S.G = F.G; S.c = F.bx;
            float* xs = (float*)(F.ws + WS_XS);
            EpiOut E{li == 0 ? F.in[0] : xs, li == 0 ? F.in[2] : xs + (size_t)TLAT * D, xs, (const float*)(F.ws + WS_MODS) + (size_t)li * 9 * 6144 + 2 * 1024};
            pg8::gemm_phase<EpiOut, PlainOrder, true, true>(F.lds, g, S, E);
        }
        SEAM(pb + 10);
        if (EN(11) && IN(pb + 11)) { MKF(); phase_norm2_router(F, li, nrows); }
        SEAM(pb + 11);
        if (EN(12) && IN(pb + 12)) { MKF(); phase_dispatch(F, li, nrows); }
        SEAM(pb + 12);
        if (EN(13) && IN(pb + 13)) { MKF(); unsigned* ctl = (unsigned*)(F.ws + WS_CTL); (void)ctl;
            pg8::Gemm g{1024, 1024, 1024}; MoeOrder S; S.A = (const char*)(F.ws + WS_P); S.B = (const char*)(F.ws + WS_WGU); S.tile_e = ctl + CW_TILE + li * 1024; S.estep = (size_t)2048 * 1024 * 2;
            S.nM = (int)ctl[CW_NT + li]; S.nN = 8; S.G = F.G; S.c = F.bx;
            EpiSwiglu E{(bf16_t*)(F.ws + WS_P + 288 * MiB), F.in[25] + (size_t)li * 32 * 2048};
            pg8::gemm_phase<EpiSwiglu, MoeOrder, true, true>(F.lds, g, S, E);
        }
        SEAM(pb + 13);
        if (EN(14) && IN(pb + 14)) { MKF(); unsigned* ctl = (unsigned*)(F.ws + WS_CTL); (void)ctl;
            pg8::Gemm g{1024, 1024, 1024}; MoeOrder S; S.A = (const char*)(F.ws + WS_P + 288 * MiB); S.B = (const char*)(F.ws + WS_WDN); S.tile_e = ctl + CW_TILE + li * 1024; S.estep = (size_t)1024 * 1024 * 2;
            S.nM = (int)ctl[CW_NT + li]; S.nN = 4; S.G = F.G; S.c = F.bx;
            EpiBf16Bias E{(bf16_t*)(F.ws + WS_B), 1024, F.in[27] + (size_t)li * 32 * 1024, 1024};
            pg8::gemm_phase<EpiBf16Bias, MoeOrder, true, true>(F.lds, g, S, E);
        }
        SEAM(pb + 14);
        if (EN(15) && IN(pb + 15)) { MKF(); phase_combine(F, li, nrows, last); }
        SEAM(pb + 15);
    }
__global__ void __launch_bounds__(NTHR, 2) mk_fwd(Args args) {
    extern __shared__ __attribute__((aligned(16))) unsigned char lds_raw[];
    const int tid0 = threadIdx.x;
    volatile LAS unsigned* MISC = (volatile LAS unsigned*)((LAS unsigned char*)lds_raw + MISC_OFF);
    if (tid0 < 32) MISC[tid0] = 0u;
    __syncthreads();
    unsigned* ctl0 = (unsigned*)(args.ws + WS_CTL);
    const int lo = args.ph_lo, hi = args.ph_hi;
    XcdBarrier bar; bar.bar = ctl0 + CW_BAR + args.region * 4096; bar.x = 0; bar.st = MISC + 8;
    if (hi - lo > 1) bar = xcd_barrier_post(ctl0 + CW_BAR + args.region * 4096, MISC + 8);

    if (IN(0)) { MKF(); phase_proA(F); }
    SEAM(0);
    if (IN(1)) { MKF(); phase_proB(F); }
    SEAM(1);
    run_layer<0>(args, lds_raw, bar, lo, hi);
    run_layer<1>(args, lds_raw, bar, lo, hi);
}

extern "C" void kernel_launch(void* const* d_in, const int* in_sizes, int n_in, void* d_out, int out_size, void* d_ws, size_t ws_size, hipStream_t stream) {
    static int grid = 0;
    if (grid == 0) {
        if (n_in != 29 || ws_size < WS_END || out_size != TLAT * D) { fprintf(stderr, "kernel_launch: unexpected problem: n_in %d ws %zu out %d\n", n_in, ws_size, out_size); grid = -1; return; }
        int dev = 0, cus = 0;
        if (hipGetDevice(&dev) != hipSuccess || hipDeviceGetAttribute(&cus, hipDeviceAttributeMultiprocessorCount, dev) != hipSuccess) { grid = -1; return; }
        if (hipFuncSetAttribute((const void*)mk_fwd, hipFuncAttributeMaxDynamicSharedMemorySize, LDS_BYTES) != hipSuccess) { fprintf(stderr, "kernel_launch: hipFuncSetAttribute failed\n"); grid = -1; return; }
        int per_cu = 0;
        if (hipOccupancyMaxActiveBlocksPerMultiprocessor(&per_cu, (const void*)mk_fwd, NTHR, LDS_BYTES) != hipSuccess || per_cu < 1) fprintf(stderr, "kernel_launch: occupancy query reports %d\n", per_cu);
        (void)hipGetLastError();
        grid = cus;
    }
    if (grid < 0) return;
    (void)hipMemsetAsync((char*)d_ws + WS_CTL, 0, CTL_BYTES, stream);
    Args a{};
    for (int i = 0; i < 29; ++i) a.in[i] = (const float*)d_in[i];
    a.out = (float*)d_out; a.ws = (unsigned char*)d_ws;
#if MK_ONE_LAUNCH
    a.ph_lo = 0; a.ph_hi = NPHASES; a.region = 0;
    hipLaunchKernelGGL(mk_fwd, dim3(grid), dim3(NTHR), LDS_BYTES, stream, a);
#else
    for (int p = 0; p < NPHASES; ++p) { a.ph_lo = p; a.ph_hi = p + 1; a.region = 0; hipLaunchKernelGGL(mk_fwd, dim3(grid), dim3(NTHR), LDS_BYTES, stream, a); }
#endif
}
```

```cpp
#include <hip/hip_runtime.h>
#include <cstdio>
#include <cstdint>

#define LAS __attribute__((address_space(3)))
typedef unsigned short bf16_t;
typedef short bf16x8 __attribute__((ext_vector_type(8)));
typedef float f32x4 __attribute__((ext_vector_type(4)));
typedef float f32x2 __attribute__((ext_vector_type(2)));
typedef unsigned u32x4 __attribute__((ext_vector_type(4)));
typedef unsigned u32x2 __attribute__((ext_vector_type(2)));

constexpr int D = 1024, NBATCH = 8, SEQ = 4096, CTXL = 256;
constexpr int TLAT = NBATCH * SEQ, TCTX = NBATCH * CTXL, TT = TLAT + TCTX;
constexpr int LDP = 11520;
constexpr int C_GQ = 0, C_GK = 512, C_GV = 1024, C_GG = 2048, C_LX = 3072, C_LG = 4096, C_RQ = 5120, C_RK = 5632, C_RV = 6144, C_RG = 7168, C_MG = 8192, C_LR = 11264;
constexpr int IN_TOTAL = 11296, NE = 32;
constexpr int SLOT_TILES_MAX = 576;
constexpr float EPS = 1e-6f;

constexpr size_t MiB = (size_t)1 << 20;
constexpr size_t WS_CTL = 0, CTL_BYTES = 1 * MiB;
constexpr size_t WS_MODP = 1 * MiB, WS_MODS = 5 * MiB, WS_COS = 6 * MiB, WS_SIN = 7 * MiB, WS_LSL = 8 * MiB, WS_CARA = 9 * MiB, WS_CARH = 11 * MiB;
constexpr size_t WS_SLOTTOK = 12 * MiB;
constexpr size_t WS_TOKE = 13 * MiB, WS_TOKW = WS_TOKE + 768 * 1024, WS_TOKP = WS_TOKW + 768 * 1024, WS_TOKS = WS_TOKP + 768 * 1024;
constexpr size_t WS_WIN = 16 * MiB, WS_WLRU = 39 * MiB, WS_WBR = 41 * MiB, WS_WOUT = 47 * MiB, WS_WGU = 49 * MiB, WS_WDN = 177 * MiB;
constexpr size_t WS_XS = 241 * MiB, WS_P = 377 * MiB, WS_B = 1142 * MiB, WS_C = 1430 * MiB, WS_D = 1702 * MiB, WS_E = 1770 * MiB, WS_END = 1906 * MiB;
constexpr size_t ROWB = (size_t)TT * D * 2;
static_assert(ROWB == 68 * MiB, "row buffer");
constexpr int CW_CNT = 1024, CW_NT = 1024 + 128, CW_TILE = 2048, CW_BAR = 8192;

__device__ __forceinline__ float bflo(unsigned w) { return __uint_as_float(w << 16); }
__device__ __forceinline__ float bfhi(unsigned w) { return __uint_as_float(w & 0xffff0000u); }
typedef __bf16 bf16x2_t __attribute__((ext_vector_type(2)));
__device__ __forceinline__ unsigned pk2(float lo, float hi) { const bf16x2_t v = __builtin_convertvector((f32x2){lo, hi}, bf16x2_t); return __builtin_bit_cast(unsigned, v); }
__device__ __forceinline__ float sigmoidf_(float x) { return __builtin_amdgcn_rcpf(1.0f + __expf(-x)); }
__device__ __forceinline__ float siluf_(float x) { return x * sigmoidf_(x); }
__device__ __forceinline__ float logsigmoidf_(float z) { return fminf(z, 0.f) - __logf(1.0f + __expf(-fabsf(z))); }
__device__ __forceinline__ float gelu_tanh_(float x) { const float u = 0.7978845608028654f * (x + 0.044715f * x * x * x); const float t = 1.0f - 2.0f * __builtin_amdgcn_rcpf(__expf(2.0f * u) + 1.0f); return 0.5f * x * (1.0f + t); }
__device__ __forceinline__ float wave_sum(float v) {
#pragma unroll
    for (int o = 1; o < 64; o <<= 1) v += __shfl_xor(v, o);
    return v;
}
#define LDS_WAIT() asm volatile("s_waitcnt lgkmcnt(0)" ::: "memory")

namespace pg8 {
#define PG8_LAS __attribute__((address_space(3)))
constexpr int BM = 256, BK = 64, HALF = 128, HTB = HALF * BK * 2, STAGE_BYTES = 8 * HTB, NXCD = 8, WGM = 8;
__host__ __device__ __forceinline__ int lds_byte(int r, int c) { const int st = (r >> 4) * 2 + (c >> 5), rr = r & 15, cc = c & 31, ob = rr * 64 + cc * 2; return st * 1024 + (ob ^ (((ob >> 9) & 1) << 5)); }
__host__ __device__ __forceinline__ void stage_rc(int b, int& R, int& C) { const int st = b / 1024, sb = b % 1024, swz = sb ^ (((sb >> 9) & 1) << 5); R = (st >> 1) * 16 + swz / 64; C = (st & 1) * 32 + (swz % 64) / 2; }
__host__ __device__ __forceinline__ int perm32(int rho) { const int n = rho >> 4, i = rho & 15; return 8 * (i >> 2) + 4 * n + (i & 3); }
struct Unit { int pm, pn, aux; const char* a; const char* b; };
struct Gemm { int lda, ldb, K; };
__device__ __forceinline__ void tile_of(int L, int nM, int nN, int& pm, int& pn) {
    const int nwg = nM * nN; int wgid = L; { const int q = nwg / NXCD, r = nwg % NXCD, xcd = wgid % NXCD, off = wgid / NXCD; wgid = (xcd < r ? xcd * (q + 1) : r * (q + 1) + (xcd - r) * q) + off; }
    const int nig = WGM * nN, gid = wgid / nig, fm = gid * WGM, gsz = (nM - fm) < WGM ? (nM - fm) : WGM;
    pm = fm + ((wgid % nig) % gsz); pn = (wgid % nig) / gsz;
}
__device__ __forceinline__ unsigned cvt_pk_bf16(float lo, float hi) { unsigned r; asm volatile("v_cvt_pk_bf16_f32 %0, %1, %2" : "=v"(r) : "v"(lo), "v"(hi)); return r; }
template <class Epi, class Sched, bool ALIGN_EPI = false, bool SP2 = false, bool GATHER = false>
__device__ __forceinline__ void gemm_phase(PG8_LAS unsigned char* lds, const Gemm g, const Sched& S, const Epi& E) {
    int tid_o = threadIdx.x; asm volatile("" : "+v"(tid_o));
    const int tid = tid_o, wid = __builtin_amdgcn_readfirstlane(tid >> 6), lane = tid & 63, wr = wid >> 2, wc = wid & 3, fr = lane & 15, fq = lane >> 4;
    const int K = g.K, nt = K / BK;
    unsigned voffA[2], voffB[2];
#pragma unroll
    for (int i = 0; i < 2; ++i) { int R, C; stage_rc(tid * 16 + i * 8192, R, C); const int Rb = Epi::PERM ? ((R & ~31) + perm32(R & 31)) : R;
        voffA[i] = (unsigned)(R * g.lda + C) * 2u; voffB[i] = (unsigned)(Rb * g.ldb + C) * 2u; }
    unsigned gA[2][2] = {{0u, 0u}, {0u, 0u}}, gN[2][2] = {{0u, 0u}, {0u, 0u}}; int gR[2], gC[2];
#pragma unroll
    for (int i = 0; i < 2; ++i) stage_rc(tid * 16 + i * 8192, gR[i], gC[i]);
#define PG8_GOFF(dst, u_) do { if constexpr (GATHER) { _Pragma("unroll") for (int h_ = 0; h_ < 2; ++h_) _Pragma("unroll") for (int i_ = 0; i_ < 2; ++i_) \
        dst[h_][i_] = (unsigned)S.rowidx[(u_).pm * BM + h_ * HALF + gR[i_]] * (unsigned)(g.lda * 2) + (unsigned)(gC[i_] * 2); } } while (0)
    const size_t kstep = (size_t)(BK * 2);
    const size_t hstepA = (size_t)HALF * g.lda * 2, hstepB = (size_t)HALF * g.ldb * 2;
    const unsigned ldsw = (unsigned)wid * 1024u;
    const int aoff = lds_byte(wr * 64 + fr, fq * 8), boff = lds_byte(wc * 32 + fr, fq * 8);
#define PG8_SA(b, h) (((b) * 2 + (h)) * HTB)
#define PG8_SB(b, h) ((4 + (b) * 2 + (h)) * HTB)
#define PG8_STAGE(bufoff, gbase, voff) do { _Pragma("unroll") for (int _i = 0; _i < 2; ++_i) \
        __builtin_amdgcn_global_load_lds((const unsigned*)((const char*)(gbase) + (voff)[_i]), (PG8_LAS unsigned*)(lds + (bufoff) + ldsw + _i * 8192), 16, 0, 0); } while (0)
#define PG8_STAGE_A(bufoff, gbase, H, NX) do { if constexpr (GATHER) { _Pragma("unroll") for (int _i = 0; _i < 2; ++_i) { const unsigned o_ = (NX) ? gN[H][_i] : gA[H][_i]; \
        __builtin_amdgcn_global_load_lds((const unsigned*)((const char*)(gbase) + o_), (PG8_LAS unsigned*)(lds + (bufoff) + ldsw + _i * 8192), 16, 0, 0); } } \
        else { PG8_STAGE(bufoff, (gbase) + (H) * hstepA, voffA); } } while (0)
#define PG8_LDA(dst, b, h) do { _Pragma("unroll") for (int m = 0; m < 4; ++m) _Pragma("unroll") for (int k = 0; k < 2; ++k) dst[m][k] = *(const PG8_LAS bf16x8*)(lds + PG8_SA(b, h) + aoff + m * 2048 + k * 1024); } while (0)
#define PG8_LDB(dst, b, h) do { _Pragma("unroll") for (int n = 0; n < 2; ++n) _Pragma("unroll") for (int k = 0; k < 2; ++k) dst[n][k] = *(const PG8_LAS bf16x8*)(lds + PG8_SB(b, h) + boff + n * 2048 + k * 1024); } while (0)
#define PG8_MMA(ai, bj, At, Bt) do { __builtin_amdgcn_s_setprio(1); _Pragma("unroll") for (int m = 0; m < 4; ++m) _Pragma("unroll") for (int n = 0; n < 2; ++n) _Pragma("unroll") for (int k = 0; k < 2; ++k) \
        acc[ai][bj][m][n] = __builtin_amdgcn_mfma_f32_16x16x32_bf16(Bt[n][k], At[m][k], acc[ai][bj][m][n], 0, 0, 0); __builtin_amdgcn_s_setprio(0); } while (0)
#define PG8_WAIT_V(n) asm volatile("s_waitcnt vmcnt(" #n ")" ::: "memory")
#define PG8_WAIT_L(n) asm volatile("s_waitcnt lgkmcnt(" #n ")" ::: "memory")
#define PG8_BAR __builtin_amdgcn_s_barrier()
#define PG8_SCHED __builtin_amdgcn_sched_barrier(0)
    Unit cur, nxt; int ui = 0;
    if (!S.next(0, cur)) return;
    f32x4 acc[2][2][4][2];
#pragma unroll
    for (int a = 0; a < 2; ++a)
#pragma unroll
        for (int b = 0; b < 2; ++b)
#pragma unroll
            for (int m = 0; m < 4; ++m)
#pragma unroll
                for (int n = 0; n < 2; ++n) acc[a][b][m][n] = (f32x4){0.f, 0.f, 0.f, 0.f};
    bf16x8 At[4][2], B0[2][2], B1[2][2];
    const char* cA = cur.a; const char* cB = cur.b;
    S.a_ready(cur);
    PG8_GOFF(gA, cur);
    if constexpr (SP2) {
        PG8_STAGE(PG8_SB(0, 0), cB, voffB); PG8_STAGE(PG8_SB(0, 1), cB + hstepB, voffB); PG8_STAGE_A(PG8_SA(0, 0), cA, 0, false); PG8_STAGE_A(PG8_SA(0, 1), cA, 1, false);
        if (wr == 1) PG8_BAR;
        PG8_WAIT_V(2); PG8_BAR;
        PG8_STAGE(PG8_SB(1, 0), cB + kstep, voffB); PG8_STAGE_A(PG8_SA(1, 0), cA + kstep, 0, false); PG8_STAGE(PG8_SB(1, 1), cB + hstepB + kstep, voffB);
        PG8_WAIT_V(6); PG8_BAR;
    } else {
        PG8_STAGE(PG8_SB(0, 0), cB, voffB); PG8_STAGE_A(PG8_SA(0, 0), cA, 0, false); PG8_STAGE(PG8_SB(0, 1), cB + hstepB, voffB); PG8_STAGE_A(PG8_SA(0, 1), cA, 1, false);
        if (wr == 1) PG8_BAR;
        PG8_WAIT_V(4); PG8_BAR;
        PG8_STAGE(PG8_SB(1, 0), cB + kstep, voffB); PG8_STAGE_A(PG8_SA(1, 0), cA + kstep, 0, false); PG8_STAGE(PG8_SB(1, 1), cB + hstepB + kstep, voffB);
        PG8_WAIT_V(6); PG8_BAR;
    }
    for (;;) {
        const bool has_next = S.next(ui + 1, nxt);
        if (has_next) PG8_GOFF(gN, nxt);
        const char* nA = has_next ? nxt.a : cA; const char* nB = has_next ? nxt.b : cB;
        for (int t = 0; t < nt; t += 2) {
            const bool last = (t == nt - 2); const bool nx_ = last && has_next;
            const char* a1 = cA + (size_t)(t + 1) * kstep;
            const char* a2 = last ? nA : cA + (size_t)(t + 2) * kstep; const char* b2 = last ? nB : cB + (size_t)(t + 2) * kstep;
            const char* a3 = a2 + kstep; const char* b3 = b2 + kstep;
            if (last && has_next) S.a_ready(nxt);
            if constexpr (SP2) {
            PG8_LDB(B0, 0, 0); PG8_LDB(B1, 0, 1); PG8_SCHED; PG8_LDA(At, 0, 0); PG8_STAGE_A(PG8_SA(1, 1), a1, 1, false);
            PG8_WAIT_V(8); PG8_WAIT_L(0); PG8_BAR; PG8_MMA(0, 0, At, B0); PG8_MMA(0, 1, At, B1); PG8_BAR; PG8_SCHED;
            PG8_LDA(At, 0, 1); PG8_STAGE(PG8_SB(0, 0), b2, voffB); PG8_STAGE(PG8_SB(0, 1), b2 + hstepB, voffB); PG8_STAGE_A(PG8_SA(0, 0), a2, 0, nx_);
            PG8_WAIT_V(8); PG8_WAIT_L(0); PG8_BAR; PG8_MMA(1, 0, At, B0); PG8_MMA(1, 1, At, B1); PG8_BAR; PG8_SCHED;
            PG8_LDB(B0, 1, 0); PG8_LDB(B1, 1, 1); PG8_SCHED; PG8_LDA(At, 1, 0); PG8_STAGE_A(PG8_SA(0, 1), a2, 1, nx_);
            PG8_WAIT_V(8); PG8_WAIT_L(0); PG8_BAR; PG8_MMA(0, 0, At, B0); PG8_MMA(0, 1, At, B1); PG8_BAR; PG8_SCHED;
            PG8_LDA(At, 1, 1); PG8_STAGE(PG8_SB(1, 0), b3, voffB); PG8_STAGE(PG8_SB(1, 1), b3 + hstepB, voffB); PG8_STAGE_A(PG8_SA(1, 0), a3, 0, nx_);
            PG8_WAIT_V(8); PG8_WAIT_L(0); PG8_BAR; PG8_MMA(1, 0, At, B0); PG8_MMA(1, 1, At, B1); PG8_BAR; PG8_SCHED;
            } else {
            PG8_LDB(B0, 0, 0); PG8_SCHED; PG8_LDA(At, 0, 0); PG8_STAGE_A(PG8_SA(1, 1), a1, 1, false);
            PG8_WAIT_L(8); PG8_BAR; PG8_WAIT_L(0); PG8_MMA(0, 0, At, B0); PG8_BAR; PG8_SCHED;
            PG8_LDB(B1, 0, 1); PG8_STAGE(PG8_SB(0, 0), b2, voffB);
            PG8_BAR; PG8_WAIT_L(0); PG8_MMA(0, 1, At, B1); PG8_BAR;
            PG8_LDA(At, 0, 1); PG8_STAGE_A(PG8_SA(0, 0), a2, 0, nx_);
            PG8_BAR; PG8_WAIT_L(0); PG8_MMA(1, 0, At, B0); PG8_BAR; PG8_SCHED;
            PG8_STAGE(PG8_SB(0, 1), b2 + hstepB, voffB);
            PG8_WAIT_V(6); PG8_BAR; PG8_MMA(1, 1, At, B1); PG8_BAR;
            PG8_LDB(B0, 1, 0); PG8_SCHED; PG8_LDA(At, 1, 0); PG8_STAGE_A(PG8_SA(0, 1), a2, 1, nx_);
            PG8_WAIT_L(8); PG8_BAR; PG8_WAIT_L(0); PG8_MMA(0, 0, At, B0); PG8_BAR; PG8_SCHED;
            PG8_LDB(B1, 1, 1); PG8_STAGE(PG8_SB(1, 0), b3, voffB);
            PG8_BAR; PG8_WAIT_L(0); PG8_MMA(0, 1, At, B1); PG8_BAR;
            PG8_LDA(At, 1, 1); PG8_STAGE_A(PG8_SA(1, 0), a3, 0, nx_);
            PG8_BAR; PG8_WAIT_L(0); PG8_MMA(1, 0, At, B0); PG8_BAR; PG8_SCHED;
            PG8_STAGE(PG8_SB(1, 1), b3 + hstepB, voffB);
            PG8_WAIT_V(6); PG8_BAR; PG8_MMA(1, 1, At, B1); PG8_BAR;
            }
        }
        if constexpr (ALIGN_EPI) { if (wr == 0) PG8_BAR; }
        if constexpr (!Epi::AFTER_DRAIN) { E(acc, cur, wr, wc, fr, fq); S.done(cur); }
        if (!has_next) break;
#pragma unroll
        for (int a = 0; a < 2; ++a)
#pragma unroll
            for (int b = 0; b < 2; ++b)
#pragma unroll
                for (int m = 0; m < 4; ++m)
#pragma unroll
                    for (int n = 0; n < 2; ++n) acc[a][b][m][n] = (f32x4){0.f, 0.f, 0.f, 0.f};
        cur = nxt; cA = nA; cB = nB; ++ui;
        if constexpr (GATHER) { _Pragma("unroll") for (int h_ = 0; h_ < 2; ++h_) _Pragma("unroll") for (int i_ = 0; i_ < 2; ++i_) gA[h_][i_] = gN[h_][i_]; }
        if constexpr (ALIGN_EPI) { if (wr == 1) PG8_BAR; }
    }
    PG8_WAIT_V(0);
    if constexpr (!ALIGN_EPI) { if (wr == 0) PG8_BAR; }
    PG8_BAR;
    if constexpr (Epi::AFTER_DRAIN) { E.fused(acc, cur, wr, wc, fr, fq, lds, wid, lane); S.done(cur); }
#undef PG8_SA
#undef PG8_SB
#undef PG8_STAGE
#undef PG8_STAGE_A
#undef PG8_GOFF
#undef PG8_LDA
#undef PG8_LDB
#undef PG8_MMA
#undef PG8_WAIT_V
#undef PG8_WAIT_L
#undef PG8_BAR
#undef PG8_SCHED
}
}

#define GAS __attribute__((address_space(1)))
typedef GAS unsigned gu32;
#define RLX_AGENT __ATOMIC_RELAXED, __HIP_MEMORY_SCOPE_AGENT
#define XB_TMO      128
#define XB_XCNT(j)  (256  + 64 * (j))
#define XB_XSUB(j)  (1280 + 64 * (j))
#define XB_XGEN(j)  (2304 + 64 * (j))
#define XB_TOP      3328
#define XB_TOPGEN   3392
#define XCD_BAR_WORDS 3456
#define XB_SPIN_CAP (1u << 18)

__device__ __forceinline__ unsigned xb_ld(unsigned* p)              { return __hip_atomic_load(p, __ATOMIC_RELAXED, __HIP_MEMORY_SCOPE_AGENT); }
__device__ __forceinline__ unsigned xb_add(unsigned* p, unsigned v) { return __hip_atomic_fetch_add(p, v, __ATOMIC_RELAXED, __HIP_MEMORY_SCOPE_AGENT); }
__device__ __forceinline__ unsigned xb_xcc_id() { return (unsigned)__builtin_amdgcn_s_getreg((3 << 11) | 20) & 0xFu; }
#define XB_SPIN(cond, bar) do { unsigned _sp = 0; while (cond) { __builtin_amdgcn_s_sleep(1); \
    if ((++_sp & 255u) == 0u) { if (xb_ld(&(bar)[XB_TMO])) break; if (_sp > XB_SPIN_CAP) { atomicAdd(&(bar)[XB_TMO], 1u); break; } } } } while (0)

struct XcdBarrier {
    unsigned* bar; unsigned x;
    volatile LAS unsigned* st;
};

__device__ __forceinline__ XcdBarrier xcd_barrier_post(unsigned* bar, volatile LAS unsigned* st) {
    XcdBarrier b; b.bar = bar; b.x = xb_xcc_id(); b.st = st;
    if (threadIdx.x == 0) (void)xb_add(&bar[XB_XCNT(b.x)], 1u);
    return b;
}
__device__ __forceinline__ void xcd_barrier_complete(unsigned* bar, unsigned x, unsigned& nloc, unsigned& nx) {
    const unsigned G = gridDim.x * gridDim.y * gridDim.z;
    unsigned sum, cnt, mine, sp = 0u;
    for (;;) {
        sum = 0u; cnt = 0u; mine = 0u;
#pragma unroll
        for (unsigned j = 0; j < 16; ++j) { const unsigned c = xb_ld(&bar[XB_XCNT(j)]); sum += c; cnt += (c > 0u) ? 1u : 0u; mine = (j == x) ? c : mine; }
        if (sum == G) break;
        __builtin_amdgcn_s_sleep(1);
        if ((++sp & 255u) == 0u) { if (xb_ld(&bar[XB_TMO])) break; if (sp > XB_SPIN_CAP) { atomicAdd(&bar[XB_TMO], 1u); break; } }
    }
    nloc = mine > 0u ? mine : 1u; nx = cnt > 0u ? cnt : 1u;
}

__device__ __forceinline__ void xcd_barrier(const XcdBarrier& b) {
    asm volatile("s_waitcnt vmcnt(0)" ::: "memory");
    __syncthreads();
    if (threadIdx.x == 0) {
        unsigned* bar = b.bar;
        __builtin_amdgcn_s_waitcnt(0);
        unsigned nloc = b.st[0], nx = b.st[1];
        if (nloc == 0u) { xcd_barrier_complete(bar, b.x, nloc, nx); b.st[0] = nloc; b.st[1] = nx; }
        const unsigned old = xb_add(&bar[XB_XSUB(b.x)], 1u);
        const unsigned gen = old / nloc;
        if (old + 1u == (gen + 1u) * nloc) {
            __builtin_amdgcn_fence(__ATOMIC_RELEASE, "agent");
            asm volatile("s_waitcnt vmcnt(0)" ::: "memory");
            const unsigned og = xb_add(&bar[XB_TOP], 1u);
            const unsigned tg = og / nx;
            if (og + 1u == (tg + 1u) * nx) xb_add(&bar[XB_TOPGEN], 1u);
            else XB_SPIN(xb_ld(&bar[XB_TOPGEN]) == tg, bar);
            __builtin_amdgcn_fence(__ATOMIC_ACQUIRE, "agent");
            xb_add(&bar[XB_XGEN(b.x)], 1u);
            asm volatile("s_waitcnt vmcnt(0)" ::: "memory");
        } else {
            XB_SPIN(xb_ld(&bar[XB_XGEN(b.x)]) == gen, bar);
            __builtin_amdgcn_fence(__ATOMIC_ACQUIRE, "agent");
            asm volatile("s_waitcnt vmcnt(0)" ::: "memory");
        }
    }
    __syncthreads();
}

struct OrderBase {
    const int* rowidx;
    __device__ __forceinline__ void a_ready(const pg8::Unit&) const {}
    __device__ __forceinline__ void done(const pg8::Unit&) const {}
};
struct PlainOrder : OrderBase {
    const char* A; const char* B; size_t astep, bstep; int nM, nN, G, c;
    __device__ __forceinline__ bool next(int i, pg8::Unit& u) const {
        const long L = (long)i * G + c; if (L >= (long)nM * nN) return false;
        pg8::tile_of((int)L, nM, nN, u.pm, u.pn); u.aux = 0; u.a = A + (size_t)u.pm * astep; u.b = B + (size_t)u.pn * bstep; return true; }
};
struct LruOrder : OrderBase {
    const char* A; const char* B; int nM, G, c;
    __device__ __forceinline__ bool next(int i, pg8::Unit& u) const {
        const long L = (long)i * G + c; if (L >= (long)nM * 16) return false;
        pg8::tile_of((int)L, nM, 16, u.pm, u.pn); u.aux = 0; u.a = A + (size_t)u.pm * (256 * 1024 * 2) + (size_t)(u.pn >> 2) * 512; u.b = B + (size_t)u.pn * (256 * 256 * 2); return true; }
};
struct BranchOrder : OrderBase {
    const char* A; const char* B; int nM, G, c;
    __device__ __forceinline__ bool next(int i, pg8::Unit& u) const {
        const int j = i / 3, br = i - 3 * j; const long L = (long)j * G + c; if (L >= (long)nM * 4) return false;
        pg8::tile_of((int)L, nM, 4, u.pm, u.pn); u.aux = br; u.a = A + (size_t)br * ROWB + (size_t)u.pm * (256 * 1024 * 2); u.b = B + (size_t)br * (1024 * 1024 * 2) + (size_t)u.pn * (256 * 1024 * 2); return true; }
};
struct MoeOrder : OrderBase {
    const char* A; const char* B; const unsigned* tile_e; size_t estep; int nM, nN, G, c, ga;
    __device__ __forceinline__ bool next(int i, pg8::Unit& u) const {
        const long L = (long)i * G + c; if (L >= (long)nM * nN) return false;
        pg8::tile_of((int)L, nM, nN, u.pm, u.pn); const int e = (int)tile_e[u.pm]; u.aux = e;
        u.a = ga ? A : A + (size_t)u.pm * (256 * 1024 * 2); u.b = B + (size_t)e * estep + (size_t)u.pn * (256 * 1024 * 2); return true; }
};

struct EpiBf16Bias {
    static constexpr bool PERM = true, AFTER_DRAIN = false;
    bf16_t* O; int ldc; const float* bias; int bstride;
    __device__ __forceinline__ void operator()(const f32x4 (&acc)[2][2][4][2], const pg8::Unit& u, int wr, int wc, int fr, int fq) const {
        const int row0 = u.pm * 256 + wr * 64 + fr, col0 = u.pn * 256 + wc * 32 + 8 * fq;
        f32x4 bv[2][2];
#pragma unroll
        for (int bj = 0; bj < 2; ++bj)
#pragma unroll
            for (int n = 0; n < 2; ++n) bv[bj][n] = bias ? *(const f32x4*)(bias + (size_t)u.aux * bstride + col0 + bj * 128 + 4 * n) : (f32x4){0.f, 0.f, 0.f, 0.f};
#pragma unroll
        for (int ai = 0; ai < 2; ++ai)
#pragma unroll
            for (int m = 0; m < 4; ++m) { bf16_t* rowp = O + (size_t)(row0 + ai * 128 + m * 16) * ldc + col0;
#pragma unroll
                for (int bj = 0; bj < 2; ++bj) { const f32x4 v0 = acc[ai][bj][m][0] + bv[bj][0], v1 = acc[ai][bj][m][1] + bv[bj][1];
                    u32x4 w; w.x = pg8::cvt_pk_bf16(v0[0], v0[1]); w.y = pg8::cvt_pk_bf16(v0[2], v0[3]); w.z = pg8::cvt_pk_bf16(v1[0], v1[1]); w.w = pg8::cvt_pk_bf16(v1[2], v1[3]);
                    *(u32x4*)(rowp + bj * 128) = w; } }
    }
};
struct EpiLru {
    static constexpr bool PERM = true, AFTER_DRAIN = false;
    const bf16_t* xc; bf16_t* LA; bf16_t* BB; const float* ba; const float* bi; const float* lsl;
    __device__ __forceinline__ void operator()(const f32x4 (&acc)[2][2][4][2], const pg8::Unit& u, int wr, int wc, int fr, int fq) const {
        const int g = u.pn >> 2, d = (u.pn >> 1) & 1, hh = u.pn & 1;
        const int row0 = u.pm * 256 + wr * 64 + fr, ch0 = 256 * g + 128 * hh + wc * 32 + 8 * fq;
#pragma unroll
        for (int ai = 0; ai < 2; ++ai)
#pragma unroll
            for (int m = 0; m < 4; ++m) { const size_t off = (size_t)(row0 + ai * 128 + m * 16) * 1024 + ch0;
                const u32x4 xw = *(const u32x4*)(xc + off); float la[8], bb[8];
#pragma unroll
                for (int n = 0; n < 2; ++n) { const f32x4 pb = *(const f32x4*)(ba + d * 1024 + ch0 + 4 * n), pi = *(const f32x4*)(bi + d * 1024 + ch0 + 4 * n), pl = *(const f32x4*)(lsl + d * 1024 + ch0 + 4 * n);
#pragma unroll
                    for (int e = 0; e < 4; ++e) { const int idx = 4 * n + e; const unsigned w = xw[idx >> 1]; const float xv = (idx & 1) ? bfhi(w) : bflo(w);
                        const float r = sigmoidf_(acc[ai][0][m][n][e] + pb[e]), ig = sigmoidf_(acc[ai][1][m][n][e] + pi[e]);
                        const float l = 8.0f * r * pl[e]; la[idx] = l; bb[idx] = sqrtf(fmaxf(1.0f - __expf(2.0f * l), 0.f)) * ig * xv; } }
                u32x4 w1, w2; w1.x = pg8::cvt_pk_bf16(la[0], la[1]); w1.y = pg8::cvt_pk_bf16(la[2], la[3]); w1.z = pg8::cvt_pk_bf16(la[4], la[5]); w1.w = pg8::cvt_pk_bf16(la[6], la[7]);
                w2.x = pg8::cvt_pk_bf16(bb[0], bb[1]); w2.y = pg8::cvt_pk_bf16(bb[2], bb[3]); w2.z = pg8::cvt_pk_bf16(bb[4], bb[5]); w2.w = pg8::cvt_pk_bf16(bb[6], bb[7]);
                *(u32x4*)(LA + (size_t)d * TT * 1024 + off) = w1; *(u32x4*)(BB + (size_t)d * TT * 1024 + off) = w2; asm volatile("" ::: "memory"); }
    }
};
struct EpiBranch {
    static constexpr bool PERM = true, AFTER_DRAIN = false;
    const bf16_t* P; float* MF; bf16_t* MG;
    __device__ __forceinline__ void operator()(const f32x4 (&acc)[2][2][4][2], const pg8::Unit& u, int wr, int wc, int fr, int fq) const {
        const int br = u.aux, row0 = u.pm * 256 + wr * 64 + fr, col0 = u.pn * 256 + wc * 32 + 8 * fq;
#pragma unroll
        for (int ai = 0; ai < 2; ++ai)
#pragma unroll
            for (int m = 0; m < 4; ++m) { const size_t row = (size_t)(row0 + ai * 128 + m * 16);
#pragma unroll
                for (int bj = 0; bj < 2; ++bj) { const int c = col0 + bj * 128;
                    const u32x4 gw = *(const u32x4*)(P + row * LDP + C_MG + br * 1024 + c);
                    f32x4 v0, v1;
                    v0[0] = sigmoidf_(bflo(gw.x)) * acc[ai][bj][m][0][0]; v0[1] = sigmoidf_(bfhi(gw.x)) * acc[ai][bj][m][0][1]; v0[2] = sigmoidf_(bflo(gw.y)) * acc[ai][bj][m][0][2]; v0[3] = sigmoidf_(bfhi(gw.y)) * acc[ai][bj][m][0][3];
                    v1[0] = sigmoidf_(bflo(gw.z)) * acc[ai][bj][m][1][0]; v1[1] = sigmoidf_(bfhi(gw.z)) * acc[ai][bj][m][1][1]; v1[2] = sigmoidf_(bflo(gw.w)) * acc[ai][bj][m][1][2]; v1[3] = sigmoidf_(bfhi(gw.w)) * acc[ai][bj][m][1][3];
                    float* mf = MF + row * 1024 + c;
                    if (br != 0) { v0 += *(const f32x4*)mf; v1 += *(const f32x4*)(mf + 4); }
                    if (br != 2) { *(f32x4*)mf = v0; *(f32x4*)(mf + 4) = v1; }
                    else { u32x4 w; w.x = pg8::cvt_pk_bf16(v0[0], v0[1]); w.y = pg8::cvt_pk_bf16(v0[2], v0[3]); w.z = pg8::cvt_pk_bf16(v1[0], v1[1]); w.w = pg8::cvt_pk_bf16(v1[2], v1[3]);
                        *(u32x4*)(MG + row * 1024 + c) = w; } } }
    }
};
struct EpiOut {
    static constexpr bool PERM = false, AFTER_DRAIN = false;
    const float* baseLat; const float* baseCtx; float* xs; const float* gate;
    __device__ __forceinline__ void operator()(const f32x4 (&acc)[2][2][4][2], const pg8::Unit& u, int wr, int wc, int fr, int fq) const {
        const int mrow = u.pm < 128 ? (u.pm >> 4) : 8; const float* gp = gate + mrow * 6144;
        const int row0 = u.pm * 256 + wr * 64 + fr, col0 = u.pn * 256 + wc * 32 + 4 * fq;
        const float* base = u.pm < 128 ? baseLat + (size_t)row0 * 1024 : baseCtx + (size_t)(row0 - TLAT) * 1024;
        f32x4 gv[2][2];
#pragma unroll
        for (int bj = 0; bj < 2; ++bj)
#pragma unroll
            for (int n = 0; n < 2; ++n) gv[bj][n] = *(const f32x4*)(gp + col0 + bj * 128 + n * 16);
#pragma unroll
        for (int ai = 0; ai < 2; ++ai)
#pragma unroll
            for (int m = 0; m < 4; ++m) { const size_t ro = (size_t)(ai * 128 + m * 16) * 1024 + col0; float* op = xs + (size_t)row0 * 1024 + ro;
#pragma unroll
                for (int bj = 0; bj < 2; ++bj)
#pragma unroll
                    for (int n = 0; n < 2; ++n) *(f32x4*)(op + bj * 128 + n * 16) = *(const f32x4*)(base + ro + bj * 128 + n * 16) + gv[bj][n] * acc[ai][bj][m][n]; }
    }
};
struct EpiSwiglu {
    static constexpr bool PERM = true, AFTER_DRAIN = false;
    bf16_t* H; const float* bgu;
    __device__ __forceinline__ void operator()(const f32x4 (&acc)[2][2][4][2], const pg8::Unit& u, int wr, int wc, int fr, int fq) const {
        const int row0 = u.pm * 256 + wr * 64 + fr, f0 = u.pn * 128 + wc * 32 + 8 * fq;
        float bg[8], bu[8];
#pragma unroll
        for (int q = 0; q < 4; ++q) { const f32x4 b = *(const f32x4*)(bgu + (size_t)u.aux * 2048 + 2 * f0 + 4 * q); bg[2 * q] = b[0]; bu[2 * q] = b[1]; bg[2 * q + 1] = b[2]; bu[2 * q + 1] = b[3]; }
#pragma unroll
        for (int ai = 0; ai < 2; ++ai)
#pragma unroll
            for (int m = 0; m < 4; ++m) { float a[8];
#pragma unroll
                for (int n = 0; n < 2; ++n)
#pragma unroll
                    for (int e = 0; e < 4; ++e) { const int idx = 4 * n + e; const float gt = fminf(acc[ai][0][m][n][e] + bg[idx], 7.0f), up = fminf(fmaxf(acc[ai][1][m][n][e] + bu[idx], -7.0f), 7.0f);
                        a[idx] = gt * sigmoidf_(1.702f * gt) * (up + 1.0f); }
                u32x4 w; w.x = pg8::cvt_pk_bf16(a[0], a[1]); w.y = pg8::cvt_pk_bf16(a[2], a[3]); w.z = pg8::cvt_pk_bf16(a[4], a[5]); w.w = pg8::cvt_pk_bf16(a[6], a[7]);
                *(u32x4*)(H + (size_t)(row0 + ai * 128 + m * 16) * 1024 + f0) = w; }
    }
};

constexpr int NWAVES = 8, NTHR = 512;
constexpr int LDS_BYTES = 163840, MISC_OFF = 163840 - 512;
struct Frame {
    LAS unsigned char* lds; GAS unsigned char* ws; const float* const* in; float* out;
    int tid, bx, lane, wave, G, gw, NGW, gtid, NGT;
};
__device__ __forceinline__ int mrow_of(int row) { return row < TLAT ? (row >> 12) : 8; }
__device__ __forceinline__ int seqrow(int d, int b, int p) {
    if (p < CTXL) return TLAT + b * CTXL + (d ? CTXL - 1 - p : p);
    const int q = p - CTXL; return b * SEQ + (d ? SEQ - 1 - q : q);
}
struct RowV { f32x4 v[4]; };
__device__ __forceinline__ RowV load_row(const float* p, int lane) { RowV r;
#pragma unroll
    for (int j = 0; j < 4; ++j) r.v[j] = *(const f32x4*)(p + 4 * lane + 256 * j);
    return r; }
__device__ __forceinline__ float row_sumsq(const RowV& r) { float s = 0.f;
#pragma unroll
    for (int j = 0; j < 4; ++j) s += (r.v[j][0] * r.v[j][0] + r.v[j][1] * r.v[j][1]) + (r.v[j][2] * r.v[j][2] + r.v[j][3] * r.v[j][3]);
    return wave_sum(s); }
__device__ __forceinline__ RowV norm_mod(const RowV& x, const float* gain, const float* shift, const float* scale, int lane) {
    const float rs = rsqrtf(row_sumsq(x) * (1.0f / D) + EPS); RowV y;
#pragma unroll
    for (int j = 0; j < 4; ++j) { const int c = 4 * lane + 256 * j; const f32x4 g = *(const f32x4*)(gain + c), sh = *(const f32x4*)(shift + c), sc = *(const f32x4*)(scale + c);
        y.v[j] = (x.v[j] * rs) * g * (sc + 1.0f) + sh; }
    return y; }
__device__ __forceinline__ void store_row_bf16(bf16_t* p, const RowV& y, int lane) {
#pragma unroll
    for (int j = 0; j < 4; ++j) { u32x2 w; w.x = pk2(y.v[j][0], y.v[j][1]); w.y = pk2(y.v[j][2], y.v[j][3]); *(u32x2*)(p + 4 * lane + 256 * j) = w; } }
__device__ __forceinline__ f32x4 ld4bf(const bf16_t* p) { const u32x2 w = *(const u32x2*)p; return (f32x4){bflo(w.x), bfhi(w.x), bflo(w.y), bfhi(w.y)}; }

__device__ __forceinline__ void phase_proA(const Frame& F) {
    const float* c = F.in[1]; const float* cc = F.in[3]; const float* w_ada = F.in[4];
    float* modp = (float*)(F.ws + WS_MODP);
    for (int it = F.gw; it < 2 * 8 * 96; it += F.NGW) {
        const int cg = it % 96, ks = (it / 96) % 8, l = it / 768, col = cg * 64 + F.lane;
        float acc[9];
#pragma unroll
        for (int r = 0; r < 9; ++r) acc[r] = 0.f;
        for (int k = ks * 128; k < ks * 128 + 128; ++k) {
            const float w = w_ada[((size_t)l * 1024 + k) * 6144 + col];
#pragma unroll
            for (int r = 0; r < 8; ++r) acc[r] += siluf_(c[r * 1024 + k]) * w;
            acc[8] += siluf_(cc[k]) * w;
        }
#pragma unroll
        for (int r = 0; r < 9; ++r) modp[((size_t)(ks * 2 + l) * 9 + r) * 6144 + col] = acc[r];
    }
    float* rc = (float*)(F.ws + WS_COS); float* rsn = (float*)(F.ws + WS_SIN);
    for (int i = F.gtid; i < SEQ * 64; i += F.NGT) {
        const int t = i >> 6, j = i & 63, f = j & 31; const float pos = (float)((j < 32) ? (t >> 6) : (t & 63));
        const float inv = exp2f(-(float)f * (13.287712379549449f / 32.0f)); const float ang = pos * inv;
        const float nn = rintf(ang * 0.15915494309189535f); float r = fmaf(-nn, 6.28125f, ang); r = fmaf(-nn, 1.9353071795864769e-3f, r);
        rc[i] = __cosf(r); rsn[i] = __sinf(r);
    }
}
__device__ __forceinline__ void phase_proB(const Frame& F) {
    const float* modp = (const float*)(F.ws + WS_MODP); float* mods = (float*)(F.ws + WS_MODS); const float* b_ada = F.in[5];
    for (int i = F.gtid; i < 2 * 9 * 6144; i += F.NGT) { const int l = i / (9 * 6144), col = i % 6144; float s = b_ada[l * 6144 + col];
#pragma unroll
        for (int ks = 0; ks < 8; ++ks) s += modp[(size_t)ks * (2 * 9 * 6144) + i];
        mods[i] = s; }
}

template <class RM> __device__ __forceinline__ void tr_item(const float* W, int ldw, int k0, int n0, bf16_t* WT, int ldt, LAS float* scr, int lane, const RM& rm) {
#pragma unroll 8
    for (int i = 0; i < 32; ++i) { const int kk = 2 * i + (lane >> 5); scr[kk * 33 + (lane & 31)] = W[(size_t)(k0 + kk) * ldw + n0 + (lane & 31)]; }
    LDS_WAIT(); asm volatile("" ::: "memory");
    const int c = lane & 7;
#pragma unroll
    for (int j = 0; j < 4; ++j) { const int n = (lane >> 3) + 8 * j; const LAS float* s = scr + (8 * c) * 33 + n; int drow; float sc; rm(n0 + n, drow, sc);
        u32x4 o; o.x = pk2(s[0 * 33] * sc, s[1 * 33] * sc); o.y = pk2(s[2 * 33] * sc, s[3 * 33] * sc); o.z = pk2(s[4 * 33] * sc, s[5 * 33] * sc); o.w = pk2(s[6 * 33] * sc, s[7 * 33] * sc);
        *(u32x4*)(WT + (size_t)drow * ldt + k0 + 8 * c) = o; }
    LDS_WAIT(); asm volatile("" ::: "memory");
}
struct RmIn { __device__ __forceinline__ void operator()(int n, int& drow, float& sc) const {
    drow = n < 3072 ? n : (n < 3104 ? C_LR + (n - 3072) : n - 32); sc = (n < 512 || (n >= 5664 && n < 6176)) ? 0.08838834764831845f : 1.0f; } };
struct RmId { __device__ __forceinline__ void operator()(int n, int& drow, float& sc) const { drow = n; sc = 1.0f; } };
struct RmLru { int base; __device__ __forceinline__ void operator()(int n, int& drow, float& sc) const { drow = base + (n & 127); sc = 1.0f; } };
struct RmGu { __device__ __forceinline__ void operator()(int n, int& drow, float& sc) const { const int f = n >> 1, u = n & 1; drow = 256 * (f >> 7) + 128 * u + (f & 127); sc = 1.0f; } };
__device__ __forceinline__ void phase_W(const Frame& F, int li) {
    LAS float* scr = (LAS float*)(F.lds + F.wave * 8704);
    bf16_t* Win_t = (bf16_t*)(F.ws + WS_WIN); bf16_t* Wlru_t = (bf16_t*)(F.ws + WS_WLRU); bf16_t* Wbr_t = (bf16_t*)(F.ws + WS_WBR);
    bf16_t* Wout_t = (bf16_t*)(F.ws + WS_WOUT); bf16_t* Wgu_t = (bf16_t*)(F.ws + WS_WGU); bf16_t* Wdn_t = (bf16_t*)(F.ws + WS_WDN);
    constexpr int I_IN = 16 * 353, I_LRU = 512, I_BR = 1536, I_OUT = 512, I_GU = 32768, I_DN = 16384, NITEMS = I_IN + I_LRU + I_BR + I_OUT + I_GU + I_DN;
    for (int it0 = F.gw; it0 < NITEMS; it0 += F.NGW) {
        int it = it0;
        if (it < I_IN) { const int kb = it / 353, nb = it % 353; tr_item(F.in[8] + (size_t)li * 1024 * IN_TOTAL, IN_TOTAL, 64 * kb, 32 * nb, Win_t, 1024, scr, F.lane, RmIn{}); continue; } it -= I_IN;
        if (it < I_LRU) { const int mat = it >> 5, r = it & 31, kb = r >> 3, nb = r & 7, ty = mat >> 3, d = (mat >> 2) & 1, g = mat & 3, n0 = 32 * nb, pn = g * 4 + d * 2 + (n0 >> 7);
            const float* src = (ty ? F.in[16] : F.in[14]) + (size_t)((li * 2 + d) * 4 + g) * 65536;
            tr_item(src, 256, 64 * kb, n0, Wlru_t, 256, scr, F.lane, RmLru{pn * 256 + ty * 128}); continue; } it -= I_LRU;
        if (it < I_BR) { const int br = it >> 9, r = it & 511, kb = r >> 5, nb = r & 31; tr_item(F.in[20] + (size_t)(li * 3 + br) * 1048576, 1024, 64 * kb, 32 * nb, Wbr_t + (size_t)br * 1048576, 1024, scr, F.lane, RmId{}); continue; } it -= I_BR;
        if (it < I_OUT) { const int kb = it >> 5, nb = it & 31; tr_item(F.in[21] + (size_t)li * 1048576, 1024, 64 * kb, 32 * nb, Wout_t, 1024, scr, F.lane, RmId{}); continue; } it -= I_OUT;
        if (it < I_GU) { const int e = it >> 10, r = it & 1023, kb = r >> 6, nb = r & 63; tr_item(F.in[24] + (size_t)(li * 32 + e) * 2097152, 2048, 64 * kb, 32 * nb, Wgu_t + (size_t)e * 2097152, 1024, scr, F.lane, RmGu{}); continue; } it -= I_GU;
        { const int e = it >> 9, r = it & 511, kb = r >> 5, nb = r & 31; tr_item(F.in[26] + (size_t)(li * 32 + e) * 1048576, 1024, 64 * kb, 32 * nb, Wdn_t + (size_t)e * 1048576, 1024, scr, F.lane, RmId{}); }
    }
    for (int i = F.gtid; i < (LDP - IN_TOTAL) * 1024 / 8; i += F.NGT) *(u32x4*)(Win_t + (size_t)IN_TOTAL * 1024 + (size_t)i * 8) = (u32x4){0u, 0u, 0u, 0u};
    float* lsl = (float*)(F.ws + WS_LSL);
    for (int i = F.gtid; i < 2048; i += F.NGT) lsl[i] = logsigmoidf_(F.in[18][li * 2048 + i]);
}
__device__ __forceinline__ void phase_norm_in(const Frame& F) {
    const float* mods = (const float*)(F.ws + WS_MODS); bf16_t* xn = (bf16_t*)(F.ws + WS_D);
    for (int row = F.gw; row < TT; row += F.NGW) {
        const float* src = row < TLAT ? F.in[0] + (size_t)row * D : F.in[2] + (size_t)(row - TLAT) * D;
        const float* mp = mods + mrow_of(row) * 6144;
        const RowV y = norm_mod(load_row(src, F.lane), F.in[6], mp, mp + 1024, F.lane);
        store_row_bf16(xn + (size_t)row * D, y, F.lane);
    }
}

__device__ __forceinline__ void phase_conv(const Frame& F, int li) {
    const bf16_t* P = (const bf16_t*)(F.ws + WS_P); bf16_t* xc = (bf16_t*)(F.ws + WS_D);
    const float* cw = F.in[12] + (size_t)li * 4 * 1024; const float* cb = F.in[13] + (size_t)li * 1024;
    for (int i = F.gtid; i < TT * 128; i += F.NGT) {
        const int row = i >> 7, ch = (i & 127) * 8;
        int t, L; if (row < TLAT) { t = row & (SEQ - 1); L = SEQ; } else { t = (row - TLAT) & (CTXL - 1); L = CTXL; }
        float a[8];
        { const f32x4 b0 = *(const f32x4*)(cb + ch), b1 = *(const f32x4*)(cb + ch + 4); a[0] = b0[0]; a[1] = b0[1]; a[2] = b0[2]; a[3] = b0[3]; a[4] = b1[0]; a[5] = b1[1]; a[6] = b1[2]; a[7] = b1[3]; }
#pragma unroll
        for (int j = 0; j < 4; ++j) { const int tt = t - 2 + j; if (tt < 0 || tt >= L) continue;
            const u32x4 xw = *(const u32x4*)(P + (size_t)(row - 2 + j) * LDP + C_LX + ch);
            const f32x4 w0 = *(const f32x4*)(cw + j * 1024 + ch), w1 = *(const f32x4*)(cw + j * 1024 + ch + 4);
            a[0] += w0[0] * bflo(xw.x); a[1] += w0[1] * bfhi(xw.x); a[2] += w0[2] * bflo(xw.y); a[3] += w0[3] * bfhi(xw.y);
            a[4] += w1[0] * bflo(xw.z); a[5] += w1[1] * bfhi(xw.z); a[6] += w1[2] * bflo(xw.w); a[7] += w1[3] * bfhi(xw.w); }
        u32x4 o; o.x = pk2(a[0], a[1]); o.y = pk2(a[2], a[3]); o.z = pk2(a[4], a[5]); o.w = pk2(a[6], a[7]);
        *(u32x4*)(xc + (size_t)row * 1024 + ch) = o;
    }
    bf16_t* Pw = (bf16_t*)(F.ws + WS_P); const float* rcos = (const float*)(F.ws + WS_COS); const float* rsin = (const float*)(F.ws + WS_SIN);
    for (int i = F.gtid; i < TLAT * 64; i += F.NGT) {
        const int g8 = i & 7, qk = (i >> 3) & 1, h = (i >> 4) & 3, row = i >> 6, t = row & (SEQ - 1);
        bf16_t* p1 = Pw + (size_t)row * LDP + (qk ? C_RK : C_RQ) + 128 * h + 8 * g8; bf16_t* p2 = p1 + 64;
        const u32x4 a = *(const u32x4*)p1, b = *(const u32x4*)p2;
        const f32x4 c0 = *(const f32x4*)(rcos + t * 64 + 8 * g8), c1 = *(const f32x4*)(rcos + t * 64 + 8 * g8 + 4), s0 = *(const f32x4*)(rsin + t * 64 + 8 * g8), s1 = *(const f32x4*)(rsin + t * 64 + 8 * g8 + 4);
        const float cs[8] = {c0[0], c0[1], c0[2], c0[3], c1[0], c1[1], c1[2], c1[3]}, sn[8] = {s0[0], s0[1], s0[2], s0[3], s1[0], s1[1], s1[2], s1[3]};
        const unsigned aw[4] = {a.x, a.y, a.z, a.w}, bw[4] = {b.x, b.y, b.z, b.w}; u32x4 o1, o2;
#pragma unroll
        for (int e = 0; e < 4; ++e) { const float x1a = bflo(aw[e]), x1b = bfhi(aw[e]), x2a = bflo(bw[e]), x2b = bfhi(bw[e]);
            o1[e] = pk2(x1a * cs[2 * e] - x2a * sn[2 * e], x1b * cs[2 * e + 1] - x2b * sn[2 * e + 1]);
            o2[e] = pk2(x1a * sn[2 * e] + x2a * cs[2 * e], x1b * sn[2 * e + 1] + x2b * cs[2 * e + 1]); }
        *(u32x4*)p1 = o1; *(u32x4*)p2 = o2;
    }
}
__device__ __forceinline__ int seg_row(int d, int b, int s, int p) {
    const int base = (s == 0) ? TLAT + b * CTXL : b * SEQ + 256 * (d ? 16 - s : s - 1);
    return base + (d ? 255 - p : p);
}
template <bool FINAL> __device__ __forceinline__ void phase_lru_scan(const Frame& F) {
    const bf16_t* LA = (const bf16_t*)(F.ws + WS_C); const bf16_t* BB = (const bf16_t*)(F.ws + WS_C + 2 * ROWB);
    float* carA = (float*)(F.ws + WS_CARA); float* carH = (float*)(F.ws + WS_CARH); bf16_t* HO = (bf16_t*)(F.ws + WS_E);
    for (int i = F.gtid; i < 2 * 8 * 17 * 256; i += F.NGT) {
        const int cq = i & 255, s = (i >> 8) % 17, db = (i >> 8) / 17, b = db & 7, d = db >> 3;
        f32x4 h = (f32x4){0.f, 0.f, 0.f, 0.f}, As = (f32x4){0.f, 0.f, 0.f, 0.f};
        if (FINAL) { for (int s2 = 0; s2 < s; ++s2) { const size_t o = ((size_t)(db * 17 + s2) * 256 + cq) * 4; h = *(const f32x4*)(carA + o) * h + *(const f32x4*)(carH + o); } }
        const size_t dofs = (size_t)d * TT * 1024;
#pragma unroll 8
        for (int p = 0; p < 256; ++p) { const size_t off = (size_t)seg_row(d, b, s, p) * 1024 + cq * 4;
            const f32x4 la = ld4bf(LA + dofs + off), bb = ld4bf(BB + dofs + off);
            f32x4 a; a[0] = __expf(la[0]); a[1] = __expf(la[1]); a[2] = __expf(la[2]); a[3] = __expf(la[3]);
            h = a * h + bb;
            if (FINAL) { u32x2 w; w.x = pk2(h[0], h[1]); w.y = pk2(h[2], h[3]); *(u32x2*)(HO + dofs + off) = w; } else As += la; }
        if (!FINAL) { const size_t o = (size_t)i * 4; f32x4 A; A[0] = __expf(As[0]); A[1] = __expf(As[1]); A[2] = __expf(As[2]); A[3] = __expf(As[3]);
            *(f32x4*)(carA + o) = A; *(f32x4*)(carH + o) = h; }
    }
}


constexpr size_t QKB = (size_t)TT * 512 * 2;
__device__ __forceinline__ void phase_scanprep(const Frame& F, int li) {
    LAS float* lrs = (LAS float*)F.lds;
    LAS float* qtot = lrs + 64 * 32;
    LAS float* gcs = qtot + 4 * 512;
    bf16_t* Pm = (bf16_t*)(F.ws + WS_P); bf16_t* QK = (bf16_t*)(F.ws + WS_C); float* EGL = (float*)(F.ws + WS_MODP);
    const int qtr = F.tid >> 7, c4 = F.tid & 127, ch0 = 4 * c4;
    for (int rc = F.bx; rc < TT / 64; rc += F.G) {
        if (F.tid < 256) { const int tok = F.tid >> 2, q8 = F.tid & 3; const u32x4 v = *(const u32x4*)(Pm + (size_t)(64 * rc + tok) * LDP + C_LR + 8 * q8);
            LAS float* dst = lrs + tok * 32 + 8 * q8; *(LAS f32x4*)dst = (f32x4){bflo(v.x), bfhi(v.x), bflo(v.y), bfhi(v.y)}; *(LAS f32x4*)(dst + 4) = (f32x4){bflo(v.z), bfhi(v.z), bflo(v.w), bfhi(v.w)}; }
        __syncthreads();
        for (int d = 0; d < 2; ++d) {
            f32x4 wv[16];
#pragma unroll
            for (int r = 0; r < 16; ++r) wv[r] = *(const f32x4*)(F.in[9] + (size_t)((li * 2 + d) * 16 + r) * 512 + ch0);
            const f32x4 bav = *(const f32x4*)(F.in[10] + (size_t)(li * 2 + d) * 512 + ch0);
            f32x4 run = (f32x4){0.f, 0.f, 0.f, 0.f};
#pragma unroll 2
            for (int i = 0; i < 16; ++i) { const int p = 16 * qtr + i, tok = d ? 63 - p : p; f32x4 z = bav;
#pragma unroll
                for (int r4 = 0; r4 < 4; ++r4) { const f32x4 l = *(const LAS f32x4*)(lrs + tok * 32 + 16 * d + 4 * r4);
#pragma unroll
                    for (int e = 0; e < 4; ++e) z += wv[4 * r4 + e] * l[e]; }
#pragma unroll
                for (int e = 0; e < 4; ++e) run[e] += logsigmoidf_(z[e]) * 0.0625f;
                *(LAS f32x4*)(gcs + p * 512 + ch0) = run; }
            *(LAS f32x4*)(qtot + qtr * 512 + ch0) = run;
            __syncthreads();
            f32x4 off = (f32x4){0.f, 0.f, 0.f, 0.f}, tot = (f32x4){0.f, 0.f, 0.f, 0.f};
#pragma unroll
            for (int q2 = 0; q2 < 4; ++q2) { const f32x4 t = *(const LAS f32x4*)(qtot + q2 * 512 + ch0); tot += t; if (q2 < qtr) off += t; }
            if (qtr == 0) { f32x4 e4; e4[0] = __expf(tot[0]); e4[1] = __expf(tot[1]); e4[2] = __expf(tot[2]); e4[3] = __expf(tot[3]); *(f32x4*)(EGL + ((size_t)d * (TT / 64) + rc) * 512 + ch0) = e4; }
            bf16_t* EGd = QK + (size_t)d * TT * 512;
#pragma unroll 4
            for (int i = 0; i < 16; ++i) { const int p = 16 * qtr + i, tok = d ? 63 - p : p; const size_t row = (size_t)(64 * rc + tok);
                const f32x4 G = *(const LAS f32x4*)(gcs + p * 512 + ch0) + off;
                u32x2 we; we.x = pk2(__expf(G[0]), __expf(G[1])); we.y = pk2(__expf(G[2]), __expf(G[3]));
                *(u32x2*)(EGd + row * 512 + ch0) = we; }
            __syncthreads();
        }
    }
}
typedef short s16x4 __attribute__((ext_vector_type(4)));
constexpr int SC_PITCH = 272, SC_QS = 0, SC_KS = 17408, SC_VS = 34816, SC_SB = 52224, SC_AS = 87040, SC_APITCH = 144, SC_OS = SC_AS + 9216;
__device__ __forceinline__ bf16x8 tr_frag(LAS unsigned char* base, int pitch, int k0, int c0, int lane) {
    const int q = (lane & 15) >> 2, p = lane & 3;
    LAS unsigned char* a = base + (k0 + q) * pitch + (c0 + 4 * p) * 2;
    const s16x4 lo = __builtin_amdgcn_ds_read_tr16_b64_v4i16((LAS s16x4*)a);
    const s16x4 hi = __builtin_amdgcn_ds_read_tr16_b64_v4i16((LAS s16x4*)(a + 4 * pitch));
    return (bf16x8){lo[0], lo[1], lo[2], lo[3], hi[0], hi[1], hi[2], hi[3]};
}
#define MFMA16(a, b, c) __builtin_amdgcn_mfma_f32_16x16x32_bf16((a), (b), (c), 0, 0, 0)
__device__ __forceinline__ int chunk_rc(int d, int b, int chn) { return chn < 4 ? (TLAT / 64) + 4 * b + (d ? 3 - chn : chn) : 64 * b + (d ? 63 - (chn - 4) : (chn - 4)); }
struct ScanSet { u32x4 q[2], k[2], v[2], e[2]; float gl[2]; };
#define GST16(ptr, val) asm volatile("global_store_dwordx4 %0, %1, off\n\ts_nop 1" :: "v"(ptr), "v"(val) : "memory")
template <int MX> __device__ __forceinline__ void scan_unit(const Frame& F, int u) {
    LAS unsigned char* L = F.lds;
    const int tid = F.tid, lane = F.lane, w = F.wave, fr = lane & 15, fq = lane >> 4, tt = tid >> 4, part = tid & 15;
    const int js = u & 1, h = (u >> 1) & 3, b = (u >> 3) & 7, d = (u >> 6) & 1;
    const bf16_t* Pq = (const bf16_t*)(F.ws + WS_P) + (MX ? C_RQ : C_GQ) + 128 * h + 8 * part; const bf16_t* Pk = Pq + 512;
    const bf16_t* Pv = (const bf16_t*)(F.ws + WS_P) + (MX ? C_RV : C_GV) + 256 * h + 128 * js + 8 * part;
    const bf16_t* EGp = (const bf16_t*)(F.ws + WS_C) + (size_t)d * TT * 512 + 128 * h + 8 * part;
    const int tmA = w >> 1, tnA = 2 * (w & 1), tmB = w & 1, tnB = w >> 1, tmS = w & 3, tnS = w >> 2;
    const float* EGLp = (const float*)(F.ws + WS_MODP) + (size_t)d * (TT / 64) * 512 + 128 * h + 32 * tmS + fr;
    bf16_t* O = (bf16_t*)(F.ws + WS_B) + (size_t)(MX * 2 + d) * TT * 1024 + 256 * h + 128 * js + 8 * part;
    float er[2] = {1.f, 1.f}, nr[2] = {1.f, 1.f}, egr = 1.0f;
    if (MX == 1) { const float x = exp2f(-5.0f - (float)h), lg = -(x + x * x * 0.5f + x * x * x * (1.0f / 3.0f) + x * x * x * x * 0.25f);
        egr = __expf(64.0f * lg); er[0] = __expf((float)(tt + 1) * lg); nr[0] = __expf(-(float)(tt + 1) * lg); er[1] = __expf((float)(tt + 33) * lg); nr[1] = __expf(-(float)(tt + 33) * lg); }
    f32x4 S[2][4];
#pragma unroll
    for (int i = 0; i < 2; ++i)
#pragma unroll
        for (int j = 0; j < 4; ++j) S[i][j] = (f32x4){0.f, 0.f, 0.f, 0.f};
    for (int i = tid; i < (128 * SC_PITCH) / 16; i += NTHR) *(LAS u32x4*)(L + SC_SB + i * 16) = (u32x4){0u, 0u, 0u, 0u};
    constexpr int NCH = (CTXL + SEQ) / 64;
    ScanSet sA, sB;
#define SC_LOAD(chn, st) do { const int rc_ = chunk_rc(d, b, (chn)); _Pragma("unroll") for (int ps = 0; ps < 2; ++ps) { const int c_ = tt + 32 * ps; const size_t row_ = (size_t)(64 * rc_ + (d ? 63 - c_ : c_)); \
        st.q[ps] = *(const u32x4*)(Pq + row_ * LDP); st.k[ps] = *(const u32x4*)(Pk + row_ * LDP); st.v[ps] = *(const u32x4*)(Pv + row_ * LDP); if (MX == 0) st.e[ps] = *(const u32x4*)(EGp + row_ * 512); } \
        if (MX == 0) { st.gl[0] = EGLp[(size_t)rc_ * 512]; st.gl[1] = EGLp[(size_t)rc_ * 512 + 16]; } } while (0)
#define SC_PUT(st) do { _Pragma("unroll") for (int ps = 0; ps < 2; ++ps) { const int c_ = tt + 32 * ps; u32x4 qo, ko; \
        _Pragma("unroll") for (int e2 = 0; e2 < 4; ++e2) { float ea, eb, na, nb; \
            if (MX == 0) { ea = bflo(st.e[ps][e2]); eb = bfhi(st.e[ps][e2]); na = __builtin_amdgcn_rcpf(ea); nb = __builtin_amdgcn_rcpf(eb); } else { ea = eb = er[ps]; na = nb = nr[ps]; } \
            qo[e2] = pk2(bflo(st.q[ps][e2]) * ea, bfhi(st.q[ps][e2]) * eb); ko[e2] = pk2(bflo(st.k[ps][e2]) * na, bfhi(st.k[ps][e2]) * nb); } \
        *(LAS u32x4*)(L + SC_QS + c_ * SC_PITCH + part * 16) = qo; *(LAS u32x4*)(L + SC_KS + c_ * SC_PITCH + part * 16) = ko; *(LAS u32x4*)(L + SC_VS + c_ * SC_PITCH + part * 16) = st.v[ps]; } } while (0)
    float eg[2] = {egr, egr}, egn[2] = {egr, egr};
    SC_LOAD(0, sA); SC_PUT(sA); if (MX == 0) { eg[0] = sA.gl[0]; eg[1] = sA.gl[1]; }
    SC_LOAD(1, sA);
    __syncthreads();
#define SC_CHUNK(ch, LS, PS) do { \
        const int rc = chunk_rc(d, b, ch); \
        SC_LOAD(((ch) + 2 < NCH ? (ch) + 2 : NCH - 1), LS); \
        {   f32x4 a[2] = {(f32x4){0.f, 0.f, 0.f, 0.f}, (f32x4){0.f, 0.f, 0.f, 0.f}}; \
        _Pragma("unroll") \
            for (int ks = 0; ks < 4; ++ks) { const bf16x8 xq = *(const LAS bf16x8*)(L + SC_QS + (16 * tmA + fr) * SC_PITCH + (32 * ks + 8 * fq) * 2); \
        _Pragma("unroll") \
                for (int j = 0; j < 2; ++j) { const bf16x8 yk = *(const LAS bf16x8*)(L + SC_KS + (16 * (tnA + j) + fr) * SC_PITCH + (32 * ks + 8 * fq) * 2); a[j] = MFMA16(yk, xq, a[j]); } } \
            const int c = 16 * tmA + fr; \
        _Pragma("unroll") \
            for (int j = 0; j < 2; ++j) { const int s0 = 16 * (tnA + j) + 4 * fq; float m[4]; \
        _Pragma("unroll") \
                for (int e = 0; e < 4; ++e) { const int s = s0 + e; const bool keep = d ? (s < c) : (s <= c); m[e] = keep ? a[j][e] : 0.f; } \
                u32x2 wv; wv.x = pk2(m[0], m[1]); wv.y = pk2(m[2], m[3]); *(LAS u32x2*)(L + SC_AS + c * SC_APITCH + s0 * 2) = wv; } } \
        __syncthreads(); \
        f32x4 o[2][2]; \
        _Pragma("unroll") \
        for (int i = 0; i < 2; ++i) \
        _Pragma("unroll") \
            for (int j = 0; j < 2; ++j) o[i][j] = (f32x4){0.f, 0.f, 0.f, 0.f}; \
        _Pragma("unroll") \
        for (int ks = 0; ks < 2; ++ks) { bf16x8 xa[2], yv[2]; \
        _Pragma("unroll") \
            for (int i = 0; i < 2; ++i) xa[i] = *(const LAS bf16x8*)(L + SC_AS + (32 * tmB + 16 * i + fr) * SC_APITCH + (32 * ks + 8 * fq) * 2); \
        _Pragma("unroll") \
            for (int j = 0; j < 2; ++j) yv[j] = tr_frag(L + SC_VS, SC_PITCH, 32 * ks + 8 * fq, 32 * tnB + 16 * j, lane); \
        _Pragma("unroll") \
            for (int i = 0; i < 2; ++i) \
        _Pragma("unroll") \
                for (int j = 0; j < 2; ++j) o[i][j] = MFMA16(yv[j], xa[i], o[i][j]); } \
        _Pragma("unroll") \
        for (int ks = 0; ks < 4; ++ks) { bf16x8 xq[2], ys[2]; \
        _Pragma("unroll") \
            for (int i = 0; i < 2; ++i) xq[i] = *(const LAS bf16x8*)(L + SC_QS + (32 * tmB + 16 * i + fr) * SC_PITCH + (32 * ks + 8 * fq) * 2); \
        _Pragma("unroll") \
            for (int j = 0; j < 2; ++j) ys[j] = tr_frag(L + SC_SB, SC_PITCH, 32 * ks + 8 * fq, 32 * tnB + 16 * j, lane); \
        _Pragma("unroll") \
            for (int i = 0; i < 2; ++i) \
        _Pragma("unroll") \
                for (int j = 0; j < 2; ++j) o[i][j] = MFMA16(ys[j], xq[i], o[i][j]); } \
        _Pragma("unroll") \
        for (int ks = 0; ks < 2; ++ks) { bf16x8 xk[2], yv[4]; \
        _Pragma("unroll") \
            for (int i = 0; i < 2; ++i) xk[i] = tr_frag(L + SC_KS, SC_PITCH, 32 * ks + 8 * fq, 32 * tmS + 16 * i, lane); \
        _Pragma("unroll") \
            for (int j = 0; j < 4; ++j) yv[j] = tr_frag(L + SC_VS, SC_PITCH, 32 * ks + 8 * fq, 64 * tnS + 16 * j, lane); \
        _Pragma("unroll") \
            for (int i = 0; i < 2; ++i) \
        _Pragma("unroll") \
                for (int j = 0; j < 4; ++j) S[i][j] = MFMA16(yv[j], xk[i], S[i][j]); } \
        __syncthreads(); \
        _Pragma("unroll") \
        for (int i = 0; i < 2; ++i) \
        _Pragma("unroll") \
            for (int j = 0; j < 2; ++j) { u32x2 wv; wv.x = pk2(o[i][j][0], o[i][j][1]); wv.y = pk2(o[i][j][2], o[i][j][3]); \
                *(LAS u32x2*)(L + SC_OS + (32 * tmB + 16 * i + fr) * SC_PITCH + (32 * tnB + 16 * j + 4 * fq) * 2) = wv; } \
        _Pragma("unroll") \
        for (int i = 0; i < 2; ++i) { const int row = 32 * tmS + 16 * i + fr; \
            _Pragma("unroll") \
            for (int j = 0; j < 4; ++j) { S[i][j] = S[i][j] * eg[i]; u32x2 wv; wv.x = pk2(S[i][j][0], S[i][j][1]); wv.y = pk2(S[i][j][2], S[i][j][3]); \
                *(LAS u32x2*)(L + SC_SB + row * SC_PITCH + (64 * tnS + 16 * j + 4 * fq) * 2) = wv; } } \
        SC_PUT(PS); if (MX == 0) { eg[0] = PS.gl[0]; eg[1] = PS.gl[1]; } \
        __syncthreads(); \
        _Pragma("unroll") \
        for (int ps = 0; ps < 2; ++ps) { const int c = tt + 32 * ps; const u32x4 v = *(const LAS u32x4*)(L + SC_OS + c * SC_PITCH + part * 16); \
            GST16(O + (size_t)(64 * rc + (d ? 63 - c : c)) * 1024, v); } \
    } while (0)
    for (int ch2 = 0; ch2 < NCH; ch2 += 2) { SC_CHUNK(ch2, sB, sA); SC_CHUNK(ch2 + 1, sA, sB); }
    (void)egn;
#undef SC_CHUNK
#undef SC_LOAD
#undef SC_PUT
    __syncthreads();
}
__device__ __forceinline__ void phase_scan_mfma(const Frame& F, int li) {
    for (int u = F.bx; u < 256; u += F.G) { if (u < 128) scan_unit<0>(F, u); else scan_unit<1>(F, u - 128); }
}

__device__ __forceinline__ void phase_finish(const Frame& F, int li, int nrows) {
    const bf16_t* P = (const bf16_t*)(F.ws + WS_P); const bf16_t* OB = (const bf16_t*)(F.ws + WS_B); const bf16_t* HB = (const bf16_t*)(F.ws + WS_E); bf16_t* A3 = (bf16_t*)(F.ws + WS_C);
    const float* gnorm = F.in[11] + (size_t)li * 1024; const float* rnorm = F.in[19] + (size_t)li * 1024;
    const size_t RS = (size_t)TT * 1024;
    for (int row = F.gw; row < nrows; row += F.NGW) {
        const bf16_t* pr = P + (size_t)row * LDP; const size_t ro = (size_t)row * 1024;
#pragma unroll
        for (int j = 0; j < 4; ++j) {
            const int c = 4 * F.lane + 256 * j;
            {
                const f32x4 o = ld4bf(OB + ro + c) + ld4bf(OB + RS + ro + c);
                const float ss = wave_sum((o[0] * o[0] + o[1] * o[1]) + (o[2] * o[2] + o[3] * o[3])); const float rs = rsqrtf(ss * (1.0f / 256.0f) + EPS);
                const f32x4 g = ld4bf(pr + C_GG + c), gn = *(const f32x4*)(gnorm + c); u32x2 w;
                w.x = pk2(o[0] * rs * gn[0] * siluf_(g[0]), o[1] * rs * gn[1] * siluf_(g[1])); w.y = pk2(o[2] * rs * gn[2] * siluf_(g[2]), o[3] * rs * gn[3] * siluf_(g[3]));
                *(u32x2*)(A3 + ro + c) = w; }
            {
                const f32x4 hh = ld4bf(HB + ro + c) + ld4bf(HB + RS + ro + c), g = ld4bf(pr + C_LG + c); u32x2 w;
                w.x = pk2(hh[0] * gelu_tanh_(g[0]), hh[1] * gelu_tanh_(g[1])); w.y = pk2(hh[2] * gelu_tanh_(g[2]), hh[3] * gelu_tanh_(g[3]));
                *(u32x2*)(A3 + RS + ro + c) = w; }
            {
                f32x4 o = ld4bf(OB + 2 * RS + ro + c) + ld4bf(OB + 3 * RS + ro + c);
                const float mean = wave_sum((o[0] + o[1]) + (o[2] + o[3])) * (1.0f / 256.0f); o = o - mean;
                const float ss = wave_sum((o[0] * o[0] + o[1] * o[1]) + (o[2] * o[2] + o[3] * o[3])); const float rs = rsqrtf(ss * (1.0f / 256.0f) + EPS);
                const f32x4 g = ld4bf(pr + C_RG + c), gn = *(const f32x4*)(rnorm + c); u32x2 w;
                w.x = pk2(o[0] * rs * gn[0] * siluf_(g[0]), o[1] * rs * gn[1] * siluf_(g[1])); w.y = pk2(o[2] * rs * gn[2] * siluf_(g[2]), o[3] * rs * gn[3] * siluf_(g[3]));
                *(u32x2*)(A3 + 2 * RS + ro + c) = w; }
        }
    }
}

__device__ __forceinline__ void phase_norm2_router(const Frame& F, int li, int ntok) {
    LAS float* wrT = (LAS float*)F.lds;
    LAS unsigned* hist = (LAS unsigned*)(F.lds + 131072); LAS unsigned* hbase = hist + 32;
    const float* wr = F.in[22] + (size_t)li * 1024 * 32; const float* br = F.in[23] + li * 32;
    for (int i = F.tid; i < 32768; i += NTHR) wrT[(i & 31) * 1024 + (i >> 5)] = wr[i];
    if (F.tid < 32) hist[F.tid] = 0u;
    __syncthreads();
    const float* xs = (const float*)(F.ws + WS_XS); const float* mods = (const float*)(F.ws + WS_MODS) + (size_t)li * 9 * 6144;
    bf16_t* xn2 = (bf16_t*)(F.ws + WS_D); int* tok_e = (int*)(F.ws + WS_TOKE); float* tok_w = (float*)(F.ws + WS_TOKW); int* tok_p = (int*)(F.ws + WS_TOKP);
    unsigned* cnt = (unsigned*)(F.ws + WS_CTL) + CW_CNT + li * 32;
    for (int row = F.gw; row < ntok; row += F.NGW) {
        const float* mp = mods + mrow_of(row) * 6144;
        const RowV y = norm_mod(load_row(xs + (size_t)row * D, F.lane), F.in[7] + (size_t)li * 1024, mp + 3 * 1024, mp + 4 * 1024, F.lane);
        store_row_bf16(xn2 + (size_t)row * D, y, F.lane);
        float lg[32];
#pragma unroll
        for (int e = 0; e < 32; ++e) { float s = 0.f;
#pragma unroll
            for (int j = 0; j < 4; ++j) { const f32x4 w = *(const LAS f32x4*)(wrT + e * 1024 + 4 * F.lane + 256 * j); s += (y.v[j][0] * w[0] + y.v[j][1] * w[1]) + (y.v[j][2] * w[2] + y.v[j][3] * w[3]); }
            lg[e] = wave_sum(s) + br[e]; }
        unsigned taken = 0u; float tl[4]; int te[4];
#pragma unroll
        for (int k = 0; k < 4; ++k) { float best = -3.0e38f; int bi = 0;
#pragma unroll
            for (int e = 0; e < 32; ++e) { const bool ok = !((taken >> e) & 1u) && lg[e] > best; best = ok ? lg[e] : best; bi = ok ? e : bi; }
            taken |= 1u << bi; tl[k] = best; te[k] = bi; }
        const float e1 = __expf(tl[1] - tl[0]), e2 = __expf(tl[2] - tl[0]), e3 = __expf(tl[3] - tl[0]); const float inv = 1.0f / (1.0f + e1 + e2 + e3);
        if (F.lane < 4) { const int k = F.lane; const int ek = k == 0 ? te[0] : k == 1 ? te[1] : k == 2 ? te[2] : te[3]; const float wk = (k == 0 ? 1.0f : k == 1 ? e1 : k == 2 ? e2 : e3) * inv;
            const unsigned lp = atomicAdd((unsigned*)&hist[ek], 1u);
            tok_e[row * 4 + k] = ek; tok_w[row * 4 + k] = wk; tok_p[row * 4 + k] = (int)lp; }
    }
    __syncthreads();
    if (F.tid < 32) hbase[F.tid] = __hip_atomic_fetch_add(cnt + F.tid, hist[F.tid], __ATOMIC_RELAXED, __HIP_MEMORY_SCOPE_AGENT);
    __syncthreads();
    for (int row = F.gw; row < ntok; row += F.NGW) if (F.lane < 4) { const int i = row * 4 + F.lane; tok_p[i] += (int)hbase[tok_e[i]]; }
    __syncthreads();
}
__device__ __forceinline__ void phase_dispatch(const Frame& F, int li, int ntok) {
    LAS unsigned* pstart = (LAS unsigned*)F.lds;
    unsigned* ctl = (unsigned*)(F.ws + WS_CTL); unsigned* cnt = ctl + CW_CNT + li * 32; unsigned* tile_e = ctl + CW_TILE + li * 1024;
    if (F.tid == 0) { unsigned ps = 0;
        for (int e = 0; e < 32; ++e) { const unsigned c = __hip_atomic_load(cnt + e, __ATOMIC_RELAXED, __HIP_MEMORY_SCOPE_AGENT), nt = (c + 255u) >> 8; pstart[e] = ps;
            if (F.bx == 0) for (unsigned j = 0; j < nt; ++j) tile_e[(ps >> 8) + j] = (unsigned)e;
            ps += nt << 8; }
        if (F.bx == 0) ctl[CW_NT + li] = ps >> 8; }
    __syncthreads();
    const int* tok_e = (const int*)(F.ws + WS_TOKE); const int* tok_p = (const int*)(F.ws + WS_TOKP); int* tok_s = (int*)(F.ws + WS_TOKS); int* slot_tok = (int*)(F.ws + WS_SLOTTOK);
    for (int it = F.gtid; it < ntok * 4; it += F.NGT) { const int slot = (int)pstart[tok_e[it]] + tok_p[it]; tok_s[it] = slot; slot_tok[slot] = it >> 2; }
    if (F.bx < 32) { const unsigned c = __hip_atomic_load(cnt + F.bx, __ATOMIC_RELAXED, __HIP_MEMORY_SCOPE_AGENT), pe = ((c + 255u) >> 8) << 8;
        for (unsigned s = c + F.tid; s < pe; s += NTHR) slot_tok[pstart[F.bx] + s] = 0; }
    __syncthreads();
}
__device__ __forceinline__ void phase_combine(const Frame& F, int li, int ntok, bool last) {
    float* xs = (float*)(F.ws + WS_XS); const bf16_t* Y = (const bf16_t*)(F.ws + WS_B); bf16_t* xn = (bf16_t*)(F.ws + WS_D);
    const float* mods = (const float*)(F.ws + WS_MODS); const float* tok_w = (const float*)(F.ws + WS_TOKW); const int* tok_s = (const int*)(F.ws + WS_TOKS);
    for (int row = F.gw; row < ntok; row += F.NGW) {
        const int mr = mrow_of(row); const float* gp = mods + ((size_t)li * 9 + mr) * 6144 + 5 * 1024;
        RowV x = load_row(xs + (size_t)row * D, F.lane);
        const int s0 = tok_s[row * 4], s1 = tok_s[row * 4 + 1], s2 = tok_s[row * 4 + 2], s3 = tok_s[row * 4 + 3];
        const float w0 = tok_w[row * 4], w1 = tok_w[row * 4 + 1], w2 = tok_w[row * 4 + 2], w3 = tok_w[row * 4 + 3];
#pragma unroll
        for (int j = 0; j < 4; ++j) { const int c = 4 * F.lane + 256 * j;
            const f32x4 y = ld4bf(Y + (size_t)s0 * 1024 + c) * w0 + ld4bf(Y + (size_t)s1 * 1024 + c) * w1 + ld4bf(Y + (size_t)s2 * 1024 + c) * w2 + ld4bf(Y + (size_t)s3 * 1024 + c) * w3;
            x.v[j] = x.v[j] + *(const f32x4*)(gp + c) * y; }
        if (!last) {
#pragma unroll
            for (int j = 0; j < 4; ++j) *(f32x4*)(xs + (size_t)row * D + 4 * F.lane + 256 * j) = x.v[j];
            const float* mp = mods + ((size_t)(li + 1) * 9 + mr) * 6144;
            const RowV y = norm_mod(x, F.in[6] + (size_t)(li + 1) * 1024, mp, mp + 1024, F.lane);
            store_row_bf16(xn + (size_t)row * D, y, F.lane);
        } else {
            const float rs = rsqrtf(row_sumsq(x) * (1.0f / D) + EPS);
#pragma unroll
            for (int j = 0; j < 4; ++j) { const int c = 4 * F.lane + 256 * j; *(f32x4*)(F.out + (size_t)row * D + c) = (x.v[j] * rs) * *(const f32x4*)(F.in[28] + c); }
        }
    }
}

#ifndef MK_SCAN_REF
#define MK_SCAN_REF 0
#endif
#ifndef MK_ONE_LAUNCH
#define MK_ONE_LAUNCH 1
#endif
constexpr int NPH_LAYER = 16, NPHASES = 2 + 2 * NPH_LAYER;
struct Args { const float* in[29]; float* out; unsigned char* ws; int ph_lo, ph_hi, region, pad; };
#ifndef MK_PHMASK
#define MK_PHMASK 0xffff
#endif
#define IN(k) (lo <= (k) && (k) < hi)
#define EN(j) ((MK_PHMASK >> (j)) & 1)
#define SEAM(k) do { if (IN(k) && IN((k) + 1)) xcd_barrier(bar); } while (0)
#define MKF() Frame F; { GAS unsigned char* ws_ = (GAS unsigned char*)args.ws; asm volatile("" : "+s"(ws_)); F.ws = ws_; F.lds = (LAS unsigned char*)lds_raw; F.out = args.out; F.in = args.in; \
        int tid_ = threadIdx.x, bx_ = blockIdx.x; asm volatile("" : "+v"(tid_), "+s"(bx_)); F.tid = tid_; F.bx = bx_; F.lane = F.tid & 63; F.wave = __builtin_amdgcn_readfirstlane(F.tid >> 6); F.G = gridDim.x; \
        F.gw = F.bx * NWAVES + F.wave; F.NGW = F.G * NWAVES; F.gtid = F.bx * NTHR + F.tid; F.NGT = F.G * NTHR; }
template <int li> __device__ __forceinline__ void run_layer(const Args& args, unsigned char* lds_raw, const XcdBarrier& bar, const int lo, const int hi) {
        const int pb = 2 + NPH_LAYER * li; const bool last = (li == 1); const int nrows = last ? TLAT : TT, nMt = nrows / 256;
        if (EN(0) && IN(pb + 0)) { MKF(); phase_W(F, li); if (li == 0) phase_norm_in(F); __syncthreads(); }
        SEAM(pb + 0);
        if (EN(1) && IN(pb + 1)) { MKF(); unsigned* ctl = (unsigned*)(F.ws + WS_CTL); (void)ctl;
            pg8::Gemm g{1024, 1024, 1024}; PlainOrder S; S.A = (const char*)(F.ws + WS_D); S.B = (const char*)(F.ws + WS_WIN); S.astep = 256 * 1024 * 2; S.bstep = 256 * 1024 * 2; S.nM = TT / 256; S.nN = LDP / 256; S.G = F.G; S.c = F.bx;
            EpiBf16Bias E{(bf16_t*)(F.ws + WS_P), LDP, nullptr, 0};
            pg8::gemm_phase<EpiBf16Bias, PlainOrder, true, true>(F.lds, g, S, E);
        }
        SEAM(pb + 1);
        if (EN(2) && IN(pb + 2)) { MKF(); phase_conv(F, li); }
        SEAM(pb + 2);
        if (EN(3) && IN(pb + 3)) { MKF(); unsigned* ctl = (unsigned*)(F.ws + WS_CTL); (void)ctl;
            pg8::Gemm g{1024, 256, 256}; LruOrder S; S.A = (const char*)(F.ws + WS_D); S.B = (const char*)(F.ws + WS_WLRU); S.nM = TT / 256; S.G = F.G; S.c = F.bx;
            EpiLru E{(const bf16_t*)(F.ws + WS_D), (bf16_t*)(F.ws + WS_C), (bf16_t*)(F.ws + WS_C + 2 * ROWB), F.in[15] + (size_t)li * 2048, F.in[17] + (size_t)li * 2048, (const float*)(F.ws + WS_LSL)};
            pg8::gemm_phase<EpiLru, LruOrder, true, true>(F.lds, g, S, E);
        }
        SEAM(pb + 3);
        if (EN(4) && IN(pb + 4)) { MKF(); phase_lru_scan<false>(F); }
        SEAM(pb + 4);
        if (EN(5) && IN(pb + 5)) { MKF(); phase_lru_scan<true>(F); }
        SEAM(pb + 5);
        if (EN(6) && IN(pb + 6)) { MKF(); phase_scanprep(F, li); }
        SEAM(pb + 6);
        if (EN(7) && IN(pb + 7)) { MKF(); phase_scan_mfma(F, li); }
        SEAM(pb + 7);
        if (EN(8) && IN(pb + 8)) { MKF(); phase_finish(F, li, nrows); }
        SEAM(pb + 8);
        if (EN(9) && IN(pb + 9)) { MKF(); unsigned* ctl = (unsigned*)(F.ws + WS_CTL); (void)ctl;
            pg8::Gemm g{1024, 1024, 1024}; BranchOrder S; S.A = (const char*)(F.ws + WS_C); S.B = (const char*)(F.ws + WS_WBR); S.nM = nMt; S.G = F.G; S.c = F.bx;
            EpiBranch E{(const bf16_t*)(F.ws + WS_P), (float*)(F.ws + WS_B), (bf16_t*)(F.ws + WS_B + 2 * ROWB)};
            pg8::gemm_phase<EpiBranch, BranchOrder, true, true>(F.lds, g, S, E);
        }
        SEAM(pb + 9);
        if (EN(10) && IN(pb + 10)) { MKF(); unsigned* ctl = (unsigned*)(F.ws + WS_CTL); (void)ctl;
            pg8::Gemm g{1024, 1024, 1024}; PlainOrder S; S.A = (const char*)(F.ws + WS_B + 2 * ROWB); S.B = (const char*)(F.ws + WS_WOUT); S.astep = 256 * 1024 * 2; S.bstep = 256 * 1024 * 2; S.nM = nMt; S.nN = 4; S.G = F.G; S.c = F.bx;
            float* xs = (float*)(F.ws + WS_XS);
            EpiOut E{li == 0 ? F.in[0] : xs, li == 0 ? F.in[2] : xs + (size_t)TLAT * D, xs, (const float*)(F.ws + WS_MODS) + (size_t)li * 9 * 6144 + 2 * 1024};
            pg8::gemm_phase<EpiOut, PlainOrder, true, true>(F.lds, g, S, E);
        }
        SEAM(pb + 10);
        if (EN(11) && IN(pb + 11)) { MKF(); phase_norm2_router(F, li, nrows); }
        SEAM(pb + 11);
        if (EN(12) && IN(pb + 12)) { MKF(); phase_dispatch(F, li, nrows); }
        SEAM(pb + 12);
        if (EN(13) && IN(pb + 13)) { MKF(); unsigned* ctl = (unsigned*)(F.ws + WS_CTL); (void)ctl;
            pg8::Gemm g{1024, 1024, 1024}; MoeOrder S; S.A = (const char*)(F.ws + WS_D); S.rowidx = (const int*)(F.ws + WS_SLOTTOK); S.B = (const char*)(F.ws + WS_WGU); S.tile_e = ctl + CW_TILE + li * 1024; S.estep = (size_t)2048 * 1024 * 2;
            S.nM = (int)ctl[CW_NT + li]; S.nN = 8; S.G = F.G; S.c = F.bx; S.ga = 1;
            EpiSwiglu E{(bf16_t*)(F.ws + WS_P + 288 * MiB), F.in[25] + (size_t)li * 32 * 2048};
            pg8::gemm_phase<EpiSwiglu, MoeOrder, true, true, true>(F.lds, g, S, E);
        }
        SEAM(pb + 13);
        if (EN(14) && IN(pb + 14)) { MKF(); unsigned* ctl = (unsigned*)(F.ws + WS_CTL); (void)ctl;
            pg8::Gemm g{1024, 1024, 1024}; MoeOrder S; S.A = (const char*)(F.ws + WS_P + 288 * MiB); S.B = (const char*)(F.ws + WS_WDN); S.tile_e = ctl + CW_TILE + li * 1024; S.estep = (size_t)1024 * 1024 * 2;
            S.nM = (int)ctl[CW_NT + li]; S.nN = 4; S.G = F.G; S.c = F.bx; S.ga = 0; S.rowidx = nullptr;
            EpiBf16Bias E{(bf16_t*)(F.ws + WS_B), 1024, F.in[27] + (size_t)li * 32 * 1024, 1024};
            pg8::gemm_phase<EpiBf16Bias, MoeOrder, true, true>(F.lds, g, S, E);
        }
        SEAM(pb + 14);
        if (EN(15) && IN(pb + 15)) { MKF(); phase_combine(F, li, nrows, last); }
        SEAM(pb + 15);
    }
__global__ void __launch_bounds__(NTHR, 2) mk_fwd(Args args) {
    extern __shared__ __attribute__((aligned(16))) unsigned char lds_raw[];
    const int tid0 = threadIdx.x;
    volatile LAS unsigned* MISC = (volatile LAS unsigned*)((LAS unsigned char*)lds_raw + MISC_OFF);
    if (tid0 < 32) MISC[tid0] = 0u;
    __syncthreads();
    unsigned* ctl0 = (unsigned*)(args.ws + WS_CTL);
    const int lo = args.ph_lo, hi = args.ph_hi;
    XcdBarrier bar; bar.bar = ctl0 + CW_BAR + args.region * 4096; bar.x = 0; bar.st = MISC + 8;
    if (hi - lo > 1) bar = xcd_barrier_post(ctl0 + CW_BAR + args.region * 4096, MISC + 8);

    if (IN(0)) { MKF(); phase_proA(F); }
    SEAM(0);
    if (IN(1)) { MKF(); phase_proB(F); }
    SEAM(1);
    run_layer<0>(args, lds_raw, bar, lo, hi);
    run_layer<1>(args, lds_raw, bar, lo, hi);
}

extern "C" void kernel_launch(void* const* d_in, const int* in_sizes, int n_in, void* d_out, int out_size, void* d_ws, size_t ws_size, hipStream_t stream) {
    static int grid = 0;
    if (grid == 0) {
        if (n_in != 29 || ws_size < WS_END || out_size != TLAT * D) { fprintf(stderr, "kernel_launch: unexpected problem: n_in %d ws %zu out %d\n", n_in, ws_size, out_size); grid = -1; return; }
        int dev = 0, cus = 0;
        if (hipGetDevice(&dev) != hipSuccess || hipDeviceGetAttribute(&cus, hipDeviceAttributeMultiprocessorCount, dev) != hipSuccess) { grid = -1; return; }
        if (hipFuncSetAttribute((const void*)mk_fwd, hipFuncAttributeMaxDynamicSharedMemorySize, LDS_BYTES) != hipSuccess) { fprintf(stderr, "kernel_launch: hipFuncSetAttribute failed\n"); grid = -1; return; }
        int per_cu = 0;
        if (hipOccupancyMaxActiveBlocksPerMultiprocessor(&per_cu, (const void*)mk_fwd, NTHR, LDS_BYTES) != hipSuccess || per_cu < 1) fprintf(stderr, "kernel_launch: occupancy query reports %d\n", per_cu);
        (void)hipGetLastError();
        grid = cus;
    }
    if (grid < 0) return;
    (void)hipMemsetAsync((char*)d_ws + WS_CTL, 0, CTL_BYTES, stream);
    Args a{};
    for (int i = 0; i < 29; ++i) a.in[i] = (const float*)d_in[i];
    a.out = (float*)d_out; a.ws = (unsigned char*)d_ws;
#if MK_ONE_LAUNCH
    a.ph_lo = 0; a.ph_hi = NPHASES; a.region = 0;
    hipLaunchKernelGGL(mk_fwd, dim3(grid), dim3(NTHR), LDS_BYTES, stream, a);
#else
    for (int p = 0; p < NPHASES; ++p) { a.ph_lo = p; a.ph_hi = p + 1; a.region = 0; hipLaunchKernelGGL(mk_fwd, dim3(grid), dim3(NTHR), LDS_BYTES, stream, a); }
#endif
}
```

```cpp
#include <hip/hip_runtime.h>
#include <cstdio>
#include <cstdint>

#define LAS __attribute__((address_space(3)))
typedef unsigned short bf16_t;
typedef short bf16x8 __attribute__((ext_vector_type(8)));
typedef float f32x4 __attribute__((ext_vector_type(4)));
typedef float f32x2 __attribute__((ext_vector_type(2)));
typedef unsigned u32x4 __attribute__((ext_vector_type(4)));
typedef unsigned u32x2 __attribute__((ext_vector_type(2)));

constexpr int D = 1024, NBATCH = 8, SEQ = 4096, CTXL = 256;
constexpr int TLAT = NBATCH * SEQ, TCTX = NBATCH * CTXL, TT = TLAT + TCTX;
constexpr int LDP = 11520;
constexpr int C_GQ = 0, C_GK = 512, C_GV = 1024, C_GG = 2048, C_LX = 3072, C_LG = 4096, C_RQ = 5120, C_RK = 5632, C_RV = 6144, C_RG = 7168, C_MG = 8192, C_LR = 11264;
constexpr int IN_TOTAL = 11296, NE = 32;
constexpr int SLOT_TILES_MAX = 576;
constexpr float EPS = 1e-6f;

constexpr size_t MiB = (size_t)1 << 20;
constexpr size_t WS_CTL = 0, CTL_BYTES = 1 * MiB;
constexpr size_t WS_MODP = 1 * MiB, WS_MODS = 5 * MiB, WS_COS = 6 * MiB, WS_SIN = 7 * MiB, WS_LSL = 8 * MiB, WS_CARA = 9 * MiB, WS_CARH = 11 * MiB;
constexpr size_t WS_SLOTTOK = 8 * MiB + 256 * 1024;
constexpr size_t WS_TOKE = 13 * MiB, WS_TOKW = WS_TOKE + 768 * 1024, WS_TOKP = WS_TOKW + 768 * 1024, WS_TOKS = WS_TOKP + 768 * 1024;
constexpr size_t WS_WIN = 16 * MiB, WS_WLRU = 39 * MiB, WS_WBR = 41 * MiB, WS_WOUT = 47 * MiB, WS_WGU = 49 * MiB, WS_WDN = 177 * MiB;
constexpr size_t WS_XS = 241 * MiB, WS_P = 377 * MiB, WS_B = 1142 * MiB, WS_C = 1430 * MiB, WS_D = 1702 * MiB, WS_E = 1770 * MiB, WS_END = 1906 * MiB;
constexpr size_t ROWB = (size_t)TT * D * 2;
static_assert(ROWB == 68 * MiB, "row buffer");
constexpr int CW_CNT = 1024, CW_NT = 1024 + 128, CW_TILE = 2048, CW_BAR = 8192;

__device__ __forceinline__ float bflo(unsigned w) { return __uint_as_float(w << 16); }
__device__ __forceinline__ float bfhi(unsigned w) { return __uint_as_float(w & 0xffff0000u); }
typedef __bf16 bf16x2_t __attribute__((ext_vector_type(2)));
__device__ __forceinline__ unsigned pk2(float lo, float hi) { const bf16x2_t v = __builtin_convertvector((f32x2){lo, hi}, bf16x2_t); return __builtin_bit_cast(unsigned, v); }
__device__ __forceinline__ float sigmoidf_(float x) { return __builtin_amdgcn_rcpf(1.0f + __expf(-x)); }
__device__ __forceinline__ float siluf_(float x) { return x * sigmoidf_(x); }
__device__ __forceinline__ float logsigmoidf_(float z) { return fminf(z, 0.f) - __logf(1.0f + __expf(-fabsf(z))); }
__device__ __forceinline__ float gelu_tanh_(float x) { const float u = 0.7978845608028654f * (x + 0.044715f * x * x * x); const float t = 1.0f - 2.0f * __builtin_amdgcn_rcpf(__expf(2.0f * u) + 1.0f); return 0.5f * x * (1.0f + t); }
__device__ __forceinline__ float wave_sum(float v) {
#pragma unroll
    for (int o = 1; o < 64; o <<= 1) v += __shfl_xor(v, o);
    return v;
}
#define LDS_WAIT() asm volatile("s_waitcnt lgkmcnt(0)" ::: "memory")

namespace pg8 {
#define PG8_LAS __attribute__((address_space(3)))
constexpr int BM = 256, BK = 64, HALF = 128, HTB = HALF * BK * 2, STAGE_BYTES = 8 * HTB, NXCD = 8, WGM = 8;
__host__ __device__ __forceinline__ int lds_byte(int r, int c) { const int st = (r >> 4) * 2 + (c >> 5), rr = r & 15, cc = c & 31, ob = rr * 64 + cc * 2; return st * 1024 + (ob ^ (((ob >> 9) & 1) << 5)); }
__host__ __device__ __forceinline__ void stage_rc(int b, int& R, int& C) { const int st = b / 1024, sb = b % 1024, swz = sb ^ (((sb >> 9) & 1) << 5); R = (st >> 1) * 16 + swz / 64; C = (st & 1) * 32 + (swz % 64) / 2; }
__host__ __device__ __forceinline__ int perm32(int rho) { const int n = rho >> 4, i = rho & 15; return 8 * (i >> 2) + 4 * n + (i & 3); }
struct Unit { int pm, pn, aux; const char* a; const char* b; };
struct Gemm { int lda, ldb, K; };
__device__ __forceinline__ void tile_of(int L, int nM, int nN, int& pm, int& pn) {
    const int nwg = nM * nN; int wgid = L; { const int q = nwg / NXCD, r = nwg % NXCD, xcd = wgid % NXCD, off = wgid / NXCD; wgid = (xcd < r ? xcd * (q + 1) : r * (q + 1) + (xcd - r) * q) + off; }
    const int nig = WGM * nN, gid = wgid / nig, fm = gid * WGM, gsz = (nM - fm) < WGM ? (nM - fm) : WGM;
    pm = fm + ((wgid % nig) % gsz); pn = (wgid % nig) / gsz;
}
__device__ __forceinline__ unsigned cvt_pk_bf16(float lo, float hi) { unsigned r; asm volatile("v_cvt_pk_bf16_f32 %0, %1, %2" : "=v"(r) : "v"(lo), "v"(hi)); return r; }
template <class Epi, class Sched, bool ALIGN_EPI = false, bool SP2 = false, bool GATHER = false>
__device__ __forceinline__ void gemm_phase(PG8_LAS unsigned char* lds, const Gemm g, const Sched& S, const Epi& E) {
    int tid_o = threadIdx.x; asm volatile("" : "+v"(tid_o));
    const int tid = tid_o, wid = __builtin_amdgcn_readfirstlane(tid >> 6), lane = tid & 63, wr = wid >> 2, wc = wid & 3, fr = lane & 15, fq = lane >> 4;
    const int K = g.K, nt = K / BK;
    unsigned voffA[2], voffB[2];
#pragma unroll
    for (int i = 0; i < 2; ++i) { int R, C; stage_rc(tid * 16 + i * 8192, R, C); const int Rb = Epi::PERM ? ((R & ~31) + perm32(R & 31)) : R;
        voffA[i] = (unsigned)(R * g.lda + C) * 2u; voffB[i] = (unsigned)(Rb * g.ldb + C) * 2u; }
    unsigned gA[2][2] = {{0u, 0u}, {0u, 0u}}, gN[2][2] = {{0u, 0u}, {0u, 0u}}; int gR[2], gC[2];
#pragma unroll
    for (int i = 0; i < 2; ++i) stage_rc(tid * 16 + i * 8192, gR[i], gC[i]);
#define PG8_GOFF(dst, u_) do { if constexpr (GATHER) { _Pragma("unroll") for (int h_ = 0; h_ < 2; ++h_) _Pragma("unroll") for (int i_ = 0; i_ < 2; ++i_) \
        dst[h_][i_] = (unsigned)S.rowidx[(u_).pm * BM + h_ * HALF + gR[i_]] * (unsigned)(g.lda * 2) + (unsigned)(gC[i_] * 2); } } while (0)
    const size_t kstep = (size_t)(BK * 2);
    const size_t hstepA = (size_t)HALF * g.lda * 2, hstepB = (size_t)HALF * g.ldb * 2;
    const unsigned ldsw = (unsigned)wid * 1024u;
    const int aoff = lds_byte(wr * 64 + fr, fq * 8), boff = lds_byte(wc * 32 + fr, fq * 8);
#define PG8_SA(b, h) (((b) * 2 + (h)) * HTB)
#define PG8_SB(b, h) ((4 + (b) * 2 + (h)) * HTB)
#define PG8_STAGE(bufoff, gbase, voff) do { _Pragma("unroll") for (int _i = 0; _i < 2; ++_i) \
        __builtin_amdgcn_global_load_lds((const unsigned*)((const char*)(gbase) + (voff)[_i]), (PG8_LAS unsigned*)(lds + (bufoff) + ldsw + _i * 8192), 16, 0, 0); } while (0)
#define PG8_STAGE_A(bufoff, gbase, H, NX) do { if constexpr (GATHER) { _Pragma("unroll") for (int _i = 0; _i < 2; ++_i) { const unsigned o_ = (NX) ? gN[H][_i] : gA[H][_i]; \
        __builtin_amdgcn_global_load_lds((const unsigned*)((const char*)(gbase) + o_), (PG8_LAS unsigned*)(lds + (bufoff) + ldsw + _i * 8192), 16, 0, 0); } } \
        else { PG8_STAGE(bufoff, (gbase) + (H) * hstepA, voffA); } } while (0)
#define PG8_LDA(dst, b, h) do { _Pragma("unroll") for (int m = 0; m < 4; ++m) _Pragma("unroll") for (int k = 0; k < 2; ++k) dst[m][k] = *(const PG8_LAS bf16x8*)(lds + PG8_SA(b, h) + aoff + m * 2048 + k * 1024); } while (0)
#define PG8_LDB(dst, b, h) do { _Pragma("unroll") for (int n = 0; n < 2; ++n) _Pragma("unroll") for (int k = 0; k < 2; ++k) dst[n][k] = *(const PG8_LAS bf16x8*)(lds + PG8_SB(b, h) + boff + n * 2048 + k * 1024); } while (0)
#define PG8_MMA(ai, bj, At, Bt) do { __builtin_amdgcn_s_setprio(1); _Pragma("unroll") for (int m = 0; m < 4; ++m) _Pragma("unroll") for (int n = 0; n < 2; ++n) _Pragma("unroll") for (int k = 0; k < 2; ++k) \
        acc[ai][bj][m][n] = __builtin_amdgcn_mfma_f32_16x16x32_bf16(Bt[n][k], At[m][k], acc[ai][bj][m][n], 0, 0, 0); __builtin_amdgcn_s_setprio(0); } while (0)
#define PG8_WAIT_V(n) asm volatile("s_waitcnt vmcnt(" #n ")" ::: "memory")
#define PG8_WAIT_L(n) asm volatile("s_waitcnt lgkmcnt(" #n ")" ::: "memory")
#define PG8_BAR __builtin_amdgcn_s_barrier()
#define PG8_SCHED __builtin_amdgcn_sched_barrier(0)
    Unit cur, nxt; int ui = 0;
    if (!S.next(0, cur)) return;
    f32x4 acc[2][2][4][2];
#pragma unroll
    for (int a = 0; a < 2; ++a)
#pragma unroll
        for (int b = 0; b < 2; ++b)
#pragma unroll
            for (int m = 0; m < 4; ++m)
#pragma unroll
                for (int n = 0; n < 2; ++n) acc[a][b][m][n] = (f32x4){0.f, 0.f, 0.f, 0.f};
    bf16x8 At[4][2], B0[2][2], B1[2][2];
    const char* cA = cur.a; const char* cB = cur.b;
    S.a_ready(cur);
    PG8_GOFF(gA, cur);
    if constexpr (SP2) {
        PG8_STAGE(PG8_SB(0, 0), cB, voffB); PG8_STAGE(PG8_SB(0, 1), cB + hstepB, voffB); PG8_STAGE_A(PG8_SA(0, 0), cA, 0, false); PG8_STAGE_A(PG8_SA(0, 1), cA, 1, false);
        if (wr == 1) PG8_BAR;
        PG8_WAIT_V(2); PG8_BAR;
        PG8_STAGE(PG8_SB(1, 0), cB + kstep, voffB); PG8_STAGE_A(PG8_SA(1, 0), cA + kstep, 0, false); PG8_STAGE(PG8_SB(1, 1), cB + hstepB + kstep, voffB);
        PG8_WAIT_V(6); PG8_BAR;
    } else {
        PG8_STAGE(PG8_SB(0, 0), cB, voffB); PG8_STAGE_A(PG8_SA(0, 0), cA, 0, false); PG8_STAGE(PG8_SB(0, 1), cB + hstepB, voffB); PG8_STAGE_A(PG8_SA(0, 1), cA, 1, false);
        if (wr == 1) PG8_BAR;
        PG8_WAIT_V(4); PG8_BAR;
        PG8_STAGE(PG8_SB(1, 0), cB + kstep, voffB); PG8_STAGE_A(PG8_SA(1, 0), cA + kstep, 0, false); PG8_STAGE(PG8_SB(1, 1), cB + hstepB + kstep, voffB);
        PG8_WAIT_V(6); PG8_BAR;
    }
    for (;;) {
        const bool has_next = S.next(ui + 1, nxt);
        if (has_next) PG8_GOFF(gN, nxt);
        const char* nA = has_next ? nxt.a : cA; const char* nB = has_next ? nxt.b : cB;
        for (int t = 0; t < nt; t += 2) {
            const bool last = (t == nt - 2); const bool nx_ = last && has_next;
            const char* a1 = cA + (size_t)(t + 1) * kstep;
            const char* a2 = last ? nA : cA + (size_t)(t + 2) * kstep; const char* b2 = last ? nB : cB + (size_t)(t + 2) * kstep;
            const char* a3 = a2 + kstep; const char* b3 = b2 + kstep;
            if (last && has_next) S.a_ready(nxt);
            if constexpr (SP2) {
            PG8_LDB(B0, 0, 0); PG8_LDB(B1, 0, 1); PG8_SCHED; PG8_LDA(At, 0, 0); PG8_STAGE_A(PG8_SA(1, 1), a1, 1, false);
            PG8_WAIT_V(8); PG8_WAIT_L(0); PG8_BAR; PG8_MMA(0, 0, At, B0); PG8_MMA(0, 1, At, B1); PG8_BAR; PG8_SCHED;
            PG8_LDA(At, 0, 1); PG8_STAGE(PG8_SB(0, 0), b2, voffB); PG8_STAGE(PG8_SB(0, 1), b2 + hstepB, voffB); PG8_STAGE_A(PG8_SA(0, 0), a2, 0, nx_);
            PG8_WAIT_V(8); PG8_WAIT_L(0); PG8_BAR; PG8_MMA(1, 0, At, B0); PG8_MMA(1, 1, At, B1); PG8_BAR; PG8_SCHED;
            PG8_LDB(B0, 1, 0); PG8_LDB(B1, 1, 1); PG8_SCHED; PG8_LDA(At, 1, 0); PG8_STAGE_A(PG8_SA(0, 1), a2, 1, nx_);
            PG8_WAIT_V(8); PG8_WAIT_L(0); PG8_BAR; PG8_MMA(0, 0, At, B0); PG8_MMA(0, 1, At, B1); PG8_BAR; PG8_SCHED;
            PG8_LDA(At, 1, 1); PG8_STAGE(PG8_SB(1, 0), b3, voffB); PG8_STAGE(PG8_SB(1, 1), b3 + hstepB, voffB); PG8_STAGE_A(PG8_SA(1, 0), a3, 0, nx_);
            PG8_WAIT_V(8); PG8_WAIT_L(0); PG8_BAR; PG8_MMA(1, 0, At, B0); PG8_MMA(1, 1, At, B1); PG8_BAR; PG8_SCHED;
            } else {
            PG8_LDB(B0, 0, 0); PG8_SCHED; PG8_LDA(At, 0, 0); PG8_STAGE_A(PG8_SA(1, 1), a1, 1, false);
            PG8_WAIT_L(8); PG8_BAR; PG8_WAIT_L(0); PG8_MMA(0, 0, At, B0); PG8_BAR; PG8_SCHED;
            PG8_LDB(B1, 0, 1); PG8_STAGE(PG8_SB(0, 0), b2, voffB);
            PG8_BAR; PG8_WAIT_L(0); PG8_MMA(0, 1, At, B1); PG8_BAR;
            PG8_LDA(At, 0, 1); PG8_STAGE_A(PG8_SA(0, 0), a2, 0, nx_);
            PG8_BAR; PG8_WAIT_L(0); PG8_MMA(1, 0, At, B0); PG8_BAR; PG8_SCHED;
            PG8_STAGE(PG8_SB(0, 1), b2 + hstepB, voffB);
            PG8_WAIT_V(6); PG8_BAR; PG8_MMA(1, 1, At, B1); PG8_BAR;
            PG8_LDB(B0, 1, 0); PG8_SCHED; PG8_LDA(At, 1, 0); PG8_STAGE_A(PG8_SA(0, 1), a2, 1, nx_);
            PG8_WAIT_L(8); PG8_BAR; PG8_WAIT_L(0); PG8_MMA(0, 0, At, B0); PG8_BAR; PG8_SCHED;
            PG8_LDB(B1, 1, 1); PG8_STAGE(PG8_SB(1, 0), b3, voffB);
            PG8_BAR; PG8_WAIT_L(0); PG8_MMA(0, 1, At, B1); PG8_BAR;
            PG8_LDA(At, 1, 1); PG8_STAGE_A(PG8_SA(1, 0), a3, 0, nx_);
            PG8_BAR; PG8_WAIT_L(0); PG8_MMA(1, 0, At, B0); PG8_BAR; PG8_SCHED;
            PG8_STAGE(PG8_SB(1, 1), b3 + hstepB, voffB);
            PG8_WAIT_V(6); PG8_BAR; PG8_MMA(1, 1, At, B1); PG8_BAR;
            }
        }
        if constexpr (ALIGN_EPI) { if (wr == 0) PG8_BAR; }
        if constexpr (!Epi::AFTER_DRAIN) { E(acc, cur, wr, wc, fr, fq); S.done(cur); }
        if (!has_next) break;
#pragma unroll
        for (int a = 0; a < 2; ++a)
#pragma unroll
            for (int b = 0; b < 2; ++b)
#pragma unroll
                for (int m = 0; m < 4; ++m)
#pragma unroll
                    for (int n = 0; n < 2; ++n) acc[a][b][m][n] = (f32x4){0.f, 0.f, 0.f, 0.f};
        cur = nxt; cA = nA; cB = nB; ++ui;
        if constexpr (GATHER) { _Pragma("unroll") for (int h_ = 0; h_ < 2; ++h_) _Pragma("unroll") for (int i_ = 0; i_ < 2; ++i_) gA[h_][i_] = gN[h_][i_]; }
        if constexpr (ALIGN_EPI) { if (wr == 1) PG8_BAR; }
    }
    PG8_WAIT_V(0);
    if constexpr (!ALIGN_EPI) { if (wr == 0) PG8_BAR; }
    PG8_BAR;
    if constexpr (Epi::AFTER_DRAIN) { E.fused(acc, cur, wr, wc, fr, fq, lds, wid, lane); S.done(cur); }
#undef PG8_SA
#undef PG8_SB
#undef PG8_STAGE
#undef PG8_STAGE_A
#undef PG8_GOFF
#undef PG8_LDA
#undef PG8_LDB
#undef PG8_MMA
#undef PG8_WAIT_V
#undef PG8_WAIT_L
#undef PG8_BAR
#undef PG8_SCHED
}
}

#define GAS __attribute__((address_space(1)))
typedef GAS unsigned gu32;
#define RLX_AGENT __ATOMIC_RELAXED, __HIP_MEMORY_SCOPE_AGENT
#define XB_TMO      128
#define XB_XCNT(j)  (256  + 64 * (j))
#define XB_XSUB(j)  (1280 + 64 * (j))
#define XB_XGEN(j)  (2304 + 64 * (j))
#define XB_TOP      3328
#define XB_TOPGEN   3392
#define XCD_BAR_WORDS 3456
#define XB_SPIN_CAP (1u << 18)

__device__ __forceinline__ unsigned xb_ld(unsigned* p)              { return __hip_atomic_load(p, __ATOMIC_RELAXED, __HIP_MEMORY_SCOPE_AGENT); }
__device__ __forceinline__ unsigned xb_add(unsigned* p, unsigned v) { return __hip_atomic_fetch_add(p, v, __ATOMIC_RELAXED, __HIP_MEMORY_SCOPE_AGENT); }
__device__ __forceinline__ unsigned xb_xcc_id() { return (unsigned)__builtin_amdgcn_s_getreg((3 << 11) | 20) & 0xFu; }
#define XB_SPIN(cond, bar) do { unsigned _sp = 0; while (cond) { __builtin_amdgcn_s_sleep(1); \
    if ((++_sp & 255u) == 0u) { if (xb_ld(&(bar)[XB_TMO])) break; if (_sp > XB_SPIN_CAP) { atomicAdd(&(bar)[XB_TMO], 1u); break; } } } } while (0)

struct XcdBarrier {
    unsigned* bar; unsigned x;
    volatile LAS unsigned* st;
};

__device__ __forceinline__ XcdBarrier xcd_barrier_post(unsigned* bar, volatile LAS unsigned* st) {
    XcdBarrier b; b.bar = bar; b.x = xb_xcc_id(); b.st = st;
    if (threadIdx.x == 0) (void)xb_add(&bar[XB_XCNT(b.x)], 1u);
    return b;
}
__device__ __forceinline__ void xcd_barrier_complete(unsigned* bar, unsigned x, unsigned& nloc, unsigned& nx) {
    const unsigned G = gridDim.x * gridDim.y * gridDim.z;
    unsigned sum, cnt, mine, sp = 0u;
    for (;;) {
        sum = 0u; cnt = 0u; mine = 0u;
#pragma unroll
        for (unsigned j = 0; j < 16; ++j) { const unsigned c = xb_ld(&bar[XB_XCNT(j)]); sum += c; cnt += (c > 0u) ? 1u : 0u; mine = (j == x) ? c : mine; }
        if (sum == G) break;
        __builtin_amdgcn_s_sleep(1);
        if ((++sp & 255u) == 0u) { if (xb_ld(&bar[XB_TMO])) break; if (sp > XB_SPIN_CAP) { atomicAdd(&bar[XB_TMO], 1u); break; } }
    }
    nloc = mine > 0u ? mine : 1u; nx = cnt > 0u ? cnt : 1u;
}

__device__ __forceinline__ void xcd_barrier(const XcdBarrier& b) {
    asm volatile("s_waitcnt vmcnt(0)" ::: "memory");
    __syncthreads();
    if (threadIdx.x == 0) {
        unsigned* bar = b.bar;
        __builtin_amdgcn_s_waitcnt(0);
        unsigned nloc = b.st[0], nx = b.st[1];
        if (nloc == 0u) { xcd_barrier_complete(bar, b.x, nloc, nx); b.st[0] = nloc; b.st[1] = nx; }
        const unsigned old = xb_add(&bar[XB_XSUB(b.x)], 1u);
        const unsigned gen = old / nloc;
        if (old + 1u == (gen + 1u) * nloc) {
            __builtin_amdgcn_fence(__ATOMIC_RELEASE, "agent");
            asm volatile("s_waitcnt vmcnt(0)" ::: "memory");
            const unsigned og = xb_add(&bar[XB_TOP], 1u);
            const unsigned tg = og / nx;
            if (og + 1u == (tg + 1u) * nx) xb_add(&bar[XB_TOPGEN], 1u);
            else XB_SPIN(xb_ld(&bar[XB_TOPGEN]) == tg, bar);
            __builtin_amdgcn_fence(__ATOMIC_ACQUIRE, "agent");
            xb_add(&bar[XB_XGEN(b.x)], 1u);
            asm volatile("s_waitcnt vmcnt(0)" ::: "memory");
        } else {
            XB_SPIN(xb_ld(&bar[XB_XGEN(b.x)]) == gen, bar);
            __builtin_amdgcn_fence(__ATOMIC_ACQUIRE, "agent");
            asm volatile("s_waitcnt vmcnt(0)" ::: "memory");
        }
    }
    __syncthreads();
}

struct OrderBase {
    const int* rowidx;
    __device__ __forceinline__ void a_ready(const pg8::Unit&) const {}
    __device__ __forceinline__ void done(const pg8::Unit&) const {}
};
struct PlainOrder : OrderBase {
    const char* A; const char* B; size_t astep, bstep; int nM, nN, G, c;
    __device__ __forceinline__ bool next(int i, pg8::Unit& u) const {
        const long L = (long)i * G + c; if (L >= (long)nM * nN) return false;
        pg8::tile_of((int)L, nM, nN, u.pm, u.pn); u.aux = 0; u.a = A + (size_t)u.pm * astep; u.b = B + (size_t)u.pn * bstep; return true; }
};
struct LruOrder : OrderBase {
    const char* A; const char* B; int nM, G, c;
    __device__ __forceinline__ bool next(int i, pg8::Unit& u) const {
        const long L = (long)i * G + c; if (L >= (long)nM * 16) return false;
        pg8::tile_of((int)L, nM, 16, u.pm, u.pn); u.aux = 0; u.a = A + (size_t)u.pm * (256 * 1024 * 2) + (size_t)(u.pn >> 2) * 512; u.b = B + (size_t)u.pn * (256 * 256 * 2); return true; }
};
struct BranchOrder : OrderBase {
    const char* A; const char* B; int nM, G, c;
    __device__ __forceinline__ bool next(int i, pg8::Unit& u) const {
        const int j = i / 3, br = i - 3 * j; const long L = (long)j * G + c; if (L >= (long)nM * 4) return false;
        pg8::tile_of((int)L, nM, 4, u.pm, u.pn); u.aux = br; u.a = A + (size_t)br * ROWB + (size_t)u.pm * (256 * 1024 * 2); u.b = B + (size_t)br * (1024 * 1024 * 2) + (size_t)u.pn * (256 * 1024 * 2); return true; }
};
struct MoeOrder : OrderBase {
    const char* A; const char* B; const unsigned* tile_e; size_t estep; int nM, nN, G, c, ga;
    __device__ __forceinline__ bool next(int i, pg8::Unit& u) const {
        const long L = (long)i * G + c; if (L >= (long)nM * nN) return false;
        pg8::tile_of((int)L, nM, nN, u.pm, u.pn); const int e = (int)tile_e[u.pm]; u.aux = e;
        u.a = ga ? A : A + (size_t)u.pm * (256 * 1024 * 2); u.b = B + (size_t)e * estep + (size_t)u.pn * (256 * 1024 * 2); return true; }
};

struct EpiBf16Bias {
    static constexpr bool PERM = true, AFTER_DRAIN = false;
    bf16_t* O; int ldc; const float* bias; int bstride;
    __device__ __forceinline__ void operator()(const f32x4 (&acc)[2][2][4][2], const pg8::Unit& u, int wr, int wc, int fr, int fq) const {
        const int row0 = u.pm * 256 + wr * 64 + fr, col0 = u.pn * 256 + wc * 32 + 8 * fq;
        f32x4 bv[2][2];
#pragma unroll
        for (int bj = 0; bj < 2; ++bj)
#pragma unroll
            for (int n = 0; n < 2; ++n) bv[bj][n] = bias ? *(const f32x4*)(bias + (size_t)u.aux * bstride + col0 + bj * 128 + 4 * n) : (f32x4){0.f, 0.f, 0.f, 0.f};
#pragma unroll
        for (int ai = 0; ai < 2; ++ai)
#pragma unroll
            for (int m = 0; m < 4; ++m) { bf16_t* rowp = O + (size_t)(row0 + ai * 128 + m * 16) * ldc + col0;
#pragma unroll
                for (int bj = 0; bj < 2; ++bj) { const f32x4 v0 = acc[ai][bj][m][0] + bv[bj][0], v1 = acc[ai][bj][m][1] + bv[bj][1];
                    u32x4 w; w.x = pg8::cvt_pk_bf16(v0[0], v0[1]); w.y = pg8::cvt_pk_bf16(v0[2], v0[3]); w.z = pg8::cvt_pk_bf16(v1[0], v1[1]); w.w = pg8::cvt_pk_bf16(v1[2], v1[3]);
                    *(u32x4*)(rowp + bj * 128) = w; } }
    }
};
struct EpiLru {
    static constexpr bool PERM = true, AFTER_DRAIN = false;
    const bf16_t* xc; bf16_t* LA; bf16_t* BB; const float* ba; const float* bi; const float* lsl;
    __device__ __forceinline__ void operator()(const f32x4 (&acc)[2][2][4][2], const pg8::Unit& u, int wr, int wc, int fr, int fq) const {
        const int g = u.pn >> 2, d = (u.pn >> 1) & 1, hh = u.pn & 1;
        const int row0 = u.pm * 256 + wr * 64 + fr, ch0 = 256 * g + 128 * hh + wc * 32 + 8 * fq;
#pragma unroll
        for (int ai = 0; ai < 2; ++ai)
#pragma unroll
            for (int m = 0; m < 4; ++m) { const size_t off = (size_t)(row0 + ai * 128 + m * 16) * 1024 + ch0;
                const u32x4 xw = *(const u32x4*)(xc + off); float la[8], bb[8];
#pragma unroll
                for (int n = 0; n < 2; ++n) { const f32x4 pb = *(const f32x4*)(ba + d * 1024 + ch0 + 4 * n), pi = *(const f32x4*)(bi + d * 1024 + ch0 + 4 * n), pl = *(const f32x4*)(lsl + d * 1024 + ch0 + 4 * n);
#pragma unroll
                    for (int e = 0; e < 4; ++e) { const int idx = 4 * n + e; const unsigned w = xw[idx >> 1]; const float xv = (idx & 1) ? bfhi(w) : bflo(w);
                        const float r = sigmoidf_(acc[ai][0][m][n][e] + pb[e]), ig = sigmoidf_(acc[ai][1][m][n][e] + pi[e]);
                        const float l = 8.0f * r * pl[e]; la[idx] = l; bb[idx] = sqrtf(fmaxf(1.0f - __expf(2.0f * l), 0.f)) * ig * xv; } }
                u32x4 w1, w2; w1.x = pg8::cvt_pk_bf16(la[0], la[1]); w1.y = pg8::cvt_pk_bf16(la[2], la[3]); w1.z = pg8::cvt_pk_bf16(la[4], la[5]); w1.w = pg8::cvt_pk_bf16(la[6], la[7]);
                w2.x = pg8::cvt_pk_bf16(bb[0], bb[1]); w2.y = pg8::cvt_pk_bf16(bb[2], bb[3]); w2.z = pg8::cvt_pk_bf16(bb[4], bb[5]); w2.w = pg8::cvt_pk_bf16(bb[6], bb[7]);
                *(u32x4*)(LA + (size_t)d * TT * 1024 + off) = w1; *(u32x4*)(BB + (size_t)d * TT * 1024 + off) = w2; asm volatile("" ::: "memory"); }
    }
};
struct EpiBranch {
    static constexpr bool PERM = true, AFTER_DRAIN = false;
    const bf16_t* P; bf16_t* MB;
    __device__ __forceinline__ void operator()(const f32x4 (&acc)[2][2][4][2], const pg8::Unit& u, int wr, int wc, int fr, int fq) const {
        const int br = u.aux, row0 = u.pm * 256 + wr * 64 + fr, col0 = u.pn * 256 + wc * 32 + 8 * fq;
        bf16_t* dst = MB + (size_t)br * TT * 1024; const bf16_t* M0 = MB; const bf16_t* M1 = MB + (size_t)TT * 1024;
#pragma unroll
        for (int ai = 0; ai < 2; ++ai)
#pragma unroll
            for (int m = 0; m < 4; ++m) { const size_t row = (size_t)(row0 + ai * 128 + m * 16);
#pragma unroll
                for (int bj = 0; bj < 2; ++bj) { const int c = col0 + bj * 128;
                    const u32x4 gw = *(const u32x4*)(P + row * LDP + C_MG + br * 1024 + c);
                    f32x4 v0, v1;
                    v0[0] = sigmoidf_(bflo(gw.x)) * acc[ai][bj][m][0][0]; v0[1] = sigmoidf_(bfhi(gw.x)) * acc[ai][bj][m][0][1]; v0[2] = sigmoidf_(bflo(gw.y)) * acc[ai][bj][m][0][2]; v0[3] = sigmoidf_(bfhi(gw.y)) * acc[ai][bj][m][0][3];
                    v1[0] = sigmoidf_(bflo(gw.z)) * acc[ai][bj][m][1][0]; v1[1] = sigmoidf_(bfhi(gw.z)) * acc[ai][bj][m][1][1]; v1[2] = sigmoidf_(bflo(gw.w)) * acc[ai][bj][m][1][2]; v1[3] = sigmoidf_(bfhi(gw.w)) * acc[ai][bj][m][1][3];
                    if (br == 2) { const u32x4 p0 = *(const u32x4*)(M0 + row * 1024 + c), p1 = *(const u32x4*)(M1 + row * 1024 + c);
                        v0[0] += bflo(p0.x) + bflo(p1.x); v0[1] += bfhi(p0.x) + bfhi(p1.x); v0[2] += bflo(p0.y) + bflo(p1.y); v0[3] += bfhi(p0.y) + bfhi(p1.y);
                        v1[0] += bflo(p0.z) + bflo(p1.z); v1[1] += bfhi(p0.z) + bfhi(p1.z); v1[2] += bflo(p0.w) + bflo(p1.w); v1[3] += bfhi(p0.w) + bfhi(p1.w); }
                    u32x4 w; w.x = pg8::cvt_pk_bf16(v0[0], v0[1]); w.y = pg8::cvt_pk_bf16(v0[2], v0[3]); w.z = pg8::cvt_pk_bf16(v1[0], v1[1]); w.w = pg8::cvt_pk_bf16(v1[2], v1[3]);
                    *(u32x4*)(dst + row * 1024 + c) = w; } }
    }
};
struct EpiOut {
    static constexpr bool PERM = false, AFTER_DRAIN = false;
    const float* baseLat; const float* baseCtx; float* xs; const float* gate;
    __device__ __forceinline__ void operator()(const f32x4 (&acc)[2][2][4][2], const pg8::Unit& u, int wr, int wc, int fr, int fq) const {
        const int mrow = u.pm < 128 ? (u.pm >> 4) : 8; const float* gp = gate + mrow * 6144;
        const int row0 = u.pm * 256 + wr * 64 + fr, col0 = u.pn * 256 + wc * 32 + 4 * fq;
        const float* base = u.pm < 128 ? baseLat + (size_t)row0 * 1024 : baseCtx + (size_t)(row0 - TLAT) * 1024;
        f32x4 gv[2][2];
#pragma unroll
        for (int bj = 0; bj < 2; ++bj)
#pragma unroll
            for (int n = 0; n < 2; ++n) gv[bj][n] = *(const f32x4*)(gp + col0 + bj * 128 + n * 16);
#pragma unroll
        for (int ai = 0; ai < 2; ++ai)
#pragma unroll
            for (int m = 0; m < 4; ++m) { const size_t ro = (size_t)(ai * 128 + m * 16) * 1024 + col0; float* op = xs + (size_t)row0 * 1024 + ro;
#pragma unroll
                for (int bj = 0; bj < 2; ++bj)
#pragma unroll
                    for (int n = 0; n < 2; ++n) *(f32x4*)(op + bj * 128 + n * 16) = *(const f32x4*)(base + ro + bj * 128 + n * 16) + gv[bj][n] * acc[ai][bj][m][n]; }
    }
};
struct EpiSwiglu {
    static constexpr bool PERM = true, AFTER_DRAIN = false;
    bf16_t* H; const float* bgu;
    __device__ __forceinline__ void operator()(const f32x4 (&acc)[2][2][4][2], const pg8::Unit& u, int wr, int wc, int fr, int fq) const {
        const int row0 = u.pm * 256 + wr * 64 + fr, f0 = u.pn * 128 + wc * 32 + 8 * fq;
        float bg[8], bu[8];
#pragma unroll
        for (int q = 0; q < 4; ++q) { const f32x4 b = *(const f32x4*)(bgu + (size_t)u.aux * 2048 + 2 * f0 + 4 * q); bg[2 * q] = b[0]; bu[2 * q] = b[1]; bg[2 * q + 1] = b[2]; bu[2 * q + 1] = b[3]; }
#pragma unroll
        for (int ai = 0; ai < 2; ++ai)
#pragma unroll
            for (int m = 0; m < 4; ++m) { float a[8];
#pragma unroll
                for (int n = 0; n < 2; ++n)
#pragma unroll
                    for (int e = 0; e < 4; ++e) { const int idx = 4 * n + e; const float gt = fminf(acc[ai][0][m][n][e] + bg[idx], 7.0f), up = fminf(fmaxf(acc[ai][1][m][n][e] + bu[idx], -7.0f), 7.0f);
                        a[idx] = gt * sigmoidf_(1.702f * gt) * (up + 1.0f); }
                u32x4 w; w.x = pg8::cvt_pk_bf16(a[0], a[1]); w.y = pg8::cvt_pk_bf16(a[2], a[3]); w.z = pg8::cvt_pk_bf16(a[4], a[5]); w.w = pg8::cvt_pk_bf16(a[6], a[7]);
                *(u32x4*)(H + (size_t)(row0 + ai * 128 + m * 16) * 1024 + f0) = w; }
    }
};

constexpr int NWAVES = 8, NTHR = 512;
constexpr int LDS_BYTES = 163840, MISC_OFF = 163840 - 512;
struct Frame {
    LAS unsigned char* lds; GAS unsigned char* ws; const float* const* in; float* out;
    int tid, bx, lane, wave, G, gw, NGW, gtid, NGT;
};
__device__ __forceinline__ int mrow_of(int row) { return row < TLAT ? (row >> 12) : 8; }
__device__ __forceinline__ int seqrow(int d, int b, int p) {
    if (p < CTXL) return TLAT + b * CTXL + (d ? CTXL - 1 - p : p);
    const int q = p - CTXL; return b * SEQ + (d ? SEQ - 1 - q : q);
}
struct RowV { f32x4 v[4]; };
__device__ __forceinline__ RowV load_row(const float* p, int lane) { RowV r;
#pragma unroll
    for (int j = 0; j < 4; ++j) r.v[j] = *(const f32x4*)(p + 4 * lane + 256 * j);
    return r; }
__device__ __forceinline__ float row_sumsq(const RowV& r) { float s = 0.f;
#pragma unroll
    for (int j = 0; j < 4; ++j) s += (r.v[j][0] * r.v[j][0] + r.v[j][1] * r.v[j][1]) + (r.v[j][2] * r.v[j][2] + r.v[j][3] * r.v[j][3]);
    return wave_sum(s); }
__device__ __forceinline__ RowV norm_mod(const RowV& x, const float* gain, const float* shift, const float* scale, int lane) {
    const float rs = rsqrtf(row_sumsq(x) * (1.0f / D) + EPS); RowV y;
#pragma unroll
    for (int j = 0; j < 4; ++j) { const int c = 4 * lane + 256 * j; const f32x4 g = *(const f32x4*)(gain + c), sh = *(const f32x4*)(shift + c), sc = *(const f32x4*)(scale + c);
        y.v[j] = (x.v[j] * rs) * g * (sc + 1.0f) + sh; }
    return y; }
__device__ __forceinline__ void store_row_bf16(bf16_t* p, const RowV& y, int lane) {
#pragma unroll
    for (int j = 0; j < 4; ++j) { u32x2 w; w.x = pk2(y.v[j][0], y.v[j][1]); w.y = pk2(y.v[j][2], y.v[j][3]); *(u32x2*)(p + 4 * lane + 256 * j) = w; } }
__device__ __forceinline__ f32x4 ld4bf(const bf16_t* p) { const u32x2 w = *(const u32x2*)p; return (f32x4){bflo(w.x), bfhi(w.x), bflo(w.y), bfhi(w.y)}; }

__device__ __forceinline__ void phase_proA(const Frame& F) {
    const float* c = F.in[1]; const float* cc = F.in[3]; const float* w_ada = F.in[4];
    float* modp = (float*)(F.ws + WS_MODP);
    for (int it = F.gw; it < 2 * 8 * 96; it += F.NGW) {
        const int cg = it % 96, ks = (it / 96) % 8, l = it / 768, col = cg * 64 + F.lane;
        float acc[9];
#pragma unroll
        for (int r = 0; r < 9; ++r) acc[r] = 0.f;
        for (int k = ks * 128; k < ks * 128 + 128; ++k) {
            const float w = w_ada[((size_t)l * 1024 + k) * 6144 + col];
#pragma unroll
            for (int r = 0; r < 8; ++r) acc[r] += siluf_(c[r * 1024 + k]) * w;
            acc[8] += siluf_(cc[k]) * w;
        }
#pragma unroll
        for (int r = 0; r < 9; ++r) modp[((size_t)(ks * 2 + l) * 9 + r) * 6144 + col] = acc[r];
    }
    float* rc = (float*)(F.ws + WS_COS); float* rsn = (float*)(F.ws + WS_SIN);
    for (int i = F.gtid; i < SEQ * 64; i += F.NGT) {
        const int t = i >> 6, j = i & 63, f = j & 31; const float pos = (float)((j < 32) ? (t >> 6) : (t & 63));
        const float inv = exp2f(-(float)f * (13.287712379549449f / 32.0f)); const float ang = pos * inv;
        const float nn = rintf(ang * 0.15915494309189535f); float r = fmaf(-nn, 6.28125f, ang); r = fmaf(-nn, 1.9353071795864769e-3f, r);
        rc[i] = __cosf(r); rsn[i] = __sinf(r);
    }
}
__device__ __forceinline__ void phase_proB(const Frame& F) {
    const float* modp = (const float*)(F.ws + WS_MODP); float* mods = (float*)(F.ws + WS_MODS); const float* b_ada = F.in[5];
    for (int i = F.gtid; i < 2 * 9 * 6144; i += F.NGT) { const int l = i / (9 * 6144), col = i % 6144; float s = b_ada[l * 6144 + col];
#pragma unroll
        for (int ks = 0; ks < 8; ++ks) s += modp[(size_t)ks * (2 * 9 * 6144) + i];
        mods[i] = s; }
}

template <class RM> __device__ __forceinline__ void tr_item(const float* W, int ldw, int k0, int n0, bf16_t* WT, int ldt, LAS float* scr, int lane, const RM& rm) {
#pragma unroll 8
    for (int i = 0; i < 32; ++i) { const int kk = 2 * i + (lane >> 5); scr[kk * 33 + (lane & 31)] = W[(size_t)(k0 + kk) * ldw + n0 + (lane & 31)]; }
    LDS_WAIT(); asm volatile("" ::: "memory");
    const int c = lane & 7;
#pragma unroll
    for (int j = 0; j < 4; ++j) { const int n = (lane >> 3) + 8 * j; const LAS float* s = scr + (8 * c) * 33 + n; int drow; float sc; rm(n0 + n, drow, sc);
        u32x4 o; o.x = pk2(s[0 * 33] * sc, s[1 * 33] * sc); o.y = pk2(s[2 * 33] * sc, s[3 * 33] * sc); o.z = pk2(s[4 * 33] * sc, s[5 * 33] * sc); o.w = pk2(s[6 * 33] * sc, s[7 * 33] * sc);
        *(u32x4*)(WT + (size_t)drow * ldt + k0 + 8 * c) = o; }
    LDS_WAIT(); asm volatile("" ::: "memory");
}
struct RmIn { __device__ __forceinline__ void operator()(int n, int& drow, float& sc) const {
    drow = n < 3072 ? n : (n < 3104 ? C_LR + (n - 3072) : n - 32); sc = (n < 512 || (n >= 5664 && n < 6176)) ? 0.08838834764831845f : 1.0f; } };
struct RmId { __device__ __forceinline__ void operator()(int n, int& drow, float& sc) const { drow = n; sc = 1.0f; } };
struct RmLru { int base; __device__ __forceinline__ void operator()(int n, int& drow, float& sc) const { drow = base + (n & 127); sc = 1.0f; } };
struct RmGu { __device__ __forceinline__ void operator()(int n, int& drow, float& sc) const { const int f = n >> 1, u = n & 1; drow = 256 * (f >> 7) + 128 * u + (f & 127); sc = 1.0f; } };
__device__ __forceinline__ void phase_W(const Frame& F, int li) {
    LAS float* scr = (LAS float*)(F.lds + F.wave * 8704);
    bf16_t* Win_t = (bf16_t*)(F.ws + WS_WIN); bf16_t* Wlru_t = (bf16_t*)(F.ws + WS_WLRU); bf16_t* Wbr_t = (bf16_t*)(F.ws + WS_WBR);
    bf16_t* Wout_t = (bf16_t*)(F.ws + WS_WOUT); bf16_t* Wgu_t = (bf16_t*)(F.ws + WS_WGU); bf16_t* Wdn_t = (bf16_t*)(F.ws + WS_WDN);
    constexpr int I_IN = 16 * 353, I_LRU = 512, I_BR = 1536, I_OUT = 512, I_GU = 32768, I_DN = 16384, NITEMS = I_IN + I_LRU + I_BR + I_OUT + I_GU + I_DN;
    for (int it0 = F.gw; it0 < NITEMS; it0 += F.NGW) {
        int it = it0;
        if (it < I_IN) { const int kb = it / 353, nb = it % 353; tr_item(F.in[8] + (size_t)li * 1024 * IN_TOTAL, IN_TOTAL, 64 * kb, 32 * nb, Win_t, 1024, scr, F.lane, RmIn{}); continue; } it -= I_IN;
        if (it < I_LRU) { const int mat = it >> 5, r = it & 31, kb = r >> 3, nb = r & 7, ty = mat >> 3, d = (mat >> 2) & 1, g = mat & 3, n0 = 32 * nb, pn = g * 4 + d * 2 + (n0 >> 7);
            const float* src = (ty ? F.in[16] : F.in[14]) + (size_t)((li * 2 + d) * 4 + g) * 65536;
            tr_item(src, 256, 64 * kb, n0, Wlru_t, 256, scr, F.lane, RmLru{pn * 256 + ty * 128}); continue; } it -= I_LRU;
        if (it < I_BR) { const int br = it >> 9, r = it & 511, kb = r >> 5, nb = r & 31; tr_item(F.in[20] + (size_t)(li * 3 + br) * 1048576, 1024, 64 * kb, 32 * nb, Wbr_t + (size_t)br * 1048576, 1024, scr, F.lane, RmId{}); continue; } it -= I_BR;
        if (it < I_OUT) { const int kb = it >> 5, nb = it & 31; tr_item(F.in[21] + (size_t)li * 1048576, 1024, 64 * kb, 32 * nb, Wout_t, 1024, scr, F.lane, RmId{}); continue; } it -= I_OUT;
        if (it < I_GU) { const int e = it >> 10, r = it & 1023, kb = r >> 6, nb = r & 63; tr_item(F.in[24] + (size_t)(li * 32 + e) * 2097152, 2048, 64 * kb, 32 * nb, Wgu_t + (size_t)e * 2097152, 1024, scr, F.lane, RmGu{}); continue; } it -= I_GU;
        { const int e = it >> 9, r = it & 511, kb = r >> 5, nb = r & 31; tr_item(F.in[26] + (size_t)(li * 32 + e) * 1048576, 1024, 64 * kb, 32 * nb, Wdn_t + (size_t)e * 1048576, 1024, scr, F.lane, RmId{}); }
    }
    for (int i = F.gtid; i < (LDP - IN_TOTAL) * 1024 / 8; i += F.NGT) *(u32x4*)(Win_t + (size_t)IN_TOTAL * 1024 + (size_t)i * 8) = (u32x4){0u, 0u, 0u, 0u};
    float* lsl = (float*)(F.ws + WS_LSL);
    for (int i = F.gtid; i < 2048; i += F.NGT) lsl[i] = logsigmoidf_(F.in[18][li * 2048 + i]);
}
__device__ __forceinline__ void phase_norm_in(const Frame& F) {
    const float* mods = (const float*)(F.ws + WS_MODS); bf16_t* xn = (bf16_t*)(F.ws + WS_D);
    for (int row = F.gw; row < TT; row += F.NGW) {
        const float* src = row < TLAT ? F.in[0] + (size_t)row * D : F.in[2] + (size_t)(row - TLAT) * D;
        const float* mp = mods + mrow_of(row) * 6144;
        const RowV y = norm_mod(load_row(src, F.lane), F.in[6], mp, mp + 1024, F.lane);
        store_row_bf16(xn + (size_t)row * D, y, F.lane);
    }
}

__device__ __forceinline__ void phase_conv(const Frame& F, int li) {
    const bf16_t* P = (const bf16_t*)(F.ws + WS_P); bf16_t* xc = (bf16_t*)(F.ws + WS_D);
    const float* cw = F.in[12] + (size_t)li * 4 * 1024; const float* cb = F.in[13] + (size_t)li * 1024;
    for (int i = F.gtid; i < TT * 128; i += F.NGT) {
        const int row = i >> 7, ch = (i & 127) * 8;
        int t, L; if (row < TLAT) { t = row & (SEQ - 1); L = SEQ; } else { t = (row - TLAT) & (CTXL - 1); L = CTXL; }
        float a[8];
        { const f32x4 b0 = *(const f32x4*)(cb + ch), b1 = *(const f32x4*)(cb + ch + 4); a[0] = b0[0]; a[1] = b0[1]; a[2] = b0[2]; a[3] = b0[3]; a[4] = b1[0]; a[5] = b1[1]; a[6] = b1[2]; a[7] = b1[3]; }
#pragma unroll
        for (int j = 0; j < 4; ++j) { const int tt = t - 2 + j; if (tt < 0 || tt >= L) continue;
            const u32x4 xw = *(const u32x4*)(P + (size_t)(row - 2 + j) * LDP + C_LX + ch);
            const f32x4 w0 = *(const f32x4*)(cw + j * 1024 + ch), w1 = *(const f32x4*)(cw + j * 1024 + ch + 4);
            a[0] += w0[0] * bflo(xw.x); a[1] += w0[1] * bfhi(xw.x); a[2] += w0[2] * bflo(xw.y); a[3] += w0[3] * bfhi(xw.y);
            a[4] += w1[0] * bflo(xw.z); a[5] += w1[1] * bfhi(xw.z); a[6] += w1[2] * bflo(xw.w); a[7] += w1[3] * bfhi(xw.w); }
        u32x4 o; o.x = pk2(a[0], a[1]); o.y = pk2(a[2], a[3]); o.z = pk2(a[4], a[5]); o.w = pk2(a[6], a[7]);
        *(u32x4*)(xc + (size_t)row * 1024 + ch) = o;
    }
    bf16_t* Pw = (bf16_t*)(F.ws + WS_P); const float* rcos = (const float*)(F.ws + WS_COS); const float* rsin = (const float*)(F.ws + WS_SIN);
    for (int i = F.gtid; i < TLAT * 64; i += F.NGT) {
        const int g8 = i & 7, qk = (i >> 3) & 1, h = (i >> 4) & 3, row = i >> 6, t = row & (SEQ - 1);
        bf16_t* p1 = Pw + (size_t)row * LDP + (qk ? C_RK : C_RQ) + 128 * h + 8 * g8; bf16_t* p2 = p1 + 64;
        const u32x4 a = *(const u32x4*)p1, b = *(const u32x4*)p2;
        const f32x4 c0 = *(const f32x4*)(rcos + t * 64 + 8 * g8), c1 = *(const f32x4*)(rcos + t * 64 + 8 * g8 + 4), s0 = *(const f32x4*)(rsin + t * 64 + 8 * g8), s1 = *(const f32x4*)(rsin + t * 64 + 8 * g8 + 4);
        const float cs[8] = {c0[0], c0[1], c0[2], c0[3], c1[0], c1[1], c1[2], c1[3]}, sn[8] = {s0[0], s0[1], s0[2], s0[3], s1[0], s1[1], s1[2], s1[3]};
        const unsigned aw[4] = {a.x, a.y, a.z, a.w}, bw[4] = {b.x, b.y, b.z, b.w}; u32x4 o1, o2;
#pragma unroll
        for (int e = 0; e < 4; ++e) { const float x1a = bflo(aw[e]), x1b = bfhi(aw[e]), x2a = bflo(bw[e]), x2b = bfhi(bw[e]);
            o1[e] = pk2(x1a * cs[2 * e] - x2a * sn[2 * e], x1b * cs[2 * e + 1] - x2b * sn[2 * e + 1]);
            o2[e] = pk2(x1a * sn[2 * e] + x2a * cs[2 * e], x1b * sn[2 * e + 1] + x2b * cs[2 * e + 1]); }
        *(u32x4*)p1 = o1; *(u32x4*)p2 = o2;
    }
}
constexpr int LSEG = 136, LNSEG = (CTXL + SEQ) / LSEG;
template <bool FINAL> __device__ __forceinline__ void phase_lru_scan(const Frame& F) {
    const bf16_t* LA = (const bf16_t*)(F.ws + WS_C); const bf16_t* BB = (const bf16_t*)(F.ws + WS_C + 2 * ROWB);
    float* carA = (float*)(F.ws + WS_CARA); float* carH = (float*)(F.ws + WS_CARH); bf16_t* HO = (bf16_t*)(F.ws + WS_E);
    for (int i = F.gtid; i < 2 * 8 * LNSEG * 256; i += F.NGT) {
        const int cq = i & 255, s = (i >> 8) % LNSEG, db = (i >> 8) / LNSEG, b = db & 7, d = db >> 3;
        f32x4 h = (f32x4){0.f, 0.f, 0.f, 0.f}, As = (f32x4){0.f, 0.f, 0.f, 0.f};
        if (FINAL) { for (int s2 = 0; s2 < s; ++s2) { const size_t o = ((size_t)(db * LNSEG + s2) * 256 + cq) * 4; h = *(const f32x4*)(carA + o) * h + *(const f32x4*)(carH + o); } }
        const size_t dofs = (size_t)d * TT * 1024;
#pragma unroll 8
        for (int p = 0; p < LSEG; ++p) { const size_t off = (size_t)seqrow(d, b, s * LSEG + p) * 1024 + cq * 4;
            const f32x4 la = ld4bf(LA + dofs + off), bb = ld4bf(BB + dofs + off);
            f32x4 a; a[0] = __expf(la[0]); a[1] = __expf(la[1]); a[2] = __expf(la[2]); a[3] = __expf(la[3]);
            h = a * h + bb;
            if (FINAL) { u32x2 w; w.x = pk2(h[0], h[1]); w.y = pk2(h[2], h[3]); *(u32x2*)(HO + dofs + off) = w; } else As += la; }
        if (!FINAL) { const size_t o = (size_t)i * 4; f32x4 A; A[0] = __expf(As[0]); A[1] = __expf(As[1]); A[2] = __expf(As[2]); A[3] = __expf(As[3]);
            *(f32x4*)(carA + o) = A; *(f32x4*)(carH + o) = h; }
    }
}


constexpr size_t QKB = (size_t)TT * 512 * 2;
__device__ __forceinline__ void phase_scanprep(const Frame& F, int li) {
    LAS float* lrs = (LAS float*)F.lds;
    LAS float* qtot = lrs + 64 * 32;
    LAS float* gcs = qtot + 4 * 512;
    bf16_t* Pm = (bf16_t*)(F.ws + WS_P); bf16_t* QK = (bf16_t*)(F.ws + WS_C); float* EGL = (float*)(F.ws + WS_MODP);
    const int qtr = F.tid >> 7, c4 = F.tid & 127, ch0 = 4 * c4;
    for (int rc = F.bx; rc < TT / 64; rc += F.G) {
        if (F.tid < 256) { const int tok = F.tid >> 2, q8 = F.tid & 3; const u32x4 v = *(const u32x4*)(Pm + (size_t)(64 * rc + tok) * LDP + C_LR + 8 * q8);
            LAS float* dst = lrs + tok * 32 + 8 * q8; *(LAS f32x4*)dst = (f32x4){bflo(v.x), bfhi(v.x), bflo(v.y), bfhi(v.y)}; *(LAS f32x4*)(dst + 4) = (f32x4){bflo(v.z), bfhi(v.z), bflo(v.w), bfhi(v.w)}; }
        __syncthreads();
        for (int d = 0; d < 2; ++d) {
            f32x4 wv[16];
#pragma unroll
            for (int r = 0; r < 16; ++r) wv[r] = *(const f32x4*)(F.in[9] + (size_t)((li * 2 + d) * 16 + r) * 512 + ch0);
            const f32x4 bav = *(const f32x4*)(F.in[10] + (size_t)(li * 2 + d) * 512 + ch0);
            f32x4 run = (f32x4){0.f, 0.f, 0.f, 0.f};
#pragma unroll 2
            for (int i = 0; i < 16; ++i) { const int p = 16 * qtr + i, tok = d ? 63 - p : p; f32x4 z = bav;
#pragma unroll
                for (int r4 = 0; r4 < 4; ++r4) { const f32x4 l = *(const LAS f32x4*)(lrs + tok * 32 + 16 * d + 4 * r4);
#pragma unroll
                    for (int e = 0; e < 4; ++e) z += wv[4 * r4 + e] * l[e]; }
#pragma unroll
                for (int e = 0; e < 4; ++e) run[e] += logsigmoidf_(z[e]) * 0.0625f;
                *(LAS f32x4*)(gcs + p * 512 + ch0) = run; }
            *(LAS f32x4*)(qtot + qtr * 512 + ch0) = run;
            __syncthreads();
            f32x4 off = (f32x4){0.f, 0.f, 0.f, 0.f}, tot = (f32x4){0.f, 0.f, 0.f, 0.f};
#pragma unroll
            for (int q2 = 0; q2 < 4; ++q2) { const f32x4 t = *(const LAS f32x4*)(qtot + q2 * 512 + ch0); tot += t; if (q2 < qtr) off += t; }
            if (qtr == 0) { f32x4 e4; e4[0] = __expf(tot[0]); e4[1] = __expf(tot[1]); e4[2] = __expf(tot[2]); e4[3] = __expf(tot[3]); *(f32x4*)(EGL + ((size_t)d * (TT / 64) + rc) * 512 + ch0) = e4; }
            bf16_t* EGd = QK + (size_t)d * TT * 512;
#pragma unroll 4
            for (int i = 0; i < 16; ++i) { const int p = 16 * qtr + i, tok = d ? 63 - p : p; const size_t row = (size_t)(64 * rc + tok);
                const f32x4 G = *(const LAS f32x4*)(gcs + p * 512 + ch0) + off;
                u32x2 we; we.x = pk2(__expf(G[0]), __expf(G[1])); we.y = pk2(__expf(G[2]), __expf(G[3]));
                *(u32x2*)(EGd + row * 512 + ch0) = we; }
            __syncthreads();
        }
    }
}
typedef short s16x4 __attribute__((ext_vector_type(4)));
constexpr int SC_PITCH = 272, SC_QS = 0, SC_KS = 17408, SC_VS = 34816, SC_SB = 52224, SC_AS = 87040, SC_APITCH = 144, SC_OS = SC_AS + 9216;
__device__ __forceinline__ bf16x8 tr_frag(LAS unsigned char* base, int pitch, int k0, int c0, int lane) {
    const int q = (lane & 15) >> 2, p = lane & 3;
    LAS unsigned char* a = base + (k0 + q) * pitch + (c0 + 4 * p) * 2;
    const s16x4 lo = __builtin_amdgcn_ds_read_tr16_b64_v4i16((LAS s16x4*)a);
    const s16x4 hi = __builtin_amdgcn_ds_read_tr16_b64_v4i16((LAS s16x4*)(a + 4 * pitch));
    return (bf16x8){lo[0], lo[1], lo[2], lo[3], hi[0], hi[1], hi[2], hi[3]};
}
#define MFMA16(a, b, c) __builtin_amdgcn_mfma_f32_16x16x32_bf16((a), (b), (c), 0, 0, 0)
__device__ __forceinline__ int chunk_rc(int d, int b, int chn) { return chn < 4 ? (TLAT / 64) + 4 * b + (d ? 3 - chn : chn) : 64 * b + (d ? 63 - (chn - 4) : (chn - 4)); }
struct ScanSet { u32x4 q[2], k[2], v[2], e[2]; float gl[2]; };
#define GST16(ptr, val) asm volatile("global_store_dwordx4 %0, %1, off\n\ts_nop 1" :: "v"(ptr), "v"(val) : "memory")
template <int MX> __device__ __forceinline__ void scan_unit(const Frame& F, int u) {
    LAS unsigned char* L = F.lds;
    const int tid = F.tid, lane = F.lane, w = F.wave, fr = lane & 15, fq = lane >> 4, tt = tid >> 4, part = tid & 15;
    const int js = u & 1, h = (u >> 1) & 3, b = (u >> 3) & 7, d = (u >> 6) & 1;
    const bf16_t* Pq = (const bf16_t*)(F.ws + WS_P) + (MX ? C_RQ : C_GQ) + 128 * h + 8 * part; const bf16_t* Pk = Pq + 512;
    const bf16_t* Pv = (const bf16_t*)(F.ws + WS_P) + (MX ? C_RV : C_GV) + 256 * h + 128 * js + 8 * part;
    const bf16_t* EGp = (const bf16_t*)(F.ws + WS_C) + (size_t)d * TT * 512 + 128 * h + 8 * part;
    const int tmA = w >> 1, tnA = 2 * (w & 1), tmB = w & 1, tnB = w >> 1, tmS = w & 3, tnS = w >> 2;
    const float* EGLp = (const float*)(F.ws + WS_MODP) + (size_t)d * (TT / 64) * 512 + 128 * h + 32 * tmS + fr;
    bf16_t* O = (bf16_t*)(F.ws + WS_B) + (size_t)(MX * 2 + d) * TT * 1024 + 256 * h + 128 * js + 8 * part;
    float er[2] = {1.f, 1.f}, nr[2] = {1.f, 1.f}, egr = 1.0f;
    if (MX == 1) { const float x = exp2f(-5.0f - (float)h), lg = -(x + x * x * 0.5f + x * x * x * (1.0f / 3.0f) + x * x * x * x * 0.25f);
        egr = __expf(64.0f * lg); er[0] = __expf((float)(tt + 1) * lg); nr[0] = __expf(-(float)(tt + 1) * lg); er[1] = __expf((float)(tt + 33) * lg); nr[1] = __expf(-(float)(tt + 33) * lg); }
    f32x4 S[2][4];
#pragma unroll
    for (int i = 0; i < 2; ++i)
#pragma unroll
        for (int j = 0; j < 4; ++j) S[i][j] = (f32x4){0.f, 0.f, 0.f, 0.f};
    for (int i = tid; i < (128 * SC_PITCH) / 16; i += NTHR) *(LAS u32x4*)(L + SC_SB + i * 16) = (u32x4){0u, 0u, 0u, 0u};
    constexpr int NCH = (CTXL + SEQ) / 64;
    ScanSet sA, sB;
#define SC_LOAD(chn, st) do { const int rc_ = chunk_rc(d, b, (chn)); _Pragma("unroll") for (int ps = 0; ps < 2; ++ps) { const int c_ = tt + 32 * ps; const size_t row_ = (size_t)(64 * rc_ + (d ? 63 - c_ : c_)); \
        st.q[ps] = *(const u32x4*)(Pq + row_ * LDP); st.k[ps] = *(const u32x4*)(Pk + row_ * LDP); st.v[ps] = *(const u32x4*)(Pv + row_ * LDP); if (MX == 0) st.e[ps] = *(const u32x4*)(EGp + row_ * 512); } \
        if (MX == 0) { st.gl[0] = EGLp[(size_t)rc_ * 512]; st.gl[1] = EGLp[(size_t)rc_ * 512 + 16]; } } while (0)
#define SC_PUT(st) do { _Pragma("unroll") for (int ps = 0; ps < 2; ++ps) { const int c_ = tt + 32 * ps; u32x4 qo, ko; \
        _Pragma("unroll") for (int e2 = 0; e2 < 4; ++e2) { float ea, eb, na, nb; \
            if (MX == 0) { ea = bflo(st.e[ps][e2]); eb = bfhi(st.e[ps][e2]); na = __builtin_amdgcn_rcpf(ea); nb = __builtin_amdgcn_rcpf(eb); } else { ea = eb = er[ps]; na = nb = nr[ps]; } \
            qo[e2] = pk2(bflo(st.q[ps][e2]) * ea, bfhi(st.q[ps][e2]) * eb); ko[e2] = pk2(bflo(st.k[ps][e2]) * na, bfhi(st.k[ps][e2]) * nb); } \
        *(LAS u32x4*)(L + SC_QS + c_ * SC_PITCH + part * 16) = qo; *(LAS u32x4*)(L + SC_KS + c_ * SC_PITCH + part * 16) = ko; *(LAS u32x4*)(L + SC_VS + c_ * SC_PITCH + part * 16) = st.v[ps]; } } while (0)
    float eg[2] = {egr, egr}, egn[2] = {egr, egr};
    SC_LOAD(0, sA); SC_PUT(sA); if (MX == 0) { eg[0] = sA.gl[0]; eg[1] = sA.gl[1]; }
    SC_LOAD(1, sA);
    __syncthreads();
#define SC_CHUNK(ch, LS, PS) do { \
        const int rc = chunk_rc(d, b, ch); \
        SC_LOAD(((ch) + 2 < NCH ? (ch) + 2 : NCH - 1), LS); \
        {   f32x4 a[2] = {(f32x4){0.f, 0.f, 0.f, 0.f}, (f32x4){0.f, 0.f, 0.f, 0.f}}; \
        _Pragma("unroll") \
            for (int ks = 0; ks < 4; ++ks) { const bf16x8 xq = *(const LAS bf16x8*)(L + SC_QS + (16 * tmA + fr) * SC_PITCH + (32 * ks + 8 * fq) * 2); \
        _Pragma("unroll") \
                for (int j = 0; j < 2; ++j) { const bf16x8 yk = *(const LAS bf16x8*)(L + SC_KS + (16 * (tnA + j) + fr) * SC_PITCH + (32 * ks + 8 * fq) * 2); a[j] = MFMA16(yk, xq, a[j]); } } \
            const int c = 16 * tmA + fr; \
        _Pragma("unroll") \
            for (int j = 0; j < 2; ++j) { const int s0 = 16 * (tnA + j) + 4 * fq; float m[4]; \
        _Pragma("unroll") \
                for (int e = 0; e < 4; ++e) { const int s = s0 + e; const bool keep = d ? (s < c) : (s <= c); m[e] = keep ? a[j][e] : 0.f; } \
                u32x2 wv; wv.x = pk2(m[0], m[1]); wv.y = pk2(m[2], m[3]); *(LAS u32x2*)(L + SC_AS + c * SC_APITCH + s0 * 2) = wv; } } \
        __syncthreads(); \
        f32x4 o[2][2]; \
        _Pragma("unroll") \
        for (int i = 0; i < 2; ++i) \
        _Pragma("unroll") \
            for (int j = 0; j < 2; ++j) o[i][j] = (f32x4){0.f, 0.f, 0.f, 0.f}; \
        _Pragma("unroll") \
        for (int ks = 0; ks < 2; ++ks) { bf16x8 xa[2], yv[2]; \
        _Pragma("unroll") \
            for (int i = 0; i < 2; ++i) xa[i] = *(const LAS bf16x8*)(L + SC_AS + (32 * tmB + 16 * i + fr) * SC_APITCH + (32 * ks + 8 * fq) * 2); \
        _Pragma("unroll") \
            for (int j = 0; j < 2; ++j) yv[j] = tr_frag(L + SC_VS, SC_PITCH, 32 * ks + 8 * fq, 32 * tnB + 16 * j, lane); \
        _Pragma("unroll") \
            for (int i = 0; i < 2; ++i) \
        _Pragma("unroll") \
                for (int j = 0; j < 2; ++j) o[i][j] = MFMA16(yv[j], xa[i], o[i][j]); } \
        _Pragma("unroll") \
        for (int ks = 0; ks < 4; ++ks) { bf16x8 xq[2], ys[2]; \
        _Pragma("unroll") \
            for (int i = 0; i < 2; ++i) xq[i] = *(const LAS bf16x8*)(L + SC_QS + (32 * tmB + 16 * i + fr) * SC_PITCH + (32 * ks + 8 * fq) * 2); \
        _Pragma("unroll") \
            for (int j = 0; j < 2; ++j) ys[j] = tr_frag(L + SC_SB, SC_PITCH, 32 * ks + 8 * fq, 32 * tnB + 16 * j, lane); \
        _Pragma("unroll") \
            for (int i = 0; i < 2; ++i) \
        _Pragma("unroll") \
                for (int j = 0; j < 2; ++j) o[i][j] = MFMA16(ys[j], xq[i], o[i][j]); } \
        _Pragma("unroll") \
        for (int ks = 0; ks < 2; ++ks) { bf16x8 xk[2], yv[4]; \
        _Pragma("unroll") \
            for (int i = 0; i < 2; ++i) xk[i] = tr_frag(L + SC_KS, SC_PITCH, 32 * ks + 8 * fq, 32 * tmS + 16 * i, lane); \
        _Pragma("unroll") \
            for (int j = 0; j < 4; ++j) yv[j] = tr_frag(L + SC_VS, SC_PITCH, 32 * ks + 8 * fq, 64 * tnS + 16 * j, lane); \
        _Pragma("unroll") \
            for (int i = 0; i < 2; ++i) \
        _Pragma("unroll") \
                for (int j = 0; j < 4; ++j) S[i][j] = MFMA16(yv[j], xk[i], S[i][j]); } \
        __syncthreads(); \
        _Pragma("unroll") \
        for (int i = 0; i < 2; ++i) \
        _Pragma("unroll") \
            for (int j = 0; j < 2; ++j) { u32x2 wv; wv.x = pk2(o[i][j][0], o[i][j][1]); wv.y = pk2(o[i][j][2], o[i][j][3]); \
                *(LAS u32x2*)(L + SC_OS + (32 * tmB + 16 * i + fr) * SC_PITCH + (32 * tnB + 16 * j + 4 * fq) * 2) = wv; } \
        _Pragma("unroll") \
        for (int i = 0; i < 2; ++i) { const int row = 32 * tmS + 16 * i + fr; \
            _Pragma("unroll") \
            for (int j = 0; j < 4; ++j) { S[i][j] = S[i][j] * eg[i]; u32x2 wv; wv.x = pk2(S[i][j][0], S[i][j][1]); wv.y = pk2(S[i][j][2], S[i][j][3]); \
                *(LAS u32x2*)(L + SC_SB + row * SC_PITCH + (64 * tnS + 16 * j + 4 * fq) * 2) = wv; } } \
        SC_PUT(PS); if (MX == 0) { eg[0] = PS.gl[0]; eg[1] = PS.gl[1]; } \
        __syncthreads(); \
        _Pragma("unroll") \
        for (int ps = 0; ps < 2; ++ps) { const int c = tt + 32 * ps; const u32x4 v = *(const LAS u32x4*)(L + SC_OS + c * SC_PITCH + part * 16); \
            GST16(O + (size_t)(64 * rc + (d ? 63 - c : c)) * 1024, v); } \
    } while (0)
    for (int ch2 = 0; ch2 < NCH; ch2 += 2) { SC_CHUNK(ch2, sB, sA); SC_CHUNK(ch2 + 1, sA, sB); }
    (void)egn;
#undef SC_CHUNK
#undef SC_LOAD
#undef SC_PUT
    __syncthreads();
}
__device__ __forceinline__ void phase_scan_mfma(const Frame& F, int li) {
    for (int u = F.bx; u < 256; u += F.G) { if (u < 128) scan_unit<0>(F, u); else scan_unit<1>(F, u - 128); }
}


__device__ __forceinline__ void phase_finish(const Frame& F, int li, int nrows) {
    const bf16_t* P = (const bf16_t*)(F.ws + WS_P); const bf16_t* OB = (const bf16_t*)(F.ws + WS_B); const bf16_t* HB = (const bf16_t*)(F.ws + WS_E); bf16_t* A3 = (bf16_t*)(F.ws + WS_C);
    const float* gnorm = F.in[11] + (size_t)li * 1024; const float* rnorm = F.in[19] + (size_t)li * 1024;
    const size_t RS = (size_t)TT * 1024;
    for (int row = F.gw; row < nrows; row += F.NGW) {
        const bf16_t* pr = P + (size_t)row * LDP; const size_t ro = (size_t)row * 1024;
#pragma unroll
        for (int j = 0; j < 4; ++j) {
            const int c = 4 * F.lane + 256 * j;
            {
                const f32x4 o = ld4bf(OB + ro + c) + ld4bf(OB + RS + ro + c);
                const float ss = wave_sum((o[0] * o[0] + o[1] * o[1]) + (o[2] * o[2] + o[3] * o[3])); const float rs = rsqrtf(ss * (1.0f / 256.0f) + EPS);
                const f32x4 g = ld4bf(pr + C_GG + c), gn = *(const f32x4*)(gnorm + c); u32x2 w;
                w.x = pk2(o[0] * rs * gn[0] * siluf_(g[0]), o[1] * rs * gn[1] * siluf_(g[1])); w.y = pk2(o[2] * rs * gn[2] * siluf_(g[2]), o[3] * rs * gn[3] * siluf_(g[3]));
                *(u32x2*)(A3 + ro + c) = w; }
            {
                const f32x4 hh = ld4bf(HB + ro + c) + ld4bf(HB + RS + ro + c), g = ld4bf(pr + C_LG + c); u32x2 w;
                w.x = pk2(hh[0] * gelu_tanh_(g[0]), hh[1] * gelu_tanh_(g[1])); w.y = pk2(hh[2] * gelu_tanh_(g[2]), hh[3] * gelu_tanh_(g[3]));
                *(u32x2*)(A3 + RS + ro + c) = w; }
            {
                f32x4 o = ld4bf(OB + 2 * RS + ro + c) + ld4bf(OB + 3 * RS + ro + c);
                const float mean = wave_sum((o[0] + o[1]) + (o[2] + o[3])) * (1.0f / 256.0f); o = o - mean;
                const float ss = wave_sum((o[0] * o[0] + o[1] * o[1]) + (o[2] * o[2] + o[3] * o[3])); const float rs = rsqrtf(ss * (1.0f / 256.0f) + EPS);
                const f32x4 g = ld4bf(pr + C_RG + c), gn = *(const f32x4*)(rnorm + c); u32x2 w;
                w.x = pk2(o[0] * rs * gn[0] * siluf_(g[0]), o[1] * rs * gn[1] * siluf_(g[1])); w.y = pk2(o[2] * rs * gn[2] * siluf_(g[2]), o[3] * rs * gn[3] * siluf_(g[3]));
                *(u32x2*)(A3 + 2 * RS + ro + c) = w; }
        }
    }
}

__device__ __forceinline__ void phase_norm2_router(const Frame& F, int li, int ntok) {
    LAS float* wrT = (LAS float*)F.lds;
    LAS unsigned* hist = (LAS unsigned*)(F.lds + 131072); LAS unsigned* hbase = hist + 32;
    const float* wr = F.in[22] + (size_t)li * 1024 * 32; const float* br = F.in[23] + li * 32;
    for (int i = F.tid; i < 32768; i += NTHR) wrT[(i & 31) * 1024 + (i >> 5)] = wr[i];
    if (F.tid < 32) hist[F.tid] = 0u;
    __syncthreads();
    const float* xs = (const float*)(F.ws + WS_XS); const float* mods = (const float*)(F.ws + WS_MODS) + (size_t)li * 9 * 6144;
    bf16_t* xn2 = (bf16_t*)(F.ws + WS_D); int* tok_e = (int*)(F.ws + WS_TOKE); float* tok_w = (float*)(F.ws + WS_TOKW); int* tok_p = (int*)(F.ws + WS_TOKP);
    unsigned* cnt = (unsigned*)(F.ws + WS_CTL) + CW_CNT + li * 32;
    for (int row = F.gw; row < ntok; row += F.NGW) {
        const float* mp = mods + mrow_of(row) * 6144;
        const RowV y = norm_mod(load_row(xs + (size_t)row * D, F.lane), F.in[7] + (size_t)li * 1024, mp + 3 * 1024, mp + 4 * 1024, F.lane);
        store_row_bf16(xn2 + (size_t)row * D, y, F.lane);
        float lg[32];
#pragma unroll
        for (int e = 0; e < 32; ++e) { float s = 0.f;
#pragma unroll
            for (int j = 0; j < 4; ++j) { const f32x4 w = *(const LAS f32x4*)(wrT + e * 1024 + 4 * F.lane + 256 * j); s += (y.v[j][0] * w[0] + y.v[j][1] * w[1]) + (y.v[j][2] * w[2] + y.v[j][3] * w[3]); }
            lg[e] = wave_sum(s) + br[e]; }
        unsigned taken = 0u; float tl[4]; int te[4];
#pragma unroll
        for (int k = 0; k < 4; ++k) { float best = -3.0e38f; int bi = 0;
#pragma unroll
            for (int e = 0; e < 32; ++e) { const bool ok = !((taken >> e) & 1u) && lg[e] > best; best = ok ? lg[e] : best; bi = ok ? e : bi; }
            taken |= 1u << bi; tl[k] = best; te[k] = bi; }
        const float e1 = __expf(tl[1] - tl[0]), e2 = __expf(tl[2] - tl[0]), e3 = __expf(tl[3] - tl[0]); const float inv = 1.0f / (1.0f + e1 + e2 + e3);
        if (F.lane < 4) { const int k = F.lane; const int ek = k == 0 ? te[0] : k == 1 ? te[1] : k == 2 ? te[2] : te[3]; const float wk = (k == 0 ? 1.0f : k == 1 ? e1 : k == 2 ? e2 : e3) * inv;
            const unsigned lp = atomicAdd((unsigned*)&hist[ek], 1u);
            tok_e[row * 4 + k] = ek; tok_w[row * 4 + k] = wk; tok_p[row * 4 + k] = (int)lp; }
    }
    __syncthreads();
    if (F.tid < 32) hbase[F.tid] = __hip_atomic_fetch_add(cnt + F.tid, hist[F.tid], __ATOMIC_RELAXED, __HIP_MEMORY_SCOPE_AGENT);
    __syncthreads();
    for (int row = F.gw; row < ntok; row += F.NGW) if (F.lane < 4) { const int i = row * 4 + F.lane; tok_p[i] += (int)hbase[tok_e[i]]; }
    __syncthreads();
}
__device__ __forceinline__ void phase_dispatch(const Frame& F, int li, int ntok) {
    LAS unsigned* pstart = (LAS unsigned*)F.lds;
    unsigned* ctl = (unsigned*)(F.ws + WS_CTL); unsigned* cnt = ctl + CW_CNT + li * 32; unsigned* tile_e = ctl + CW_TILE + li * 1024;
    if (F.tid == 0) { unsigned ps = 0;
        for (int e = 0; e < 32; ++e) { const unsigned c = __hip_atomic_load(cnt + e, __ATOMIC_RELAXED, __HIP_MEMORY_SCOPE_AGENT), nt = (c + 255u) >> 8; pstart[e] = ps;
            if (F.bx == 0) for (unsigned j = 0; j < nt; ++j) tile_e[(ps >> 8) + j] = (unsigned)e;
            ps += nt << 8; }
        if (F.bx == 0) ctl[CW_NT + li] = ps >> 8; }
    __syncthreads();
    const int* tok_e = (const int*)(F.ws + WS_TOKE); const int* tok_p = (const int*)(F.ws + WS_TOKP); int* tok_s = (int*)(F.ws + WS_TOKS); int* slot_tok = (int*)(F.ws + WS_SLOTTOK);
    for (int it = F.gtid; it < ntok * 4; it += F.NGT) { const int slot = (int)pstart[tok_e[it]] + tok_p[it]; tok_s[it] = slot; slot_tok[slot] = it >> 2; }
    if (F.bx < 32) { const unsigned c = __hip_atomic_load(cnt + F.bx, __ATOMIC_RELAXED, __HIP_MEMORY_SCOPE_AGENT), pe = ((c + 255u) >> 8) << 8;
        for (unsigned s = c + F.tid; s < pe; s += NTHR) slot_tok[pstart[F.bx] + s] = 0; }
    __syncthreads();
}
__device__ __forceinline__ void phase_combine(const Frame& F, int li, int ntok, bool last) {
    float* xs = (float*)(F.ws + WS_XS); const bf16_t* Y = (const bf16_t*)(F.ws + WS_B); bf16_t* xn = (bf16_t*)(F.ws + WS_D);
    const float* mods = (const float*)(F.ws + WS_MODS); const float* tok_w = (const float*)(F.ws + WS_TOKW); const int* tok_s = (const int*)(F.ws + WS_TOKS);
    for (int row = F.gw; row < ntok; row += F.NGW) {
        const int mr = mrow_of(row); const float* gp = mods + ((size_t)li * 9 + mr) * 6144 + 5 * 1024;
        RowV x = load_row(xs + (size_t)row * D, F.lane);
        const int s0 = tok_s[row * 4], s1 = tok_s[row * 4 + 1], s2 = tok_s[row * 4 + 2], s3 = tok_s[row * 4 + 3];
        const float w0 = tok_w[row * 4], w1 = tok_w[row * 4 + 1], w2 = tok_w[row * 4 + 2], w3 = tok_w[row * 4 + 3];
#pragma unroll
        for (int j = 0; j < 4; ++j) { const int c = 4 * F.lane + 256 * j;
            const f32x4 y = ld4bf(Y + (size_t)s0 * 1024 + c) * w0 + ld4bf(Y + (size_t)s1 * 1024 + c) * w1 + ld4bf(Y + (size_t)s2 * 1024 + c) * w2 + ld4bf(Y + (size_t)s3 * 1024 + c) * w3;
            x.v[j] = x.v[j] + *(const f32x4*)(gp + c) * y; }
        if (!last) {
#pragma unroll
            for (int j = 0; j < 4; ++j) *(f32x4*)(xs + (size_t)row * D + 4 * F.lane + 256 * j) = x.v[j];
            const float* mp = mods + ((size_t)(li + 1) * 9 + mr) * 6144;
            const RowV y = norm_mod(x, F.in[6] + (size_t)(li + 1) * 1024, mp, mp + 1024, F.lane);
            store_row_bf16(xn + (size_t)row * D, y, F.lane);
        } else {
            const float rs = rsqrtf(row_sumsq(x) * (1.0f / D) + EPS);
#pragma unroll
            for (int j = 0; j < 4; ++j) { const int c = 4 * F.lane + 256 * j; *(f32x4*)(F.out + (size_t)row * D + c) = (x.v[j] * rs) * *(const f32x4*)(F.in[28] + c); }
        }
    }
}

#ifndef MK_SCAN_REF
#define MK_SCAN_REF 0
#endif
#ifndef MK_ONE_LAUNCH
#define MK_ONE_LAUNCH 1
#endif
constexpr int NPH_LAYER = 15, NPHASES = 2 + 2 * NPH_LAYER;
struct Args { const float* in[29]; float* out; unsigned char* ws; int ph_lo, ph_hi, region, pad; };
#ifndef MK_PHMASK
#define MK_PHMASK 0x7fff
#endif
#define IN(k) (lo <= (k) && (k) < hi)
#define EN(j) ((MK_PHMASK >> (j)) & 1)
#define SEAM(k) do { if (IN(k) && IN((k) + 1)) xcd_barrier(bar); } while (0)
#define MKF() Frame F; { GAS unsigned char* ws_ = (GAS unsigned char*)args.ws; asm volatile("" : "+s"(ws_)); F.ws = ws_; F.lds = (LAS unsigned char*)lds_raw; F.out = args.out; F.in = args.in; \
        int tid_ = threadIdx.x, bx_ = blockIdx.x; asm volatile("" : "+v"(tid_), "+s"(bx_)); F.tid = tid_; F.bx = bx_; F.lane = F.tid & 63; F.wave = __builtin_amdgcn_readfirstlane(F.tid >> 6); F.G = gridDim.x; \
        F.gw = F.bx * NWAVES + F.wave; F.NGW = F.G * NWAVES; F.gtid = F.bx * NTHR + F.tid; F.NGT = F.G * NTHR; }
template <int li> __device__ __forceinline__ void run_layer(const Args& args, unsigned char* lds_raw, const XcdBarrier& bar, const int lo, const int hi) {
        const int pb = 2 + NPH_LAYER * li; const bool last = (li == 1); const int nrows = last ? TLAT : TT, nMt = nrows / 256;
        if (EN(0) && IN(pb + 0)) { MKF(); phase_W(F, li); if (li == 0) phase_norm_in(F); __syncthreads(); }
        SEAM(pb + 0);
        if (EN(1) && IN(pb + 1)) { MKF(); unsigned* ctl = (unsigned*)(F.ws + WS_CTL); (void)ctl;
            pg8::Gemm g{1024, 1024, 1024}; PlainOrder S; S.A = (const char*)(F.ws + WS_D); S.B = (const char*)(F.ws + WS_WIN); S.astep = 256 * 1024 * 2; S.bstep = 256 * 1024 * 2; S.nM = TT / 256; S.nN = LDP / 256; S.G = F.G; S.c = F.bx;
            EpiBf16Bias E{(bf16_t*)(F.ws + WS_P), LDP, nullptr, 0};
            pg8::gemm_phase<EpiBf16Bias, PlainOrder, true, true>(F.lds, g, S, E);
        }
        SEAM(pb + 1);
        if (EN(2) && IN(pb + 2)) { MKF(); phase_conv(F, li); phase_scanprep(F, li); }
        SEAM(pb + 2);
        if (EN(3) && IN(pb + 3)) { MKF(); phase_scan_mfma(F, li); }
        SEAM(pb + 3);
        if (EN(4) && IN(pb + 4)) { MKF(); unsigned* ctl = (unsigned*)(F.ws + WS_CTL); (void)ctl;
            pg8::Gemm g{1024, 256, 256}; LruOrder S; S.A = (const char*)(F.ws + WS_D); S.B = (const char*)(F.ws + WS_WLRU); S.nM = TT / 256; S.G = F.G; S.c = F.bx;
            EpiLru E{(const bf16_t*)(F.ws + WS_D), (bf16_t*)(F.ws + WS_C), (bf16_t*)(F.ws + WS_C + 2 * ROWB), F.in[15] + (size_t)li * 2048, F.in[17] + (size_t)li * 2048, (const float*)(F.ws + WS_LSL)};
            pg8::gemm_phase<EpiLru, LruOrder, true, true>(F.lds, g, S, E);
        }
        SEAM(pb + 4);
        if (EN(5) && IN(pb + 5)) { MKF(); phase_lru_scan<false>(F); }
        SEAM(pb + 5);
        if (EN(6) && IN(pb + 6)) { MKF(); phase_lru_scan<true>(F); }
        SEAM(pb + 6);
        if (EN(7) && IN(pb + 7)) { MKF(); phase_finish(F, li, nrows); }
        SEAM(pb + 7);
        if (EN(8) && IN(pb + 8)) { MKF(); unsigned* ctl = (unsigned*)(F.ws + WS_CTL); (void)ctl;
            pg8::Gemm g{1024, 1024, 1024}; BranchOrder S; S.A = (const char*)(F.ws + WS_C); S.B = (const char*)(F.ws + WS_WBR); S.nM = nMt; S.G = F.G; S.c = F.bx;
            EpiBranch E{(const bf16_t*)(F.ws + WS_P), (bf16_t*)(F.ws + WS_B)};
            pg8::gemm_phase<EpiBranch, BranchOrder, true, true>(F.lds, g, S, E);
        }
        SEAM(pb + 8);
        if (EN(9) && IN(pb + 9)) { MKF(); unsigned* ctl = (unsigned*)(F.ws + WS_CTL); (void)ctl;
            pg8::Gemm g{1024, 1024, 1024}; PlainOrder S; S.A = (const char*)(F.ws + WS_B + 2 * ROWB); S.B = (const char*)(F.ws + WS_WOUT); S.astep = 256 * 1024 * 2; S.bstep = 256 * 1024 * 2; S.nM = nMt; S.nN = 4; S.G = F.G; S.c = F.bx;
            float* xs = (float*)(F.ws + WS_XS);
            EpiOut E{li == 0 ? F.in[0] : xs, li == 0 ? F.in[2] : xs + (size_t)TLAT * D, xs, (const float*)(F.ws + WS_MODS) + (size_t)li * 9 * 6144 + 2 * 1024};
            pg8::gemm_phase<EpiOut, PlainOrder, true, true>(F.lds, g, S, E);
        }
        SEAM(pb + 9);
        if (EN(10) && IN(pb + 10)) { MKF(); phase_norm2_router(F, li, nrows); }
        SEAM(pb + 10);
        if (EN(11) && IN(pb + 11)) { MKF(); phase_dispatch(F, li, nrows); }
        SEAM(pb + 11);
        if (EN(12) && IN(pb + 12)) { MKF(); unsigned* ctl = (unsigned*)(F.ws + WS_CTL); (void)ctl;
            pg8::Gemm g{1024, 1024, 1024}; MoeOrder S; S.A = (const char*)(F.ws + WS_D); S.rowidx = (const int*)(F.ws + WS_SLOTTOK); S.B = (const char*)(F.ws + WS_WGU); S.tile_e = ctl + CW_TILE + li * 1024; S.estep = (size_t)2048 * 1024 * 2;
            S.nM = (int)ctl[CW_NT + li]; S.nN = 8; S.G = F.G; S.c = F.bx; S.ga = 1;
            EpiSwiglu E{(bf16_t*)(F.ws + WS_P + 288 * MiB), F.in[25] + (size_t)li * 32 * 2048};
            pg8::gemm_phase<EpiSwiglu, MoeOrder, true, true, true>(F.lds, g, S, E);
        }
        SEAM(pb + 12);
        if (EN(13) && IN(pb + 13)) { MKF(); unsigned* ctl = (unsigned*)(F.ws + WS_CTL); (void)ctl;
            pg8::Gemm g{1024, 1024, 1024}; MoeOrder S; S.A = (const char*)(F.ws + WS_P + 288 * MiB); S.B = (const char*)(F.ws + WS_WDN); S.tile_e = ctl + CW_TILE + li * 1024; S.estep = (size_t)1024 * 1024 * 2;
            S.nM = (int)ctl[CW_NT + li]; S.nN = 4; S.G = F.G; S.c = F.bx; S.ga = 0; S.rowidx = nullptr;
            EpiBf16Bias E{(bf16_t*)(F.ws + WS_B), 1024, F.in[27] + (size_t)li * 32 * 1024, 1024};
            pg8::gemm_phase<EpiBf16Bias, MoeOrder, true, true>(F.lds, g, S, E);
        }
        SEAM(pb + 13);
        if (EN(14) && IN(pb + 14)) { MKF(); phase_combine(F, li, nrows, last); }
        SEAM(pb + 14);
    }
__global__ void __launch_bounds__(NTHR, 2) mk_fwd(Args args) {
    extern __shared__ __attribute__((aligned(16))) unsigned char lds_raw[];
    const int tid0 = threadIdx.x;
    volatile LAS unsigned* MISC = (volatile LAS unsigned*)((LAS unsigned char*)lds_raw + MISC_OFF);
    if (tid0 < 32) MISC[tid0] = 0u;
    __syncthreads();
    unsigned* ctl0 = (unsigned*)(args.ws + WS_CTL);
    const int lo = args.ph_lo, hi = args.ph_hi;
    XcdBarrier bar; bar.bar = ctl0 + CW_BAR + args.region * 4096; bar.x = 0; bar.st = MISC + 8;
    if (hi - lo > 1) bar = xcd_barrier_post(ctl0 + CW_BAR + args.region * 4096, MISC + 8);

    if (IN(0)) { MKF(); phase_proA(F); }
    SEAM(0);
    if (IN(1)) { MKF(); phase_proB(F); }
    SEAM(1);
    run_layer<0>(args, lds_raw, bar, lo, hi);
    run_layer<1>(args, lds_raw, bar, lo, hi);
}

extern "C" void kernel_launch(void* const* d_in, const int* in_sizes, int n_in, void* d_out, int out_size, void* d_ws, size_t ws_size, hipStream_t stream) {
    static int grid = 0;
    if (grid == 0) {
        if (n_in != 29 || ws_size < WS_END || out_size != TLAT * D) { fprintf(stderr, "kernel_launch: unexpected problem: n_in %d ws %zu out %d\n", n_in, ws_size, out_size); grid = -1; return; }
        int dev = 0, cus = 0;
        if (hipGetDevice(&dev) != hipSuccess || hipDeviceGetAttribute(&cus, hipDeviceAttributeMultiprocessorCount, dev) != hipSuccess) { grid = -1; return; }
        if (hipFuncSetAttribute((const void*)mk_fwd, hipFuncAttributeMaxDynamicSharedMemorySize, LDS_BYTES) != hipSuccess) { fprintf(stderr, "kernel_launch: hipFuncSetAttribute failed\n"); grid = -1; return; }
        int per_cu = 0;
        if (hipOccupancyMaxActiveBlocksPerMultiprocessor(&per_cu, (const void*)mk_fwd, NTHR, LDS_BYTES) != hipSuccess || per_cu < 1) fprintf(stderr, "kernel_launch: occupancy query reports %d\n", per_cu);
        (void)hipGetLastError();
        grid = cus;
    }
    if (grid < 0) return;
    (void)hipMemsetAsync((char*)d_ws + WS_CTL, 0, CTL_BYTES, stream);
    Args a{};
    for (int i = 0; i < 29; ++i) a.in[i] = (const float*)d_in[i];
    a.out = (float*)d_out; a.ws = (unsigned char*)d_ws;
#if MK_ONE_LAUNCH
    a.ph_lo = 0; a.ph_hi = NPHASES; a.region = 0;
    hipLaunchKernelGGL(mk_fwd, dim3(grid), dim3(NTHR), LDS_BYTES, stream, a);
#else
    for (int p = 0; p < NPHASES; ++p) { a.ph_lo = p; a.ph_hi = p + 1; a.region = 0; hipLaunchKernelGGL(mk_fwd, dim3(grid), dim3(NTHR), LDS_BYTES, stream, a); }
#endif
}
```

```cpp
#include <hip/hip_runtime.h>
#include <cstdio>
#include <cstdint>

#define LAS __attribute__((address_space(3)))
typedef unsigned short bf16_t;
typedef short bf16x8 __attribute__((ext_vector_type(8)));
typedef float f32x4 __attribute__((ext_vector_type(4)));
typedef float f32x2 __attribute__((ext_vector_type(2)));
typedef unsigned u32x4 __attribute__((ext_vector_type(4)));
typedef unsigned u32x2 __attribute__((ext_vector_type(2)));

constexpr int D = 1024, NBATCH = 8, SEQ = 4096, CTXL = 256;
constexpr int TLAT = NBATCH * SEQ, TCTX = NBATCH * CTXL, TT = TLAT + TCTX;
constexpr int LDP = 11520;
constexpr int C_GQ = 0, C_GK = 512, C_GV = 1024, C_GG = 2048, C_LX = 3072, C_LG = 4096, C_RQ = 5120, C_RK = 5632, C_RV = 6144, C_RG = 7168, C_MG = 8192, C_LR = 11264;
constexpr int IN_TOTAL = 11296, NE = 32;
constexpr int SLOT_TILES_MAX = 576;
constexpr float EPS = 1e-6f;

constexpr size_t MiB = (size_t)1 << 20;
constexpr size_t WS_CTL = 0, CTL_BYTES = 1 * MiB;
constexpr size_t WS_MODP = 1 * MiB, WS_MODS = 5 * MiB, WS_COS = 6 * MiB, WS_SIN = 7 * MiB, WS_LSL = 8 * MiB, WS_CARA = 9 * MiB, WS_CARH = 11 * MiB;
constexpr size_t WS_SLOTTOK = 8 * MiB + 256 * 1024;
constexpr size_t WS_TOKE = 13 * MiB, WS_TOKW = WS_TOKE + 768 * 1024, WS_TOKP = WS_TOKW + 768 * 1024, WS_TOKS = WS_TOKP + 768 * 1024;
constexpr size_t WS_WIN = 16 * MiB, WS_WLRU = 39 * MiB, WS_WBR = 41 * MiB, WS_WOUT = 47 * MiB, WS_WGU = 49 * MiB, WS_WDN = 177 * MiB;
constexpr size_t WS_XS = 241 * MiB, WS_P = 377 * MiB, WS_B = 1142 * MiB, WS_C = 1430 * MiB, WS_D = 1702 * MiB, WS_E = 1770 * MiB, WS_END = 1906 * MiB;
constexpr size_t ROWB = (size_t)TT * D * 2;
static_assert(ROWB == 68 * MiB, "row buffer");
constexpr int CW_CNT = 1024, CW_NT = 1024 + 128, CW_TILE = 2048, CW_BAR = 8192;

__device__ __forceinline__ float bflo(unsigned w) { return __uint_as_float(w << 16); }
__device__ __forceinline__ float bfhi(unsigned w) { return __uint_as_float(w & 0xffff0000u); }
typedef __bf16 bf16x2_t __attribute__((ext_vector_type(2)));
__device__ __forceinline__ unsigned pk2(float lo, float hi) { const bf16x2_t v = __builtin_convertvector((f32x2){lo, hi}, bf16x2_t); return __builtin_bit_cast(unsigned, v); }
__device__ __forceinline__ float sigmoidf_(float x) { return __builtin_amdgcn_rcpf(1.0f + __expf(-x)); }
__device__ __forceinline__ float siluf_(float x) { return x * sigmoidf_(x); }
__device__ __forceinline__ float logsigmoidf_(float z) { return fminf(z, 0.f) - __logf(1.0f + __expf(-fabsf(z))); }
__device__ __forceinline__ float gelu_tanh_(float x) { const float u = 0.7978845608028654f * (x + 0.044715f * x * x * x); const float t = 1.0f - 2.0f * __builtin_amdgcn_rcpf(__expf(2.0f * u) + 1.0f); return 0.5f * x * (1.0f + t); }
__device__ __forceinline__ float wave_sum(float v) {
#pragma unroll
    for (int o = 1; o < 64; o <<= 1) v += __shfl_xor(v, o);
    return v;
}
#define LDS_WAIT() asm volatile("s_waitcnt lgkmcnt(0)" ::: "memory")

namespace pg8 {
#define PG8_LAS __attribute__((address_space(3)))
constexpr int BM = 256, BK = 64, HALF = 128, HTB = HALF * BK * 2, STAGE_BYTES = 8 * HTB, NXCD = 8, WGM = 8;
__host__ __device__ __forceinline__ int lds_byte(int r, int c) { const int st = (r >> 4) * 2 + (c >> 5), rr = r & 15, cc = c & 31, ob = rr * 64 + cc * 2; return st * 1024 + (ob ^ (((ob >> 9) & 1) << 5)); }
__host__ __device__ __forceinline__ void stage_rc(int b, int& R, int& C) { const int st = b / 1024, sb = b % 1024, swz = sb ^ (((sb >> 9) & 1) << 5); R = (st >> 1) * 16 + swz / 64; C = (st & 1) * 32 + (swz % 64) / 2; }
__host__ __device__ __forceinline__ int perm32(int rho) { const int n = rho >> 4, i = rho & 15; return 8 * (i >> 2) + 4 * n + (i & 3); }
struct Unit { int pm, pn, aux; const char* a; const char* b; };
struct Gemm { int lda, ldb, K; };
__device__ __forceinline__ void tile_of(int L, int nM, int nN, int& pm, int& pn) {
    const int nwg = nM * nN; int wgid = L; { const int q = nwg / NXCD, r = nwg % NXCD, xcd = wgid % NXCD, off = wgid / NXCD; wgid = (xcd < r ? xcd * (q + 1) : r * (q + 1) + (xcd - r) * q) + off; }
    const int nig = WGM * nN, gid = wgid / nig, fm = gid * WGM, gsz = (nM - fm) < WGM ? (nM - fm) : WGM;
    pm = fm + ((wgid % nig) % gsz); pn = (wgid % nig) / gsz;
}
__device__ __forceinline__ unsigned cvt_pk_bf16(float lo, float hi) { unsigned r; asm volatile("v_cvt_pk_bf16_f32 %0, %1, %2" : "=v"(r) : "v"(lo), "v"(hi)); return r; }
template <class Epi, class Sched, bool ALIGN_EPI = false, bool SP2 = false, bool GATHER = false>
__device__ __forceinline__ void gemm_phase(PG8_LAS unsigned char* lds, const Gemm g, const Sched& S, const Epi& E) {
    int tid_o = threadIdx.x; asm volatile("" : "+v"(tid_o));
    const int tid = tid_o, wid = __builtin_amdgcn_readfirstlane(tid >> 6), lane = tid & 63, wr = wid >> 2, wc = wid & 3, fr = lane & 15, fq = lane >> 4;
    const int K = g.K, nt = K / BK;
    unsigned voffA[2], voffB[2];
#pragma unroll
    for (int i = 0; i < 2; ++i) { int R, C; stage_rc(tid * 16 + i * 8192, R, C); const int Rb = Epi::PERM ? ((R & ~31) + perm32(R & 31)) : R;
        voffA[i] = (unsigned)(R * g.lda + C) * 2u; voffB[i] = (unsigned)(Rb * g.ldb + C) * 2u; }
    unsigned gA[2][2] = {{0u, 0u}, {0u, 0u}}, gN[2][2] = {{0u, 0u}, {0u, 0u}}; int gR[2], gC[2];
#pragma unroll
    for (int i = 0; i < 2; ++i) stage_rc(tid * 16 + i * 8192, gR[i], gC[i]);
#define PG8_GOFF(dst, u_) do { if constexpr (GATHER) { _Pragma("unroll") for (int h_ = 0; h_ < 2; ++h_) _Pragma("unroll") for (int i_ = 0; i_ < 2; ++i_) \
        dst[h_][i_] = (unsigned)S.rowidx[(u_).pm * BM + h_ * HALF + gR[i_]] * (unsigned)(g.lda * 2) + (unsigned)(gC[i_] * 2); } } while (0)
    const size_t kstep = (size_t)(BK * 2);
    const size_t hstepA = (size_t)HALF * g.lda * 2, hstepB = (size_t)HALF * g.ldb * 2;
    const unsigned ldsw = (unsigned)wid * 1024u;
    const int aoff = lds_byte(wr * 64 + fr, fq * 8), boff = lds_byte(wc * 32 + fr, fq * 8);
#define PG8_SA(b, h) (((b) * 2 + (h)) * HTB)
#define PG8_SB(b, h) ((4 + (b) * 2 + (h)) * HTB)
#define PG8_STAGE(bufoff, gbase, voff) do { _Pragma("unroll") for (int _i = 0; _i < 2; ++_i) \
        __builtin_amdgcn_global_load_lds((const unsigned*)((const char*)(gbase) + (voff)[_i]), (PG8_LAS unsigned*)(lds + (bufoff) + ldsw + _i * 8192), 16, 0, 0); } while (0)
#define PG8_STAGE_A(bufoff, gbase, H, NX) do { if constexpr (GATHER) { _Pragma("unroll") for (int _i = 0; _i < 2; ++_i) { const unsigned o_ = (NX) ? gN[H][_i] : gA[H][_i]; \
        __builtin_amdgcn_global_load_lds((const unsigned*)((const char*)(gbase) + o_), (PG8_LAS unsigned*)(lds + (bufoff) + ldsw + _i * 8192), 16, 0, 0); } } \
        else { PG8_STAGE(bufoff, (gbase) + (H) * hstepA, voffA); } } while (0)
#define PG8_LDA(dst, b, h) do { _Pragma("unroll") for (int m = 0; m < 4; ++m) _Pragma("unroll") for (int k = 0; k < 2; ++k) dst[m][k] = *(const PG8_LAS bf16x8*)(lds + PG8_SA(b, h) + aoff + m * 2048 + k * 1024); } while (0)
#define PG8_LDB(dst, b, h) do { _Pragma("unroll") for (int n = 0; n < 2; ++n) _Pragma("unroll") for (int k = 0; k < 2; ++k) dst[n][k] = *(const PG8_LAS bf16x8*)(lds + PG8_SB(b, h) + boff + n * 2048 + k * 1024); } while (0)
#define PG8_MMA(ai, bj, At, Bt) do { __builtin_amdgcn_s_setprio(1); _Pragma("unroll") for (int m = 0; m < 4; ++m) _Pragma("unroll") for (int n = 0; n < 2; ++n) _Pragma("unroll") for (int k = 0; k < 2; ++k) \
        acc[ai][bj][m][n] = __builtin_amdgcn_mfma_f32_16x16x32_bf16(Bt[n][k], At[m][k], acc[ai][bj][m][n], 0, 0, 0); __builtin_amdgcn_s_setprio(0); } while (0)
#define PG8_WAIT_V(n) asm volatile("s_waitcnt vmcnt(" #n ")" ::: "memory")
#define PG8_WAIT_L(n) asm volatile("s_waitcnt lgkmcnt(" #n ")" ::: "memory")
#define PG8_BAR __builtin_amdgcn_s_barrier()
#define PG8_SCHED __builtin_amdgcn_sched_barrier(0)
    Unit cur, nxt; int ui = 0;
    if (!S.next(0, cur)) return;
    f32x4 acc[2][2][4][2];
#pragma unroll
    for (int a = 0; a < 2; ++a)
#pragma unroll
        for (int b = 0; b < 2; ++b)
#pragma unroll
            for (int m = 0; m < 4; ++m)
#pragma unroll
                for (int n = 0; n < 2; ++n) acc[a][b][m][n] = (f32x4){0.f, 0.f, 0.f, 0.f};
    bf16x8 At[4][2], B0[2][2], B1[2][2];
    const char* cA = cur.a; const char* cB = cur.b;
    S.a_ready(cur);
    PG8_GOFF(gA, cur);
    if constexpr (SP2) {
        PG8_STAGE(PG8_SB(0, 0), cB, voffB); PG8_STAGE(PG8_SB(0, 1), cB + hstepB, voffB); PG8_STAGE_A(PG8_SA(0, 0), cA, 0, false); PG8_STAGE_A(PG8_SA(0, 1), cA, 1, false);
        if (wr == 1) PG8_BAR;
        PG8_WAIT_V(2); PG8_BAR;
        PG8_STAGE(PG8_SB(1, 0), cB + kstep, voffB); PG8_STAGE_A(PG8_SA(1, 0), cA + kstep, 0, false); PG8_STAGE(PG8_SB(1, 1), cB + hstepB + kstep, voffB);
        PG8_WAIT_V(6); PG8_BAR;
    } else {
        PG8_STAGE(PG8_SB(0, 0), cB, voffB); PG8_STAGE_A(PG8_SA(0, 0), cA, 0, false); PG8_STAGE(PG8_SB(0, 1), cB + hstepB, voffB); PG8_STAGE_A(PG8_SA(0, 1), cA, 1, false);
        if (wr == 1) PG8_BAR;
        PG8_WAIT_V(4); PG8_BAR;
        PG8_STAGE(PG8_SB(1, 0), cB + kstep, voffB); PG8_STAGE_A(PG8_SA(1, 0), cA + kstep, 0, false); PG8_STAGE(PG8_SB(1, 1), cB + hstepB + kstep, voffB);
        PG8_WAIT_V(6); PG8_BAR;
    }
    for (;;) {
        const bool has_next = S.next(ui + 1, nxt);
        if (has_next) PG8_GOFF(gN, nxt);
        const char* nA = has_next ? nxt.a : cA; const char* nB = has_next ? nxt.b : cB;
        for (int t = 0; t < nt; t += 2) {
            const bool last = (t == nt - 2); const bool nx_ = last && has_next;
            const char* a1 = cA + (size_t)(t + 1) * kstep;
            const char* a2 = last ? nA : cA + (size_t)(t + 2) * kstep; const char* b2 = last ? nB : cB + (size_t)(t + 2) * kstep;
            const char* a3 = a2 + kstep; const char* b3 = b2 + kstep;
            if (last && has_next) S.a_ready(nxt);
            if constexpr (SP2) {
            PG8_LDB(B0, 0, 0); PG8_LDB(B1, 0, 1); PG8_SCHED; PG8_LDA(At, 0, 0); PG8_STAGE_A(PG8_SA(1, 1), a1, 1, false);
            PG8_WAIT_V(8); PG8_WAIT_L(0); PG8_BAR; PG8_MMA(0, 0, At, B0); PG8_MMA(0, 1, At, B1); PG8_BAR; PG8_SCHED;
            PG8_LDA(At, 0, 1); PG8_STAGE(PG8_SB(0, 0), b2, voffB); PG8_STAGE(PG8_SB(0, 1), b2 + hstepB, voffB); PG8_STAGE_A(PG8_SA(0, 0), a2, 0, nx_);
            PG8_WAIT_V(8); PG8_WAIT_L(0); PG8_BAR; PG8_MMA(1, 0, At, B0); PG8_MMA(1, 1, At, B1); PG8_BAR; PG8_SCHED;
            PG8_LDB(B0, 1, 0); PG8_LDB(B1, 1, 1); PG8_SCHED; PG8_LDA(At, 1, 0); PG8_STAGE_A(PG8_SA(0, 1), a2, 1, nx_);
            PG8_WAIT_V(8); PG8_WAIT_L(0); PG8_BAR; PG8_MMA(0, 0, At, B0); PG8_MMA(0, 1, At, B1); PG8_BAR; PG8_SCHED;
            PG8_LDA(At, 1, 1); PG8_STAGE(PG8_SB(1, 0), b3, voffB); PG8_STAGE(PG8_SB(1, 1), b3 + hstepB, voffB); PG8_STAGE_A(PG8_SA(1, 0), a3, 0, nx_);
            PG8_WAIT_V(8); PG8_WAIT_L(0); PG8_BAR; PG8_MMA(1, 0, At, B0); PG8_MMA(1, 1, At, B1); PG8_BAR; PG8_SCHED;
            } else {
            PG8_LDB(B0, 0, 0); PG8_SCHED; PG8_LDA(At, 0, 0); PG8_STAGE_A(PG8_SA(1, 1), a1, 1, false);
            PG8_WAIT_L(8); PG8_BAR; PG8_WAIT_L(0); PG8_MMA(0, 0, At, B0); PG8_BAR; PG8_SCHED;
            PG8_LDB(B1, 0, 1); PG8_STAGE(PG8_SB(0, 0), b2, voffB);
            PG8_BAR; PG8_WAIT_L(0); PG8_MMA(0, 1, At, B1); PG8_BAR;
            PG8_LDA(At, 0, 1); PG8_STAGE_A(PG8_SA(0, 0), a2, 0, nx_);
            PG8_BAR; PG8_WAIT_L(0); PG8_MMA(1, 0, At, B0); PG8_BAR; PG8_SCHED;
            PG8_STAGE(PG8_SB(0, 1), b2 + hstepB, voffB);
            PG8_WAIT_V(6); PG8_BAR; PG8_MMA(1, 1, At, B1); PG8_BAR;
            PG8_LDB(B0, 1, 0); PG8_SCHED; PG8_LDA(At, 1, 0); PG8_STAGE_A(PG8_SA(0, 1), a2, 1, nx_);
            PG8_WAIT_L(8); PG8_BAR; PG8_WAIT_L(0); PG8_MMA(0, 0, At, B0); PG8_BAR; PG8_SCHED;
            PG8_LDB(B1, 1, 1); PG8_STAGE(PG8_SB(1, 0), b3, voffB);
            PG8_BAR; PG8_WAIT_L(0); PG8_MMA(0, 1, At, B1); PG8_BAR;
            PG8_LDA(At, 1, 1); PG8_STAGE_A(PG8_SA(1, 0), a3, 0, nx_);
            PG8_BAR; PG8_WAIT_L(0); PG8_MMA(1, 0, At, B0); PG8_BAR; PG8_SCHED;
            PG8_STAGE(PG8_SB(1, 1), b3 + hstepB, voffB);
            PG8_WAIT_V(6); PG8_BAR; PG8_MMA(1, 1, At, B1); PG8_BAR;
            }
        }
        if constexpr (ALIGN_EPI) { if (wr == 0) PG8_BAR; }
        if constexpr (!Epi::AFTER_DRAIN) { E(acc, cur, wr, wc, fr, fq); S.done(cur); }
        if (!has_next) break;
#pragma unroll
        for (int a = 0; a < 2; ++a)
#pragma unroll
            for (int b = 0; b < 2; ++b)
#pragma unroll
                for (int m = 0; m < 4; ++m)
#pragma unroll
                    for (int n = 0; n < 2; ++n) acc[a][b][m][n] = (f32x4){0.f, 0.f, 0.f, 0.f};
        cur = nxt; cA = nA; cB = nB; ++ui;
        if constexpr (GATHER) { _Pragma("unroll") for (int h_ = 0; h_ < 2; ++h_) _Pragma("unroll") for (int i_ = 0; i_ < 2; ++i_) gA[h_][i_] = gN[h_][i_]; }
        if constexpr (ALIGN_EPI) { if (wr == 1) PG8_BAR; }
    }
    PG8_WAIT_V(0);
    if constexpr (!ALIGN_EPI) { if (wr == 0) PG8_BAR; }
    PG8_BAR;
    if constexpr (Epi::AFTER_DRAIN) { E.fused(acc, cur, wr, wc, fr, fq, lds, wid, lane); S.done(cur); }
#undef PG8_SA
#undef PG8_SB
#undef PG8_STAGE
#undef PG8_STAGE_A
#undef PG8_GOFF
#undef PG8_LDA
#undef PG8_LDB
#undef PG8_MMA
#undef PG8_WAIT_V
#undef PG8_WAIT_L
#undef PG8_BAR
#undef PG8_SCHED
}
}

#define GAS __attribute__((address_space(1)))
typedef GAS unsigned gu32;
#define RLX_AGENT __ATOMIC_RELAXED, __HIP_MEMORY_SCOPE_AGENT
#define XB_TMO      128
#define XB_XCNT(j)  (256  + 64 * (j))
#define XB_XSUB(j)  (1280 + 64 * (j))
#define XB_XGEN(j)  (2304 + 64 * (j))
#define XB_TOP      3328
#define XB_TOPGEN   3392
#define XCD_BAR_WORDS 3456
#define XB_SPIN_CAP (1u << 18)

__device__ __forceinline__ unsigned xb_ld(unsigned* p)              { return __hip_atomic_load(p, __ATOMIC_RELAXED, __HIP_MEMORY_SCOPE_AGENT); }
__device__ __forceinline__ unsigned xb_add(unsigned* p, unsigned v) { return __hip_atomic_fetch_add(p, v, __ATOMIC_RELAXED, __HIP_MEMORY_SCOPE_AGENT); }
__device__ __forceinline__ unsigned xb_xcc_id() { return (unsigned)__builtin_amdgcn_s_getreg((3 << 11) | 20) & 0xFu; }
#define XB_SPIN(cond, bar) do { unsigned _sp = 0; while (cond) { __builtin_amdgcn_s_sleep(1); \
    if ((++_sp & 255u) == 0u) { if (xb_ld(&(bar)[XB_TMO])) break; if (_sp > XB_SPIN_CAP) { atomicAdd(&(bar)[XB_TMO], 1u); break; } } } } while (0)

struct XcdBarrier {
    unsigned* bar; unsigned x;
    volatile LAS unsigned* st;
};

__device__ __forceinline__ XcdBarrier xcd_barrier_post(unsigned* bar, volatile LAS unsigned* st) {
    XcdBarrier b; b.bar = bar; b.x = xb_xcc_id(); b.st = st;
    if (threadIdx.x == 0) (void)xb_add(&bar[XB_XCNT(b.x)], 1u);
    return b;
}
__device__ __forceinline__ void xcd_barrier_complete(unsigned* bar, unsigned x, unsigned& nloc, unsigned& nx) {
    const unsigned G = gridDim.x * gridDim.y * gridDim.z;
    unsigned sum, cnt, mine, sp = 0u;
    for (;;) {
        sum = 0u; cnt = 0u; mine = 0u;
#pragma unroll
        for (unsigned j = 0; j < 16; ++j) { const unsigned c = xb_ld(&bar[XB_XCNT(j)]); sum += c; cnt += (c > 0u) ? 1u : 0u; mine = (j == x) ? c : mine; }
        if (sum == G) break;
        __builtin_amdgcn_s_sleep(1);
        if ((++sp & 255u) == 0u) { if (xb_ld(&bar[XB_TMO])) break; if (sp > XB_SPIN_CAP) { atomicAdd(&bar[XB_TMO], 1u); break; } }
    }
    nloc = mine > 0u ? mine : 1u; nx = cnt > 0u ? cnt : 1u;
}

__device__ __forceinline__ void xcd_barrier(const XcdBarrier& b) {
    asm volatile("s_waitcnt vmcnt(0)" ::: "memory");
    __syncthreads();
    if (threadIdx.x == 0) {
        unsigned* bar = b.bar;
        __builtin_amdgcn_s_waitcnt(0);
        unsigned nloc = b.st[0], nx = b.st[1];
        if (nloc == 0u) { xcd_barrier_complete(bar, b.x, nloc, nx); b.st[0] = nloc; b.st[1] = nx; }
        const unsigned old = xb_add(&bar[XB_XSUB(b.x)], 1u);
        const unsigned gen = old / nloc;
        if (old + 1u == (gen + 1u) * nloc) {
            __builtin_amdgcn_fence(__ATOMIC_RELEASE, "agent");
            asm volatile("s_waitcnt vmcnt(0)" ::: "memory");
            const unsigned og = xb_add(&bar[XB_TOP], 1u);
            const unsigned tg = og / nx;
            if (og + 1u == (tg + 1u) * nx) xb_add(&bar[XB_TOPGEN], 1u);
            else XB_SPIN(xb_ld(&bar[XB_TOPGEN]) == tg, bar);
            __builtin_amdgcn_fence(__ATOMIC_ACQUIRE, "agent");
            xb_add(&bar[XB_XGEN(b.x)], 1u);
            asm volatile("s_waitcnt vmcnt(0)" ::: "memory");
        } else {
            XB_SPIN(xb_ld(&bar[XB_XGEN(b.x)]) == gen, bar);
            __builtin_amdgcn_fence(__ATOMIC_ACQUIRE, "agent");
            asm volatile("s_waitcnt vmcnt(0)" ::: "memory");
        }
    }
    __syncthreads();
}

struct OrderBase {
    const int* rowidx;
    __device__ __forceinline__ void a_ready(const pg8::Unit&) const {}
    __device__ __forceinline__ void done(const pg8::Unit&) const {}
};
struct PlainOrder : OrderBase {
    const char* A; const char* B; size_t astep, bstep; int nM, nN, G, c;
    __device__ __forceinline__ bool next(int i, pg8::Unit& u) const {
        const long L = (long)i * G + c; if (L >= (long)nM * nN) return false;
        pg8::tile_of((int)L, nM, nN, u.pm, u.pn); u.aux = 0; u.a = A + (size_t)u.pm * astep; u.b = B + (size_t)u.pn * bstep; return true; }
};
struct LruOrder : OrderBase {
    const char* A; const char* B; int nM, G, c;
    __device__ __forceinline__ bool next(int i, pg8::Unit& u) const {
        const long L = (long)i * G + c; if (L >= (long)nM * 16) return false;
        pg8::tile_of((int)L, nM, 16, u.pm, u.pn); u.aux = 0; u.a = A + (size_t)u.pm * (256 * 1024 * 2) + (size_t)(u.pn >> 2) * 512; u.b = B + (size_t)u.pn * (256 * 256 * 2); return true; }
};
struct BranchOrder : OrderBase {
    const char* A; const char* B; int nM, G, c;
    __device__ __forceinline__ bool next(int i, pg8::Unit& u) const {
        const int j = i / 3, br = i - 3 * j; const long L = (long)j * G + c; if (L >= (long)nM * 4) return false;
        pg8::tile_of((int)L, nM, 4, u.pm, u.pn); u.aux = br; u.a = A + (size_t)br * ROWB + (size_t)u.pm * (256 * 1024 * 2); u.b = B + (size_t)br * (1024 * 1024 * 2) + (size_t)u.pn * (256 * 1024 * 2); return true; }
};
struct MoeOrder : OrderBase {
    const char* A; const char* B; const unsigned* tile_e; size_t estep; int nM, nN, G, c, ga;
    __device__ __forceinline__ bool next(int i, pg8::Unit& u) const {
        const long L = (long)i * G + c; if (L >= (long)nM * nN) return false;
        pg8::tile_of((int)L, nM, nN, u.pm, u.pn); const int e = (int)tile_e[u.pm]; u.aux = e;
        u.a = ga ? A : A + (size_t)u.pm * (256 * 1024 * 2); u.b = B + (size_t)e * estep + (size_t)u.pn * (256 * 1024 * 2); return true; }
};

struct EpiBf16Bias {
    static constexpr bool PERM = true, AFTER_DRAIN = false;
    bf16_t* O; int ldc; const float* bias; int bstride;
    __device__ __forceinline__ void operator()(const f32x4 (&acc)[2][2][4][2], const pg8::Unit& u, int wr, int wc, int fr, int fq) const {
        const int row0 = u.pm * 256 + wr * 64 + fr, col0 = u.pn * 256 + wc * 32 + 8 * fq;
        f32x4 bv[2][2];
#pragma unroll
        for (int bj = 0; bj < 2; ++bj)
#pragma unroll
            for (int n = 0; n < 2; ++n) bv[bj][n] = bias ? *(const f32x4*)(bias + (size_t)u.aux * bstride + col0 + bj * 128 + 4 * n) : (f32x4){0.f, 0.f, 0.f, 0.f};
#pragma unroll
        for (int ai = 0; ai < 2; ++ai)
#pragma unroll
            for (int m = 0; m < 4; ++m) { bf16_t* rowp = O + (size_t)(row0 + ai * 128 + m * 16) * ldc + col0;
#pragma unroll
                for (int bj = 0; bj < 2; ++bj) { const f32x4 v0 = acc[ai][bj][m][0] + bv[bj][0], v1 = acc[ai][bj][m][1] + bv[bj][1];
                    u32x4 w; w.x = pg8::cvt_pk_bf16(v0[0], v0[1]); w.y = pg8::cvt_pk_bf16(v0[2], v0[3]); w.z = pg8::cvt_pk_bf16(v1[0], v1[1]); w.w = pg8::cvt_pk_bf16(v1[2], v1[3]);
                    *(u32x4*)(rowp + bj * 128) = w; } }
    }
};
struct EpiLru {
    static constexpr bool PERM = true, AFTER_DRAIN = false;
    const bf16_t* xc; bf16_t* LA; bf16_t* BB; const float* ba; const float* bi; const float* lsl;
    __device__ __forceinline__ void operator()(const f32x4 (&acc)[2][2][4][2], const pg8::Unit& u, int wr, int wc, int fr, int fq) const {
        const int g = u.pn >> 2, d = (u.pn >> 1) & 1, hh = u.pn & 1;
        const int row0 = u.pm * 256 + wr * 64 + fr, ch0 = 256 * g + 128 * hh + wc * 32 + 8 * fq;
#pragma unroll
        for (int ai = 0; ai < 2; ++ai)
#pragma unroll
            for (int m = 0; m < 4; ++m) { const size_t off = (size_t)(row0 + ai * 128 + m * 16) * 1024 + ch0;
                const u32x4 xw = *(const u32x4*)(xc + off); float la[8], bb[8];
#pragma unroll
                for (int n = 0; n < 2; ++n) { const f32x4 pb = *(const f32x4*)(ba + d * 1024 + ch0 + 4 * n), pi = *(const f32x4*)(bi + d * 1024 + ch0 + 4 * n), pl = *(const f32x4*)(lsl + d * 1024 + ch0 + 4 * n);
#pragma unroll
                    for (int e = 0; e < 4; ++e) { const int idx = 4 * n + e; const unsigned w = xw[idx >> 1]; const float xv = (idx & 1) ? bfhi(w) : bflo(w);
                        const float r = sigmoidf_(acc[ai][0][m][n][e] + pb[e]), ig = sigmoidf_(acc[ai][1][m][n][e] + pi[e]);
                        const float l = 8.0f * r * pl[e]; la[idx] = l; bb[idx] = sqrtf(fmaxf(1.0f - __expf(2.0f * l), 0.f)) * ig * xv; } }
                u32x4 w1, w2; w1.x = pg8::cvt_pk_bf16(la[0], la[1]); w1.y = pg8::cvt_pk_bf16(la[2], la[3]); w1.z = pg8::cvt_pk_bf16(la[4], la[5]); w1.w = pg8::cvt_pk_bf16(la[6], la[7]);
                w2.x = pg8::cvt_pk_bf16(bb[0], bb[1]); w2.y = pg8::cvt_pk_bf16(bb[2], bb[3]); w2.z = pg8::cvt_pk_bf16(bb[4], bb[5]); w2.w = pg8::cvt_pk_bf16(bb[6], bb[7]);
                *(u32x4*)(LA + (size_t)d * TT * 1024 + off) = w1; *(u32x4*)(BB + (size_t)d * TT * 1024 + off) = w2; asm volatile("" ::: "memory"); }
    }
};
struct EpiBranch {
    static constexpr bool PERM = true, AFTER_DRAIN = false;
    const bf16_t* P; bf16_t* MB;
    __device__ __forceinline__ void operator()(const f32x4 (&acc)[2][2][4][2], const pg8::Unit& u, int wr, int wc, int fr, int fq) const {
        const int br = u.aux, row0 = u.pm * 256 + wr * 64 + fr, col0 = u.pn * 256 + wc * 32 + 8 * fq;
        bf16_t* dst = MB + (size_t)br * TT * 1024; const bf16_t* M0 = MB; const bf16_t* M1 = MB + (size_t)TT * 1024;
#pragma unroll
        for (int ai = 0; ai < 2; ++ai)
#pragma unroll
            for (int m = 0; m < 4; ++m) { const size_t row = (size_t)(row0 + ai * 128 + m * 16);
#pragma unroll
                for (int bj = 0; bj < 2; ++bj) { const int c = col0 + bj * 128;
                    const u32x4 gw = *(const u32x4*)(P + row * LDP + C_MG + br * 1024 + c);
                    f32x4 v0, v1;
                    v0[0] = sigmoidf_(bflo(gw.x)) * acc[ai][bj][m][0][0]; v0[1] = sigmoidf_(bfhi(gw.x)) * acc[ai][bj][m][0][1]; v0[2] = sigmoidf_(bflo(gw.y)) * acc[ai][bj][m][0][2]; v0[3] = sigmoidf_(bfhi(gw.y)) * acc[ai][bj][m][0][3];
                    v1[0] = sigmoidf_(bflo(gw.z)) * acc[ai][bj][m][1][0]; v1[1] = sigmoidf_(bfhi(gw.z)) * acc[ai][bj][m][1][1]; v1[2] = sigmoidf_(bflo(gw.w)) * acc[ai][bj][m][1][2]; v1[3] = sigmoidf_(bfhi(gw.w)) * acc[ai][bj][m][1][3];
                    if (br == 2) { const u32x4 p0 = *(const u32x4*)(M0 + row * 1024 + c), p1 = *(const u32x4*)(M1 + row * 1024 + c);
                        v0[0] += bflo(p0.x) + bflo(p1.x); v0[1] += bfhi(p0.x) + bfhi(p1.x); v0[2] += bflo(p0.y) + bflo(p1.y); v0[3] += bfhi(p0.y) + bfhi(p1.y);
                        v1[0] += bflo(p0.z) + bflo(p1.z); v1[1] += bfhi(p0.z) + bfhi(p1.z); v1[2] += bflo(p0.w) + bflo(p1.w); v1[3] += bfhi(p0.w) + bfhi(p1.w); }
                    u32x4 w; w.x = pg8::cvt_pk_bf16(v0[0], v0[1]); w.y = pg8::cvt_pk_bf16(v0[2], v0[3]); w.z = pg8::cvt_pk_bf16(v1[0], v1[1]); w.w = pg8::cvt_pk_bf16(v1[2], v1[3]);
                    *(u32x4*)(dst + row * 1024 + c) = w; } }
    }
};
struct EpiOut {
    static constexpr bool PERM = false, AFTER_DRAIN = false;
    const float* baseLat; const float* baseCtx; float* xs; const float* gate;
    __device__ __forceinline__ void operator()(const f32x4 (&acc)[2][2][4][2], const pg8::Unit& u, int wr, int wc, int fr, int fq) const {
        const int mrow = u.pm < 128 ? (u.pm >> 4) : 8; const float* gp = gate + mrow * 6144;
        const int row0 = u.pm * 256 + wr * 64 + fr, col0 = u.pn * 256 + wc * 32 + 4 * fq;
        const float* base = u.pm < 128 ? baseLat + (size_t)row0 * 1024 : baseCtx + (size_t)(row0 - TLAT) * 1024;
        f32x4 gv[2][2];
#pragma unroll
        for (int bj = 0; bj < 2; ++bj)
#pragma unroll
            for (int n = 0; n < 2; ++n) gv[bj][n] = *(const f32x4*)(gp + col0 + bj * 128 + n * 16);
#pragma unroll
        for (int ai = 0; ai < 2; ++ai)
#pragma unroll
            for (int m = 0; m < 4; ++m) { const size_t ro = (size_t)(ai * 128 + m * 16) * 1024 + col0; float* op = xs + (size_t)row0 * 1024 + ro;
#pragma unroll
                for (int bj = 0; bj < 2; ++bj)
#pragma unroll
                    for (int n = 0; n < 2; ++n) *(f32x4*)(op + bj * 128 + n * 16) = *(const f32x4*)(base + ro + bj * 128 + n * 16) + gv[bj][n] * acc[ai][bj][m][n]; }
    }
};
struct EpiSwiglu {
    static constexpr bool PERM = true, AFTER_DRAIN = false;
    bf16_t* H; const float* bgu;
    __device__ __forceinline__ void operator()(const f32x4 (&acc)[2][2][4][2], const pg8::Unit& u, int wr, int wc, int fr, int fq) const {
        const int row0 = u.pm * 256 + wr * 64 + fr, f0 = u.pn * 128 + wc * 32 + 8 * fq;
        float bg[8], bu[8];
#pragma unroll
        for (int q = 0; q < 4; ++q) { const f32x4 b = *(const f32x4*)(bgu + (size_t)u.aux * 2048 + 2 * f0 + 4 * q); bg[2 * q] = b[0]; bu[2 * q] = b[1]; bg[2 * q + 1] = b[2]; bu[2 * q + 1] = b[3]; }
#pragma unroll
        for (int ai = 0; ai < 2; ++ai)
#pragma unroll
            for (int m = 0; m < 4; ++m) { float a[8];
#pragma unroll
                for (int n = 0; n < 2; ++n)
#pragma unroll
                    for (int e = 0; e < 4; ++e) { const int idx = 4 * n + e; const float gt = fminf(acc[ai][0][m][n][e] + bg[idx], 7.0f), up = fminf(fmaxf(acc[ai][1][m][n][e] + bu[idx], -7.0f), 7.0f);
                        a[idx] = gt * sigmoidf_(1.702f * gt) * (up + 1.0f); }
                u32x4 w; w.x = pg8::cvt_pk_bf16(a[0], a[1]); w.y = pg8::cvt_pk_bf16(a[2], a[3]); w.z = pg8::cvt_pk_bf16(a[4], a[5]); w.w = pg8::cvt_pk_bf16(a[6], a[7]);
                *(u32x4*)(H + (size_t)(row0 + ai * 128 + m * 16) * 1024 + f0) = w; }
    }
};

constexpr int NWAVES = 8, NTHR = 512;
constexpr int LDS_BYTES = 163840, MISC_OFF = 163840 - 512;
template <int I> __device__ __forceinline__ const float* inptr() { const GAS float* p;
    asm volatile("s_load_dwordx2 %0, %1, %2\n\ts_waitcnt lgkmcnt(0)" : "=s"(p) : "s"(__builtin_amdgcn_kernarg_segment_ptr()), "n"(I * 8)); return (const float*)p; }
struct Frame {
    LAS unsigned char* lds; GAS unsigned char* ws; float* out;
    int tid, bx, lane, wave, G, gw, NGW, gtid, NGT;
};
__device__ __forceinline__ int mrow_of(int row) { return row < TLAT ? (row >> 12) : 8; }
__device__ __forceinline__ int seqrow(int d, int b, int p) {
    if (p < CTXL) return TLAT + b * CTXL + (d ? CTXL - 1 - p : p);
    const int q = p - CTXL; return b * SEQ + (d ? SEQ - 1 - q : q);
}
struct RowV { f32x4 v[4]; };
__device__ __forceinline__ RowV load_row(const float* p, int lane) { RowV r;
#pragma unroll
    for (int j = 0; j < 4; ++j) r.v[j] = *(const f32x4*)(p + 4 * lane + 256 * j);
    return r; }
__device__ __forceinline__ float row_sumsq(const RowV& r) { float s = 0.f;
#pragma unroll
    for (int j = 0; j < 4; ++j) s += (r.v[j][0] * r.v[j][0] + r.v[j][1] * r.v[j][1]) + (r.v[j][2] * r.v[j][2] + r.v[j][3] * r.v[j][3]);
    return wave_sum(s); }
__device__ __forceinline__ RowV norm_mod(const RowV& x, const float* gain, const float* shift, const float* scale, int lane) {
    const float rs = rsqrtf(row_sumsq(x) * (1.0f / D) + EPS); RowV y;
#pragma unroll
    for (int j = 0; j < 4; ++j) { const int c = 4 * lane + 256 * j; const f32x4 g = *(const f32x4*)(gain + c), sh = *(const f32x4*)(shift + c), sc = *(const f32x4*)(scale + c);
        y.v[j] = (x.v[j] * rs) * g * (sc + 1.0f) + sh; }
    return y; }
__device__ __forceinline__ void store_row_bf16(bf16_t* p, const RowV& y, int lane) {
#pragma unroll
    for (int j = 0; j < 4; ++j) { u32x2 w; w.x = pk2(y.v[j][0], y.v[j][1]); w.y = pk2(y.v[j][2], y.v[j][3]); *(u32x2*)(p + 4 * lane + 256 * j) = w; } }
__device__ __forceinline__ f32x4 ld4bf(const bf16_t* p) { const u32x2 w = *(const u32x2*)p; return (f32x4){bflo(w.x), bfhi(w.x), bflo(w.y), bfhi(w.y)}; }

__device__ __forceinline__ void phase_proA(const Frame& F) {
    const float* c = inptr<1>(); const float* cc = inptr<3>(); const float* w_ada = inptr<4>();
    float* modp = (float*)(F.ws + WS_MODP);
    for (int it = F.gw; it < 2 * 8 * 96; it += F.NGW) {
        const int cg = it % 96, ks = (it / 96) % 8, l = it / 768, col = cg * 64 + F.lane;
        float acc[9];
#pragma unroll
        for (int r = 0; r < 9; ++r) acc[r] = 0.f;
        for (int k = ks * 128; k < ks * 128 + 128; ++k) {
            const float w = w_ada[((size_t)l * 1024 + k) * 6144 + col];
#pragma unroll
            for (int r = 0; r < 8; ++r) acc[r] += siluf_(c[r * 1024 + k]) * w;
            acc[8] += siluf_(cc[k]) * w;
        }
#pragma unroll
        for (int r = 0; r < 9; ++r) modp[((size_t)(ks * 2 + l) * 9 + r) * 6144 + col] = acc[r];
    }
    float* rc = (float*)(F.ws + WS_COS); float* rsn = (float*)(F.ws + WS_SIN);
    for (int i = F.gtid; i < SEQ * 64; i += F.NGT) {
        const int t = i >> 6, j = i & 63, f = j & 31; const float pos = (float)((j < 32) ? (t >> 6) : (t & 63));
        const float inv = exp2f(-(float)f * (13.287712379549449f / 32.0f)); const float ang = pos * inv;
        const float nn = rintf(ang * 0.15915494309189535f); float r = fmaf(-nn, 6.28125f, ang); r = fmaf(-nn, 1.9353071795864769e-3f, r);
        rc[i] = __cosf(r); rsn[i] = __sinf(r);
    }
}
__device__ __forceinline__ void phase_proB(const Frame& F) {
    const float* modp = (const float*)(F.ws + WS_MODP); float* mods = (float*)(F.ws + WS_MODS); const float* b_ada = inptr<5>();
    for (int i = F.gtid; i < 2 * 9 * 6144; i += F.NGT) { const int l = i / (9 * 6144), col = i % 6144; float s = b_ada[l * 6144 + col];
#pragma unroll
        for (int ks = 0; ks < 8; ++ks) s += modp[(size_t)ks * (2 * 9 * 6144) + i];
        mods[i] = s; }
}

template <class RM> __device__ __forceinline__ void tr_item(const float* W, int ldw, int k0, int n0, bf16_t* WT, int ldt, LAS float* scr, int lane, const RM& rm) {
#pragma unroll 8
    for (int i = 0; i < 32; ++i) { const int kk = 2 * i + (lane >> 5); scr[kk * 33 + (lane & 31)] = W[(size_t)(k0 + kk) * ldw + n0 + (lane & 31)]; }
    LDS_WAIT(); asm volatile("" ::: "memory");
    const int c = lane & 7;
#pragma unroll
    for (int j = 0; j < 4; ++j) { const int n = (lane >> 3) + 8 * j; const LAS float* s = scr + (8 * c) * 33 + n; int drow; float sc; rm(n0 + n, drow, sc);
        u32x4 o; o.x = pk2(s[0 * 33] * sc, s[1 * 33] * sc); o.y = pk2(s[2 * 33] * sc, s[3 * 33] * sc); o.z = pk2(s[4 * 33] * sc, s[5 * 33] * sc); o.w = pk2(s[6 * 33] * sc, s[7 * 33] * sc);
        *(u32x4*)(WT + (size_t)drow * ldt + k0 + 8 * c) = o; }
    LDS_WAIT(); asm volatile("" ::: "memory");
}
struct RmIn { __device__ __forceinline__ void operator()(int n, int& drow, float& sc) const {
    drow = n < 3072 ? n : (n < 3104 ? C_LR + (n - 3072) : n - 32); sc = (n < 512 || (n >= 5664 && n < 6176)) ? 0.08838834764831845f : 1.0f; } };
struct RmId { __device__ __forceinline__ void operator()(int n, int& drow, float& sc) const { drow = n; sc = 1.0f; } };
struct RmLru { int base; __device__ __forceinline__ void operator()(int n, int& drow, float& sc) const { drow = base + (n & 127); sc = 1.0f; } };
struct RmGu { __device__ __forceinline__ void operator()(int n, int& drow, float& sc) const { const int f = n >> 1, u = n & 1; drow = 256 * (f >> 7) + 128 * u + (f & 127); sc = 1.0f; } };
__device__ __forceinline__ void phase_W(const Frame& F, int li) {
    LAS float* scr = (LAS float*)(F.lds + F.wave * 8704);
    bf16_t* Win_t = (bf16_t*)(F.ws + WS_WIN); bf16_t* Wlru_t = (bf16_t*)(F.ws + WS_WLRU); bf16_t* Wbr_t = (bf16_t*)(F.ws + WS_WBR);
    bf16_t* Wout_t = (bf16_t*)(F.ws + WS_WOUT); bf16_t* Wgu_t = (bf16_t*)(F.ws + WS_WGU); bf16_t* Wdn_t = (bf16_t*)(F.ws + WS_WDN);
    constexpr int I_IN = 16 * 353, I_LRU = 512, I_BR = 1536, I_OUT = 512, I_GU = 32768, I_DN = 16384, NITEMS = I_IN + I_LRU + I_BR + I_OUT + I_GU + I_DN;
    for (int it0 = F.gw; it0 < NITEMS; it0 += F.NGW) {
        int it = it0;
        if (it < I_IN) { const int kb = it / 353, nb = it % 353; tr_item(inptr<8>() + (size_t)li * 1024 * IN_TOTAL, IN_TOTAL, 64 * kb, 32 * nb, Win_t, 1024, scr, F.lane, RmIn{}); continue; } it -= I_IN;
        if (it < I_LRU) { const int mat = it >> 5, r = it & 31, kb = r >> 3, nb = r & 7, ty = mat >> 3, d = (mat >> 2) & 1, g = mat & 3, n0 = 32 * nb, pn = g * 4 + d * 2 + (n0 >> 7);
            const float* src = (ty ? inptr<16>() : inptr<14>()) + (size_t)((li * 2 + d) * 4 + g) * 65536;
            tr_item(src, 256, 64 * kb, n0, Wlru_t, 256, scr, F.lane, RmLru{pn * 256 + ty * 128}); continue; } it -= I_LRU;
        if (it < I_BR) { const int br = it >> 9, r = it & 511, kb = r >> 5, nb = r & 31; tr_item(inptr<20>() + (size_t)(li * 3 + br) * 1048576, 1024, 64 * kb, 32 * nb, Wbr_t + (size_t)br * 1048576, 1024, scr, F.lane, RmId{}); continue; } it -= I_BR;
        if (it < I_OUT) { const int kb = it >> 5, nb = it & 31; tr_item(inptr<21>() + (size_t)li * 1048576, 1024, 64 * kb, 32 * nb, Wout_t, 1024, scr, F.lane, RmId{}); continue; } it -= I_OUT;
        if (it < I_GU) { const int e = it >> 10, r = it & 1023, kb = r >> 6, nb = r & 63; tr_item(inptr<24>() + (size_t)(li * 32 + e) * 2097152, 2048, 64 * kb, 32 * nb, Wgu_t + (size_t)e * 2097152, 1024, scr, F.lane, RmGu{}); continue; } it -= I_GU;
        { const int e = it >> 9, r = it & 511, kb = r >> 5, nb = r & 31; tr_item(inptr<26>() + (size_t)(li * 32 + e) * 1048576, 1024, 64 * kb, 32 * nb, Wdn_t + (size_t)e * 1048576, 1024, scr, F.lane, RmId{}); }
    }
    for (int i = F.gtid; i < (LDP - IN_TOTAL) * 1024 / 8; i += F.NGT) *(u32x4*)(Win_t + (size_t)IN_TOTAL * 1024 + (size_t)i * 8) = (u32x4){0u, 0u, 0u, 0u};
    float* lsl = (float*)(F.ws + WS_LSL);
    for (int i = F.gtid; i < 2048; i += F.NGT) lsl[i] = logsigmoidf_(inptr<18>()[li * 2048 + i]);
}
__device__ __forceinline__ void phase_norm_in(const Frame& F) {
    const float* mods = (const float*)(F.ws + WS_MODS); bf16_t* xn = (bf16_t*)(F.ws + WS_D);
    for (int row = F.gw; row < TT; row += F.NGW) {
        const float* src = row < TLAT ? inptr<0>() + (size_t)row * D : inptr<2>() + (size_t)(row - TLAT) * D;
        const float* mp = mods + mrow_of(row) * 6144;
        const RowV y = norm_mod(load_row(src, F.lane), inptr<6>(), mp, mp + 1024, F.lane);
        store_row_bf16(xn + (size_t)row * D, y, F.lane);
    }
}

__device__ __forceinline__ void phase_conv(const Frame& F, int li) {
    const bf16_t* P = (const bf16_t*)(F.ws + WS_P); bf16_t* xc = (bf16_t*)(F.ws + WS_D);
    const float* cw = inptr<12>() + (size_t)li * 4 * 1024; const float* cb = inptr<13>() + (size_t)li * 1024;
    for (int i = F.gtid; i < TT * 128; i += F.NGT) {
        const int row = i >> 7, ch = (i & 127) * 8;
        int t, L; if (row < TLAT) { t = row & (SEQ - 1); L = SEQ; } else { t = (row - TLAT) & (CTXL - 1); L = CTXL; }
        float a[8];
        { const f32x4 b0 = *(const f32x4*)(cb + ch), b1 = *(const f32x4*)(cb + ch + 4); a[0] = b0[0]; a[1] = b0[1]; a[2] = b0[2]; a[3] = b0[3]; a[4] = b1[0]; a[5] = b1[1]; a[6] = b1[2]; a[7] = b1[3]; }
#pragma unroll
        for (int j = 0; j < 4; ++j) { const int tt = t - 2 + j; if (tt < 0 || tt >= L) continue;
            const u32x4 xw = *(const u32x4*)(P + (size_t)(row - 2 + j) * LDP + C_LX + ch);
            const f32x4 w0 = *(const f32x4*)(cw + j * 1024 + ch), w1 = *(const f32x4*)(cw + j * 1024 + ch + 4);
            a[0] += w0[0] * bflo(xw.x); a[1] += w0[1] * bfhi(xw.x); a[2] += w0[2] * bflo(xw.y); a[3] += w0[3] * bfhi(xw.y);
            a[4] += w1[0] * bflo(xw.z); a[5] += w1[1] * bfhi(xw.z); a[6] += w1[2] * bflo(xw.w); a[7] += w1[3] * bfhi(xw.w); }
        u32x4 o; o.x = pk2(a[0], a[1]); o.y = pk2(a[2], a[3]); o.z = pk2(a[4], a[5]); o.w = pk2(a[6], a[7]);
        *(u32x4*)(xc + (size_t)row * 1024 + ch) = o;
    }
    bf16_t* Pw = (bf16_t*)(F.ws + WS_P); const float* rcos = (const float*)(F.ws + WS_COS); const float* rsin = (const float*)(F.ws + WS_SIN);
    for (int i = F.gtid; i < TLAT * 64; i += F.NGT) {
        const int g8 = i & 7, qk = (i >> 3) & 1, h = (i >> 4) & 3, row = i >> 6, t = row & (SEQ - 1);
        bf16_t* p1 = Pw + (size_t)row * LDP + (qk ? C_RK : C_RQ) + 128 * h + 8 * g8; bf16_t* p2 = p1 + 64;
        const u32x4 a = *(const u32x4*)p1, b = *(const u32x4*)p2;
        const f32x4 c0 = *(const f32x4*)(rcos + t * 64 + 8 * g8), c1 = *(const f32x4*)(rcos + t * 64 + 8 * g8 + 4), s0 = *(const f32x4*)(rsin + t * 64 + 8 * g8), s1 = *(const f32x4*)(rsin + t * 64 + 8 * g8 + 4);
        const float cs[8] = {c0[0], c0[1], c0[2], c0[3], c1[0], c1[1], c1[2], c1[3]}, sn[8] = {s0[0], s0[1], s0[2], s0[3], s1[0], s1[1], s1[2], s1[3]};
        const unsigned aw[4] = {a.x, a.y, a.z, a.w}, bw[4] = {b.x, b.y, b.z, b.w}; u32x4 o1, o2;
#pragma unroll
        for (int e = 0; e < 4; ++e) { const float x1a = bflo(aw[e]), x1b = bfhi(aw[e]), x2a = bflo(bw[e]), x2b = bfhi(bw[e]);
            o1[e] = pk2(x1a * cs[2 * e] - x2a * sn[2 * e], x1b * cs[2 * e + 1] - x2b * sn[2 * e + 1]);
            o2[e] = pk2(x1a * sn[2 * e] + x2a * cs[2 * e], x1b * sn[2 * e + 1] + x2b * cs[2 * e + 1]); }
        *(u32x4*)p1 = o1; *(u32x4*)p2 = o2;
    }
}
constexpr int LSEG = 136, LNSEG = (CTXL + SEQ) / LSEG;
template <bool FINAL> __device__ __forceinline__ void phase_lru_scan(const Frame& F) {
    const bf16_t* LA = (const bf16_t*)(F.ws + WS_C); const bf16_t* BB = (const bf16_t*)(F.ws + WS_C + 2 * ROWB);
    float* carA = (float*)(F.ws + WS_CARA); float* carH = (float*)(F.ws + WS_CARH); bf16_t* HO = (bf16_t*)(F.ws + WS_E);
    for (int i = F.gtid; i < 2 * 8 * LNSEG * 256; i += F.NGT) {
        const int cq = i & 255, s = (i >> 8) % LNSEG, db = (i >> 8) / LNSEG, b = db & 7, d = db >> 3;
        f32x4 h = (f32x4){0.f, 0.f, 0.f, 0.f}, As = (f32x4){0.f, 0.f, 0.f, 0.f};
        if (FINAL) { for (int s2 = 0; s2 < s; ++s2) { const size_t o = ((size_t)(db * LNSEG + s2) * 256 + cq) * 4; h = *(const f32x4*)(carA + o) * h + *(const f32x4*)(carH + o); } }
        const size_t dofs = (size_t)d * TT * 1024;
#pragma unroll 8
        for (int p = 0; p < LSEG; ++p) { const size_t off = (size_t)seqrow(d, b, s * LSEG + p) * 1024 + cq * 4;
            const f32x4 la = ld4bf(LA + dofs + off), bb = ld4bf(BB + dofs + off);
            f32x4 a; a[0] = __expf(la[0]); a[1] = __expf(la[1]); a[2] = __expf(la[2]); a[3] = __expf(la[3]);
            h = a * h + bb;
            if (FINAL) { u32x2 w; w.x = pk2(h[0], h[1]); w.y = pk2(h[2], h[3]); *(u32x2*)(HO + dofs + off) = w; } else As += la; }
        if (!FINAL) { const size_t o = (size_t)i * 4; f32x4 A; A[0] = __expf(As[0]); A[1] = __expf(As[1]); A[2] = __expf(As[2]); A[3] = __expf(As[3]);
            *(f32x4*)(carA + o) = A; *(f32x4*)(carH + o) = h; }
    }
}


constexpr size_t QKB = (size_t)TT * 512 * 2;
__device__ __forceinline__ void phase_scanprep(const Frame& F, int li) {
    LAS float* lrs = (LAS float*)F.lds;
    LAS float* qtot = lrs + 64 * 32;
    LAS float* gcs = qtot + 4 * 512;
    bf16_t* Pm = (bf16_t*)(F.ws + WS_P); bf16_t* QK = (bf16_t*)(F.ws + WS_C); float* EGL = (float*)(F.ws + WS_MODP);
    const int qtr = F.tid >> 7, c4 = F.tid & 127, ch0 = 4 * c4;
    for (int rc = F.bx; rc < TT / 64; rc += F.G) {
        if (F.tid < 256) { const int tok = F.tid >> 2, q8 = F.tid & 3; const u32x4 v = *(const u32x4*)(Pm + (size_t)(64 * rc + tok) * LDP + C_LR + 8 * q8);
            LAS float* dst = lrs + tok * 32 + 8 * q8; *(LAS f32x4*)dst = (f32x4){bflo(v.x), bfhi(v.x), bflo(v.y), bfhi(v.y)}; *(LAS f32x4*)(dst + 4) = (f32x4){bflo(v.z), bfhi(v.z), bflo(v.w), bfhi(v.w)}; }
        __syncthreads();
        for (int d = 0; d < 2; ++d) {
            f32x4 wv[16];
#pragma unroll
            for (int r = 0; r < 16; ++r) wv[r] = *(const f32x4*)(inptr<9>() + (size_t)((li * 2 + d) * 16 + r) * 512 + ch0);
            const f32x4 bav = *(const f32x4*)(inptr<10>() + (size_t)(li * 2 + d) * 512 + ch0);
            f32x4 run = (f32x4){0.f, 0.f, 0.f, 0.f};
#pragma unroll 2
            for (int i = 0; i < 16; ++i) { const int p = 16 * qtr + i, tok = d ? 63 - p : p; f32x4 z = bav;
#pragma unroll
                for (int r4 = 0; r4 < 4; ++r4) { const f32x4 l = *(const LAS f32x4*)(lrs + tok * 32 + 16 * d + 4 * r4);
#pragma unroll
                    for (int e = 0; e < 4; ++e) z += wv[4 * r4 + e] * l[e]; }
#pragma unroll
                for (int e = 0; e < 4; ++e) run[e] += logsigmoidf_(z[e]) * 0.0625f;
                *(LAS f32x4*)(gcs + p * 512 + ch0) = run; }
            *(LAS f32x4*)(qtot + qtr * 512 + ch0) = run;
            __syncthreads();
            f32x4 off = (f32x4){0.f, 0.f, 0.f, 0.f}, tot = (f32x4){0.f, 0.f, 0.f, 0.f};
#pragma unroll
            for (int q2 = 0; q2 < 4; ++q2) { const f32x4 t = *(const LAS f32x4*)(qtot + q2 * 512 + ch0); tot += t; if (q2 < qtr) off += t; }
            if (qtr == 0) { f32x4 e4; e4[0] = __expf(tot[0]); e4[1] = __expf(tot[1]); e4[2] = __expf(tot[2]); e4[3] = __expf(tot[3]); *(f32x4*)(EGL + ((size_t)d * (TT / 64) + rc) * 512 + ch0) = e4; }
            bf16_t* EGd = QK + (size_t)d * TT * 512;
#pragma unroll 4
            for (int i = 0; i < 16; ++i) { const int p = 16 * qtr + i, tok = d ? 63 - p : p; const size_t row = (size_t)(64 * rc + tok);
                const f32x4 G = *(const LAS f32x4*)(gcs + p * 512 + ch0) + off;
                u32x2 we; we.x = pk2(__expf(G[0]), __expf(G[1])); we.y = pk2(__expf(G[2]), __expf(G[3]));
                *(u32x2*)(EGd + row * 512 + ch0) = we; }
            __syncthreads();
        }
    }
}
typedef short s16x4 __attribute__((ext_vector_type(4)));
constexpr int SC_PITCH = 272, SC_QS = 0, SC_KS = 17408, SC_VS = 34816, SC_SB = 52224, SC_AS = 87040, SC_APITCH = 144, SC_OS = SC_AS + 9216;
__device__ __forceinline__ bf16x8 tr_frag(LAS unsigned char* base, int pitch, int k0, int c0, int lane) {
    const int q = (lane & 15) >> 2, p = lane & 3;
    LAS unsigned char* a = base + (k0 + q) * pitch + (c0 + 4 * p) * 2;
    const s16x4 lo = __builtin_amdgcn_ds_read_tr16_b64_v4i16((LAS s16x4*)a);
    const s16x4 hi = __builtin_amdgcn_ds_read_tr16_b64_v4i16((LAS s16x4*)(a + 4 * pitch));
    return (bf16x8){lo[0], lo[1], lo[2], lo[3], hi[0], hi[1], hi[2], hi[3]};
}
#define MFMA16(a, b, c) __builtin_amdgcn_mfma_f32_16x16x32_bf16((a), (b), (c), 0, 0, 0)
__device__ __forceinline__ int chunk_rc(int d, int b, int chn) { return chn < 4 ? (TLAT / 64) + 4 * b + (d ? 3 - chn : chn) : 64 * b + (d ? 63 - (chn - 4) : (chn - 4)); }
struct ScanSet { u32x4 q[2], k[2], v[2], e[2]; float gl[2]; };
#define GST16(ptr, val) asm volatile("global_store_dwordx4 %0, %1, off\n\ts_nop 1" :: "v"(ptr), "v"(val) : "memory")
template <int MX> __device__ __forceinline__ void scan_unit(const Frame& F, int u) {
    LAS unsigned char* L = F.lds;
    const int tid = F.tid, lane = F.lane, w = F.wave, fr = lane & 15, fq = lane >> 4, tt = tid >> 4, part = tid & 15;
    const int js = u & 1, h = (u >> 1) & 3, b = (u >> 3) & 7, d = (u >> 6) & 1;
    const bf16_t* Pq = (const bf16_t*)(F.ws + WS_P) + (MX ? C_RQ : C_GQ) + 128 * h + 8 * part; const bf16_t* Pk = Pq + 512;
    const bf16_t* Pv = (const bf16_t*)(F.ws + WS_P) + (MX ? C_RV : C_GV) + 256 * h + 128 * js + 8 * part;
    const bf16_t* EGp = (const bf16_t*)(F.ws + WS_C) + (size_t)d * TT * 512 + 128 * h + 8 * part;
    const int tmA = w >> 1, tnA = 2 * (w & 1), tmB = w & 1, tnB = w >> 1, tmS = w & 3, tnS = w >> 2;
    const float* EGLp = (const float*)(F.ws + WS_MODP) + (size_t)d * (TT / 64) * 512 + 128 * h + 32 * tmS + fr;
    bf16_t* O = (bf16_t*)(F.ws + WS_B) + (size_t)(MX * 2 + d) * TT * 1024 + 256 * h + 128 * js + 8 * part;
    float er[2] = {1.f, 1.f}, nr[2] = {1.f, 1.f}, egr = 1.0f;
    if (MX == 1) { const float x = exp2f(-5.0f - (float)h), lg = -(x + x * x * 0.5f + x * x * x * (1.0f / 3.0f) + x * x * x * x * 0.25f);
        egr = __expf(64.0f * lg); er[0] = __expf((float)(tt + 1) * lg); nr[0] = __expf(-(float)(tt + 1) * lg); er[1] = __expf((float)(tt + 33) * lg); nr[1] = __expf(-(float)(tt + 33) * lg); }
    f32x4 S[2][4];
#pragma unroll
    for (int i = 0; i < 2; ++i)
#pragma unroll
        for (int j = 0; j < 4; ++j) S[i][j] = (f32x4){0.f, 0.f, 0.f, 0.f};
    for (int i = tid; i < (128 * SC_PITCH) / 16; i += NTHR) *(LAS u32x4*)(L + SC_SB + i * 16) = (u32x4){0u, 0u, 0u, 0u};
    constexpr int NCH = (CTXL + SEQ) / 64;
    ScanSet sA, sB;
#define SC_LOAD(chn, st) do { const int rc_ = chunk_rc(d, b, (chn)); _Pragma("unroll") for (int ps = 0; ps < 2; ++ps) { const int c_ = tt + 32 * ps; const size_t row_ = (size_t)(64 * rc_ + (d ? 63 - c_ : c_)); \
        st.q[ps] = *(const u32x4*)(Pq + row_ * LDP); st.k[ps] = *(const u32x4*)(Pk + row_ * LDP); st.v[ps] = *(const u32x4*)(Pv + row_ * LDP); if (MX == 0) st.e[ps] = *(const u32x4*)(EGp + row_ * 512); } \
        if (MX == 0) { st.gl[0] = EGLp[(size_t)rc_ * 512]; st.gl[1] = EGLp[(size_t)rc_ * 512 + 16]; } } while (0)
#define SC_PUT(st) do { _Pragma("unroll") for (int ps = 0; ps < 2; ++ps) { const int c_ = tt + 32 * ps; u32x4 qo, ko; \
        _Pragma("unroll") for (int e2 = 0; e2 < 4; ++e2) { float ea, eb, na, nb; \
            if (MX == 0) { ea = bflo(st.e[ps][e2]); eb = bfhi(st.e[ps][e2]); na = __builtin_amdgcn_rcpf(ea); nb = __builtin_amdgcn_rcpf(eb); } else { ea = eb = er[ps]; na = nb = nr[ps]; } \
            qo[e2] = pk2(bflo(st.q[ps][e2]) * ea, bfhi(st.q[ps][e2]) * eb); ko[e2] = pk2(bflo(st.k[ps][e2]) * na, bfhi(st.k[ps][e2]) * nb); } \
        *(LAS u32x4*)(L + SC_QS + c_ * SC_PITCH + part * 16) = qo; *(LAS u32x4*)(L + SC_KS + c_ * SC_PITCH + part * 16) = ko; *(LAS u32x4*)(L + SC_VS + c_ * SC_PITCH + part * 16) = st.v[ps]; } } while (0)
    float eg[2] = {egr, egr}, egn[2] = {egr, egr};
    SC_LOAD(0, sA); SC_PUT(sA); if (MX == 0) { eg[0] = sA.gl[0]; eg[1] = sA.gl[1]; }
    SC_LOAD(1, sA);
    __syncthreads();
#define SC_CHUNK(ch, LS, PS) do { \
        const int rc = chunk_rc(d, b, ch); \
        SC_LOAD(((ch) + 2 < NCH ? (ch) + 2 : NCH - 1), LS); \
        {   f32x4 a[2] = {(f32x4){0.f, 0.f, 0.f, 0.f}, (f32x4){0.f, 0.f, 0.f, 0.f}}; \
        _Pragma("unroll") \
            for (int ks = 0; ks < 4; ++ks) { const bf16x8 xq = *(const LAS bf16x8*)(L + SC_QS + (16 * tmA + fr) * SC_PITCH + (32 * ks + 8 * fq) * 2); \
        _Pragma("unroll") \
                for (int j = 0; j < 2; ++j) { const bf16x8 yk = *(const LAS bf16x8*)(L + SC_KS + (16 * (tnA + j) + fr) * SC_PITCH + (32 * ks + 8 * fq) * 2); a[j] = MFMA16(yk, xq, a[j]); } } \
            const int c = 16 * tmA + fr; \
        _Pragma("unroll") \
            for (int j = 0; j < 2; ++j) { const int s0 = 16 * (tnA + j) + 4 * fq; float m[4]; \
        _Pragma("unroll") \
                for (int e = 0; e < 4; ++e) { const int s = s0 + e; const bool keep = d ? (s < c) : (s <= c); m[e] = keep ? a[j][e] : 0.f; } \
                u32x2 wv; wv.x = pk2(m[0], m[1]); wv.y = pk2(m[2], m[3]); *(LAS u32x2*)(L + SC_AS + c * SC_APITCH + s0 * 2) = wv; } } \
        __syncthreads(); \
        f32x4 o[2][2]; \
        _Pragma("unroll") \
        for (int i = 0; i < 2; ++i) \
        _Pragma("unroll") \
            for (int j = 0; j < 2; ++j) o[i][j] = (f32x4){0.f, 0.f, 0.f, 0.f}; \
        _Pragma("unroll") \
        for (int ks = 0; ks < 2; ++ks) { bf16x8 xa[2], yv[2]; \
        _Pragma("unroll") \
            for (int i = 0; i < 2; ++i) xa[i] = *(const LAS bf16x8*)(L + SC_AS + (32 * tmB + 16 * i + fr) * SC_APITCH + (32 * ks + 8 * fq) * 2); \
        _Pragma("unroll") \
            for (int j = 0; j < 2; ++j) yv[j] = tr_frag(L + SC_VS, SC_PITCH, 32 * ks + 8 * fq, 32 * tnB + 16 * j, lane); \
        _Pragma("unroll") \
            for (int i = 0; i < 2; ++i) \
        _Pragma("unroll") \
                for (int j = 0; j < 2; ++j) o[i][j] = MFMA16(yv[j], xa[i], o[i][j]); } \
        _Pragma("unroll") \
        for (int ks = 0; ks < 4; ++ks) { bf16x8 xq[2], ys[2]; \
        _Pragma("unroll") \
            for (int i = 0; i < 2; ++i) xq[i] = *(const LAS bf16x8*)(L + SC_QS + (32 * tmB + 16 * i + fr) * SC_PITCH + (32 * ks + 8 * fq) * 2); \
        _Pragma("unroll") \
            for (int j = 0; j < 2; ++j) ys[j] = tr_frag(L + SC_SB, SC_PITCH, 32 * ks + 8 * fq, 32 * tnB + 16 * j, lane); \
        _Pragma("unroll") \
            for (int i = 0; i < 2; ++i) \
        _Pragma("unroll") \
                for (int j = 0; j < 2; ++j) o[i][j] = MFMA16(ys[j], xq[i], o[i][j]); } \
        _Pragma("unroll") \
        for (int ks = 0; ks < 2; ++ks) { bf16x8 xk[2], yv[4]; \
        _Pragma("unroll") \
            for (int i = 0; i < 2; ++i) xk[i] = tr_frag(L + SC_KS, SC_PITCH, 32 * ks + 8 * fq, 32 * tmS + 16 * i, lane); \
        _Pragma("unroll") \
            for (int j = 0; j < 4; ++j) yv[j] = tr_frag(L + SC_VS, SC_PITCH, 32 * ks + 8 * fq, 64 * tnS + 16 * j, lane); \
        _Pragma("unroll") \
            for (int i = 0; i < 2; ++i) \
        _Pragma("unroll") \
                for (int j = 0; j < 4; ++j) S[i][j] = MFMA16(yv[j], xk[i], S[i][j]); } \
        __syncthreads(); \
        _Pragma("unroll") \
        for (int i = 0; i < 2; ++i) \
        _Pragma("unroll") \
            for (int j = 0; j < 2; ++j) { u32x2 wv; wv.x = pk2(o[i][j][0], o[i][j][1]); wv.y = pk2(o[i][j][2], o[i][j][3]); \
                *(LAS u32x2*)(L + SC_OS + (32 * tmB + 16 * i + fr) * SC_PITCH + (32 * tnB + 16 * j + 4 * fq) * 2) = wv; } \
        _Pragma("unroll") \
        for (int i = 0; i < 2; ++i) { const int row = 32 * tmS + 16 * i + fr; \
            _Pragma("unroll") \
            for (int j = 0; j < 4; ++j) { S[i][j] = S[i][j] * eg[i]; u32x2 wv; wv.x = pk2(S[i][j][0], S[i][j][1]); wv.y = pk2(S[i][j][2], S[i][j][3]); \
                *(LAS u32x2*)(L + SC_SB + row * SC_PITCH + (64 * tnS + 16 * j + 4 * fq) * 2) = wv; } } \
        SC_PUT(PS); if (MX == 0) { eg[0] = PS.gl[0]; eg[1] = PS.gl[1]; } \
        __syncthreads(); \
        _Pragma("unroll") \
        for (int ps = 0; ps < 2; ++ps) { const int c = tt + 32 * ps; const u32x4 v = *(const LAS u32x4*)(L + SC_OS + c * SC_PITCH + part * 16); \
            GST16(O + (size_t)(64 * rc + (d ? 63 - c : c)) * 1024, v); } \
    } while (0)
    for (int ch2 = 0; ch2 < NCH; ch2 += 2) { SC_CHUNK(ch2, sB, sA); SC_CHUNK(ch2 + 1, sA, sB); }
    (void)egn;
#undef SC_CHUNK
#undef SC_LOAD
#undef SC_PUT
    __syncthreads();
}
__device__ __forceinline__ void phase_scan_mfma(const Frame& F, int li) {
    for (int u = F.bx; u < 256; u += F.G) { if (u < 128) scan_unit<0>(F, u); else scan_unit<1>(F, u - 128); }
}


__device__ __forceinline__ void phase_finish(const Frame& F, int li, int nrows) {
    const bf16_t* P = (const bf16_t*)(F.ws + WS_P); const bf16_t* OB = (const bf16_t*)(F.ws + WS_B); const bf16_t* HB = (const bf16_t*)(F.ws + WS_E); bf16_t* A3 = (bf16_t*)(F.ws + WS_C);
    const float* gnorm = inptr<11>() + (size_t)li * 1024; const float* rnorm = inptr<19>() + (size_t)li * 1024;
    const size_t RS = (size_t)TT * 1024;
    for (int row = F.gw; row < nrows; row += F.NGW) {
        const bf16_t* pr = P + (size_t)row * LDP; const size_t ro = (size_t)row * 1024;
#pragma unroll
        for (int j = 0; j < 4; ++j) {
            const int c = 4 * F.lane + 256 * j;
            {
                const f32x4 o = ld4bf(OB + ro + c) + ld4bf(OB + RS + ro + c);
                const float ss = wave_sum((o[0] * o[0] + o[1] * o[1]) + (o[2] * o[2] + o[3] * o[3])); const float rs = rsqrtf(ss * (1.0f / 256.0f) + EPS);
                const f32x4 g = ld4bf(pr + C_GG + c), gn = *(const f32x4*)(gnorm + c); u32x2 w;
                w.x = pk2(o[0] * rs * gn[0] * siluf_(g[0]), o[1] * rs * gn[1] * siluf_(g[1])); w.y = pk2(o[2] * rs * gn[2] * siluf_(g[2]), o[3] * rs * gn[3] * siluf_(g[3]));
                *(u32x2*)(A3 + ro + c) = w; }
            {
                const f32x4 hh = ld4bf(HB + ro + c) + ld4bf(HB + RS + ro + c), g = ld4bf(pr + C_LG + c); u32x2 w;
                w.x = pk2(hh[0] * gelu_tanh_(g[0]), hh[1] * gelu_tanh_(g[1])); w.y = pk2(hh[2] * gelu_tanh_(g[2]), hh[3] * gelu_tanh_(g[3]));
                *(u32x2*)(A3 + RS + ro + c) = w; }
            {
                f32x4 o = ld4bf(OB + 2 * RS + ro + c) + ld4bf(OB + 3 * RS + ro + c);
                const float mean = wave_sum((o[0] + o[1]) + (o[2] + o[3])) * (1.0f / 256.0f); o = o - mean;
                const float ss = wave_sum((o[0] * o[0] + o[1] * o[1]) + (o[2] * o[2] + o[3] * o[3])); const float rs = rsqrtf(ss * (1.0f / 256.0f) + EPS);
                const f32x4 g = ld4bf(pr + C_RG + c), gn = *(const f32x4*)(rnorm + c); u32x2 w;
                w.x = pk2(o[0] * rs * gn[0] * siluf_(g[0]), o[1] * rs * gn[1] * siluf_(g[1])); w.y = pk2(o[2] * rs * gn[2] * siluf_(g[2]), o[3] * rs * gn[3] * siluf_(g[3]));
                *(u32x2*)(A3 + 2 * RS + ro + c) = w; }
        }
    }
}

constexpr int RT_PITCH = 2064, RT_XH = 0, RT_XL = 16 * RT_PITCH, RT_PART = 2 * 16 * RT_PITCH, RT_PP = 33, RT_HIST = RT_PART + 8 * 16 * RT_PP * 4;
__device__ __forceinline__ void phase_norm2_router(const Frame& F, int li, int ntok) {
    LAS unsigned char* L = F.lds; LAS float* part = (LAS float*)(L + RT_PART); LAS unsigned* hist = (LAS unsigned*)(L + RT_HIST); LAS unsigned* hbase = hist + 32;
    const int lane = F.lane, w = F.wave, fr = lane & 15, fq = lane >> 4;
    const float* wr = inptr<22>() + (size_t)li * 1024 * 32; const float* br = inptr<23>() + li * 32;
    bf16x8 Bh[2][4], Bl[2][4];
#pragma unroll
    for (int nt = 0; nt < 2; ++nt)
#pragma unroll
        for (int ks = 0; ks < 4; ++ks) { u32x4 hw, lw;
#pragma unroll
            for (int i2 = 0; i2 < 4; ++i2) { const float a = wr[(size_t)(128 * w + 32 * ks + 8 * fq + 2 * i2) * 32 + 16 * nt + fr], b = wr[(size_t)(128 * w + 32 * ks + 8 * fq + 2 * i2 + 1) * 32 + 16 * nt + fr];
                hw[i2] = pk2(a, b); lw[i2] = pk2(a - bflo(hw[i2]), b - bfhi(hw[i2])); }
            Bh[nt][ks] = __builtin_bit_cast(bf16x8, hw); Bl[nt][ks] = __builtin_bit_cast(bf16x8, lw); }
    if (F.tid < 32) hist[F.tid] = 0u;
    __syncthreads();
    const float* xs = (const float*)(F.ws + WS_XS); const float* mods = (const float*)(F.ws + WS_MODS) + (size_t)li * 9 * 6144;
    bf16_t* xn2 = (bf16_t*)(F.ws + WS_D); int* tok_e = (int*)(F.ws + WS_TOKE); float* tok_w = (float*)(F.ws + WS_TOKW); int* tok_p = (int*)(F.ws + WS_TOKP);
    unsigned* cnt = (unsigned*)(F.ws + WS_CTL) + CW_CNT + li * 32;
    const int ntile = ntok / 16;
    for (int t = F.bx; t < ntile; t += F.G) {
#pragma unroll
        for (int rr = 0; rr < 2; ++rr) { const int lr = 2 * w + rr, row = 16 * t + lr; const float* mp = mods + mrow_of(row) * 6144;
            const RowV y = norm_mod(load_row(xs + (size_t)row * D, lane), inptr<7>() + (size_t)li * 1024, mp + 3 * 1024, mp + 4 * 1024, lane);
#pragma unroll
            for (int j = 0; j < 4; ++j) { u32x2 h, l2; h.x = pk2(y.v[j][0], y.v[j][1]); h.y = pk2(y.v[j][2], y.v[j][3]);
                l2.x = pk2(y.v[j][0] - bflo(h.x), y.v[j][1] - bfhi(h.x)); l2.y = pk2(y.v[j][2] - bflo(h.y), y.v[j][3] - bfhi(h.y));
                *(u32x2*)(xn2 + (size_t)row * D + 4 * lane + 256 * j) = h;
                *(LAS u32x2*)(L + RT_XH + lr * RT_PITCH + (4 * lane + 256 * j) * 2) = h; *(LAS u32x2*)(L + RT_XL + lr * RT_PITCH + (4 * lane + 256 * j) * 2) = l2; } }
        __syncthreads();
        {   f32x4 acc[2] = {(f32x4){0.f, 0.f, 0.f, 0.f}, (f32x4){0.f, 0.f, 0.f, 0.f}};
#pragma unroll
            for (int ks = 0; ks < 4; ++ks) { const int co = (128 * w + 32 * ks + 8 * fq) * 2;
                const bf16x8 ah = *(const LAS bf16x8*)(L + RT_XH + fr * RT_PITCH + co), al = *(const LAS bf16x8*)(L + RT_XL + fr * RT_PITCH + co);
#pragma unroll
                for (int nt = 0; nt < 2; ++nt) { acc[nt] = __builtin_amdgcn_mfma_f32_16x16x32_bf16(Bh[nt][ks], ah, acc[nt], 0, 0, 0); acc[nt] = __builtin_amdgcn_mfma_f32_16x16x32_bf16(Bl[nt][ks], ah, acc[nt], 0, 0, 0);
                    acc[nt] = __builtin_amdgcn_mfma_f32_16x16x32_bf16(Bh[nt][ks], al, acc[nt], 0, 0, 0); } }
#pragma unroll
            for (int nt = 0; nt < 2; ++nt)
#pragma unroll
                for (int j = 0; j < 4; ++j) part[(w * 16 + fr) * RT_PP + 16 * nt + 4 * fq + j] = acc[nt][j]; }
        __syncthreads();
        {
            const int e = lane & 31, tk = 2 * w + (lane >> 5), row = 16 * t + tk; float v = br[e];
#pragma unroll
            for (int w2 = 0; w2 < 8; ++w2) v += part[(w2 * 16 + tk) * RT_PP + e];
            float tl0, tl1, tl2, tl3; int te0, te1, te2, te3;
#define RT_ARGMAX(TL, TE) do { float bv = v; int bi = e; _Pragma("unroll") for (int o = 16; o >= 1; o >>= 1) { const float ov = __shfl_xor(bv, o); const int oi = __shfl_xor(bi, o); \
                const bool tk_ = (ov > bv) || (ov == bv && oi < bi); bv = tk_ ? ov : bv; bi = tk_ ? oi : bi; } TL = bv; TE = bi; v = (e == bi) ? -3.0e38f : v; } while (0)
            RT_ARGMAX(tl0, te0); RT_ARGMAX(tl1, te1); RT_ARGMAX(tl2, te2); RT_ARGMAX(tl3, te3);
#undef RT_ARGMAX
            const float e1 = __expf(tl1 - tl0), e2 = __expf(tl2 - tl0), e3 = __expf(tl3 - tl0); const float inv = 1.0f / (1.0f + e1 + e2 + e3);
            if (e < 4) { const int ek = e == 0 ? te0 : e == 1 ? te1 : e == 2 ? te2 : te3; const float wk = (e == 0 ? 1.0f : e == 1 ? e1 : e == 2 ? e2 : e3) * inv;
                const unsigned lp = atomicAdd((unsigned*)&hist[ek], 1u); tok_e[row * 4 + e] = ek; tok_w[row * 4 + e] = wk; tok_p[row * 4 + e] = (int)lp; } }
        __syncthreads();
    }
    if (F.tid < 32) hbase[F.tid] = __hip_atomic_fetch_add(cnt + F.tid, hist[F.tid], __ATOMIC_RELAXED, __HIP_MEMORY_SCOPE_AGENT);
    __syncthreads();
    for (int t = F.bx; t < ntile; t += F.G) if (F.tid < 64) { const int i = 16 * t * 4 + F.tid; tok_p[i] += (int)hbase[tok_e[i]]; }
    __syncthreads();
}
__device__ __forceinline__ void phase_dispatch(const Frame& F, int li, int ntok) {
    LAS unsigned* pstart = (LAS unsigned*)F.lds;
    unsigned* ctl = (unsigned*)(F.ws + WS_CTL); unsigned* cnt = ctl + CW_CNT + li * 32; unsigned* tile_e = ctl + CW_TILE + li * 1024;
    if (F.tid == 0) { unsigned ps = 0;
        for (int e = 0; e < 32; ++e) { const unsigned c = __hip_atomic_load(cnt + e, __ATOMIC_RELAXED, __HIP_MEMORY_SCOPE_AGENT), nt = (c + 255u) >> 8; pstart[e] = ps;
            if (F.bx == 0) for (unsigned j = 0; j < nt; ++j) tile_e[(ps >> 8) + j] = (unsigned)e;
            ps += nt << 8; }
        if (F.bx == 0) ctl[CW_NT + li] = ps >> 8; }
    __syncthreads();
    const int* tok_e = (const int*)(F.ws + WS_TOKE); const int* tok_p = (const int*)(F.ws + WS_TOKP); int* tok_s = (int*)(F.ws + WS_TOKS); int* slot_tok = (int*)(F.ws + WS_SLOTTOK);
    for (int it = F.gtid; it < ntok * 4; it += F.NGT) { const int slot = (int)pstart[tok_e[it]] + tok_p[it]; tok_s[it] = slot; slot_tok[slot] = it >> 2; }
    if (F.bx < 32) { const unsigned c = __hip_atomic_load(cnt + F.bx, __ATOMIC_RELAXED, __HIP_MEMORY_SCOPE_AGENT), pe = ((c + 255u) >> 8) << 8;
        for (unsigned s = c + F.tid; s < pe; s += NTHR) slot_tok[pstart[F.bx] + s] = 0; }
    __syncthreads();
}
__device__ __forceinline__ void phase_combine(const Frame& F, int li, int ntok, bool last) {
    float* xs = (float*)(F.ws + WS_XS); const bf16_t* Y = (const bf16_t*)(F.ws + WS_B); bf16_t* xn = (bf16_t*)(F.ws + WS_D);
    const float* mods = (const float*)(F.ws + WS_MODS); const float* tok_w = (const float*)(F.ws + WS_TOKW); const int* tok_s = (const int*)(F.ws + WS_TOKS);
    for (int row = F.gw; row < ntok; row += F.NGW) {
        const int mr = mrow_of(row); const float* gp = mods + ((size_t)li * 9 + mr) * 6144 + 5 * 1024;
        RowV x = load_row(xs + (size_t)row * D, F.lane);
        const int s0 = tok_s[row * 4], s1 = tok_s[row * 4 + 1], s2 = tok_s[row * 4 + 2], s3 = tok_s[row * 4 + 3];
        const float w0 = tok_w[row * 4], w1 = tok_w[row * 4 + 1], w2 = tok_w[row * 4 + 2], w3 = tok_w[row * 4 + 3];
#pragma unroll
        for (int j = 0; j < 4; ++j) { const int c = 4 * F.lane + 256 * j;
            const f32x4 y = ld4bf(Y + (size_t)s0 * 1024 + c) * w0 + ld4bf(Y + (size_t)s1 * 1024 + c) * w1 + ld4bf(Y + (size_t)s2 * 1024 + c) * w2 + ld4bf(Y + (size_t)s3 * 1024 + c) * w3;
            x.v[j] = x.v[j] + *(const f32x4*)(gp + c) * y; }
        if (!last) {
#pragma unroll
            for (int j = 0; j < 4; ++j) *(f32x4*)(xs + (size_t)row * D + 4 * F.lane + 256 * j) = x.v[j];
            const float* mp = mods + ((size_t)(li + 1) * 9 + mr) * 6144;
            const RowV y = norm_mod(x, inptr<6>() + (size_t)(li + 1) * 1024, mp, mp + 1024, F.lane);
            store_row_bf16(xn + (size_t)row * D, y, F.lane);
        } else {
            const float rs = rsqrtf(row_sumsq(x) * (1.0f / D) + EPS);
#pragma unroll
            for (int j = 0; j < 4; ++j) { const int c = 4 * F.lane + 256 * j; *(f32x4*)(F.out + (size_t)row * D + c) = (x.v[j] * rs) * *(const f32x4*)(inptr<28>() + c); }
        }
    }
}

#ifndef MK_SCAN_REF
#define MK_SCAN_REF 0
#endif
#ifndef MK_ONE_LAUNCH
#define MK_ONE_LAUNCH 1
#endif
constexpr int NPH_LAYER = 15, NPHASES = 2 + 2 * NPH_LAYER;
struct Args { const float* in[29]; float* out; unsigned char* ws; int ph_lo, ph_hi, region, pad; };
#ifndef MK_PHMASK
#define MK_PHMASK 0x7fff
#endif
#define IN(k) (lo <= (k) && (k) < hi)
#define EN(j) ((MK_PHMASK >> (j)) & 1)
#define SEAM(k) do { if (IN(k) && IN((k) + 1)) xcd_barrier(bar); } while (0)
#define MKF() Frame F; { GAS unsigned char* ws_ = (GAS unsigned char*)args.ws; asm volatile("" : "+s"(ws_)); F.ws = ws_; F.lds = (LAS unsigned char*)lds_raw; F.out = args.out; \
        int tid_ = threadIdx.x, bx_ = blockIdx.x; asm volatile("" : "+v"(tid_), "+s"(bx_)); F.tid = tid_; F.bx = bx_; F.lane = F.tid & 63; F.wave = __builtin_amdgcn_readfirstlane(F.tid >> 6); F.G = gridDim.x; \
        F.gw = F.bx * NWAVES + F.wave; F.NGW = F.G * NWAVES; F.gtid = F.bx * NTHR + F.tid; F.NGT = F.G * NTHR; }
template <int li> __device__ __forceinline__ void run_layer(const Args& args, unsigned char* lds_raw, const XcdBarrier& bar, const int lo, const int hi) {
        const int pb = 2 + NPH_LAYER * li; const bool last = (li == 1); const int nrows = last ? TLAT : TT, nMt = nrows / 256;
        if (EN(0) && IN(pb + 0)) { MKF(); phase_W(F, li); if (li == 0) phase_norm_in(F); __syncthreads(); }
        SEAM(pb + 0);
        if (EN(1) && IN(pb + 1)) { MKF(); unsigned* ctl = (unsigned*)(F.ws + WS_CTL); (void)ctl;
            pg8::Gemm g{1024, 1024, 1024}; PlainOrder S; S.A = (const char*)(F.ws + WS_D); S.B = (const char*)(F.ws + WS_WIN); S.astep = 256 * 1024 * 2; S.bstep = 256 * 1024 * 2; S.nM = TT / 256; S.nN = LDP / 256; S.G = F.G; S.c = F.bx;
            EpiBf16Bias E{(bf16_t*)(F.ws + WS_P), LDP, nullptr, 0};
            pg8::gemm_phase<EpiBf16Bias, PlainOrder, true, true>(F.lds, g, S, E);
        }
        SEAM(pb + 1);
        if (EN(2) && IN(pb + 2)) { MKF(); phase_conv(F, li); phase_scanprep(F, li); }
        SEAM(pb + 2);
        if (EN(3) && IN(pb + 3)) { MKF(); phase_scan_mfma(F, li); }
        SEAM(pb + 3);
        if (EN(4) && IN(pb + 4)) { MKF(); unsigned* ctl = (unsigned*)(F.ws + WS_CTL); (void)ctl;
            pg8::Gemm g{1024, 256, 256}; LruOrder S; S.A = (const char*)(F.ws + WS_D); S.B = (const char*)(F.ws + WS_WLRU); S.nM = TT / 256; S.G = F.G; S.c = F.bx;
            EpiLru E{(const bf16_t*)(F.ws + WS_D), (bf16_t*)(F.ws + WS_C), (bf16_t*)(F.ws + WS_C + 2 * ROWB), inptr<15>() + (size_t)li * 2048, inptr<17>() + (size_t)li * 2048, (const float*)(F.ws + WS_LSL)};
            pg8::gemm_phase<EpiLru, LruOrder, true, true>(F.lds, g, S, E);
        }
        SEAM(pb + 4);
        if (EN(5) && IN(pb + 5)) { MKF(); phase_lru_scan<false>(F); }
        SEAM(pb + 5);
        if (EN(6) && IN(pb + 6)) { MKF(); phase_lru_scan<true>(F); }
        SEAM(pb + 6);
        if (EN(7) && IN(pb + 7)) { MKF(); phase_finish(F, li, nrows); }
        SEAM(pb + 7);
        if (EN(8) && IN(pb + 8)) { MKF(); unsigned* ctl = (unsigned*)(F.ws + WS_CTL); (void)ctl;
            pg8::Gemm g{1024, 1024, 1024}; BranchOrder S; S.A = (const char*)(F.ws + WS_C); S.B = (const char*)(F.ws + WS_WBR); S.nM = nMt; S.G = F.G; S.c = F.bx;
            EpiBranch E{(const bf16_t*)(F.ws + WS_P), (bf16_t*)(F.ws + WS_B)};
            pg8::gemm_phase<EpiBranch, BranchOrder, true, true>(F.lds, g, S, E);
        }
        SEAM(pb + 8);
        if (EN(9) && IN(pb + 9)) { MKF(); unsigned* ctl = (unsigned*)(F.ws + WS_CTL); (void)ctl;
            pg8::Gemm g{1024, 1024, 1024}; PlainOrder S; S.A = (const char*)(F.ws + WS_B + 2 * ROWB); S.B = (const char*)(F.ws + WS_WOUT); S.astep = 256 * 1024 * 2; S.bstep = 256 * 1024 * 2; S.nM = nMt; S.nN = 4; S.G = F.G; S.c = F.bx;
            float* xs = (float*)(F.ws + WS_XS);
            EpiOut E{li == 0 ? inptr<0>() : xs, li == 0 ? inptr<2>() : xs + (size_t)TLAT * D, xs, (const float*)(F.ws + WS_MODS) + (size_t)li * 9 * 6144 + 2 * 1024};
            pg8::gemm_phase<EpiOut, PlainOrder, true, true>(F.lds, g, S, E);
        }
        SEAM(pb + 9);
        if (EN(10) && IN(pb + 10)) { MKF(); phase_norm2_router(F, li, nrows); }
        SEAM(pb + 10);
        if (EN(11) && IN(pb + 11)) { MKF(); phase_dispatch(F, li, nrows); }
        SEAM(pb + 11);
        if (EN(12) && IN(pb + 12)) { MKF(); unsigned* ctl = (unsigned*)(F.ws + WS_CTL); (void)ctl;
            pg8::Gemm g{1024, 1024, 1024}; MoeOrder S; S.A = (const char*)(F.ws + WS_D); S.rowidx = (const int*)(F.ws + WS_SLOTTOK); S.B = (const char*)(F.ws + WS_WGU); S.tile_e = ctl + CW_TILE + li * 1024; S.estep = (size_t)2048 * 1024 * 2;
            S.nM = (int)ctl[CW_NT + li]; S.nN = 8; S.G = F.G; S.c = F.bx; S.ga = 1;
            EpiSwiglu E{(bf16_t*)(F.ws + WS_P + 288 * MiB), inptr<25>() + (size_t)li * 32 * 2048};
            pg8::gemm_phase<EpiSwiglu, MoeOrder, true, true, true>(F.lds, g, S, E);
        }
        SEAM(pb + 12);
        if (EN(13) && IN(pb + 13)) { MKF(); unsigned* ctl = (unsigned*)(F.ws + WS_CTL); (void)ctl;
            pg8::Gemm g{1024, 1024, 1024}; MoeOrder S; S.A = (const char*)(F.ws + WS_P + 288 * MiB); S.B = (const char*)(F.ws + WS_WDN); S.tile_e = ctl + CW_TILE + li * 1024; S.estep = (size_t)1024 * 1024 * 2;
            S.nM = (int)ctl[CW_NT + li]; S.nN = 4; S.G = F.G; S.c = F.bx; S.ga = 0; S.rowidx = nullptr;
            EpiBf16Bias E{(bf16_t*)(F.ws + WS_B), 1024, inptr<27>() + (size_t)li * 32 * 1024, 1024};
            pg8::gemm_phase<EpiBf16Bias, MoeOrder, true, true>(F.lds, g, S, E);
        }
        SEAM(pb + 13);
        if (EN(14) && IN(pb + 14)) { MKF(); phase_combine(F, li, nrows, last); }
        SEAM(pb + 14);
    }
__global__ void __launch_bounds__(NTHR, 2) mk_fwd(Args args) {
    extern __shared__ __attribute__((aligned(16))) unsigned char lds_raw[];
    const int tid0 = threadIdx.x;
    volatile LAS unsigned* MISC = (volatile LAS unsigned*)((LAS unsigned char*)lds_raw + MISC_OFF);
    if (tid0 < 32) MISC[tid0] = 0u;
    __syncthreads();
    unsigned* ctl0 = (unsigned*)(args.ws + WS_CTL);
    const int lo = args.ph_lo, hi = args.ph_hi;
    XcdBarrier bar; bar.bar = ctl0 + CW_BAR + args.region * 4096; bar.x = 0; bar.st = MISC + 8;
    if (hi - lo > 1) bar = xcd_barrier_post(ctl0 + CW_BAR + args.region * 4096, MISC + 8);

    if (IN(0)) { MKF(); phase_proA(F); }
    SEAM(0);
    if (IN(1)) { MKF(); phase_proB(F); }
    SEAM(1);
    run_layer<0>(args, lds_raw, bar, lo, hi);
    run_layer<1>(args, lds_raw, bar, lo, hi);
}

extern "C" void kernel_launch(void* const* d_in, const int* in_sizes, int n_in, void* d_out, int out_size, void* d_ws, size_t ws_size, hipStream_t stream) {
    static int grid = 0;
    if (grid == 0) {
        if (n_in != 29 || ws_size < WS_END || out_size != TLAT * D) { fprintf(stderr, "kernel_launch: unexpected problem: n_in %d ws %zu out %d\n", n_in, ws_size, out_size); grid = -1; return; }
        int dev = 0, cus = 0;
        if (hipGetDevice(&dev) != hipSuccess || hipDeviceGetAttribute(&cus, hipDeviceAttributeMultiprocessorCount, dev) != hipSuccess) { grid = -1; return; }
        if (hipFuncSetAttribute((const void*)mk_fwd, hipFuncAttributeMaxDynamicSharedMemorySize, LDS_BYTES) != hipSuccess) { fprintf(stderr, "kernel_launch: hipFuncSetAttribute failed\n"); grid = -1; return; }
        int per_cu = 0;
        if (hipOccupancyMaxActiveBlocksPerMultiprocessor(&per_cu, (const void*)mk_fwd, NTHR, LDS_BYTES) != hipSuccess || per_cu < 1) fprintf(stderr, "kernel_launch: occupancy query reports %d\n", per_cu);
        (void)hipGetLastError();
        grid = cus;
    }
    if (grid < 0) return;
    (void)hipMemsetAsync((char*)d_ws + WS_CTL, 0, CTL_BYTES, stream);
    Args a{};
    for (int i = 0; i < 29; ++i) a.in[i] = (const float*)d_in[i];
    a.out = (float*)d_out; a.ws = (unsigned char*)d_ws;
#if MK_ONE_LAUNCH
    a.ph_lo = 0; a.ph_hi = NPHASES; a.region = 0;
    hipLaunchKernelGGL(mk_fwd, dim3(grid), dim3(NTHR), LDS_BYTES, stream, a);
#else
    for (int p = 0; p < NPHASES; ++p) { a.ph_lo = p; a.ph_hi = p + 1; a.region = 0; hipLaunchKernelGGL(mk_fwd, dim3(grid), dim3(NTHR), LDS_BYTES, stream, a); }
#endif
}
```

```cpp
#include <hip/hip_runtime.h>
#include <cstdio>
#include <cstdint>

#define LAS __attribute__((address_space(3)))
typedef unsigned short bf16_t;
typedef short bf16x8 __attribute__((ext_vector_type(8)));
typedef float f32x4 __attribute__((ext_vector_type(4)));
typedef float f32x2 __attribute__((ext_vector_type(2)));
typedef unsigned u32x4 __attribute__((ext_vector_type(4)));
typedef unsigned u32x2 __attribute__((ext_vector_type(2)));

constexpr int D = 1024, NBATCH = 8, SEQ = 4096, CTXL = 256;
constexpr int TLAT = NBATCH * SEQ, TCTX = NBATCH * CTXL, TT = TLAT + TCTX;
constexpr int LDP = 11520;
constexpr int C_GQ = 0, C_GK = 512, C_GV = 1024, C_GG = 2048, C_LX = 3072, C_LG = 4096, C_RQ = 5120, C_RK = 5632, C_RV = 6144, C_RG = 7168, C_MG = 8192, C_LR = 11264;
constexpr int IN_TOTAL = 11296, NE = 32;
constexpr int SLOT_TILES_MAX = 576;
constexpr float EPS = 1e-6f;

constexpr size_t MiB = (size_t)1 << 20;
constexpr size_t WS_CTL = 0, CTL_BYTES = 1 * MiB;
constexpr size_t WS_MODP = 1 * MiB, WS_MODS = 5 * MiB, WS_COS = 6 * MiB, WS_SIN = 7 * MiB, WS_LSL = 8 * MiB, WS_CARA = 9 * MiB, WS_CARH = 11 * MiB;
constexpr size_t WS_SLOTTOK = 8 * MiB + 256 * 1024;
constexpr size_t WS_TOKE = 13 * MiB, WS_TOKW = WS_TOKE + 768 * 1024, WS_TOKP = WS_TOKW + 768 * 1024, WS_TOKS = WS_TOKP + 768 * 1024;
constexpr size_t WS_WIN = 16 * MiB, WS_WLRU = 39 * MiB, WS_WBR = 41 * MiB, WS_WOUT = 47 * MiB, WS_WGU = 49 * MiB, WS_WDN = 177 * MiB;
constexpr size_t WS_XS = 241 * MiB, WS_P = 377 * MiB, WS_B = 1142 * MiB, WS_C = 1430 * MiB, WS_D = 1702 * MiB, WS_E = 1770 * MiB, WS_END = 1906 * MiB;
constexpr size_t ROWB = (size_t)TT * D * 2;
static_assert(ROWB == 68 * MiB, "row buffer");
constexpr int CW_CNT = 1024, CW_NT = 1024 + 128, CW_TILE = 2048, CW_BAR = 8192;

__device__ __forceinline__ float bflo(unsigned w) { return __uint_as_float(w << 16); }
__device__ __forceinline__ float bfhi(unsigned w) { return __uint_as_float(w & 0xffff0000u); }
typedef __bf16 bf16x2_t __attribute__((ext_vector_type(2)));
__device__ __forceinline__ unsigned pk2(float lo, float hi) { const bf16x2_t v = __builtin_convertvector((f32x2){lo, hi}, bf16x2_t); return __builtin_bit_cast(unsigned, v); }
__device__ __forceinline__ float sigmoidf_(float x) { return __builtin_amdgcn_rcpf(1.0f + __expf(-x)); }
__device__ __forceinline__ float siluf_(float x) { return x * sigmoidf_(x); }
__device__ __forceinline__ float logsigmoidf_(float z) { return fminf(z, 0.f) - __logf(1.0f + __expf(-fabsf(z))); }
__device__ __forceinline__ float gelu_tanh_(float x) { const float u = 0.7978845608028654f * (x + 0.044715f * x * x * x); const float t = 1.0f - 2.0f * __builtin_amdgcn_rcpf(__expf(2.0f * u) + 1.0f); return 0.5f * x * (1.0f + t); }
__device__ __forceinline__ float wave_sum(float v) {
#pragma unroll
    for (int o = 1; o < 64; o <<= 1) v += __shfl_xor(v, o);
    return v;
}
#define LDS_WAIT() asm volatile("s_waitcnt lgkmcnt(0)" ::: "memory")

namespace pg8 {
#define PG8_LAS __attribute__((address_space(3)))
constexpr int BM = 256, BK = 64, HALF = 128, HTB = HALF * BK * 2, STAGE_BYTES = 8 * HTB, NXCD = 8, WGM = 8;
__host__ __device__ __forceinline__ int lds_byte(int r, int c) { const int st = (r >> 4) * 2 + (c >> 5), rr = r & 15, cc = c & 31, ob = rr * 64 + cc * 2; return st * 1024 + (ob ^ (((ob >> 9) & 1) << 5)); }
__host__ __device__ __forceinline__ void stage_rc(int b, int& R, int& C) { const int st = b / 1024, sb = b % 1024, swz = sb ^ (((sb >> 9) & 1) << 5); R = (st >> 1) * 16 + swz / 64; C = (st & 1) * 32 + (swz % 64) / 2; }
__host__ __device__ __forceinline__ int perm32(int rho) { const int n = rho >> 4, i = rho & 15; return 8 * (i >> 2) + 4 * n + (i & 3); }
struct Unit { int pm, pn, aux; const char* a; const char* b; };
struct Gemm { int lda, ldb, K; };
__device__ __forceinline__ void tile_of(int L, int nM, int nN, int& pm, int& pn) {
    const int nwg = nM * nN; int wgid = L; { const int q = nwg / NXCD, r = nwg % NXCD, xcd = wgid % NXCD, off = wgid / NXCD; wgid = (xcd < r ? xcd * (q + 1) : r * (q + 1) + (xcd - r) * q) + off; }
    const int nig = WGM * nN, gid = wgid / nig, fm = gid * WGM, gsz = (nM - fm) < WGM ? (nM - fm) : WGM;
    pm = fm + ((wgid % nig) % gsz); pn = (wgid % nig) / gsz;
}
__device__ __forceinline__ unsigned cvt_pk_bf16(float lo, float hi) { unsigned r; asm volatile("v_cvt_pk_bf16_f32 %0, %1, %2" : "=v"(r) : "v"(lo), "v"(hi)); return r; }
template <class Epi, class Sched, bool ALIGN_EPI = false, bool SP2 = false, bool GATHER = false>
__device__ __forceinline__ void gemm_phase(PG8_LAS unsigned char* lds, const Gemm g, const Sched& S, const Epi& E) {
    int tid_o = threadIdx.x; asm volatile("" : "+v"(tid_o));
    const int tid = tid_o, wid = __builtin_amdgcn_readfirstlane(tid >> 6), lane = tid & 63, wr = wid >> 2, wc = wid & 3, fr = lane & 15, fq = lane >> 4;
    const int K = g.K, nt = K / BK;
    unsigned voffA[2], voffB[2];
#pragma unroll
    for (int i = 0; i < 2; ++i) { int R, C; stage_rc(tid * 16 + i * 8192, R, C); const int Rb = Epi::PERM ? ((R & ~31) + perm32(R & 31)) : R;
        voffA[i] = (unsigned)(R * g.lda + C) * 2u; voffB[i] = (unsigned)(Rb * g.ldb + C) * 2u; }
    unsigned gA[2][2] = {{0u, 0u}, {0u, 0u}}, gN[2][2] = {{0u, 0u}, {0u, 0u}}; int gR[2], gC[2];
#pragma unroll
    for (int i = 0; i < 2; ++i) stage_rc(tid * 16 + i * 8192, gR[i], gC[i]);
#define PG8_GOFF(dst, u_) do { if constexpr (GATHER) { _Pragma("unroll") for (int h_ = 0; h_ < 2; ++h_) _Pragma("unroll") for (int i_ = 0; i_ < 2; ++i_) \
        dst[h_][i_] = (unsigned)S.rowidx[(u_).pm * BM + h_ * HALF + gR[i_]] * (unsigned)(g.lda * 2) + (unsigned)(gC[i_] * 2); } } while (0)
    const size_t kstep = (size_t)(BK * 2);
    const size_t hstepA = (size_t)HALF * g.lda * 2, hstepB = (size_t)HALF * g.ldb * 2;
    const unsigned ldsw = (unsigned)wid * 1024u;
    const int aoff = lds_byte(wr * 64 + fr, fq * 8), boff = lds_byte(wc * 32 + fr, fq * 8);
#define PG8_SA(b, h) (((b) * 2 + (h)) * HTB)
#define PG8_SB(b, h) ((4 + (b) * 2 + (h)) * HTB)
#define PG8_STAGE(bufoff, gbase, voff) do { _Pragma("unroll") for (int _i = 0; _i < 2; ++_i) \
        __builtin_amdgcn_global_load_lds((const unsigned*)((const char*)(gbase) + (voff)[_i]), (PG8_LAS unsigned*)(lds + (bufoff) + ldsw + _i * 8192), 16, 0, 0); } while (0)
#define PG8_STAGE_A(bufoff, gbase, H, NX) do { if constexpr (GATHER) { _Pragma("unroll") for (int _i = 0; _i < 2; ++_i) { const unsigned o_ = (NX) ? gN[H][_i] : gA[H][_i]; \
        __builtin_amdgcn_global_load_lds((const unsigned*)((const char*)(gbase) + o_), (PG8_LAS unsigned*)(lds + (bufoff) + ldsw + _i * 8192), 16, 0, 0); } } \
        else { PG8_STAGE(bufoff, (gbase) + (H) * hstepA, voffA); } } while (0)
#define PG8_LDA(dst, b, h) do { _Pragma("unroll") for (int m = 0; m < 4; ++m) _Pragma("unroll") for (int k = 0; k < 2; ++k) dst[m][k] = *(const PG8_LAS bf16x8*)(lds + PG8_SA(b, h) + aoff + m * 2048 + k * 1024); } while (0)
#define PG8_LDB(dst, b, h) do { _Pragma("unroll") for (int n = 0; n < 2; ++n) _Pragma("unroll") for (int k = 0; k < 2; ++k) dst[n][k] = *(const PG8_LAS bf16x8*)(lds + PG8_SB(b, h) + boff + n * 2048 + k * 1024); } while (0)
#define PG8_MMA(ai, bj, At, Bt) do { __builtin_amdgcn_s_setprio(1); _Pragma("unroll") for (int m = 0; m < 4; ++m) _Pragma("unroll") for (int n = 0; n < 2; ++n) _Pragma("unroll") for (int k = 0; k < 2; ++k) \
        acc[ai][bj][m][n] = __builtin_amdgcn_mfma_f32_16x16x32_bf16(Bt[n][k], At[m][k], acc[ai][bj][m][n], 0, 0, 0); __builtin_amdgcn_s_setprio(0); } while (0)
#define PG8_WAIT_V(n) asm volatile("s_waitcnt vmcnt(" #n ")" ::: "memory")
#define PG8_WAIT_L(n) asm volatile("s_waitcnt lgkmcnt(" #n ")" ::: "memory")
#define PG8_BAR __builtin_amdgcn_s_barrier()
#define PG8_SCHED __builtin_amdgcn_sched_barrier(0)
    Unit cur, nxt; int ui = 0;
    if (!S.next(0, cur)) return;
    f32x4 acc[2][2][4][2];
#pragma unroll
    for (int a = 0; a < 2; ++a)
#pragma unroll
        for (int b = 0; b < 2; ++b)
#pragma unroll
            for (int m = 0; m < 4; ++m)
#pragma unroll
                for (int n = 0; n < 2; ++n) acc[a][b][m][n] = (f32x4){0.f, 0.f, 0.f, 0.f};
    bf16x8 At[4][2], B0[2][2], B1[2][2];
    const char* cA = cur.a; const char* cB = cur.b;
    S.a_ready(cur);
    PG8_GOFF(gA, cur);
    if constexpr (SP2) {
        PG8_STAGE(PG8_SB(0, 0), cB, voffB); PG8_STAGE(PG8_SB(0, 1), cB + hstepB, voffB); PG8_STAGE_A(PG8_SA(0, 0), cA, 0, false); PG8_STAGE_A(PG8_SA(0, 1), cA, 1, false);
        if (wr == 1) PG8_BAR;
        PG8_WAIT_V(2); PG8_BAR;
        PG8_STAGE(PG8_SB(1, 0), cB + kstep, voffB); PG8_STAGE_A(PG8_SA(1, 0), cA + kstep, 0, false); PG8_STAGE(PG8_SB(1, 1), cB + hstepB + kstep, voffB);
        PG8_WAIT_V(6); PG8_BAR;
    } else {
        PG8_STAGE(PG8_SB(0, 0), cB, voffB); PG8_STAGE_A(PG8_SA(0, 0), cA, 0, false); PG8_STAGE(PG8_SB(0, 1), cB + hstepB, voffB); PG8_STAGE_A(PG8_SA(0, 1), cA, 1, false);
        if (wr == 1) PG8_BAR;
        PG8_WAIT_V(4); PG8_BAR;
        PG8_STAGE(PG8_SB(1, 0), cB + kstep, voffB); PG8_STAGE_A(PG8_SA(1, 0), cA + kstep, 0, false); PG8_STAGE(PG8_SB(1, 1), cB + hstepB + kstep, voffB);
        PG8_WAIT_V(6); PG8_BAR;
    }
    for (;;) {
        const bool has_next = S.next(ui + 1, nxt);
        if (has_next) PG8_GOFF(gN, nxt);
        const char* nA = has_next ? nxt.a : cA; const char* nB = has_next ? nxt.b : cB;
        for (int t = 0; t < nt; t += 2) {
            const bool last = (t == nt - 2); const bool nx_ = last && has_next;
            const char* a1 = cA + (size_t)(t + 1) * kstep;
            const char* a2 = last ? nA : cA + (size_t)(t + 2) * kstep; const char* b2 = last ? nB : cB + (size_t)(t + 2) * kstep;
            const char* a3 = a2 + kstep; const char* b3 = b2 + kstep;
            if (last && has_next) S.a_ready(nxt);
            if constexpr (SP2) {
            PG8_LDB(B0, 0, 0); PG8_LDB(B1, 0, 1); PG8_SCHED; PG8_LDA(At, 0, 0); PG8_STAGE_A(PG8_SA(1, 1), a1, 1, false);
            PG8_WAIT_V(8); PG8_WAIT_L(0); PG8_BAR; PG8_MMA(0, 0, At, B0); PG8_MMA(0, 1, At, B1); PG8_BAR; PG8_SCHED;
            PG8_LDA(At, 0, 1); PG8_STAGE(PG8_SB(0, 0), b2, voffB); PG8_STAGE(PG8_SB(0, 1), b2 + hstepB, voffB); PG8_STAGE_A(PG8_SA(0, 0), a2, 0, nx_);
            PG8_WAIT_V(8); PG8_WAIT_L(0); PG8_BAR; PG8_MMA(1, 0, At, B0); PG8_MMA(1, 1, At, B1); PG8_BAR; PG8_SCHED;
            PG8_LDB(B0, 1, 0); PG8_LDB(B1, 1, 1); PG8_SCHED; PG8_LDA(At, 1, 0); PG8_STAGE_A(PG8_SA(0, 1), a2, 1, nx_);
            PG8_WAIT_V(8); PG8_WAIT_L(0); PG8_BAR; PG8_MMA(0, 0, At, B0); PG8_MMA(0, 1, At, B1); PG8_BAR; PG8_SCHED;
            PG8_LDA(At, 1, 1); PG8_STAGE(PG8_SB(1, 0), b3, voffB); PG8_STAGE(PG8_SB(1, 1), b3 + hstepB, voffB); PG8_STAGE_A(PG8_SA(1, 0), a3, 0, nx_);
            PG8_WAIT_V(8); PG8_WAIT_L(0); PG8_BAR; PG8_MMA(1, 0, At, B0); PG8_MMA(1, 1, At, B1); PG8_BAR; PG8_SCHED;
            } else {
            PG8_LDB(B0, 0, 0); PG8_SCHED; PG8_LDA(At, 0, 0); PG8_STAGE_A(PG8_SA(1, 1), a1, 1, false);
            PG8_WAIT_L(8); PG8_BAR; PG8_WAIT_L(0); PG8_MMA(0, 0, At, B0); PG8_BAR; PG8_SCHED;
            PG8_LDB(B1, 0, 1); PG8_STAGE(PG8_SB(0, 0), b2, voffB);
            PG8_BAR; PG8_WAIT_L(0); PG8_MMA(0, 1, At, B1); PG8_BAR;
            PG8_LDA(At, 0, 1); PG8_STAGE_A(PG8_SA(0, 0), a2, 0, nx_);
            PG8_BAR; PG8_WAIT_L(0); PG8_MMA(1, 0, At, B0); PG8_BAR; PG8_SCHED;
            PG8_STAGE(PG8_SB(0, 1), b2 + hstepB, voffB);
            PG8_WAIT_V(6); PG8_BAR; PG8_MMA(1, 1, At, B1); PG8_BAR;
            PG8_LDB(B0, 1, 0); PG8_SCHED; PG8_LDA(At, 1, 0); PG8_STAGE_A(PG8_SA(0, 1), a2, 1, nx_);
            PG8_WAIT_L(8); PG8_BAR; PG8_WAIT_L(0); PG8_MMA(0, 0, At, B0); PG8_BAR; PG8_SCHED;
            PG8_LDB(B1, 1, 1); PG8_STAGE(PG8_SB(1, 0), b3, voffB);
            PG8_BAR; PG8_WAIT_L(0); PG8_MMA(0, 1, At, B1); PG8_BAR;
            PG8_LDA(At, 1, 1); PG8_STAGE_A(PG8_SA(1, 0), a3, 0, nx_);
            PG8_BAR; PG8_WAIT_L(0); PG8_MMA(1, 0, At, B0); PG8_BAR; PG8_SCHED;
            PG8_STAGE(PG8_SB(1, 1), b3 + hstepB, voffB);
            PG8_WAIT_V(6); PG8_BAR; PG8_MMA(1, 1, At, B1); PG8_BAR;
            }
        }
        if constexpr (ALIGN_EPI) { if (wr == 0) PG8_BAR; }
        if constexpr (!Epi::AFTER_DRAIN) { E(acc, cur, wr, wc, fr, fq); S.done(cur); }
        if (!has_next) break;
#pragma unroll
        for (int a = 0; a < 2; ++a)
#pragma unroll
            for (int b = 0; b < 2; ++b)
#pragma unroll
                for (int m = 0; m < 4; ++m)
#pragma unroll
                    for (int n = 0; n < 2; ++n) acc[a][b][m][n] = (f32x4){0.f, 0.f, 0.f, 0.f};
        cur = nxt; cA = nA; cB = nB; ++ui;
        if constexpr (GATHER) { _Pragma("unroll") for (int h_ = 0; h_ < 2; ++h_) _Pragma("unroll") for (int i_ = 0; i_ < 2; ++i_) gA[h_][i_] = gN[h_][i_]; }
        if constexpr (ALIGN_EPI) { if (wr == 1) PG8_BAR; }
    }
    PG8_WAIT_V(0);
    if constexpr (!ALIGN_EPI) { if (wr == 0) PG8_BAR; }
    PG8_BAR;
    if constexpr (Epi::AFTER_DRAIN) { E.fused(acc, cur, wr, wc, fr, fq, lds, wid, lane); S.done(cur); }
#undef PG8_SA
#undef PG8_SB
#undef PG8_STAGE
#undef PG8_STAGE_A
#undef PG8_GOFF
#undef PG8_LDA
#undef PG8_LDB
#undef PG8_MMA
#undef PG8_WAIT_V
#undef PG8_WAIT_L
#undef PG8_BAR
#undef PG8_SCHED
}
}

#define GAS __attribute__((address_space(1)))
typedef GAS unsigned gu32;
#define RLX_AGENT __ATOMIC_RELAXED, __HIP_MEMORY_SCOPE_AGENT
#define XB_TMO      128
#define XB_XCNT(j)  (256  + 64 * (j))
#define XB_XSUB(j)  (1280 + 64 * (j))
#define XB_XGEN(j)  (2304 + 64 * (j))
#define XB_TOP      3328
#define XB_TOPGEN   3392
#define XCD_BAR_WORDS 3456
#define XB_SPIN_CAP (1u << 18)

__device__ __forceinline__ unsigned xb_ld(unsigned* p)              { return __hip_atomic_load(p, __ATOMIC_RELAXED, __HIP_MEMORY_SCOPE_AGENT); }
__device__ __forceinline__ unsigned xb_add(unsigned* p, unsigned v) { return __hip_atomic_fetch_add(p, v, __ATOMIC_RELAXED, __HIP_MEMORY_SCOPE_AGENT); }
__device__ __forceinline__ unsigned xb_xcc_id() { return (unsigned)__builtin_amdgcn_s_getreg((3 << 11) | 20) & 0xFu; }
#define XB_SPIN(cond, bar) do { unsigned _sp = 0; while (cond) { __builtin_amdgcn_s_sleep(1); \
    if ((++_sp & 255u) == 0u) { if (xb_ld(&(bar)[XB_TMO])) break; if (_sp > XB_SPIN_CAP) { atomicAdd(&(bar)[XB_TMO], 1u); break; } } } } while (0)

struct XcdBarrier {
    unsigned* bar; unsigned x;
    volatile LAS unsigned* st;
};

__device__ __forceinline__ XcdBarrier xcd_barrier_post(unsigned* bar, volatile LAS unsigned* st) {
    XcdBarrier b; b.bar = bar; b.x = xb_xcc_id(); b.st = st;
    if (threadIdx.x == 0) (void)xb_add(&bar[XB_XCNT(b.x)], 1u);
    return b;
}
__device__ __forceinline__ void xcd_barrier_complete(unsigned* bar, unsigned x, unsigned& nloc, unsigned& nx) {
    const unsigned G = gridDim.x * gridDim.y * gridDim.z;
    unsigned sum, cnt, mine, sp = 0u;
    for (;;) {
        sum = 0u; cnt = 0u; mine = 0u;
#pragma unroll
        for (unsigned j = 0; j < 16; ++j) { const unsigned c = xb_ld(&bar[XB_XCNT(j)]); sum += c; cnt += (c > 0u) ? 1u : 0u; mine = (j == x) ? c : mine; }
        if (sum == G) break;
        __builtin_amdgcn_s_sleep(1);
        if ((++sp & 255u) == 0u) { if (xb_ld(&bar[XB_TMO])) break; if (sp > XB_SPIN_CAP) { atomicAdd(&bar[XB_TMO], 1u); break; } }
    }
    nloc = mine > 0u ? mine : 1u; nx = cnt > 0u ? cnt : 1u;
}

__device__ __forceinline__ void xcd_barrier(const XcdBarrier& b) {
    asm volatile("s_waitcnt vmcnt(0)" ::: "memory");
    __syncthreads();
    if (threadIdx.x == 0) {
        unsigned* bar = b.bar;
        __builtin_amdgcn_s_waitcnt(0);
        unsigned nloc = b.st[0], nx = b.st[1];
        if (nloc == 0u) { xcd_barrier_complete(bar, b.x, nloc, nx); b.st[0] = nloc; b.st[1] = nx; }
        const unsigned old = xb_add(&bar[XB_XSUB(b.x)], 1u);
        const unsigned gen = old / nloc;
        if (old + 1u == (gen + 1u) * nloc) {
            __builtin_amdgcn_fence(__ATOMIC_RELEASE, "agent");
            asm volatile("s_waitcnt vmcnt(0)" ::: "memory");
            const unsigned og = xb_add(&bar[XB_TOP], 1u);
            const unsigned tg = og / nx;
            if (og + 1u == (tg + 1u) * nx) xb_add(&bar[XB_TOPGEN], 1u);
            else XB_SPIN(xb_ld(&bar[XB_TOPGEN]) == tg, bar);
            __builtin_amdgcn_fence(__ATOMIC_ACQUIRE, "agent");
            xb_add(&bar[XB_XGEN(b.x)], 1u);
            asm volatile("s_waitcnt vmcnt(0)" ::: "memory");
        } else {
            XB_SPIN(xb_ld(&bar[XB_XGEN(b.x)]) == gen, bar);
            __builtin_amdgcn_fence(__ATOMIC_ACQUIRE, "agent");
            asm volatile("s_waitcnt vmcnt(0)" ::: "memory");
        }
    }
    __syncthreads();
}

struct OrderBase {
    const int* rowidx;
    __device__ __forceinline__ void a_ready(const pg8::Unit&) const {}
    __device__ __forceinline__ void done(const pg8::Unit&) const {}
};
struct PlainOrder : OrderBase {
    const char* A; const char* B; size_t astep, bstep; int nM, nN, G, c;
    __device__ __forceinline__ bool next(int i, pg8::Unit& u) const {
        const long L = (long)i * G + c; if (L >= (long)nM * nN) return false;
        pg8::tile_of((int)L, nM, nN, u.pm, u.pn); u.aux = 0; u.a = A + (size_t)u.pm * astep; u.b = B + (size_t)u.pn * bstep; return true; }
};
struct LruOrder : OrderBase {
    const char* A; const char* B; int nM, G, c;
    __device__ __forceinline__ bool next(int i, pg8::Unit& u) const {
        const long L = (long)i * G + c; if (L >= (long)nM * 16) return false;
        pg8::tile_of((int)L, nM, 16, u.pm, u.pn); u.aux = 0; u.a = A + (size_t)u.pm * (256 * 1024 * 2) + (size_t)(u.pn >> 2) * 512; u.b = B + (size_t)u.pn * (256 * 256 * 2); return true; }
};
struct BranchOrder : OrderBase {
    const char* A; const char* B; int nM, G, c;
    __device__ __forceinline__ bool next(int i, pg8::Unit& u) const {
        const int j = i / 3, br = i - 3 * j; const long L = (long)j * G + c; if (L >= (long)nM * 4) return false;
        pg8::tile_of((int)L, nM, 4, u.pm, u.pn); u.aux = br; u.a = A + (size_t)br * ROWB + (size_t)u.pm * (256 * 1024 * 2); u.b = B + (size_t)br * (1024 * 1024 * 2) + (size_t)u.pn * (256 * 1024 * 2); return true; }
};
struct MoeOrder : OrderBase {
    const char* A; const char* B; const unsigned* tile_e; size_t estep; int nM, nN, G, c, ga;
    __device__ __forceinline__ bool next(int i, pg8::Unit& u) const {
        const long L = (long)i * G + c; if (L >= (long)nM * nN) return false;
        pg8::tile_of((int)L, nM, nN, u.pm, u.pn); const int e = (int)tile_e[u.pm]; u.aux = e;
        u.a = ga ? A : A + (size_t)u.pm * (256 * 1024 * 2); u.b = B + (size_t)e * estep + (size_t)u.pn * (256 * 1024 * 2); return true; }
};

struct EpiBf16Bias {
    static constexpr bool PERM = true, AFTER_DRAIN = false;
    bf16_t* O; int ldc; const float* bias; int bstride;
    __device__ __forceinline__ void operator()(const f32x4 (&acc)[2][2][4][2], const pg8::Unit& u, int wr, int wc, int fr, int fq) const {
        const int row0 = u.pm * 256 + wr * 64 + fr, col0 = u.pn * 256 + wc * 32 + 8 * fq;
        f32x4 bv[2][2];
#pragma unroll
        for (int bj = 0; bj < 2; ++bj)
#pragma unroll
            for (int n = 0; n < 2; ++n) bv[bj][n] = bias ? *(const f32x4*)(bias + (size_t)u.aux * bstride + col0 + bj * 128 + 4 * n) : (f32x4){0.f, 0.f, 0.f, 0.f};
#pragma unroll
        for (int ai = 0; ai < 2; ++ai)
#pragma unroll
            for (int m = 0; m < 4; ++m) { bf16_t* rowp = O + (size_t)(row0 + ai * 128 + m * 16) * ldc + col0;
#pragma unroll
                for (int bj = 0; bj < 2; ++bj) { const f32x4 v0 = acc[ai][bj][m][0] + bv[bj][0], v1 = acc[ai][bj][m][1] + bv[bj][1];
                    u32x4 w; w.x = pg8::cvt_pk_bf16(v0[0], v0[1]); w.y = pg8::cvt_pk_bf16(v0[2], v0[3]); w.z = pg8::cvt_pk_bf16(v1[0], v1[1]); w.w = pg8::cvt_pk_bf16(v1[2], v1[3]);
                    *(u32x4*)(rowp + bj * 128) = w; } }
    }
};
struct EpiLru {
    static constexpr bool PERM = true, AFTER_DRAIN = false;
    const bf16_t* xc; bf16_t* LA; bf16_t* BB; const float* ba; const float* bi; const float* lsl;
    __device__ __forceinline__ void operator()(const f32x4 (&acc)[2][2][4][2], const pg8::Unit& u, int wr, int wc, int fr, int fq) const {
        const int g = u.pn >> 2, d = (u.pn >> 1) & 1, hh = u.pn & 1;
        const int row0 = u.pm * 256 + wr * 64 + fr, ch0 = 256 * g + 128 * hh + wc * 32 + 8 * fq;
#pragma unroll
        for (int ai = 0; ai < 2; ++ai)
#pragma unroll
            for (int m = 0; m < 4; ++m) { const size_t off = (size_t)(row0 + ai * 128 + m * 16) * 1024 + ch0;
                const u32x4 xw = *(const u32x4*)(xc + off); float la[8], bb[8];
#pragma unroll
                for (int n = 0; n < 2; ++n) { const f32x4 pb = *(const f32x4*)(ba + d * 1024 + ch0 + 4 * n), pi = *(const f32x4*)(bi + d * 1024 + ch0 + 4 * n), pl = *(const f32x4*)(lsl + d * 1024 + ch0 + 4 * n);
#pragma unroll
                    for (int e = 0; e < 4; ++e) { const int idx = 4 * n + e; const unsigned w = xw[idx >> 1]; const float xv = (idx & 1) ? bfhi(w) : bflo(w);
                        const float r = sigmoidf_(acc[ai][0][m][n][e] + pb[e]), ig = sigmoidf_(acc[ai][1][m][n][e] + pi[e]);
                        const float l = 8.0f * r * pl[e]; la[idx] = l; bb[idx] = sqrtf(fmaxf(1.0f - __expf(2.0f * l), 0.f)) * ig * xv; } }
                u32x4 w1, w2; w1.x = pg8::cvt_pk_bf16(la[0], la[1]); w1.y = pg8::cvt_pk_bf16(la[2], la[3]); w1.z = pg8::cvt_pk_bf16(la[4], la[5]); w1.w = pg8::cvt_pk_bf16(la[6], la[7]);
                w2.x = pg8::cvt_pk_bf16(bb[0], bb[1]); w2.y = pg8::cvt_pk_bf16(bb[2], bb[3]); w2.z = pg8::cvt_pk_bf16(bb[4], bb[5]); w2.w = pg8::cvt_pk_bf16(bb[6], bb[7]);
                *(u32x4*)(LA + (size_t)d * TT * 1024 + off) = w1; *(u32x4*)(BB + (size_t)d * TT * 1024 + off) = w2; asm volatile("" ::: "memory"); }
    }
};
struct EpiBranch {
    static constexpr bool PERM = true, AFTER_DRAIN = false;
    const bf16_t* P; bf16_t* MB;
    __device__ __forceinline__ void operator()(const f32x4 (&acc)[2][2][4][2], const pg8::Unit& u, int wr, int wc, int fr, int fq) const {
        const int br = u.aux, row0 = u.pm * 256 + wr * 64 + fr, col0 = u.pn * 256 + wc * 32 + 8 * fq;
        bf16_t* dst = MB + (size_t)br * TT * 1024; const bf16_t* M0 = MB; const bf16_t* M1 = MB + (size_t)TT * 1024;
#pragma unroll
        for (int ai = 0; ai < 2; ++ai)
#pragma unroll
            for (int m = 0; m < 4; ++m) { const size_t row = (size_t)(row0 + ai * 128 + m * 16);
#pragma unroll
                for (int bj = 0; bj < 2; ++bj) { const int c = col0 + bj * 128;
                    const u32x4 gw = *(const u32x4*)(P + row * LDP + C_MG + br * 1024 + c);
                    f32x4 v0, v1;
                    v0[0] = sigmoidf_(bflo(gw.x)) * acc[ai][bj][m][0][0]; v0[1] = sigmoidf_(bfhi(gw.x)) * acc[ai][bj][m][0][1]; v0[2] = sigmoidf_(bflo(gw.y)) * acc[ai][bj][m][0][2]; v0[3] = sigmoidf_(bfhi(gw.y)) * acc[ai][bj][m][0][3];
                    v1[0] = sigmoidf_(bflo(gw.z)) * acc[ai][bj][m][1][0]; v1[1] = sigmoidf_(bfhi(gw.z)) * acc[ai][bj][m][1][1]; v1[2] = sigmoidf_(bflo(gw.w)) * acc[ai][bj][m][1][2]; v1[3] = sigmoidf_(bfhi(gw.w)) * acc[ai][bj][m][1][3];
                    if (br == 2) { const u32x4 p0 = *(const u32x4*)(M0 + row * 1024 + c), p1 = *(const u32x4*)(M1 + row * 1024 + c);
                        v0[0] += bflo(p0.x) + bflo(p1.x); v0[1] += bfhi(p0.x) + bfhi(p1.x); v0[2] += bflo(p0.y) + bflo(p1.y); v0[3] += bfhi(p0.y) + bfhi(p1.y);
                        v1[0] += bflo(p0.z) + bflo(p1.z); v1[1] += bfhi(p0.z) + bfhi(p1.z); v1[2] += bflo(p0.w) + bflo(p1.w); v1[3] += bfhi(p0.w) + bfhi(p1.w); }
                    u32x4 w; w.x = pg8::cvt_pk_bf16(v0[0], v0[1]); w.y = pg8::cvt_pk_bf16(v0[2], v0[3]); w.z = pg8::cvt_pk_bf16(v1[0], v1[1]); w.w = pg8::cvt_pk_bf16(v1[2], v1[3]);
                    *(u32x4*)(dst + row * 1024 + c) = w; } }
    }
};
template <bool BASE_F32> struct EpiOut {
    static constexpr bool PERM = true, AFTER_DRAIN = false;
    const float* baseLat; const float* baseCtx; bf16_t* xs; const float* gate;
    __device__ __forceinline__ void operator()(const f32x4 (&acc)[2][2][4][2], const pg8::Unit& u, int wr, int wc, int fr, int fq) const {
        const int mrow = u.pm < 128 ? (u.pm >> 4) : 8; const float* gp = gate + mrow * 6144;
        const int row0 = u.pm * 256 + wr * 64 + fr, col0 = u.pn * 256 + wc * 32 + 8 * fq;
        const float* base = u.pm < 128 ? baseLat + (size_t)row0 * 1024 : baseCtx + (size_t)(row0 - TLAT) * 1024;
        f32x4 gv[2][2];
#pragma unroll
        for (int bj = 0; bj < 2; ++bj)
#pragma unroll
            for (int n = 0; n < 2; ++n) gv[bj][n] = *(const f32x4*)(gp + col0 + bj * 128 + 4 * n);
#pragma unroll
        for (int ai = 0; ai < 2; ++ai)
#pragma unroll
            for (int m = 0; m < 4; ++m) { const size_t ro = (size_t)(ai * 128 + m * 16) * 1024 + col0; bf16_t* op = xs + (size_t)row0 * 1024 + ro;
#pragma unroll
                for (int bj = 0; bj < 2; ++bj) { f32x4 b0, b1;
                    if (BASE_F32) { b0 = *(const f32x4*)(base + ro + bj * 128); b1 = *(const f32x4*)(base + ro + bj * 128 + 4); }
                    else { const u32x4 w = *(const u32x4*)(op + bj * 128); b0 = (f32x4){bflo(w.x), bfhi(w.x), bflo(w.y), bfhi(w.y)}; b1 = (f32x4){bflo(w.z), bfhi(w.z), bflo(w.w), bfhi(w.w)}; }
                    const f32x4 v0 = b0 + gv[bj][0] * acc[ai][bj][m][0], v1 = b1 + gv[bj][1] * acc[ai][bj][m][1];
                    u32x4 w; w.x = pg8::cvt_pk_bf16(v0[0], v0[1]); w.y = pg8::cvt_pk_bf16(v0[2], v0[3]); w.z = pg8::cvt_pk_bf16(v1[0], v1[1]); w.w = pg8::cvt_pk_bf16(v1[2], v1[3]);
                    *(u32x4*)(op + bj * 128) = w; } }
    }
};
struct EpiSwiglu {
    static constexpr bool PERM = true, AFTER_DRAIN = false;
    bf16_t* H; const float* bgu;
    __device__ __forceinline__ void operator()(const f32x4 (&acc)[2][2][4][2], const pg8::Unit& u, int wr, int wc, int fr, int fq) const {
        const int row0 = u.pm * 256 + wr * 64 + fr, f0 = u.pn * 128 + wc * 32 + 8 * fq;
        float bg[8], bu[8];
#pragma unroll
        for (int q = 0; q < 4; ++q) { const f32x4 b = *(const f32x4*)(bgu + (size_t)u.aux * 2048 + 2 * f0 + 4 * q); bg[2 * q] = b[0]; bu[2 * q] = b[1]; bg[2 * q + 1] = b[2]; bu[2 * q + 1] = b[3]; }
#pragma unroll
        for (int ai = 0; ai < 2; ++ai)
#pragma unroll
            for (int m = 0; m < 4; ++m) { float a[8];
#pragma unroll
                for (int n = 0; n < 2; ++n)
#pragma unroll
                    for (int e = 0; e < 4; ++e) { const int idx = 4 * n + e; const float gt = fminf(acc[ai][0][m][n][e] + bg[idx], 7.0f), up = fminf(fmaxf(acc[ai][1][m][n][e] + bu[idx], -7.0f), 7.0f);
                        a[idx] = gt * sigmoidf_(1.702f * gt) * (up + 1.0f); }
                u32x4 w; w.x = pg8::cvt_pk_bf16(a[0], a[1]); w.y = pg8::cvt_pk_bf16(a[2], a[3]); w.z = pg8::cvt_pk_bf16(a[4], a[5]); w.w = pg8::cvt_pk_bf16(a[6], a[7]);
                *(u32x4*)(H + (size_t)(row0 + ai * 128 + m * 16) * 1024 + f0) = w; }
    }
};

constexpr int NWAVES = 8, NTHR = 512;
constexpr int LDS_BYTES = 163840, MISC_OFF = 163840 - 512;
template <int I> __device__ __forceinline__ const float* inptr() { const GAS float* p;
    asm volatile("s_load_dwordx2 %0, %1, %2\n\ts_waitcnt lgkmcnt(0)" : "=s"(p) : "s"(__builtin_amdgcn_kernarg_segment_ptr()), "n"(I * 8)); return (const float*)p; }
struct Frame {
    LAS unsigned char* lds; GAS unsigned char* ws; float* out;
    int tid, bx, lane, wave, G, gw, NGW, gtid, NGT;
};
__device__ __forceinline__ int mrow_of(int row) { return row < TLAT ? (row >> 12) : 8; }
__device__ __forceinline__ int seqrow(int d, int b, int p) {
    if (p < CTXL) return TLAT + b * CTXL + (d ? CTXL - 1 - p : p);
    const int q = p - CTXL; return b * SEQ + (d ? SEQ - 1 - q : q);
}
struct RowV { f32x4 v[4]; };
__device__ __forceinline__ RowV load_row(const float* p, int lane) { RowV r;
#pragma unroll
    for (int j = 0; j < 4; ++j) r.v[j] = *(const f32x4*)(p + 4 * lane + 256 * j);
    return r; }
__device__ __forceinline__ RowV load_row_bf16(const bf16_t* p, int lane) { RowV r;
#pragma unroll
    for (int j = 0; j < 4; ++j) { const u32x2 w = *(const u32x2*)(p + 4 * lane + 256 * j); r.v[j] = (f32x4){bflo(w.x), bfhi(w.x), bflo(w.y), bfhi(w.y)}; }
    return r; }
__device__ __forceinline__ float row_sumsq(const RowV& r) { float s = 0.f;
#pragma unroll
    for (int j = 0; j < 4; ++j) s += (r.v[j][0] * r.v[j][0] + r.v[j][1] * r.v[j][1]) + (r.v[j][2] * r.v[j][2] + r.v[j][3] * r.v[j][3]);
    return wave_sum(s); }
__device__ __forceinline__ RowV norm_mod(const RowV& x, const float* gain, const float* shift, const float* scale, int lane) {
    const float rs = rsqrtf(row_sumsq(x) * (1.0f / D) + EPS); RowV y;
#pragma unroll
    for (int j = 0; j < 4; ++j) { const int c = 4 * lane + 256 * j; const f32x4 g = *(const f32x4*)(gain + c), sh = *(const f32x4*)(shift + c), sc = *(const f32x4*)(scale + c);
        y.v[j] = (x.v[j] * rs) * g * (sc + 1.0f) + sh; }
    return y; }
__device__ __forceinline__ void store_row_bf16(bf16_t* p, const RowV& y, int lane) {
#pragma unroll
    for (int j = 0; j < 4; ++j) { u32x2 w; w.x = pk2(y.v[j][0], y.v[j][1]); w.y = pk2(y.v[j][2], y.v[j][3]); *(u32x2*)(p + 4 * lane + 256 * j) = w; } }
__device__ __forceinline__ f32x4 ld4bf(const bf16_t* p) { const u32x2 w = *(const u32x2*)p; return (f32x4){bflo(w.x), bfhi(w.x), bflo(w.y), bfhi(w.y)}; }

__device__ __forceinline__ void phase_proA(const Frame& F) {
    const float* c = inptr<1>(); const float* cc = inptr<3>(); const float* w_ada = inptr<4>();
    float* modp = (float*)(F.ws + WS_MODP);
    for (int it = F.gw; it < 2 * 8 * 96; it += F.NGW) {
        const int cg = it % 96, ks = (it / 96) % 8, l = it / 768, col = cg * 64 + F.lane;
        float acc[9];
#pragma unroll
        for (int r = 0; r < 9; ++r) acc[r] = 0.f;
        for (int k = ks * 128; k < ks * 128 + 128; ++k) {
            const float w = w_ada[((size_t)l * 1024 + k) * 6144 + col];
#pragma unroll
            for (int r = 0; r < 8; ++r) acc[r] += siluf_(c[r * 1024 + k]) * w;
            acc[8] += siluf_(cc[k]) * w;
        }
#pragma unroll
        for (int r = 0; r < 9; ++r) modp[((size_t)(ks * 2 + l) * 9 + r) * 6144 + col] = acc[r];
    }
    float* rc = (float*)(F.ws + WS_COS); float* rsn = (float*)(F.ws + WS_SIN);
    for (int i = F.gtid; i < SEQ * 64; i += F.NGT) {
        const int t = i >> 6, j = i & 63, f = j & 31; const float pos = (float)((j < 32) ? (t >> 6) : (t & 63));
        const float inv = exp2f(-(float)f * (13.287712379549449f / 32.0f)); const float ang = pos * inv;
        const float nn = rintf(ang * 0.15915494309189535f); float r = fmaf(-nn, 6.28125f, ang); r = fmaf(-nn, 1.9353071795864769e-3f, r);
        rc[i] = __cosf(r); rsn[i] = __sinf(r);
    }
}
__device__ __forceinline__ void phase_proB(const Frame& F) {
    const float* modp = (const float*)(F.ws + WS_MODP); float* mods = (float*)(F.ws + WS_MODS); const float* b_ada = inptr<5>();
    for (int i = F.gtid; i < 2 * 9 * 6144; i += F.NGT) { const int l = i / (9 * 6144), col = i % 6144; float s = b_ada[l * 6144 + col];
#pragma unroll
        for (int ks = 0; ks < 8; ++ks) s += modp[(size_t)ks * (2 * 9 * 6144) + i];
        mods[i] = s; }
}

template <class RM> __device__ __forceinline__ void tr_item(const float* W, int ldw, int k0, int n0, bf16_t* WT, int ldt, LAS float* scr, int lane, const RM& rm) {
#pragma unroll 8
    for (int i = 0; i < 32; ++i) { const int kk = 2 * i + (lane >> 5); scr[kk * 33 + (lane & 31)] = W[(size_t)(k0 + kk) * ldw + n0 + (lane & 31)]; }
    LDS_WAIT(); asm volatile("" ::: "memory");
    const int c = lane & 7;
#pragma unroll
    for (int j = 0; j < 4; ++j) { const int n = (lane >> 3) + 8 * j; const LAS float* s = scr + (8 * c) * 33 + n; int drow; float sc; rm(n0 + n, drow, sc);
        u32x4 o; o.x = pk2(s[0 * 33] * sc, s[1 * 33] * sc); o.y = pk2(s[2 * 33] * sc, s[3 * 33] * sc); o.z = pk2(s[4 * 33] * sc, s[5 * 33] * sc); o.w = pk2(s[6 * 33] * sc, s[7 * 33] * sc);
        *(u32x4*)(WT + (size_t)drow * ldt + k0 + 8 * c) = o; }
    LDS_WAIT(); asm volatile("" ::: "memory");
}
struct RmIn { __device__ __forceinline__ void operator()(int n, int& drow, float& sc) const {
    drow = n < 3072 ? n : (n < 3104 ? C_LR + (n - 3072) : n - 32); sc = (n < 512 || (n >= 5664 && n < 6176)) ? 0.08838834764831845f : 1.0f; } };
struct RmId { __device__ __forceinline__ void operator()(int n, int& drow, float& sc) const { drow = n; sc = 1.0f; } };
struct RmLru { int base; __device__ __forceinline__ void operator()(int n, int& drow, float& sc) const { drow = base + (n & 127); sc = 1.0f; } };
struct RmGu { __device__ __forceinline__ void operator()(int n, int& drow, float& sc) const { const int f = n >> 1, u = n & 1; drow = 256 * (f >> 7) + 128 * u + (f & 127); sc = 1.0f; } };
__device__ __forceinline__ void phase_W(const Frame& F, int li) {
    LAS float* scr = (LAS float*)(F.lds + F.wave * 8704);
    bf16_t* Win_t = (bf16_t*)(F.ws + WS_WIN); bf16_t* Wlru_t = (bf16_t*)(F.ws + WS_WLRU); bf16_t* Wbr_t = (bf16_t*)(F.ws + WS_WBR);
    bf16_t* Wout_t = (bf16_t*)(F.ws + WS_WOUT); bf16_t* Wgu_t = (bf16_t*)(F.ws + WS_WGU); bf16_t* Wdn_t = (bf16_t*)(F.ws + WS_WDN);
    constexpr int I_IN = 16 * 353, I_LRU = 512, I_BR = 1536, I_OUT = 512, I_GU = 32768, I_DN = 16384, NITEMS = I_IN + I_LRU + I_BR + I_OUT + I_GU + I_DN;
    for (int it0 = F.gw; it0 < NITEMS; it0 += F.NGW) {
        int it = it0;
        if (it < I_IN) { const int kb = it / 353, nb = it % 353; tr_item(inptr<8>() + (size_t)li * 1024 * IN_TOTAL, IN_TOTAL, 64 * kb, 32 * nb, Win_t, 1024, scr, F.lane, RmIn{}); continue; } it -= I_IN;
        if (it < I_LRU) { const int mat = it >> 5, r = it & 31, kb = r >> 3, nb = r & 7, ty = mat >> 3, d = (mat >> 2) & 1, g = mat & 3, n0 = 32 * nb, pn = g * 4 + d * 2 + (n0 >> 7);
            const float* src = (ty ? inptr<16>() : inptr<14>()) + (size_t)((li * 2 + d) * 4 + g) * 65536;
            tr_item(src, 256, 64 * kb, n0, Wlru_t, 256, scr, F.lane, RmLru{pn * 256 + ty * 128}); continue; } it -= I_LRU;
        if (it < I_BR) { const int br = it >> 9, r = it & 511, kb = r >> 5, nb = r & 31; tr_item(inptr<20>() + (size_t)(li * 3 + br) * 1048576, 1024, 64 * kb, 32 * nb, Wbr_t + (size_t)br * 1048576, 1024, scr, F.lane, RmId{}); continue; } it -= I_BR;
        if (it < I_OUT) { const int kb = it >> 5, nb = it & 31; tr_item(inptr<21>() + (size_t)li * 1048576, 1024, 64 * kb, 32 * nb, Wout_t, 1024, scr, F.lane, RmId{}); continue; } it -= I_OUT;
        if (it < I_GU) { const int e = it >> 10, r = it & 1023, kb = r >> 6, nb = r & 63; tr_item(inptr<24>() + (size_t)(li * 32 + e) * 2097152, 2048, 64 * kb, 32 * nb, Wgu_t + (size_t)e * 2097152, 1024, scr, F.lane, RmGu{}); continue; } it -= I_GU;
        { const int e = it >> 9, r = it & 511, kb = r >> 5, nb = r & 31; tr_item(inptr<26>() + (size_t)(li * 32 + e) * 1048576, 1024, 64 * kb, 32 * nb, Wdn_t + (size_t)e * 1048576, 1024, scr, F.lane, RmId{}); }
    }
    for (int i = F.gtid; i < (LDP - IN_TOTAL) * 1024 / 8; i += F.NGT) *(u32x4*)(Win_t + (size_t)IN_TOTAL * 1024 + (size_t)i * 8) = (u32x4){0u, 0u, 0u, 0u};
    float* lsl = (float*)(F.ws + WS_LSL);
    for (int i = F.gtid; i < 2048; i += F.NGT) lsl[i] = logsigmoidf_(inptr<18>()[li * 2048 + i]);
}
__device__ __forceinline__ void phase_norm_in(const Frame& F) {
    const float* mods = (const float*)(F.ws + WS_MODS); bf16_t* xn = (bf16_t*)(F.ws + WS_D);
    for (int row = F.gw; row < TT; row += F.NGW) {
        const float* src = row < TLAT ? inptr<0>() + (size_t)row * D : inptr<2>() + (size_t)(row - TLAT) * D;
        const float* mp = mods + mrow_of(row) * 6144;
        const RowV y = norm_mod(load_row(src, F.lane), inptr<6>(), mp, mp + 1024, F.lane);
        store_row_bf16(xn + (size_t)row * D, y, F.lane);
    }
}

__device__ __forceinline__ void phase_conv(const Frame& F, int li) {
    const bf16_t* P = (const bf16_t*)(F.ws + WS_P); bf16_t* xc = (bf16_t*)(F.ws + WS_D);
    const float* cw = inptr<12>() + (size_t)li * 4 * 1024; const float* cb = inptr<13>() + (size_t)li * 1024;
    for (int i = F.gtid; i < TT * 128; i += F.NGT) {
        const int row = i >> 7, ch = (i & 127) * 8;
        int t, L; if (row < TLAT) { t = row & (SEQ - 1); L = SEQ; } else { t = (row - TLAT) & (CTXL - 1); L = CTXL; }
        float a[8];
        { const f32x4 b0 = *(const f32x4*)(cb + ch), b1 = *(const f32x4*)(cb + ch + 4); a[0] = b0[0]; a[1] = b0[1]; a[2] = b0[2]; a[3] = b0[3]; a[4] = b1[0]; a[5] = b1[1]; a[6] = b1[2]; a[7] = b1[3]; }
#pragma unroll
        for (int j = 0; j < 4; ++j) { const int tt = t - 2 + j; if (tt < 0 || tt >= L) continue;
            const u32x4 xw = *(const u32x4*)(P + (size_t)(row - 2 + j) * LDP + C_LX + ch);
            const f32x4 w0 = *(const f32x4*)(cw + j * 1024 + ch), w1 = *(const f32x4*)(cw + j * 1024 + ch + 4);
            a[0] += w0[0] * bflo(xw.x); a[1] += w0[1] * bfhi(xw.x); a[2] += w0[2] * bflo(xw.y); a[3] += w0[3] * bfhi(xw.y);
            a[4] += w1[0] * bflo(xw.z); a[5] += w1[1] * bfhi(xw.z); a[6] += w1[2] * bflo(xw.w); a[7] += w1[3] * bfhi(xw.w); }
        u32x4 o; o.x = pk2(a[0], a[1]); o.y = pk2(a[2], a[3]); o.z = pk2(a[4], a[5]); o.w = pk2(a[6], a[7]);
        *(u32x4*)(xc + (size_t)row * 1024 + ch) = o;
    }
    bf16_t* Pw = (bf16_t*)(F.ws + WS_P); const float* rcos = (const float*)(F.ws + WS_COS); const float* rsin = (const float*)(F.ws + WS_SIN);
    for (int i = F.gtid; i < TLAT * 64; i += F.NGT) {
        const int g8 = i & 7, qk = (i >> 3) & 1, h = (i >> 4) & 3, row = i >> 6, t = row & (SEQ - 1);
        bf16_t* p1 = Pw + (size_t)row * LDP + (qk ? C_RK : C_RQ) + 128 * h + 8 * g8; bf16_t* p2 = p1 + 64;
        const u32x4 a = *(const u32x4*)p1, b = *(const u32x4*)p2;
        const f32x4 c0 = *(const f32x4*)(rcos + t * 64 + 8 * g8), c1 = *(const f32x4*)(rcos + t * 64 + 8 * g8 + 4), s0 = *(const f32x4*)(rsin + t * 64 + 8 * g8), s1 = *(const f32x4*)(rsin + t * 64 + 8 * g8 + 4);
        const float cs[8] = {c0[0], c0[1], c0[2], c0[3], c1[0], c1[1], c1[2], c1[3]}, sn[8] = {s0[0], s0[1], s0[2], s0[3], s1[0], s1[1], s1[2], s1[3]};
        const unsigned aw[4] = {a.x, a.y, a.z, a.w}, bw[4] = {b.x, b.y, b.z, b.w}; u32x4 o1, o2;
#pragma unroll
        for (int e = 0; e < 4; ++e) { const float x1a = bflo(aw[e]), x1b = bfhi(aw[e]), x2a = bflo(bw[e]), x2b = bfhi(bw[e]);
            o1[e] = pk2(x1a * cs[2 * e] - x2a * sn[2 * e], x1b * cs[2 * e + 1] - x2b * sn[2 * e + 1]);
            o2[e] = pk2(x1a * sn[2 * e] + x2a * cs[2 * e], x1b * sn[2 * e + 1] + x2b * cs[2 * e + 1]); }
        *(u32x4*)p1 = o1; *(u32x4*)p2 = o2;
    }
}
constexpr int LSEG = 136, LNSEG = (CTXL + SEQ) / LSEG;
template <bool FINAL> __device__ __forceinline__ void phase_lru_scan(const Frame& F) {
    const bf16_t* LA = (const bf16_t*)(F.ws + WS_C); const bf16_t* BB = (const bf16_t*)(F.ws + WS_C + 2 * ROWB);
    float* carA = (float*)(F.ws + WS_CARA); float* carH = (float*)(F.ws + WS_CARH); bf16_t* HO = (bf16_t*)(F.ws + WS_E);
    for (int i = F.gtid; i < 2 * 8 * LNSEG * 256; i += F.NGT) {
        const int cq = i & 255, s = (i >> 8) % LNSEG, db = (i >> 8) / LNSEG, b = db & 7, d = db >> 3;
        f32x4 h = (f32x4){0.f, 0.f, 0.f, 0.f}, As = (f32x4){0.f, 0.f, 0.f, 0.f};
        if (FINAL) { for (int s2 = 0; s2 < s; ++s2) { const size_t o = ((size_t)(db * LNSEG + s2) * 256 + cq) * 4; h = *(const f32x4*)(carA + o) * h + *(const f32x4*)(carH + o); } }
        const size_t dofs = (size_t)d * TT * 1024;
#pragma unroll 8
        for (int p = 0; p < LSEG; ++p) { const size_t off = (size_t)seqrow(d, b, s * LSEG + p) * 1024 + cq * 4;
            const f32x4 la = ld4bf(LA + dofs + off), bb = ld4bf(BB + dofs + off);
            f32x4 a; a[0] = __expf(la[0]); a[1] = __expf(la[1]); a[2] = __expf(la[2]); a[3] = __expf(la[3]);
            h = a * h + bb;
            if (FINAL) { u32x2 w; w.x = pk2(h[0], h[1]); w.y = pk2(h[2], h[3]); *(u32x2*)(HO + dofs + off) = w; } else As += la; }
        if (!FINAL) { const size_t o = (size_t)i * 4; f32x4 A; A[0] = __expf(As[0]); A[1] = __expf(As[1]); A[2] = __expf(As[2]); A[3] = __expf(As[3]);
            *(f32x4*)(carA + o) = A; *(f32x4*)(carH + o) = h; }
    }
}


constexpr size_t QKB = (size_t)TT * 512 * 2;
__device__ __forceinline__ void phase_scanprep(const Frame& F, int li) {
    LAS float* lrs = (LAS float*)F.lds;
    LAS float* qtot = lrs + 64 * 32;
    LAS float* gcs = qtot + 4 * 512;
    bf16_t* Pm = (bf16_t*)(F.ws + WS_P); bf16_t* QK = (bf16_t*)(F.ws + WS_C); float* EGL = (float*)(F.ws + WS_MODP);
    const int qtr = F.tid >> 7, c4 = F.tid & 127, ch0 = 4 * c4;
    for (int rc = F.bx; rc < TT / 64; rc += F.G) {
        if (F.tid < 256) { const int tok = F.tid >> 2, q8 = F.tid & 3; const u32x4 v = *(const u32x4*)(Pm + (size_t)(64 * rc + tok) * LDP + C_LR + 8 * q8);
            LAS float* dst = lrs + tok * 32 + 8 * q8; *(LAS f32x4*)dst = (f32x4){bflo(v.x), bfhi(v.x), bflo(v.y), bfhi(v.y)}; *(LAS f32x4*)(dst + 4) = (f32x4){bflo(v.z), bfhi(v.z), bflo(v.w), bfhi(v.w)}; }
        __syncthreads();
        for (int d = 0; d < 2; ++d) {
            f32x4 wv[16];
#pragma unroll
            for (int r = 0; r < 16; ++r) wv[r] = *(const f32x4*)(inptr<9>() + (size_t)((li * 2 + d) * 16 + r) * 512 + ch0);
            const f32x4 bav = *(const f32x4*)(inptr<10>() + (size_t)(li * 2 + d) * 512 + ch0);
            f32x4 run = (f32x4){0.f, 0.f, 0.f, 0.f};
#pragma unroll 2
            for (int i = 0; i < 16; ++i) { const int p = 16 * qtr + i, tok = d ? 63 - p : p; f32x4 z = bav;
#pragma unroll
                for (int r4 = 0; r4 < 4; ++r4) { const f32x4 l = *(const LAS f32x4*)(lrs + tok * 32 + 16 * d + 4 * r4);
#pragma unroll
                    for (int e = 0; e < 4; ++e) z += wv[4 * r4 + e] * l[e]; }
#pragma unroll
                for (int e = 0; e < 4; ++e) run[e] += logsigmoidf_(z[e]) * 0.0625f;
                *(LAS f32x4*)(gcs + p * 512 + ch0) = run; }
            *(LAS f32x4*)(qtot + qtr * 512 + ch0) = run;
            __syncthreads();
            f32x4 off = (f32x4){0.f, 0.f, 0.f, 0.f}, tot = (f32x4){0.f, 0.f, 0.f, 0.f};
#pragma unroll
            for (int q2 = 0; q2 < 4; ++q2) { const f32x4 t = *(const LAS f32x4*)(qtot + q2 * 512 + ch0); tot += t; if (q2 < qtr) off += t; }
            if (qtr == 0) { f32x4 e4; e4[0] = __expf(tot[0]); e4[1] = __expf(tot[1]); e4[2] = __expf(tot[2]); e4[3] = __expf(tot[3]); *(f32x4*)(EGL + ((size_t)d * (TT / 64) + rc) * 512 + ch0) = e4; }
            bf16_t* EGd = QK + (size_t)d * TT * 512;
#pragma unroll 4
            for (int i = 0; i < 16; ++i) { const int p = 16 * qtr + i, tok = d ? 63 - p : p; const size_t row = (size_t)(64 * rc + tok);
                const f32x4 G = *(const LAS f32x4*)(gcs + p * 512 + ch0) + off;
                u32x2 we; we.x = pk2(__expf(G[0]), __expf(G[1])); we.y = pk2(__expf(G[2]), __expf(G[3]));
                *(u32x2*)(EGd + row * 512 + ch0) = we; }
            __syncthreads();
        }
    }
}
typedef short s16x4 __attribute__((ext_vector_type(4)));
constexpr int SC_PITCH = 272, SC_QS = 0, SC_KS = 17408, SC_VS = 34816, SC_SB = 52224, SC_AS = 87040, SC_APITCH = 144, SC_OS = SC_AS + 9216;
__device__ __forceinline__ bf16x8 tr_frag(LAS unsigned char* base, int pitch, int k0, int c0, int lane) {
    const int q = (lane & 15) >> 2, p = lane & 3;
    LAS unsigned char* a = base + (k0 + q) * pitch + (c0 + 4 * p) * 2;
    const s16x4 lo = __builtin_amdgcn_ds_read_tr16_b64_v4i16((LAS s16x4*)a);
    const s16x4 hi = __builtin_amdgcn_ds_read_tr16_b64_v4i16((LAS s16x4*)(a + 4 * pitch));
    return (bf16x8){lo[0], lo[1], lo[2], lo[3], hi[0], hi[1], hi[2], hi[3]};
}
#define MFMA16(a, b, c) __builtin_amdgcn_mfma_f32_16x16x32_bf16((a), (b), (c), 0, 0, 0)
__device__ __forceinline__ int chunk_rc(int d, int b, int chn) { return chn < 4 ? (TLAT / 64) + 4 * b + (d ? 3 - chn : chn) : 64 * b + (d ? 63 - (chn - 4) : (chn - 4)); }
struct ScanSet { u32x4 q[2], k[2], v[2], e[2]; float gl[2]; };
#define GST16(ptr, val) asm volatile("global_store_dwordx4 %0, %1, off\n\ts_nop 1" :: "v"(ptr), "v"(val) : "memory")
template <int MX> __device__ __forceinline__ void scan_unit(const Frame& F, int u) {
    LAS unsigned char* L = F.lds;
    const int tid = F.tid, lane = F.lane, w = F.wave, fr = lane & 15, fq = lane >> 4, tt = tid >> 4, part = tid & 15;
    const int js = u & 1, h = (u >> 1) & 3, b = (u >> 3) & 7, d = (u >> 6) & 1;
    const bf16_t* Pq = (const bf16_t*)(F.ws + WS_P) + (MX ? C_RQ : C_GQ) + 128 * h + 8 * part; const bf16_t* Pk = Pq + 512;
    const bf16_t* Pv = (const bf16_t*)(F.ws + WS_P) + (MX ? C_RV : C_GV) + 256 * h + 128 * js + 8 * part;
    const bf16_t* EGp = (const bf16_t*)(F.ws + WS_C) + (size_t)d * TT * 512 + 128 * h + 8 * part;
    const int tmA = w >> 1, tnA = 2 * (w & 1), tmB = w & 1, tnB = w >> 1, tmS = w & 3, tnS = w >> 2;
    const float* EGLp = (const float*)(F.ws + WS_MODP) + (size_t)d * (TT / 64) * 512 + 128 * h + 32 * tmS + fr;
    bf16_t* O = (bf16_t*)(F.ws + WS_B) + (size_t)(MX * 2 + d) * TT * 1024 + 256 * h + 128 * js + 8 * part;
    float er[2] = {1.f, 1.f}, nr[2] = {1.f, 1.f}, egr = 1.0f;
    if (MX == 1) { const float x = exp2f(-5.0f - (float)h), lg = -(x + x * x * 0.5f + x * x * x * (1.0f / 3.0f) + x * x * x * x * 0.25f);
        egr = __expf(64.0f * lg); er[0] = __expf((float)(tt + 1) * lg); nr[0] = __expf(-(float)(tt + 1) * lg); er[1] = __expf((float)(tt + 33) * lg); nr[1] = __expf(-(float)(tt + 33) * lg); }
    f32x4 S[2][4];
#pragma unroll
    for (int i = 0; i < 2; ++i)
#pragma unroll
        for (int j = 0; j < 4; ++j) S[i][j] = (f32x4){0.f, 0.f, 0.f, 0.f};
    for (int i = tid; i < (128 * SC_PITCH) / 16; i += NTHR) *(LAS u32x4*)(L + SC_SB + i * 16) = (u32x4){0u, 0u, 0u, 0u};
    constexpr int NCH = (CTXL + SEQ) / 64;
    ScanSet sA, sB;
#define SC_LOAD(chn, st) do { const int rc_ = chunk_rc(d, b, (chn)); _Pragma("unroll") for (int ps = 0; ps < 2; ++ps) { const int c_ = tt + 32 * ps; const size_t row_ = (size_t)(64 * rc_ + (d ? 63 - c_ : c_)); \
        st.q[ps] = *(const u32x4*)(Pq + row_ * LDP); st.k[ps] = *(const u32x4*)(Pk + row_ * LDP); st.v[ps] = *(const u32x4*)(Pv + row_ * LDP); if (MX == 0) st.e[ps] = *(const u32x4*)(EGp + row_ * 512); } \
        if (MX == 0) { st.gl[0] = EGLp[(size_t)rc_ * 512]; st.gl[1] = EGLp[(size_t)rc_ * 512 + 16]; } } while (0)
#define SC_PUT(st) do { _Pragma("unroll") for (int ps = 0; ps < 2; ++ps) { const int c_ = tt + 32 * ps; u32x4 qo, ko; \
        _Pragma("unroll") for (int e2 = 0; e2 < 4; ++e2) { float ea, eb, na, nb; \
            if (MX == 0) { ea = bflo(st.e[ps][e2]); eb = bfhi(st.e[ps][e2]); na = __builtin_amdgcn_rcpf(ea); nb = __builtin_amdgcn_rcpf(eb); } else { ea = eb = er[ps]; na = nb = nr[ps]; } \
            qo[e2] = pk2(bflo(st.q[ps][e2]) * ea, bfhi(st.q[ps][e2]) * eb); ko[e2] = pk2(bflo(st.k[ps][e2]) * na, bfhi(st.k[ps][e2]) * nb); } \
        *(LAS u32x4*)(L + SC_QS + c_ * SC_PITCH + part * 16) = qo; *(LAS u32x4*)(L + SC_KS + c_ * SC_PITCH + part * 16) = ko; *(LAS u32x4*)(L + SC_VS + c_ * SC_PITCH + part * 16) = st.v[ps]; } } while (0)
    float eg[2] = {egr, egr}, egn[2] = {egr, egr};
    SC_LOAD(0, sA); SC_PUT(sA); if (MX == 0) { eg[0] = sA.gl[0]; eg[1] = sA.gl[1]; }
    SC_LOAD(1, sA);
    __syncthreads();
#define SC_CHUNK(ch, LS, PS) do { \
        const int rc = chunk_rc(d, b, ch); \
        SC_LOAD(((ch) + 2 < NCH ? (ch) + 2 : NCH - 1), LS); \
        {   f32x4 a[2] = {(f32x4){0.f, 0.f, 0.f, 0.f}, (f32x4){0.f, 0.f, 0.f, 0.f}}; \
        _Pragma("unroll") \
            for (int ks = 0; ks < 4; ++ks) { const bf16x8 xq = *(const LAS bf16x8*)(L + SC_QS + (16 * tmA + fr) * SC_PITCH + (32 * ks + 8 * fq) * 2); \
        _Pragma("unroll") \
                for (int j = 0; j < 2; ++j) { const bf16x8 yk = *(const LAS bf16x8*)(L + SC_KS + (16 * (tnA + j) + fr) * SC_PITCH + (32 * ks + 8 * fq) * 2); a[j] = MFMA16(yk, xq, a[j]); } } \
            const int c = 16 * tmA + fr; \
        _Pragma("unroll") \
            for (int j = 0; j < 2; ++j) { const int s0 = 16 * (tnA + j) + 4 * fq; float m[4]; \
        _Pragma("unroll") \
                for (int e = 0; e < 4; ++e) { const int s = s0 + e; const bool keep = d ? (s < c) : (s <= c); m[e] = keep ? a[j][e] : 0.f; } \
                u32x2 wv; wv.x = pk2(m[0], m[1]); wv.y = pk2(m[2], m[3]); *(LAS u32x2*)(L + SC_AS + c * SC_APITCH + s0 * 2) = wv; } } \
        __syncthreads(); \
        f32x4 o[2][2]; \
        _Pragma("unroll") \
        for (int i = 0; i < 2; ++i) \
        _Pragma("unroll") \
            for (int j = 0; j < 2; ++j) o[i][j] = (f32x4){0.f, 0.f, 0.f, 0.f}; \
        _Pragma("unroll") \
        for (int ks = 0; ks < 2; ++ks) { bf16x8 xa[2], yv[2]; \
        _Pragma("unroll") \
            for (int i = 0; i < 2; ++i) xa[i] = *(const LAS bf16x8*)(L + SC_AS + (32 * tmB + 16 * i + fr) * SC_APITCH + (32 * ks + 8 * fq) * 2); \
        _Pragma("unroll") \
            for (int j = 0; j < 2; ++j) yv[j] = tr_frag(L + SC_VS, SC_PITCH, 32 * ks + 8 * fq, 32 * tnB + 16 * j, lane); \
        _Pragma("unroll") \
            for (int i = 0; i < 2; ++i) \
        _Pragma("unroll") \
                for (int j = 0; j < 2; ++j) o[i][j] = MFMA16(yv[j], xa[i], o[i][j]); } \
        _Pragma("unroll") \
        for (int ks = 0; ks < 4; ++ks) { bf16x8 xq[2], ys[2]; \
        _Pragma("unroll") \
            for (int i = 0; i < 2; ++i) xq[i] = *(const LAS bf16x8*)(L + SC_QS + (32 * tmB + 16 * i + fr) * SC_PITCH + (32 * ks + 8 * fq) * 2); \
        _Pragma("unroll") \
            for (int j = 0; j < 2; ++j) ys[j] = tr_frag(L + SC_SB, SC_PITCH, 32 * ks + 8 * fq, 32 * tnB + 16 * j, lane); \
        _Pragma("unroll") \
            for (int i = 0; i < 2; ++i) \
        _Pragma("unroll") \
                for (int j = 0; j < 2; ++j) o[i][j] = MFMA16(ys[j], xq[i], o[i][j]); } \
        _Pragma("unroll") \
        for (int ks = 0; ks < 2; ++ks) { bf16x8 xk[2], yv[4]; \
        _Pragma("unroll") \
            for (int i = 0; i < 2; ++i) xk[i] = tr_frag(L + SC_KS, SC_PITCH, 32 * ks + 8 * fq, 32 * tmS + 16 * i, lane); \
        _Pragma("unroll") \
            for (int j = 0; j < 4; ++j) yv[j] = tr_frag(L + SC_VS, SC_PITCH, 32 * ks + 8 * fq, 64 * tnS + 16 * j, lane); \
        _Pragma("unroll") \
            for (int i = 0; i < 2; ++i) \
        _Pragma("unroll") \
                for (int j = 0; j < 4; ++j) S[i][j] = MFMA16(yv[j], xk[i], S[i][j]); } \
        __syncthreads(); \
        _Pragma("unroll") \
        for (int i = 0; i < 2; ++i) \
        _Pragma("unroll") \
            for (int j = 0; j < 2; ++j) { u32x2 wv; wv.x = pk2(o[i][j][0], o[i][j][1]); wv.y = pk2(o[i][j][2], o[i][j][3]); \
                *(LAS u32x2*)(L + SC_OS + (32 * tmB + 16 * i + fr) * SC_PITCH + (32 * tnB + 16 * j + 4 * fq) * 2) = wv; } \
        _Pragma("unroll") \
        for (int i = 0; i < 2; ++i) { const int row = 32 * tmS + 16 * i + fr; \
            _Pragma("unroll") \
            for (int j = 0; j < 4; ++j) { S[i][j] = S[i][j] * eg[i]; u32x2 wv; wv.x = pk2(S[i][j][0], S[i][j][1]); wv.y = pk2(S[i][j][2], S[i][j][3]); \
                *(LAS u32x2*)(L + SC_SB + row * SC_PITCH + (64 * tnS + 16 * j + 4 * fq) * 2) = wv; } } \
        SC_PUT(PS); if (MX == 0) { eg[0] = PS.gl[0]; eg[1] = PS.gl[1]; } \
        __syncthreads(); \
        _Pragma("unroll") \
        for (int ps = 0; ps < 2; ++ps) { const int c = tt + 32 * ps; const u32x4 v = *(const LAS u32x4*)(L + SC_OS + c * SC_PITCH + part * 16); \
            GST16(O + (size_t)(64 * rc + (d ? 63 - c : c)) * 1024, v); } \
    } while (0)
    for (int ch2 = 0; ch2 < NCH; ch2 += 2) { SC_CHUNK(ch2, sB, sA); SC_CHUNK(ch2 + 1, sA, sB); }
    (void)egn;
#undef SC_CHUNK
#undef SC_LOAD
#undef SC_PUT
    __syncthreads();
}
__device__ __forceinline__ void phase_scan_mfma(const Frame& F, int li) {
    for (int u = F.bx; u < 256; u += F.G) { if (u < 128) scan_unit<0>(F, u); else scan_unit<1>(F, u - 128); }
}


__device__ __forceinline__ void phase_finish(const Frame& F, int li, int nrows) {
    const bf16_t* P = (const bf16_t*)(F.ws + WS_P); const bf16_t* OB = (const bf16_t*)(F.ws + WS_B); const bf16_t* HB = (const bf16_t*)(F.ws + WS_E); bf16_t* A3 = (bf16_t*)(F.ws + WS_C);
    const float* gnorm = inptr<11>() + (size_t)li * 1024; const float* rnorm = inptr<19>() + (size_t)li * 1024;
    const size_t RS = (size_t)TT * 1024;
    for (int row = F.gw; row < nrows; row += F.NGW) {
        const bf16_t* pr = P + (size_t)row * LDP; const size_t ro = (size_t)row * 1024;
#pragma unroll
        for (int j = 0; j < 4; ++j) {
            const int c = 4 * F.lane + 256 * j;
            {
                const f32x4 o = ld4bf(OB + ro + c) + ld4bf(OB + RS + ro + c);
                const float ss = wave_sum((o[0] * o[0] + o[1] * o[1]) + (o[2] * o[2] + o[3] * o[3])); const float rs = rsqrtf(ss * (1.0f / 256.0f) + EPS);
                const f32x4 g = ld4bf(pr + C_GG + c), gn = *(const f32x4*)(gnorm + c); u32x2 w;
                w.x = pk2(o[0] * rs * gn[0] * siluf_(g[0]), o[1] * rs * gn[1] * siluf_(g[1])); w.y = pk2(o[2] * rs * gn[2] * siluf_(g[2]), o[3] * rs * gn[3] * siluf_(g[3]));
                *(u32x2*)(A3 + ro + c) = w; }
            {
                const f32x4 hh = ld4bf(HB + ro + c) + ld4bf(HB + RS + ro + c), g = ld4bf(pr + C_LG + c); u32x2 w;
                w.x = pk2(hh[0] * gelu_tanh_(g[0]), hh[1] * gelu_tanh_(g[1])); w.y = pk2(hh[2] * gelu_tanh_(g[2]), hh[3] * gelu_tanh_(g[3]));
                *(u32x2*)(A3 + RS + ro + c) = w; }
            {
                f32x4 o = ld4bf(OB + 2 * RS + ro + c) + ld4bf(OB + 3 * RS + ro + c);
                const float mean = wave_sum((o[0] + o[1]) + (o[2] + o[3])) * (1.0f / 256.0f); o = o - mean;
                const float ss = wave_sum((o[0] * o[0] + o[1] * o[1]) + (o[2] * o[2] + o[3] * o[3])); const float rs = rsqrtf(ss * (1.0f / 256.0f) + EPS);
                const f32x4 g = ld4bf(pr + C_RG + c), gn = *(const f32x4*)(rnorm + c); u32x2 w;
                w.x = pk2(o[0] * rs * gn[0] * siluf_(g[0]), o[1] * rs * gn[1] * siluf_(g[1])); w.y = pk2(o[2] * rs * gn[2] * siluf_(g[2]), o[3] * rs * gn[3] * siluf_(g[3]));
                *(u32x2*)(A3 + 2 * RS + ro + c) = w; }
        }
    }
}

constexpr int RT_PITCH = 2064, RT_XH = 0, RT_XL = 16 * RT_PITCH, RT_PART = 2 * 16 * RT_PITCH, RT_PP = 33, RT_HIST = RT_PART + 8 * 16 * RT_PP * 4;
__device__ __forceinline__ void phase_norm2_router(const Frame& F, int li, int ntok) {
    LAS unsigned char* L = F.lds; LAS float* part = (LAS float*)(L + RT_PART); LAS unsigned* hist = (LAS unsigned*)(L + RT_HIST); LAS unsigned* hbase = hist + 32;
    const int lane = F.lane, w = F.wave, fr = lane & 15, fq = lane >> 4;
    const float* wr = inptr<22>() + (size_t)li * 1024 * 32; const float* br = inptr<23>() + li * 32;
    bf16x8 Bh[2][4], Bl[2][4];
#pragma unroll
    for (int nt = 0; nt < 2; ++nt)
#pragma unroll
        for (int ks = 0; ks < 4; ++ks) { u32x4 hw, lw;
#pragma unroll
            for (int i2 = 0; i2 < 4; ++i2) { const float a = wr[(size_t)(128 * w + 32 * ks + 8 * fq + 2 * i2) * 32 + 16 * nt + fr], b = wr[(size_t)(128 * w + 32 * ks + 8 * fq + 2 * i2 + 1) * 32 + 16 * nt + fr];
                hw[i2] = pk2(a, b); lw[i2] = pk2(a - bflo(hw[i2]), b - bfhi(hw[i2])); }
            Bh[nt][ks] = __builtin_bit_cast(bf16x8, hw); Bl[nt][ks] = __builtin_bit_cast(bf16x8, lw); }
    if (F.tid < 32) hist[F.tid] = 0u;
    __syncthreads();
    const bf16_t* xs = (const bf16_t*)(F.ws + WS_XS); const float* mods = (const float*)(F.ws + WS_MODS) + (size_t)li * 9 * 6144;
    bf16_t* xn2 = (bf16_t*)(F.ws + WS_D); int* tok_e = (int*)(F.ws + WS_TOKE); float* tok_w = (float*)(F.ws + WS_TOKW); int* tok_p = (int*)(F.ws + WS_TOKP);
    unsigned* cnt = (unsigned*)(F.ws + WS_CTL) + CW_CNT + li * 32;
    const int ntile = ntok / 16;
    for (int t = F.bx; t < ntile; t += F.G) {
#pragma unroll
        for (int rr = 0; rr < 2; ++rr) { const int lr = 2 * w + rr, row = 16 * t + lr; const float* mp = mods + mrow_of(row) * 6144;
            const RowV y = norm_mod(load_row_bf16(xs + (size_t)row * D, lane), inptr<7>() + (size_t)li * 1024, mp + 3 * 1024, mp + 4 * 1024, lane);
#pragma unroll
            for (int j = 0; j < 4; ++j) { u32x2 h, l2; h.x = pk2(y.v[j][0], y.v[j][1]); h.y = pk2(y.v[j][2], y.v[j][3]);
                l2.x = pk2(y.v[j][0] - bflo(h.x), y.v[j][1] - bfhi(h.x)); l2.y = pk2(y.v[j][2] - bflo(h.y), y.v[j][3] - bfhi(h.y));
                *(u32x2*)(xn2 + (size_t)row * D + 4 * lane + 256 * j) = h;
                *(LAS u32x2*)(L + RT_XH + lr * RT_PITCH + (4 * lane + 256 * j) * 2) = h; *(LAS u32x2*)(L + RT_XL + lr * RT_PITCH + (4 * lane + 256 * j) * 2) = l2; } }
        __syncthreads();
        {   f32x4 acc[2] = {(f32x4){0.f, 0.f, 0.f, 0.f}, (f32x4){0.f, 0.f, 0.f, 0.f}};
#pragma unroll
            for (int ks = 0; ks < 4; ++ks) { const int co = (128 * w + 32 * ks + 8 * fq) * 2;
                const bf16x8 ah = *(const LAS bf16x8*)(L + RT_XH + fr * RT_PITCH + co), al = *(const LAS bf16x8*)(L + RT_XL + fr * RT_PITCH + co);
#pragma unroll
                for (int nt = 0; nt < 2; ++nt) { acc[nt] = __builtin_amdgcn_mfma_f32_16x16x32_bf16(Bh[nt][ks], ah, acc[nt], 0, 0, 0); acc[nt] = __builtin_amdgcn_mfma_f32_16x16x32_bf16(Bl[nt][ks], ah, acc[nt], 0, 0, 0);
                    acc[nt] = __builtin_amdgcn_mfma_f32_16x16x32_bf16(Bh[nt][ks], al, acc[nt], 0, 0, 0); } }
#pragma unroll
            for (int nt = 0; nt < 2; ++nt)
#pragma unroll
                for (int j = 0; j < 4; ++j) part[(w * 16 + fr) * RT_PP + 16 * nt + 4 * fq + j] = acc[nt][j]; }
        __syncthreads();
        {
            const int e = lane & 31, tk = 2 * w + (lane >> 5), row = 16 * t + tk; float v = br[e];
#pragma unroll
            for (int w2 = 0; w2 < 8; ++w2) v += part[(w2 * 16 + tk) * RT_PP + e];
            float tl0, tl1, tl2, tl3; int te0, te1, te2, te3;
#define RT_ARGMAX(TL, TE) do { float bv = v; int bi = e; _Pragma("unroll") for (int o = 16; o >= 1; o >>= 1) { const float ov = __shfl_xor(bv, o); const int oi = __shfl_xor(bi, o); \
                const bool tk_ = (ov > bv) || (ov == bv && oi < bi); bv = tk_ ? ov : bv; bi = tk_ ? oi : bi; } TL = bv; TE = bi; v = (e == bi) ? -3.0e38f : v; } while (0)
            RT_ARGMAX(tl0, te0); RT_ARGMAX(tl1, te1); RT_ARGMAX(tl2, te2); RT_ARGMAX(tl3, te3);
#undef RT_ARGMAX
            const float e1 = __expf(tl1 - tl0), e2 = __expf(tl2 - tl0), e3 = __expf(tl3 - tl0); const float inv = 1.0f / (1.0f + e1 + e2 + e3);
            if (e < 4) { const int ek = e == 0 ? te0 : e == 1 ? te1 : e == 2 ? te2 : te3; const float wk = (e == 0 ? 1.0f : e == 1 ? e1 : e == 2 ? e2 : e3) * inv;
                const unsigned lp = atomicAdd((unsigned*)&hist[ek], 1u); tok_e[row * 4 + e] = ek; tok_w[row * 4 + e] = wk; tok_p[row * 4 + e] = (int)lp; } }
        __syncthreads();
    }
    if (F.tid < 32) hbase[F.tid] = __hip_atomic_fetch_add(cnt + F.tid, hist[F.tid], __ATOMIC_RELAXED, __HIP_MEMORY_SCOPE_AGENT);
    __syncthreads();
    for (int t = F.bx; t < ntile; t += F.G) if (F.tid < 64) { const int i = 16 * t * 4 + F.tid; tok_p[i] += (int)hbase[tok_e[i]]; }
    __syncthreads();
}
__device__ __forceinline__ void phase_dispatch(const Frame& F, int li, int ntok) {
    LAS unsigned* pstart = (LAS unsigned*)F.lds;
    unsigned* ctl = (unsigned*)(F.ws + WS_CTL); unsigned* cnt = ctl + CW_CNT + li * 32; unsigned* tile_e = ctl + CW_TILE + li * 1024;
    if (F.tid == 0) { unsigned ps = 0;
        for (int e = 0; e < 32; ++e) { const unsigned c = __hip_atomic_load(cnt + e, __ATOMIC_RELAXED, __HIP_MEMORY_SCOPE_AGENT), nt = (c + 255u) >> 8; pstart[e] = ps;
            if (F.bx == 0) for (unsigned j = 0; j < nt; ++j) tile_e[(ps >> 8) + j] = (unsigned)e;
            ps += nt << 8; }
        if (F.bx == 0) ctl[CW_NT + li] = ps >> 8; }
    __syncthreads();
    const int* tok_e = (const int*)(F.ws + WS_TOKE); const int* tok_p = (const int*)(F.ws + WS_TOKP); int* tok_s = (int*)(F.ws + WS_TOKS); int* slot_tok = (int*)(F.ws + WS_SLOTTOK);
    for (int it = F.gtid; it < ntok * 4; it += F.NGT) { const int slot = (int)pstart[tok_e[it]] + tok_p[it]; tok_s[it] = slot; slot_tok[slot] = it >> 2; }
    if (F.bx < 32) { const unsigned c = __hip_atomic_load(cnt + F.bx, __ATOMIC_RELAXED, __HIP_MEMORY_SCOPE_AGENT), pe = ((c + 255u) >> 8) << 8;
        for (unsigned s = c + F.tid; s < pe; s += NTHR) slot_tok[pstart[F.bx] + s] = 0; }
    __syncthreads();
}
__device__ __forceinline__ void phase_combine(const Frame& F, int li, int ntok, bool last) {
    bf16_t* xs = (bf16_t*)(F.ws + WS_XS); const bf16_t* Y = (const bf16_t*)(F.ws + WS_B); bf16_t* xn = (bf16_t*)(F.ws + WS_D);
    const float* mods = (const float*)(F.ws + WS_MODS); const float* tok_w = (const float*)(F.ws + WS_TOKW); const int* tok_s = (const int*)(F.ws + WS_TOKS);
    for (int row = F.gw; row < ntok; row += F.NGW) {
        const int mr = mrow_of(row); const float* gp = mods + ((size_t)li * 9 + mr) * 6144 + 5 * 1024;
        RowV x = load_row_bf16(xs + (size_t)row * D, F.lane);
        const int s0 = tok_s[row * 4], s1 = tok_s[row * 4 + 1], s2 = tok_s[row * 4 + 2], s3 = tok_s[row * 4 + 3];
        const float w0 = tok_w[row * 4], w1 = tok_w[row * 4 + 1], w2 = tok_w[row * 4 + 2], w3 = tok_w[row * 4 + 3];
#pragma unroll
        for (int j = 0; j < 4; ++j) { const int c = 4 * F.lane + 256 * j;
            const f32x4 y = ld4bf(Y + (size_t)s0 * 1024 + c) * w0 + ld4bf(Y + (size_t)s1 * 1024 + c) * w1 + ld4bf(Y + (size_t)s2 * 1024 + c) * w2 + ld4bf(Y + (size_t)s3 * 1024 + c) * w3;
            x.v[j] = x.v[j] + *(const f32x4*)(gp + c) * y; }
        if (!last) {
            store_row_bf16(xs + (size_t)row * D, x, F.lane);
            const float* mp = mods + ((size_t)(li + 1) * 9 + mr) * 6144;
            const RowV y = norm_mod(x, inptr<6>() + (size_t)(li + 1) * 1024, mp, mp + 1024, F.lane);
            store_row_bf16(xn + (size_t)row * D, y, F.lane);
        } else {
            const float rs = rsqrtf(row_sumsq(x) * (1.0f / D) + EPS);
#pragma unroll
            for (int j = 0; j < 4; ++j) { const int c = 4 * F.lane + 256 * j; *(f32x4*)(F.out + (size_t)row * D + c) = (x.v[j] * rs) * *(const f32x4*)(inptr<28>() + c); }
        }
    }
}

#ifndef MK_SCAN_REF
#define MK_SCAN_REF 0
#endif
#ifndef MK_ONE_LAUNCH
#define MK_ONE_LAUNCH 1
#endif
constexpr int NPH_LAYER = 15, NPHASES = 2 + 2 * NPH_LAYER;
struct Args { const float* in[29]; float* out; unsigned char* ws; int ph_lo, ph_hi, region, pad; };
#ifndef MK_PHMASK
#define MK_PHMASK 0x7fff
#endif
#define IN(k) (lo <= (k) && (k) < hi)
#define EN(j) ((MK_PHMASK >> (j)) & 1)
#define SEAM(k) do { if (IN(k) && IN((k) + 1)) xcd_barrier(bar); } while (0)
#define MKF() Frame F; { GAS unsigned char* ws_ = (GAS unsigned char*)args.ws; asm volatile("" : "+s"(ws_)); F.ws = ws_; F.lds = (LAS unsigned char*)lds_raw; F.out = args.out; \
        int tid_ = threadIdx.x, bx_ = blockIdx.x; asm volatile("" : "+v"(tid_), "+s"(bx_)); F.tid = tid_; F.bx = bx_; F.lane = F.tid & 63; F.wave = __builtin_amdgcn_readfirstlane(F.tid >> 6); F.G = gridDim.x; \
        F.gw = F.bx * NWAVES + F.wave; F.NGW = F.G * NWAVES; F.gtid = F.bx * NTHR + F.tid; F.NGT = F.G * NTHR; }
template <int li> __device__ __forceinline__ void run_layer(const Args& args, unsigned char* lds_raw, const XcdBarrier& bar, const int lo, const int hi) {
        const int pb = 2 + NPH_LAYER * li; const bool last = (li == 1); const int nrows = last ? TLAT : TT, nMt = nrows / 256;
        if (EN(0) && IN(pb + 0)) { MKF(); phase_W(F, li); if (li == 0) phase_norm_in(F); __syncthreads(); }
        SEAM(pb + 0);
        if (EN(1) && IN(pb + 1)) { MKF(); unsigned* ctl = (unsigned*)(F.ws + WS_CTL); (void)ctl;
            pg8::Gemm g{1024, 1024, 1024}; PlainOrder S; S.A = (const char*)(F.ws + WS_D); S.B = (const char*)(F.ws + WS_WIN); S.astep = 256 * 1024 * 2; S.bstep = 256 * 1024 * 2; S.nM = TT / 256; S.nN = LDP / 256; S.G = F.G; S.c = F.bx;
            EpiBf16Bias E{(bf16_t*)(F.ws + WS_P), LDP, nullptr, 0};
            pg8::gemm_phase<EpiBf16Bias, PlainOrder, true, true>(F.lds, g, S, E);
        }
        SEAM(pb + 1);
        if (EN(2) && IN(pb + 2)) { MKF(); phase_conv(F, li); phase_scanprep(F, li); }
        SEAM(pb + 2);
        if (EN(3) && IN(pb + 3)) { MKF(); phase_scan_mfma(F, li); }
        SEAM(pb + 3);
        if (EN(4) && IN(pb + 4)) { MKF(); unsigned* ctl = (unsigned*)(F.ws + WS_CTL); (void)ctl;
            pg8::Gemm g{1024, 256, 256}; LruOrder S; S.A = (const char*)(F.ws + WS_D); S.B = (const char*)(F.ws + WS_WLRU); S.nM = TT / 256; S.G = F.G; S.c = F.bx;
            EpiLru E{(const bf16_t*)(F.ws + WS_D), (bf16_t*)(F.ws + WS_C), (bf16_t*)(F.ws + WS_C + 2 * ROWB), inptr<15>() + (size_t)li * 2048, inptr<17>() + (size_t)li * 2048, (const float*)(F.ws + WS_LSL)};
            pg8::gemm_phase<EpiLru, LruOrder, true, true>(F.lds, g, S, E);
        }
        SEAM(pb + 4);
        if (EN(5) && IN(pb + 5)) { MKF(); phase_lru_scan<false>(F); }
        SEAM(pb + 5);
        if (EN(6) && IN(pb + 6)) { MKF(); phase_lru_scan<true>(F); }
        SEAM(pb + 6);
        if (EN(7) && IN(pb + 7)) { MKF(); phase_finish(F, li, nrows); }
        SEAM(pb + 7);
        if (EN(8) && IN(pb + 8)) { MKF(); unsigned* ctl = (unsigned*)(F.ws + WS_CTL); (void)ctl;
            pg8::Gemm g{1024, 1024, 1024}; BranchOrder S; S.A = (const char*)(F.ws + WS_C); S.B = (const char*)(F.ws + WS_WBR); S.nM = nMt; S.G = F.G; S.c = F.bx;
            EpiBranch E{(const bf16_t*)(F.ws + WS_P), (bf16_t*)(F.ws + WS_B)};
            pg8::gemm_phase<EpiBranch, BranchOrder, true, true>(F.lds, g, S, E);
        }
        SEAM(pb + 8);
        if (EN(9) && IN(pb + 9)) { MKF(); unsigned* ctl = (unsigned*)(F.ws + WS_CTL); (void)ctl;
            pg8::Gemm g{1024, 1024, 1024}; PlainOrder S; S.A = (const char*)(F.ws + WS_B + 2 * ROWB); S.B = (const char*)(F.ws + WS_WOUT); S.astep = 256 * 1024 * 2; S.bstep = 256 * 1024 * 2; S.nM = nMt; S.nN = 4; S.G = F.G; S.c = F.bx;
            bf16_t* xs = (bf16_t*)(F.ws + WS_XS);
            EpiOut<li == 0> E{inptr<0>(), inptr<2>(), xs, (const float*)(F.ws + WS_MODS) + (size_t)li * 9 * 6144 + 2 * 1024};
            pg8::gemm_phase<EpiOut<li == 0>, PlainOrder, true, true>(F.lds, g, S, E);
        }
        SEAM(pb + 9);
        if (EN(10) && IN(pb + 10)) { MKF(); phase_norm2_router(F, li, nrows); }
        SEAM(pb + 10);
        if (EN(11) && IN(pb + 11)) { MKF(); phase_dispatch(F, li, nrows); }
        SEAM(pb + 11);
        if (EN(12) && IN(pb + 12)) { MKF(); unsigned* ctl = (unsigned*)(F.ws + WS_CTL); (void)ctl;
            pg8::Gemm g{1024, 1024, 1024}; MoeOrder S; S.A = (const char*)(F.ws + WS_D); S.rowidx = (const int*)(F.ws + WS_SLOTTOK); S.B = (const char*)(F.ws + WS_WGU); S.tile_e = ctl + CW_TILE + li * 1024; S.estep = (size_t)2048 * 1024 * 2;
            S.nM = (int)ctl[CW_NT + li]; S.nN = 8; S.G = F.G; S.c = F.bx; S.ga = 1;
            EpiSwiglu E{(bf16_t*)(F.ws + WS_P + 288 * MiB), inptr<25>() + (size_t)li * 32 * 2048};
            pg8::gemm_phase<EpiSwiglu, MoeOrder, true, true, true>(F.lds, g, S, E);
        }
        SEAM(pb + 12);
        if (EN(13) && IN(pb + 13)) { MKF(); unsigned* ctl = (unsigned*)(F.ws + WS_CTL); (void)ctl;
            pg8::Gemm g{1024, 1024, 1024}; MoeOrder S; S.A = (const char*)(F.ws + WS_P + 288 * MiB); S.B = (const char*)(F.ws + WS_WDN); S.tile_e = ctl + CW_TILE + li * 1024; S.estep = (size_t)1024 * 1024 * 2;
            S.nM = (int)ctl[CW_NT + li]; S.nN = 4; S.G = F.G; S.c = F.bx; S.ga = 0; S.rowidx = nullptr;
            EpiBf16Bias E{(bf16_t*)(F.ws + WS_B), 1024, inptr<27>() + (size_t)li * 32 * 1024, 1024};
            pg8::gemm_phase<EpiBf16Bias, MoeOrder, true, true>(F.lds, g, S, E);
        }
        SEAM(pb + 13);
        if (EN(14) && IN(pb + 14)) { MKF(); phase_combine(F, li, nrows, last); }
        SEAM(pb + 14);
    }
__global__ void __launch_bounds__(NTHR, 2) mk_fwd(Args args) {
    extern __shared__ __attribute__((aligned(16))) unsigned char lds_raw[];
    const int tid0 = threadIdx.x;
    volatile LAS unsigned* MISC = (volatile LAS unsigned*)((LAS unsigned char*)lds_raw + MISC_OFF);
    if (tid0 < 32) MISC[tid0] = 0u;
    __syncthreads();
    unsigned* ctl0 = (unsigned*)(args.ws + WS_CTL);
    const int lo = args.ph_lo, hi = args.ph_hi;
    XcdBarrier bar; bar.bar = ctl0 + CW_BAR + args.region * 4096; bar.x = 0; bar.st = MISC + 8;
    if (hi - lo > 1) bar = xcd_barrier_post(ctl0 + CW_BAR + args.region * 4096, MISC + 8);

    if (IN(0)) { MKF(); phase_proA(F); }
    SEAM(0);
    if (IN(1)) { MKF(); phase_proB(F); }
    SEAM(1);
    run_layer<0>(args, lds_raw, bar, lo, hi);
    run_layer<1>(args, lds_raw, bar, lo, hi);
}

extern "C" void kernel_launch(void* const* d_in, const int* in_sizes, int n_in, void* d_out, int out_size, void* d_ws, size_t ws_size, hipStream_t stream) {
    static int grid = 0;
    if (grid == 0) {
        if (n_in != 29 || ws_size < WS_END || out_size != TLAT * D) { fprintf(stderr, "kernel_launch: unexpected problem: n_in %d ws %zu out %d\n", n_in, ws_size, out_size); grid = -1; return; }
        int dev = 0, cus = 0;
        if (hipGetDevice(&dev) != hipSuccess || hipDeviceGetAttribute(&cus, hipDeviceAttributeMultiprocessorCount, dev) != hipSuccess) { grid = -1; return; }
        if (hipFuncSetAttribute((const void*)mk_fwd, hipFuncAttributeMaxDynamicSharedMemorySize, LDS_BYTES) != hipSuccess) { fprintf(stderr, "kernel_launch: hipFuncSetAttribute failed\n"); grid = -1; return; }
        int per_cu = 0;
        if (hipOccupancyMaxActiveBlocksPerMultiprocessor(&per_cu, (const void*)mk_fwd, NTHR, LDS_BYTES) != hipSuccess || per_cu < 1) fprintf(stderr, "kernel_launch: occupancy query reports %d\n", per_cu);
        (void)hipGetLastError();
        grid = cus;
    }
    if (grid < 0) return;
    (void)hipMemsetAsync((char*)d_ws + WS_CTL, 0, CTL_BYTES, stream);
    Args a{};
    for (int i = 0; i < 29; ++i) a.in[i] = (const float*)d_in[i];
    a.out = (float*)d_out; a.ws = (unsigned char*)d_ws;
#if MK_ONE_LAUNCH
    a.ph_lo = 0; a.ph_hi = NPHASES; a.region = 0;
    hipLaunchKernelGGL(mk_fwd, dim3(grid), dim3(NTHR), LDS_BYTES, stream, a);
#else
    for (int p = 0; p < NPHASES; ++p) { a.ph_lo = p; a.ph_hi = p + 1; a.region = 0; hipLaunchKernelGGL(mk_fwd, dim3(grid), dim3(NTHR), LDS_BYTES, stream, a); }
#endif
}
```

```cpp
#include <hip/hip_runtime.h>
#include <cstdio>
#include <cstdint>

#define LAS __attribute__((address_space(3)))
typedef unsigned short bf16_t;
typedef short bf16x8 __attribute__((ext_vector_type(8)));
typedef float f32x4 __attribute__((ext_vector_type(4)));
typedef float f32x2 __attribute__((ext_vector_type(2)));
typedef unsigned u32x4 __attribute__((ext_vector_type(4)));
typedef unsigned u32x2 __attribute__((ext_vector_type(2)));

constexpr int D = 1024, NBATCH = 8, SEQ = 4096, CTXL = 256;
constexpr int TLAT = NBATCH * SEQ, TCTX = NBATCH * CTXL, TT = TLAT + TCTX;
constexpr int LDP = 11520;
constexpr int C_GQ = 0, C_GK = 512, C_GV = 1024, C_GG = 2048, C_LX = 3072, C_LG = 4096, C_RQ = 5120, C_RK = 5632, C_RV = 6144, C_RG = 7168, C_MG = 8192, C_LR = 11264;
constexpr int IN_TOTAL = 11296, NE = 32;
constexpr int SLOT_TILES_MAX = 576;
constexpr float EPS = 1e-6f;

constexpr size_t MiB = (size_t)1 << 20;
constexpr size_t WS_CTL = 0, CTL_BYTES = 1 * MiB;
constexpr size_t WS_MODP = 1 * MiB, WS_MODS = 5 * MiB, WS_COS = 6 * MiB, WS_SIN = 7 * MiB, WS_LSL = 8 * MiB, WS_CARA = 9 * MiB, WS_CARH = 11 * MiB;
constexpr size_t WS_SLOTTOK = 8 * MiB + 256 * 1024;
constexpr size_t WS_TOKE = 13 * MiB, WS_TOKW = WS_TOKE + 768 * 1024, WS_TOKP = WS_TOKW + 768 * 1024, WS_TOKS = WS_TOKP + 768 * 1024;
constexpr size_t WS_WIN = 16 * MiB, WS_WLRU = 39 * MiB, WS_WBR = 41 * MiB, WS_WOUT = 47 * MiB, WS_WGU = 49 * MiB, WS_WDN = 177 * MiB;
constexpr size_t WS_XS = 241 * MiB, WS_P = 377 * MiB, WS_B = 1142 * MiB, WS_C = 1430 * MiB, WS_D = 1702 * MiB, WS_E = 1770 * MiB, WS_END = 1906 * MiB;
constexpr size_t ROWB = (size_t)TT * D * 2;
static_assert(ROWB == 68 * MiB, "row buffer");
constexpr int CW_CNT = 1024, CW_NT = 1024 + 128, CW_TILE = 2048, CW_BAR = 8192;

__device__ __forceinline__ float bflo(unsigned w) { return __uint_as_float(w << 16); }
__device__ __forceinline__ float bfhi(unsigned w) { return __uint_as_float(w & 0xffff0000u); }
typedef __bf16 bf16x2_t __attribute__((ext_vector_type(2)));
__device__ __forceinline__ unsigned pk2(float lo, float hi) { const bf16x2_t v = __builtin_convertvector((f32x2){lo, hi}, bf16x2_t); return __builtin_bit_cast(unsigned, v); }
__device__ __forceinline__ float sigmoidf_(float x) { return __builtin_amdgcn_rcpf(1.0f + __expf(-x)); }
__device__ __forceinline__ float siluf_(float x) { return x * sigmoidf_(x); }
__device__ __forceinline__ float logsigmoidf_(float z) { return fminf(z, 0.f) - __logf(1.0f + __expf(-fabsf(z))); }
__device__ __forceinline__ float gelu_tanh_(float x) { const float u = 0.7978845608028654f * (x + 0.044715f * x * x * x); const float t = 1.0f - 2.0f * __builtin_amdgcn_rcpf(__expf(2.0f * u) + 1.0f); return 0.5f * x * (1.0f + t); }
__device__ __forceinline__ float wave_sum(float v) {
#pragma unroll
    for (int o = 1; o < 64; o <<= 1) v += __shfl_xor(v, o);
    return v;
}
#define LDS_WAIT() asm volatile("s_waitcnt lgkmcnt(0)" ::: "memory")

namespace pg8 {
#define PG8_LAS __attribute__((address_space(3)))
constexpr int BM = 256, BK = 64, HALF = 128, HTB = HALF * BK * 2, STAGE_BYTES = 8 * HTB, NXCD = 8, WGM = 8;
__host__ __device__ __forceinline__ int lds_byte(int r, int c) { const int st = (r >> 4) * 2 + (c >> 5), rr = r & 15, cc = c & 31, ob = rr * 64 + cc * 2; return st * 1024 + (ob ^ (((ob >> 9) & 1) << 5)); }
__host__ __device__ __forceinline__ void stage_rc(int b, int& R, int& C) { const int st = b / 1024, sb = b % 1024, swz = sb ^ (((sb >> 9) & 1) << 5); R = (st >> 1) * 16 + swz / 64; C = (st & 1) * 32 + (swz % 64) / 2; }
__host__ __device__ __forceinline__ int perm32(int rho) { const int n = rho >> 4, i = rho & 15; return 8 * (i >> 2) + 4 * n + (i & 3); }
struct Unit { int pm, pn, aux; const char* a; const char* b; };
struct Gemm { int lda, ldb, K; };
__device__ __forceinline__ void tile_of(int L, int nM, int nN, int& pm, int& pn) {
    const int nwg = nM * nN; int wgid = L; { const int q = nwg / NXCD, r = nwg % NXCD, xcd = wgid % NXCD, off = wgid / NXCD; wgid = (xcd < r ? xcd * (q + 1) : r * (q + 1) + (xcd - r) * q) + off; }
    const int nig = WGM * nN, gid = wgid / nig, fm = gid * WGM, gsz = (nM - fm) < WGM ? (nM - fm) : WGM;
    pm = fm + ((wgid % nig) % gsz); pn = (wgid % nig) / gsz;
}
__device__ __forceinline__ unsigned cvt_pk_bf16(float lo, float hi) { unsigned r; asm volatile("v_cvt_pk_bf16_f32 %0, %1, %2" : "=v"(r) : "v"(lo), "v"(hi)); return r; }
template <class Epi, class Sched, bool ALIGN_EPI = false, bool SP2 = false, bool GATHER = false>
__device__ __forceinline__ void gemm_phase(PG8_LAS unsigned char* lds, const Gemm g, const Sched& S, const Epi& E) {
    int tid_o = threadIdx.x; asm volatile("" : "+v"(tid_o));
    const int tid = tid_o, wid = __builtin_amdgcn_readfirstlane(tid >> 6), lane = tid & 63, wr = wid >> 2, wc = wid & 3, fr = lane & 15, fq = lane >> 4;
    const int K = g.K, nt = K / BK;
    unsigned voffA[2], voffB[2];
#pragma unroll
    for (int i = 0; i < 2; ++i) { int R, C; stage_rc(tid * 16 + i * 8192, R, C); const int Rb = Epi::PERM ? ((R & ~31) + perm32(R & 31)) : R;
        voffA[i] = (unsigned)(R * g.lda + C) * 2u; voffB[i] = (unsigned)(Rb * g.ldb + C) * 2u; }
    unsigned gA[2][2] = {{0u, 0u}, {0u, 0u}}, gN[2][2] = {{0u, 0u}, {0u, 0u}}; int gR[2], gC[2];
#pragma unroll
    for (int i = 0; i < 2; ++i) stage_rc(tid * 16 + i * 8192, gR[i], gC[i]);
#define PG8_GOFF(dst, u_) do { if constexpr (GATHER) { _Pragma("unroll") for (int h_ = 0; h_ < 2; ++h_) _Pragma("unroll") for (int i_ = 0; i_ < 2; ++i_) \
        dst[h_][i_] = (unsigned)S.rowidx[(u_).pm * BM + h_ * HALF + gR[i_]] * (unsigned)(g.lda * 2) + (unsigned)(gC[i_] * 2); } } while (0)
    const size_t kstep = (size_t)(BK * 2);
    const size_t hstepA = (size_t)HALF * g.lda * 2, hstepB = (size_t)HALF * g.ldb * 2;
    const unsigned ldsw = (unsigned)wid * 1024u;
    const int aoff = lds_byte(wr * 64 + fr, fq * 8), boff = lds_byte(wc * 32 + fr, fq * 8);
#define PG8_SA(b, h) (((b) * 2 + (h)) * HTB)
#define PG8_SB(b, h) ((4 + (b) * 2 + (h)) * HTB)
#define PG8_STAGE(bufoff, gbase, voff) do { _Pragma("unroll") for (int _i = 0; _i < 2; ++_i) \
        __builtin_amdgcn_global_load_lds((const unsigned*)((const char*)(gbase) + (voff)[_i]), (PG8_LAS unsigned*)(lds + (bufoff) + ldsw + _i * 8192), 16, 0, 0); } while (0)
#define PG8_STAGE_A(bufoff, gbase, H, NX) do { if constexpr (GATHER) { _Pragma("unroll") for (int _i = 0; _i < 2; ++_i) { const unsigned o_ = (NX) ? gN[H][_i] : gA[H][_i]; \
        __builtin_amdgcn_global_load_lds((const unsigned*)((const char*)(gbase) + o_), (PG8_LAS unsigned*)(lds + (bufoff) + ldsw + _i * 8192), 16, 0, 0); } } \
        else { PG8_STAGE(bufoff, (gbase) + (H) * hstepA, voffA); } } while (0)
#define PG8_LDA(dst, b, h) do { _Pragma("unroll") for (int m = 0; m < 4; ++m) _Pragma("unroll") for (int k = 0; k < 2; ++k) dst[m][k] = *(const PG8_LAS bf16x8*)(lds + PG8_SA(b, h) + aoff + m * 2048 + k * 1024); } while (0)
#define PG8_LDB(dst, b, h) do { _Pragma("unroll") for (int n = 0; n < 2; ++n) _Pragma("unroll") for (int k = 0; k < 2; ++k) dst[n][k] = *(const PG8_LAS bf16x8*)(lds + PG8_SB(b, h) + boff + n * 2048 + k * 1024); } while (0)
#define PG8_MMA(ai, bj, At, Bt) do { __builtin_amdgcn_s_setprio(1); _Pragma("unroll") for (int m = 0; m < 4; ++m) _Pragma("unroll") for (int n = 0; n < 2; ++n) _Pragma("unroll") for (int k = 0; k < 2; ++k) \
        acc[ai][bj][m][n] = __builtin_amdgcn_mfma_f32_16x16x32_bf16(Bt[n][k], At[m][k], acc[ai][bj][m][n], 0, 0, 0); __builtin_amdgcn_s_setprio(0); } while (0)
#define PG8_WAIT_V(n) asm volatile("s_waitcnt vmcnt(" #n ")" ::: "memory")
#define PG8_WAIT_L(n) asm volatile("s_waitcnt lgkmcnt(" #n ")" ::: "memory")
#define PG8_BAR __builtin_amdgcn_s_barrier()
#define PG8_SCHED __builtin_amdgcn_sched_barrier(0)
    Unit cur, nxt; int ui = 0;
    if (!S.next(0, cur)) return;
    f32x4 acc[2][2][4][2];
#pragma unroll
    for (int a = 0; a < 2; ++a)
#pragma unroll
        for (int b = 0; b < 2; ++b)
#pragma unroll
            for (int m = 0; m < 4; ++m)
#pragma unroll
                for (int n = 0; n < 2; ++n) acc[a][b][m][n] = (f32x4){0.f, 0.f, 0.f, 0.f};
    bf16x8 At[4][2], B0[2][2], B1[2][2];
    const char* cA = cur.a; const char* cB = cur.b;
    S.a_ready(cur);
    PG8_GOFF(gA, cur);
    if constexpr (SP2) {
        PG8_STAGE(PG8_SB(0, 0), cB, voffB); PG8_STAGE(PG8_SB(0, 1), cB + hstepB, voffB); PG8_STAGE_A(PG8_SA(0, 0), cA, 0, false); PG8_STAGE_A(PG8_SA(0, 1), cA, 1, false);
        if (wr == 1) PG8_BAR;
        PG8_WAIT_V(2); PG8_BAR;
        PG8_STAGE(PG8_SB(1, 0), cB + kstep, voffB); PG8_STAGE_A(PG8_SA(1, 0), cA + kstep, 0, false); PG8_STAGE(PG8_SB(1, 1), cB + hstepB + kstep, voffB);
        PG8_WAIT_V(6); PG8_BAR;
    } else {
        PG8_STAGE(PG8_SB(0, 0), cB, voffB); PG8_STAGE_A(PG8_SA(0, 0), cA, 0, false); PG8_STAGE(PG8_SB(0, 1), cB + hstepB, voffB); PG8_STAGE_A(PG8_SA(0, 1), cA, 1, false);
        if (wr == 1) PG8_BAR;
        PG8_WAIT_V(4); PG8_BAR;
        PG8_STAGE(PG8_SB(1, 0), cB + kstep, voffB); PG8_STAGE_A(PG8_SA(1, 0), cA + kstep, 0, false); PG8_STAGE(PG8_SB(1, 1), cB + hstepB + kstep, voffB);
        PG8_WAIT_V(6); PG8_BAR;
    }
    for (;;) {
        const bool has_next = S.next(ui + 1, nxt);
        if (has_next) PG8_GOFF(gN, nxt);
        const char* nA = has_next ? nxt.a : cA; const char* nB = has_next ? nxt.b : cB;
        for (int t = 0; t < nt; t += 2) {
            const bool last = (t == nt - 2); const bool nx_ = last && has_next;
            const char* a1 = cA + (size_t)(t + 1) * kstep;
            const char* a2 = last ? nA : cA + (size_t)(t + 2) * kstep; const char* b2 = last ? nB : cB + (size_t)(t + 2) * kstep;
            const char* a3 = a2 + kstep; const char* b3 = b2 + kstep;
            if (last && has_next) S.a_ready(nxt);
            if constexpr (SP2) {
            PG8_LDB(B0, 0, 0); PG8_LDB(B1, 0, 1); PG8_SCHED; PG8_LDA(At, 0, 0); PG8_STAGE_A(PG8_SA(1, 1), a1, 1, false);
            PG8_WAIT_V(8); PG8_WAIT_L(0); PG8_BAR; PG8_MMA(0, 0, At, B0); PG8_MMA(0, 1, At, B1); PG8_BAR; PG8_SCHED;
            PG8_LDA(At, 0, 1); PG8_STAGE(PG8_SB(0, 0), b2, voffB); PG8_STAGE(PG8_SB(0, 1), b2 + hstepB, voffB); PG8_STAGE_A(PG8_SA(0, 0), a2, 0, nx_);
            PG8_WAIT_V(8); PG8_WAIT_L(0); PG8_BAR; PG8_MMA(1, 0, At, B0); PG8_MMA(1, 1, At, B1); PG8_BAR; PG8_SCHED;
            PG8_LDB(B0, 1, 0); PG8_LDB(B1, 1, 1); PG8_SCHED; PG8_LDA(At, 1, 0); PG8_STAGE_A(PG8_SA(0, 1), a2, 1, nx_);
            PG8_WAIT_V(8); PG8_WAIT_L(0); PG8_BAR; PG8_MMA(0, 0, At, B0); PG8_MMA(0, 1, At, B1); PG8_BAR; PG8_SCHED;
            PG8_LDA(At, 1, 1); PG8_STAGE(PG8_SB(1, 0), b3, voffB); PG8_STAGE(PG8_SB(1, 1), b3 + hstepB, voffB); PG8_STAGE_A(PG8_SA(1, 0), a3, 0, nx_);
            PG8_WAIT_V(8); PG8_WAIT_L(0); PG8_BAR; PG8_MMA(1, 0, At, B0); PG8_MMA(1, 1, At, B1); PG8_BAR; PG8_SCHED;
            } else {
            PG8_LDB(B0, 0, 0); PG8_SCHED; PG8_LDA(At, 0, 0); PG8_STAGE_A(PG8_SA(1, 1), a1, 1, false);
            PG8_WAIT_L(8); PG8_BAR; PG8_WAIT_L(0); PG8_MMA(0, 0, At, B0); PG8_BAR; PG8_SCHED;
            PG8_LDB(B1, 0, 1); PG8_STAGE(PG8_SB(0, 0), b2, voffB);
            PG8_BAR; PG8_WAIT_L(0); PG8_MMA(0, 1, At, B1); PG8_BAR;
            PG8_LDA(At, 0, 1); PG8_STAGE_A(PG8_SA(0, 0), a2, 0, nx_);
            PG8_BAR; PG8_WAIT_L(0); PG8_MMA(1, 0, At, B0); PG8_BAR; PG8_SCHED;
            PG8_STAGE(PG8_SB(0, 1), b2 + hstepB, voffB);
            PG8_WAIT_V(6); PG8_BAR; PG8_MMA(1, 1, At, B1); PG8_BAR;
            PG8_LDB(B0, 1, 0); PG8_SCHED; PG8_LDA(At, 1, 0); PG8_STAGE_A(PG8_SA(0, 1), a2, 1, nx_);
            PG8_WAIT_L(8); PG8_BAR; PG8_WAIT_L(0); PG8_MMA(0, 0, At, B0); PG8_BAR; PG8_SCHED;
            PG8_LDB(B1, 1, 1); PG8_STAGE(PG8_SB(1, 0), b3, voffB);
            PG8_BAR; PG8_WAIT_L(0); PG8_MMA(0, 1, At, B1); PG8_BAR;
            PG8_LDA(At, 1, 1); PG8_STAGE_A(PG8_SA(1, 0), a3, 0, nx_);
            PG8_BAR; PG8_WAIT_L(0); PG8_MMA(1, 0, At, B0); PG8_BAR; PG8_SCHED;
            PG8_STAGE(PG8_SB(1, 1), b3 + hstepB, voffB);
            PG8_WAIT_V(6); PG8_BAR; PG8_MMA(1, 1, At, B1); PG8_BAR;
            }
        }
        if constexpr (ALIGN_EPI) { if (wr == 0) PG8_BAR; }
        if constexpr (!Epi::AFTER_DRAIN) { E(acc, cur, wr, wc, fr, fq); S.done(cur); }
        if (!has_next) break;
#pragma unroll
        for (int a = 0; a < 2; ++a)
#pragma unroll
            for (int b = 0; b < 2; ++b)
#pragma unroll
                for (int m = 0; m < 4; ++m)
#pragma unroll
                    for (int n = 0; n < 2; ++n) acc[a][b][m][n] = (f32x4){0.f, 0.f, 0.f, 0.f};
        cur = nxt; cA = nA; cB = nB; ++ui;
        if constexpr (GATHER) { _Pragma("unroll") for (int h_ = 0; h_ < 2; ++h_) _Pragma("unroll") for (int i_ = 0; i_ < 2; ++i_) gA[h_][i_] = gN[h_][i_]; }
        if constexpr (ALIGN_EPI) { if (wr == 1) PG8_BAR; }
    }
    PG8_WAIT_V(0);
    if constexpr (!ALIGN_EPI) { if (wr == 0) PG8_BAR; }
    PG8_BAR;
    if constexpr (Epi::AFTER_DRAIN) { E.fused(acc, cur, wr, wc, fr, fq, lds, wid, lane); S.done(cur); }
#undef PG8_SA
#undef PG8_SB
#undef PG8_STAGE
#undef PG8_STAGE_A
#undef PG8_GOFF
#undef PG8_LDA
#undef PG8_LDB
#undef PG8_MMA
#undef PG8_WAIT_V
#undef PG8_WAIT_L
#undef PG8_BAR
#undef PG8_SCHED
}
}

#define GAS __attribute__((address_space(1)))
typedef GAS unsigned gu32;
#define RLX_AGENT __ATOMIC_RELAXED, __HIP_MEMORY_SCOPE_AGENT
#define XB_TMO      128
#define XB_XCNT(j)  (256  + 64 * (j))
#define XB_XSUB(j)  (1280 + 64 * (j))
#define XB_XGEN(j)  (2304 + 64 * (j))
#define XB_TOP      3328
#define XB_TOPGEN   3392
#define XCD_BAR_WORDS 3456
#define XB_SPIN_CAP (1u << 18)

__device__ __forceinline__ unsigned xb_ld(unsigned* p)              { return __hip_atomic_load(p, __ATOMIC_RELAXED, __HIP_MEMORY_SCOPE_AGENT); }
__device__ __forceinline__ unsigned xb_add(unsigned* p, unsigned v) { return __hip_atomic_fetch_add(p, v, __ATOMIC_RELAXED, __HIP_MEMORY_SCOPE_AGENT); }
__device__ __forceinline__ unsigned xb_xcc_id() { return (unsigned)__builtin_amdgcn_s_getreg((3 << 11) | 20) & 0xFu; }
#define XB_SPIN(cond, bar) do { unsigned _sp = 0; while (cond) { __builtin_amdgcn_s_sleep(1); \
    if ((++_sp & 255u) == 0u) { if (xb_ld(&(bar)[XB_TMO])) break; if (_sp > XB_SPIN_CAP) { atomicAdd(&(bar)[XB_TMO], 1u); break; } } } } while (0)

struct XcdBarrier {
    unsigned* bar; unsigned x;
    volatile LAS unsigned* st;
};

__device__ __forceinline__ XcdBarrier xcd_barrier_post(unsigned* bar, volatile LAS unsigned* st) {
    XcdBarrier b; b.bar = bar; b.x = xb_xcc_id(); b.st = st;
    if (threadIdx.x == 0) (void)xb_add(&bar[XB_XCNT(b.x)], 1u);
    return b;
}
__device__ __forceinline__ void xcd_barrier_complete(unsigned* bar, unsigned x, unsigned& nloc, unsigned& nx) {
    const unsigned G = gridDim.x * gridDim.y * gridDim.z;
    unsigned sum, cnt, mine, sp = 0u;
    for (;;) {
        sum = 0u; cnt = 0u; mine = 0u;
#pragma unroll
        for (unsigned j = 0; j < 16; ++j) { const unsigned c = xb_ld(&bar[XB_XCNT(j)]); sum += c; cnt += (c > 0u) ? 1u : 0u; mine = (j == x) ? c : mine; }
        if (sum == G) break;
        __builtin_amdgcn_s_sleep(1);
        if ((++sp & 255u) == 0u) { if (xb_ld(&bar[XB_TMO])) break; if (sp > XB_SPIN_CAP) { atomicAdd(&bar[XB_TMO], 1u); break; } }
    }
    nloc = mine > 0u ? mine : 1u; nx = cnt > 0u ? cnt : 1u;
}

__device__ __forceinline__ void xcd_barrier(const XcdBarrier& b) {
    asm volatile("s_waitcnt vmcnt(0)" ::: "memory");
    __syncthreads();
    if (threadIdx.x == 0) {
        unsigned* bar = b.bar;
        __builtin_amdgcn_s_waitcnt(0);
        unsigned nloc = b.st[0], nx = b.st[1];
        if (nloc == 0u) { xcd_barrier_complete(bar, b.x, nloc, nx); b.st[0] = nloc; b.st[1] = nx; }
        const unsigned old = xb_add(&bar[XB_XSUB(b.x)], 1u);
        const unsigned gen = old / nloc;
        if (old + 1u == (gen + 1u) * nloc) {
            __builtin_amdgcn_fence(__ATOMIC_RELEASE, "agent");
            asm volatile("s_waitcnt vmcnt(0)" ::: "memory");
            const unsigned og = xb_add(&bar[XB_TOP], 1u);
            const unsigned tg = og / nx;
            if (og + 1u == (tg + 1u) * nx) xb_add(&bar[XB_TOPGEN], 1u);
            else XB_SPIN(xb_ld(&bar[XB_TOPGEN]) == tg, bar);
            __builtin_amdgcn_fence(__ATOMIC_ACQUIRE, "agent");
            xb_add(&bar[XB_XGEN(b.x)], 1u);
            asm volatile("s_waitcnt vmcnt(0)" ::: "memory");
        } else {
            XB_SPIN(xb_ld(&bar[XB_XGEN(b.x)]) == gen, bar);
            __builtin_amdgcn_fence(__ATOMIC_ACQUIRE, "agent");
            asm volatile("s_waitcnt vmcnt(0)" ::: "memory");
        }
    }
    __syncthreads();
}

struct OrderBase {
    const int* rowidx;
    __device__ __forceinline__ void a_ready(const pg8::Unit&) const {}
    __device__ __forceinline__ void done(const pg8::Unit&) const {}
};
struct PlainOrder : OrderBase {
    const char* A; const char* B; size_t astep, bstep; int nM, nN, G, c;
    __device__ __forceinline__ bool next(int i, pg8::Unit& u) const {
        const long L = (long)i * G + c; if (L >= (long)nM * nN) return false;
        pg8::tile_of((int)L, nM, nN, u.pm, u.pn); u.aux = 0; u.a = A + (size_t)u.pm * astep; u.b = B + (size_t)u.pn * bstep; return true; }
};
struct LruOrder : OrderBase {
    const char* A; const char* B; int nM, G, c;
    __device__ __forceinline__ bool next(int i, pg8::Unit& u) const {
        const long L = (long)i * G + c; if (L >= (long)nM * 16) return false;
        pg8::tile_of((int)L, nM, 16, u.pm, u.pn); u.aux = 0; u.a = A + (size_t)u.pm * (256 * 1024 * 2) + (size_t)(u.pn >> 2) * 512; u.b = B + (size_t)u.pn * (256 * 256 * 2); return true; }
};
struct BranchOrder : OrderBase {
    const char* A; const char* B; int nM, G, c;
    __device__ __forceinline__ bool next(int i, pg8::Unit& u) const {
        const int j = i / 3, br = i - 3 * j; const long L = (long)j * G + c; if (L >= (long)nM * 4) return false;
        pg8::tile_of((int)L, nM, 4, u.pm, u.pn); u.aux = br; u.a = A + (size_t)br * ROWB + (size_t)u.pm * (256 * 1024 * 2); u.b = B + (size_t)br * (1024 * 1024 * 2) + (size_t)u.pn * (256 * 1024 * 2); return true; }
};
struct MoeOrder : OrderBase {
    const char* A; const char* B; const unsigned* tile_e; size_t estep; int nM, nN, G, c, ga;
    __device__ __forceinline__ bool next(int i, pg8::Unit& u) const {
        const long L = (long)i * G + c; if (L >= (long)nM * nN) return false;
        pg8::tile_of((int)L, nM, nN, u.pm, u.pn); const int e = (int)tile_e[u.pm]; u.aux = e;
        u.a = ga ? A : A + (size_t)u.pm * (256 * 1024 * 2); u.b = B + (size_t)e * estep + (size_t)u.pn * (256 * 1024 * 2); return true; }
};

struct EpiBf16Bias {
    static constexpr bool PERM = true, AFTER_DRAIN = false;
    bf16_t* O; int ldc; const float* bias; int bstride;
    __device__ __forceinline__ void operator()(const f32x4 (&acc)[2][2][4][2], const pg8::Unit& u, int wr, int wc, int fr, int fq) const {
        const int row0 = u.pm * 256 + wr * 64 + fr, col0 = u.pn * 256 + wc * 32 + 8 * fq;
        f32x4 bv[2][2];
#pragma unroll
        for (int bj = 0; bj < 2; ++bj)
#pragma unroll
            for (int n = 0; n < 2; ++n) bv[bj][n] = bias ? *(const f32x4*)(bias + (size_t)u.aux * bstride + col0 + bj * 128 + 4 * n) : (f32x4){0.f, 0.f, 0.f, 0.f};
#pragma unroll
        for (int ai = 0; ai < 2; ++ai)
#pragma unroll
            for (int m = 0; m < 4; ++m) { bf16_t* rowp = O + (size_t)(row0 + ai * 128 + m * 16) * ldc + col0;
#pragma unroll
                for (int bj = 0; bj < 2; ++bj) { const f32x4 v0 = acc[ai][bj][m][0] + bv[bj][0], v1 = acc[ai][bj][m][1] + bv[bj][1];
                    u32x4 w; w.x = pg8::cvt_pk_bf16(v0[0], v0[1]); w.y = pg8::cvt_pk_bf16(v0[2], v0[3]); w.z = pg8::cvt_pk_bf16(v1[0], v1[1]); w.w = pg8::cvt_pk_bf16(v1[2], v1[3]);
                    *(u32x4*)(rowp + bj * 128) = w; } }
    }
};
struct EpiProj {
    static constexpr bool PERM = true, AFTER_DRAIN = false;
    bf16_t* O; const float* rcos; const float* rsin;
    __device__ __forceinline__ void operator()(const f32x4 (&acc)[2][2][4][2], const pg8::Unit& u, int wr, int wc, int fr, int fq) const {
        const int row0 = u.pm * 256 + wr * 64 + fr, col0 = u.pn * 256 + wc * 32 + 8 * fq;
        if (u.pn >= 20 && u.pn < 24 && u.pm < 128) {
#pragma unroll
            for (int ai = 0; ai < 2; ++ai)
#pragma unroll
                for (int m = 0; m < 4; ++m) { const int row = row0 + ai * 128 + m * 16, t = row & (SEQ - 1); bf16_t* rowp = O + (size_t)row * LDP + col0;
                    const f32x4 cs = *(const f32x4*)(rcos + t * 64 + 16 * wc + 4 * fq), sn = *(const f32x4*)(rsin + t * 64 + 16 * wc + 4 * fq);
#pragma unroll
                    for (int bj = 0; bj < 2; ++bj) { const f32x4 x1 = acc[ai][bj][m][0], x2 = acc[ai][bj][m][1]; const f32x4 v0 = x1 * cs - x2 * sn, v1 = x1 * sn + x2 * cs;
                        u32x4 w; w.x = pg8::cvt_pk_bf16(v0[0], v0[1]); w.y = pg8::cvt_pk_bf16(v0[2], v0[3]); w.z = pg8::cvt_pk_bf16(v1[0], v1[1]); w.w = pg8::cvt_pk_bf16(v1[2], v1[3]);
                        *(u32x4*)(rowp + bj * 128) = w; } }
        } else {
#pragma unroll
            for (int ai = 0; ai < 2; ++ai)
#pragma unroll
                for (int m = 0; m < 4; ++m) { bf16_t* rowp = O + (size_t)(row0 + ai * 128 + m * 16) * LDP + col0;
#pragma unroll
                    for (int bj = 0; bj < 2; ++bj) { const f32x4 v0 = acc[ai][bj][m][0], v1 = acc[ai][bj][m][1];
                        u32x4 w; w.x = pg8::cvt_pk_bf16(v0[0], v0[1]); w.y = pg8::cvt_pk_bf16(v0[2], v0[3]); w.z = pg8::cvt_pk_bf16(v1[0], v1[1]); w.w = pg8::cvt_pk_bf16(v1[2], v1[3]);
                        *(u32x4*)(rowp + bj * 128) = w; } }
        }
    }
};
struct EpiLru {
    static constexpr bool PERM = true, AFTER_DRAIN = false;
    const bf16_t* xc; bf16_t* LA; bf16_t* BB; const float* ba; const float* bi; const float* lsl;
    __device__ __forceinline__ void operator()(const f32x4 (&acc)[2][2][4][2], const pg8::Unit& u, int wr, int wc, int fr, int fq) const {
        const int g = u.pn >> 2, d = (u.pn >> 1) & 1, hh = u.pn & 1;
        const int row0 = u.pm * 256 + wr * 64 + fr, ch0 = 256 * g + 128 * hh + wc * 32 + 8 * fq;
#pragma unroll
        for (int ai = 0; ai < 2; ++ai)
#pragma unroll
            for (int m = 0; m < 4; ++m) { const size_t off = (size_t)(row0 + ai * 128 + m * 16) * 1024 + ch0;
                const u32x4 xw = *(const u32x4*)(xc + off); float la[8], bb[8];
#pragma unroll
                for (int n = 0; n < 2; ++n) { const f32x4 pb = *(const f32x4*)(ba + d * 1024 + ch0 + 4 * n), pi = *(const f32x4*)(bi + d * 1024 + ch0 + 4 * n), pl = *(const f32x4*)(lsl + d * 1024 + ch0 + 4 * n);
#pragma unroll
                    for (int e = 0; e < 4; ++e) { const int idx = 4 * n + e; const unsigned w = xw[idx >> 1]; const float xv = (idx & 1) ? bfhi(w) : bflo(w);
                        const float r = sigmoidf_(acc[ai][0][m][n][e] + pb[e]), ig = sigmoidf_(acc[ai][1][m][n][e] + pi[e]);
                        const float l = 8.0f * r * pl[e]; la[idx] = l; bb[idx] = sqrtf(fmaxf(1.0f - __expf(2.0f * l), 0.f)) * ig * xv; } }
                u32x4 w1, w2; w1.x = pg8::cvt_pk_bf16(la[0], la[1]); w1.y = pg8::cvt_pk_bf16(la[2], la[3]); w1.z = pg8::cvt_pk_bf16(la[4], la[5]); w1.w = pg8::cvt_pk_bf16(la[6], la[7]);
                w2.x = pg8::cvt_pk_bf16(bb[0], bb[1]); w2.y = pg8::cvt_pk_bf16(bb[2], bb[3]); w2.z = pg8::cvt_pk_bf16(bb[4], bb[5]); w2.w = pg8::cvt_pk_bf16(bb[6], bb[7]);
                *(u32x4*)(LA + (size_t)d * TT * 1024 + off) = w1; *(u32x4*)(BB + (size_t)d * TT * 1024 + off) = w2; asm volatile("" ::: "memory"); }
    }
};
struct EpiBranch {
    static constexpr bool PERM = true, AFTER_DRAIN = false;
    const bf16_t* P; bf16_t* MB;
    __device__ __forceinline__ void operator()(const f32x4 (&acc)[2][2][4][2], const pg8::Unit& u, int wr, int wc, int fr, int fq) const {
        const int br = u.aux, row0 = u.pm * 256 + wr * 64 + fr, col0 = u.pn * 256 + wc * 32 + 8 * fq;
        bf16_t* dst = MB + (size_t)br * TT * 1024; const bf16_t* M0 = MB; const bf16_t* M1 = MB + (size_t)TT * 1024;
#pragma unroll
        for (int ai = 0; ai < 2; ++ai)
#pragma unroll
            for (int m = 0; m < 4; ++m) { const size_t row = (size_t)(row0 + ai * 128 + m * 16);
#pragma unroll
                for (int bj = 0; bj < 2; ++bj) { const int c = col0 + bj * 128;
                    const u32x4 gw = *(const u32x4*)(P + row * LDP + C_MG + br * 1024 + c);
                    f32x4 v0, v1;
                    v0[0] = sigmoidf_(bflo(gw.x)) * acc[ai][bj][m][0][0]; v0[1] = sigmoidf_(bfhi(gw.x)) * acc[ai][bj][m][0][1]; v0[2] = sigmoidf_(bflo(gw.y)) * acc[ai][bj][m][0][2]; v0[3] = sigmoidf_(bfhi(gw.y)) * acc[ai][bj][m][0][3];
                    v1[0] = sigmoidf_(bflo(gw.z)) * acc[ai][bj][m][1][0]; v1[1] = sigmoidf_(bfhi(gw.z)) * acc[ai][bj][m][1][1]; v1[2] = sigmoidf_(bflo(gw.w)) * acc[ai][bj][m][1][2]; v1[3] = sigmoidf_(bfhi(gw.w)) * acc[ai][bj][m][1][3];
                    if (br == 2) { const u32x4 p0 = *(const u32x4*)(M0 + row * 1024 + c), p1 = *(const u32x4*)(M1 + row * 1024 + c);
                        v0[0] += bflo(p0.x) + bflo(p1.x); v0[1] += bfhi(p0.x) + bfhi(p1.x); v0[2] += bflo(p0.y) + bflo(p1.y); v0[3] += bfhi(p0.y) + bfhi(p1.y);
                        v1[0] += bflo(p0.z) + bflo(p1.z); v1[1] += bfhi(p0.z) + bfhi(p1.z); v1[2] += bflo(p0.w) + bflo(p1.w); v1[3] += bfhi(p0.w) + bfhi(p1.w); }
                    u32x4 w; w.x = pg8::cvt_pk_bf16(v0[0], v0[1]); w.y = pg8::cvt_pk_bf16(v0[2], v0[3]); w.z = pg8::cvt_pk_bf16(v1[0], v1[1]); w.w = pg8::cvt_pk_bf16(v1[2], v1[3]);
                    *(u32x4*)(dst + row * 1024 + c) = w; } }
    }
};
template <bool BASE_F32> struct EpiOut {
    static constexpr bool PERM = true, AFTER_DRAIN = false;
    const float* baseLat; const float* baseCtx; bf16_t* xs; const float* gate;
    __device__ __forceinline__ void operator()(const f32x4 (&acc)[2][2][4][2], const pg8::Unit& u, int wr, int wc, int fr, int fq) const {
        const int mrow = u.pm < 128 ? (u.pm >> 4) : 8; const float* gp = gate + mrow * 6144;
        const int row0 = u.pm * 256 + wr * 64 + fr, col0 = u.pn * 256 + wc * 32 + 8 * fq;
        const float* base = u.pm < 128 ? baseLat + (size_t)row0 * 1024 : baseCtx + (size_t)(row0 - TLAT) * 1024;
        f32x4 gv[2][2];
#pragma unroll
        for (int bj = 0; bj < 2; ++bj)
#pragma unroll
            for (int n = 0; n < 2; ++n) gv[bj][n] = *(const f32x4*)(gp + col0 + bj * 128 + 4 * n);
#pragma unroll
        for (int ai = 0; ai < 2; ++ai)
#pragma unroll
            for (int m = 0; m < 4; ++m) { const size_t ro = (size_t)(ai * 128 + m * 16) * 1024 + col0; bf16_t* op = xs + (size_t)row0 * 1024 + ro;
#pragma unroll
                for (int bj = 0; bj < 2; ++bj) { f32x4 b0, b1;
                    if (BASE_F32) { b0 = *(const f32x4*)(base + ro + bj * 128); b1 = *(const f32x4*)(base + ro + bj * 128 + 4); }
                    else { const u32x4 w = *(const u32x4*)(op + bj * 128); b0 = (f32x4){bflo(w.x), bfhi(w.x), bflo(w.y), bfhi(w.y)}; b1 = (f32x4){bflo(w.z), bfhi(w.z), bflo(w.w), bfhi(w.w)}; }
                    const f32x4 v0 = b0 + gv[bj][0] * acc[ai][bj][m][0], v1 = b1 + gv[bj][1] * acc[ai][bj][m][1];
                    u32x4 w; w.x = pg8::cvt_pk_bf16(v0[0], v0[1]); w.y = pg8::cvt_pk_bf16(v0[2], v0[3]); w.z = pg8::cvt_pk_bf16(v1[0], v1[1]); w.w = pg8::cvt_pk_bf16(v1[2], v1[3]);
                    *(u32x4*)(op + bj * 128) = w; } }
    }
};
struct EpiSwiglu {
    static constexpr bool PERM = true, AFTER_DRAIN = false;
    bf16_t* H; const float* bgu;
    __device__ __forceinline__ void operator()(const f32x4 (&acc)[2][2][4][2], const pg8::Unit& u, int wr, int wc, int fr, int fq) const {
        const int row0 = u.pm * 256 + wr * 64 + fr, f0 = u.pn * 128 + wc * 32 + 8 * fq;
        float bg[8], bu[8];
#pragma unroll
        for (int q = 0; q < 4; ++q) { const f32x4 b = *(const f32x4*)(bgu + (size_t)u.aux * 2048 + 2 * f0 + 4 * q); bg[2 * q] = b[0]; bu[2 * q] = b[1]; bg[2 * q + 1] = b[2]; bu[2 * q + 1] = b[3]; }
#pragma unroll
        for (int ai = 0; ai < 2; ++ai)
#pragma unroll
            for (int m = 0; m < 4; ++m) { float a[8];
#pragma unroll
                for (int n = 0; n < 2; ++n)
#pragma unroll
                    for (int e = 0; e < 4; ++e) { const int idx = 4 * n + e; const float gt = fminf(acc[ai][0][m][n][e] + bg[idx], 7.0f), up = fminf(fmaxf(acc[ai][1][m][n][e] + bu[idx], -7.0f), 7.0f);
                        a[idx] = gt * sigmoidf_(1.702f * gt) * (up + 1.0f); }
                u32x4 w; w.x = pg8::cvt_pk_bf16(a[0], a[1]); w.y = pg8::cvt_pk_bf16(a[2], a[3]); w.z = pg8::cvt_pk_bf16(a[4], a[5]); w.w = pg8::cvt_pk_bf16(a[6], a[7]);
                *(u32x4*)(H + (size_t)(row0 + ai * 128 + m * 16) * 1024 + f0) = w; }
    }
};

constexpr int NWAVES = 8, NTHR = 512;
constexpr int LDS_BYTES = 163840, MISC_OFF = 163840 - 512;
template <int I> __device__ __forceinline__ const float* inptr() { const GAS float* p;
    asm volatile("s_load_dwordx2 %0, %1, %2\n\ts_waitcnt lgkmcnt(0)" : "=s"(p) : "s"(__builtin_amdgcn_kernarg_segment_ptr()), "n"(I * 8)); return (const float*)p; }
struct Frame {
    LAS unsigned char* lds; GAS unsigned char* ws; float* out;
    int tid, bx, lane, wave, G, gw, NGW, gtid, NGT;
};
__device__ __forceinline__ int mrow_of(int row) { return row < TLAT ? (row >> 12) : 8; }
__device__ __forceinline__ int seqrow(int d, int b, int p) {
    if (p < CTXL) return TLAT + b * CTXL + (d ? CTXL - 1 - p : p);
    const int q = p - CTXL; return b * SEQ + (d ? SEQ - 1 - q : q);
}
struct RowV { f32x4 v[4]; };
__device__ __forceinline__ RowV load_row(const float* p, int lane) { RowV r;
#pragma unroll
    for (int j = 0; j < 4; ++j) r.v[j] = *(const f32x4*)(p + 4 * lane + 256 * j);
    return r; }
__device__ __forceinline__ RowV load_row_bf16(const bf16_t* p, int lane) { RowV r;
#pragma unroll
    for (int j = 0; j < 4; ++j) { const u32x2 w = *(const u32x2*)(p + 4 * lane + 256 * j); r.v[j] = (f32x4){bflo(w.x), bfhi(w.x), bflo(w.y), bfhi(w.y)}; }
    return r; }
__device__ __forceinline__ float row_sumsq(const RowV& r) { float s = 0.f;
#pragma unroll
    for (int j = 0; j < 4; ++j) s += (r.v[j][0] * r.v[j][0] + r.v[j][1] * r.v[j][1]) + (r.v[j][2] * r.v[j][2] + r.v[j][3] * r.v[j][3]);
    return wave_sum(s); }
__device__ __forceinline__ RowV norm_mod(const RowV& x, const float* gain, const float* shift, const float* scale, int lane) {
    const float rs = rsqrtf(row_sumsq(x) * (1.0f / D) + EPS); RowV y;
#pragma unroll
    for (int j = 0; j < 4; ++j) { const int c = 4 * lane + 256 * j; const f32x4 g = *(const f32x4*)(gain + c), sh = *(const f32x4*)(shift + c), sc = *(const f32x4*)(scale + c);
        y.v[j] = (x.v[j] * rs) * g * (sc + 1.0f) + sh; }
    return y; }
__device__ __forceinline__ void store_row_bf16(bf16_t* p, const RowV& y, int lane) {
#pragma unroll
    for (int j = 0; j < 4; ++j) { u32x2 w; w.x = pk2(y.v[j][0], y.v[j][1]); w.y = pk2(y.v[j][2], y.v[j][3]); *(u32x2*)(p + 4 * lane + 256 * j) = w; } }
__device__ __forceinline__ f32x4 ld4bf(const bf16_t* p) { const u32x2 w = *(const u32x2*)p; return (f32x4){bflo(w.x), bfhi(w.x), bflo(w.y), bfhi(w.y)}; }

__device__ __forceinline__ void phase_proA(const Frame& F) {
    const float* c = inptr<1>(); const float* cc = inptr<3>(); const float* w_ada = inptr<4>();
    float* modp = (float*)(F.ws + WS_MODP);
    for (int it = F.gw; it < 2 * 8 * 96; it += F.NGW) {
        const int cg = it % 96, ks = (it / 96) % 8, l = it / 768, col = cg * 64 + F.lane;
        float acc[9];
#pragma unroll
        for (int r = 0; r < 9; ++r) acc[r] = 0.f;
        for (int k = ks * 128; k < ks * 128 + 128; ++k) {
            const float w = w_ada[((size_t)l * 1024 + k) * 6144 + col];
#pragma unroll
            for (int r = 0; r < 8; ++r) acc[r] += siluf_(c[r * 1024 + k]) * w;
            acc[8] += siluf_(cc[k]) * w;
        }
#pragma unroll
        for (int r = 0; r < 9; ++r) modp[((size_t)(ks * 2 + l) * 9 + r) * 6144 + col] = acc[r];
    }
    float* rc = (float*)(F.ws + WS_COS); float* rsn = (float*)(F.ws + WS_SIN);
    for (int i = F.gtid; i < SEQ * 64; i += F.NGT) {
        const int t = i >> 6, j = i & 63, f = j & 31; const float pos = (float)((j < 32) ? (t >> 6) : (t & 63));
        const float inv = exp2f(-(float)f * (13.287712379549449f / 32.0f)); const float ang = pos * inv;
        const float nn = rintf(ang * 0.15915494309189535f); float r = fmaf(-nn, 6.28125f, ang); r = fmaf(-nn, 1.9353071795864769e-3f, r);
        rc[i] = __cosf(r); rsn[i] = __sinf(r);
    }
}
__device__ __forceinline__ void phase_proB(const Frame& F) {
    const float* modp = (const float*)(F.ws + WS_MODP); float* mods = (float*)(F.ws + WS_MODS); const float* b_ada = inptr<5>();
    for (int i = F.gtid; i < 2 * 9 * 6144; i += F.NGT) { const int l = i / (9 * 6144), col = i % 6144; float s = b_ada[l * 6144 + col];
#pragma unroll
        for (int ks = 0; ks < 8; ++ks) s += modp[(size_t)ks * (2 * 9 * 6144) + i];
        mods[i] = s; }
}

template <class RM> __device__ __forceinline__ void tr_item(const float* W, int ldw, int k0, int n0, bf16_t* WT, int ldt, LAS float* scr, int lane, const RM& rm) {
#pragma unroll 8
    for (int i = 0; i < 32; ++i) { const int kk = 2 * i + (lane >> 5); scr[kk * 33 + (lane & 31)] = W[(size_t)(k0 + kk) * ldw + n0 + (lane & 31)]; }
    LDS_WAIT(); asm volatile("" ::: "memory");
    const int c = lane & 7;
#pragma unroll
    for (int j = 0; j < 4; ++j) { const int n = (lane >> 3) + 8 * j; const LAS float* s = scr + (8 * c) * 33 + n; int drow; float sc; rm(n0 + n, drow, sc);
        u32x4 o; o.x = pk2(s[0 * 33] * sc, s[1 * 33] * sc); o.y = pk2(s[2 * 33] * sc, s[3 * 33] * sc); o.z = pk2(s[4 * 33] * sc, s[5 * 33] * sc); o.w = pk2(s[6 * 33] * sc, s[7 * 33] * sc);
        *(u32x4*)(WT + (size_t)drow * ldt + k0 + 8 * c) = o; }
    LDS_WAIT(); asm volatile("" ::: "memory");
}
struct RmIn { __device__ __forceinline__ void operator()(int n, int& drow, float& sc) const {
    drow = n < 3072 ? n : (n < 3104 ? C_LR + (n - 3072) : n - 32); sc = (n < 512 || (n >= 5664 && n < 6176)) ? 0.08838834764831845f : 1.0f;
    if (n >= 5152 && n < 6176) { const int o = (n - 5152) & 127, i = o & 63, x2 = o >> 6; drow = (n - 32) - o + 32 * (i >> 4) + 8 * ((i >> 2) & 3) + 4 * x2 + (i & 3); } } };
struct RmId { __device__ __forceinline__ void operator()(int n, int& drow, float& sc) const { drow = n; sc = 1.0f; } };
struct RmLru { int base; __device__ __forceinline__ void operator()(int n, int& drow, float& sc) const { drow = base + (n & 127); sc = 1.0f; } };
struct RmGu { __device__ __forceinline__ void operator()(int n, int& drow, float& sc) const { const int f = n >> 1, u = n & 1; drow = 256 * (f >> 7) + 128 * u + (f & 127); sc = 1.0f; } };
__device__ __forceinline__ void phase_W(const Frame& F, int li) {
    LAS float* scr = (LAS float*)(F.lds + F.wave * 8704);
    bf16_t* Win_t = (bf16_t*)(F.ws + WS_WIN); bf16_t* Wlru_t = (bf16_t*)(F.ws + WS_WLRU); bf16_t* Wbr_t = (bf16_t*)(F.ws + WS_WBR);
    bf16_t* Wout_t = (bf16_t*)(F.ws + WS_WOUT); bf16_t* Wgu_t = (bf16_t*)(F.ws + WS_WGU); bf16_t* Wdn_t = (bf16_t*)(F.ws + WS_WDN);
    constexpr int I_IN = 16 * 353, I_LRU = 512, I_BR = 1536, I_OUT = 512, I_GU = 32768, I_DN = 16384, NITEMS = I_IN + I_LRU + I_BR + I_OUT + I_GU + I_DN;
    for (int it0 = F.gw; it0 < NITEMS; it0 += F.NGW) {
        int it = it0;
        if (it < I_IN) { const int kb = it / 353, nb = it % 353; tr_item(inptr<8>() + (size_t)li * 1024 * IN_TOTAL, IN_TOTAL, 64 * kb, 32 * nb, Win_t, 1024, scr, F.lane, RmIn{}); continue; } it -= I_IN;
        if (it < I_LRU) { const int mat = it >> 5, r = it & 31, kb = r >> 3, nb = r & 7, ty = mat >> 3, d = (mat >> 2) & 1, g = mat & 3, n0 = 32 * nb, pn = g * 4 + d * 2 + (n0 >> 7);
            const float* src = (ty ? inptr<16>() : inptr<14>()) + (size_t)((li * 2 + d) * 4 + g) * 65536;
            tr_item(src, 256, 64 * kb, n0, Wlru_t, 256, scr, F.lane, RmLru{pn * 256 + ty * 128}); continue; } it -= I_LRU;
        if (it < I_BR) { const int br = it >> 9, r = it & 511, kb = r >> 5, nb = r & 31; tr_item(inptr<20>() + (size_t)(li * 3 + br) * 1048576, 1024, 64 * kb, 32 * nb, Wbr_t + (size_t)br * 1048576, 1024, scr, F.lane, RmId{}); continue; } it -= I_BR;
        if (it < I_OUT) { const int kb = it >> 5, nb = it & 31; tr_item(inptr<21>() + (size_t)li * 1048576, 1024, 64 * kb, 32 * nb, Wout_t, 1024, scr, F.lane, RmId{}); continue; } it -= I_OUT;
        if (it < I_GU) { const int e = it >> 10, r = it & 1023, kb = r >> 6, nb = r & 63; tr_item(inptr<24>() + (size_t)(li * 32 + e) * 2097152, 2048, 64 * kb, 32 * nb, Wgu_t + (size_t)e * 2097152, 1024, scr, F.lane, RmGu{}); continue; } it -= I_GU;
        { const int e = it >> 9, r = it & 511, kb = r >> 5, nb = r & 31; tr_item(inptr<26>() + (size_t)(li * 32 + e) * 1048576, 1024, 64 * kb, 32 * nb, Wdn_t + (size_t)e * 1048576, 1024, scr, F.lane, RmId{}); }
    }
    for (int i = F.gtid; i < (LDP - IN_TOTAL) * 1024 / 8; i += F.NGT) *(u32x4*)(Win_t + (size_t)IN_TOTAL * 1024 + (size_t)i * 8) = (u32x4){0u, 0u, 0u, 0u};
    float* lsl = (float*)(F.ws + WS_LSL);
    for (int i = F.gtid; i < 2048; i += F.NGT) lsl[i] = logsigmoidf_(inptr<18>()[li * 2048 + i]);
}
__device__ __forceinline__ void phase_norm_in(const Frame& F) {
    const float* mods = (const float*)(F.ws + WS_MODS); bf16_t* xn = (bf16_t*)(F.ws + WS_D);
    for (int row = F.gw; row < TT; row += F.NGW) {
        const float* src = row < TLAT ? inptr<0>() + (size_t)row * D : inptr<2>() + (size_t)(row - TLAT) * D;
        const float* mp = mods + mrow_of(row) * 6144;
        const RowV y = norm_mod(load_row(src, F.lane), inptr<6>(), mp, mp + 1024, F.lane);
        store_row_bf16(xn + (size_t)row * D, y, F.lane);
    }
}

__device__ __forceinline__ void phase_conv(const Frame& F, int li) {
    const bf16_t* P = (const bf16_t*)(F.ws + WS_P); bf16_t* xc = (bf16_t*)(F.ws + WS_D);
    const float* cw = inptr<12>() + (size_t)li * 4 * 1024; const float* cb = inptr<13>() + (size_t)li * 1024;
    for (int i = F.gtid; i < TT * 128; i += F.NGT) {
        const int row = i >> 7, ch = (i & 127) * 8;
        int t, L; if (row < TLAT) { t = row & (SEQ - 1); L = SEQ; } else { t = (row - TLAT) & (CTXL - 1); L = CTXL; }
        float a[8];
        { const f32x4 b0 = *(const f32x4*)(cb + ch), b1 = *(const f32x4*)(cb + ch + 4); a[0] = b0[0]; a[1] = b0[1]; a[2] = b0[2]; a[3] = b0[3]; a[4] = b1[0]; a[5] = b1[1]; a[6] = b1[2]; a[7] = b1[3]; }
#pragma unroll
        for (int j = 0; j < 4; ++j) { const int tt = t - 2 + j; if (tt < 0 || tt >= L) continue;
            const u32x4 xw = *(const u32x4*)(P + (size_t)(row - 2 + j) * LDP + C_LX + ch);
            const f32x4 w0 = *(const f32x4*)(cw + j * 1024 + ch), w1 = *(const f32x4*)(cw + j * 1024 + ch + 4);
            a[0] += w0[0] * bflo(xw.x); a[1] += w0[1] * bfhi(xw.x); a[2] += w0[2] * bflo(xw.y); a[3] += w0[3] * bfhi(xw.y);
            a[4] += w1[0] * bflo(xw.z); a[5] += w1[1] * bfhi(xw.z); a[6] += w1[2] * bflo(xw.w); a[7] += w1[3] * bfhi(xw.w); }
        u32x4 o; o.x = pk2(a[0], a[1]); o.y = pk2(a[2], a[3]); o.z = pk2(a[4], a[5]); o.w = pk2(a[6], a[7]);
        *(u32x4*)(xc + (size_t)row * 1024 + ch) = o;
    }
}
constexpr int LSEG = 136, LNSEG = (CTXL + SEQ) / LSEG;
template <bool FINAL> __device__ __forceinline__ void phase_lru_scan(const Frame& F) {
    const bf16_t* LA = (const bf16_t*)(F.ws + WS_C); const bf16_t* BB = (const bf16_t*)(F.ws + WS_C + 2 * ROWB);
    float* carA = (float*)(F.ws + WS_CARA); float* carH = (float*)(F.ws + WS_CARH); bf16_t* HO = (bf16_t*)(F.ws + WS_E);
    for (int i = F.gtid; i < 2 * 8 * LNSEG * 256; i += F.NGT) {
        const int cq = i & 255, s = (i >> 8) % LNSEG, db = (i >> 8) / LNSEG, b = db & 7, d = db >> 3;
        f32x4 h = (f32x4){0.f, 0.f, 0.f, 0.f}, As = (f32x4){0.f, 0.f, 0.f, 0.f};
        if (FINAL) { for (int s2 = 0; s2 < s; ++s2) { const size_t o = ((size_t)(db * LNSEG + s2) * 256 + cq) * 4; h = *(const f32x4*)(carA + o) * h + *(const f32x4*)(carH + o); } }
        const size_t dofs = (size_t)d * TT * 1024;
#pragma unroll 8
        for (int p = 0; p < LSEG; ++p) { const size_t off = (size_t)seqrow(d, b, s * LSEG + p) * 1024 + cq * 4;
            const f32x4 la = ld4bf(LA + dofs + off), bb = ld4bf(BB + dofs + off);
            f32x4 a; a[0] = __expf(la[0]); a[1] = __expf(la[1]); a[2] = __expf(la[2]); a[3] = __expf(la[3]);
            h = a * h + bb;
            if (FINAL) { u32x2 w; w.x = pk2(h[0], h[1]); w.y = pk2(h[2], h[3]); *(u32x2*)(HO + dofs + off) = w; } else As += la; }
        if (!FINAL) { const size_t o = (size_t)i * 4; f32x4 A; A[0] = __expf(As[0]); A[1] = __expf(As[1]); A[2] = __expf(As[2]); A[3] = __expf(As[3]);
            *(f32x4*)(carA + o) = A; *(f32x4*)(carH + o) = h; }
    }
}


constexpr size_t QKB = (size_t)TT * 512 * 2;
__device__ __forceinline__ void phase_scanprep(const Frame& F, int li) {
    LAS float* lrs = (LAS float*)F.lds;
    LAS float* qtot = lrs + 64 * 32;
    LAS float* gcs = qtot + 4 * 512;
    bf16_t* Pm = (bf16_t*)(F.ws + WS_P); bf16_t* QK = (bf16_t*)(F.ws + WS_C); float* EGL = (float*)(F.ws + WS_MODP);
    const int qtr = F.tid >> 7, c4 = F.tid & 127, ch0 = 4 * c4;
    for (int rc = F.bx; rc < TT / 64; rc += F.G) {
        if (F.tid < 256) { const int tok = F.tid >> 2, q8 = F.tid & 3; const u32x4 v = *(const u32x4*)(Pm + (size_t)(64 * rc + tok) * LDP + C_LR + 8 * q8);
            LAS float* dst = lrs + tok * 32 + 8 * q8; *(LAS f32x4*)dst = (f32x4){bflo(v.x), bfhi(v.x), bflo(v.y), bfhi(v.y)}; *(LAS f32x4*)(dst + 4) = (f32x4){bflo(v.z), bfhi(v.z), bflo(v.w), bfhi(v.w)}; }
        __syncthreads();
        for (int d = 0; d < 2; ++d) {
            f32x4 wv[16];
#pragma unroll
            for (int r = 0; r < 16; ++r) wv[r] = *(const f32x4*)(inptr<9>() + (size_t)((li * 2 + d) * 16 + r) * 512 + ch0);
            const f32x4 bav = *(const f32x4*)(inptr<10>() + (size_t)(li * 2 + d) * 512 + ch0);
            f32x4 run = (f32x4){0.f, 0.f, 0.f, 0.f};
#pragma unroll 2
            for (int i = 0; i < 16; ++i) { const int p = 16 * qtr + i, tok = d ? 63 - p : p; f32x4 z = bav;
#pragma unroll
                for (int r4 = 0; r4 < 4; ++r4) { const f32x4 l = *(const LAS f32x4*)(lrs + tok * 32 + 16 * d + 4 * r4);
#pragma unroll
                    for (int e = 0; e < 4; ++e) z += wv[4 * r4 + e] * l[e]; }
#pragma unroll
                for (int e = 0; e < 4; ++e) run[e] += logsigmoidf_(z[e]) * 0.0625f;
                *(LAS f32x4*)(gcs + p * 512 + ch0) = run; }
            *(LAS f32x4*)(qtot + qtr * 512 + ch0) = run;
            __syncthreads();
            f32x4 off = (f32x4){0.f, 0.f, 0.f, 0.f}, tot = (f32x4){0.f, 0.f, 0.f, 0.f};
#pragma unroll
            for (int q2 = 0; q2 < 4; ++q2) { const f32x4 t = *(const LAS f32x4*)(qtot + q2 * 512 + ch0); tot += t; if (q2 < qtr) off += t; }
            if (qtr == 0) { f32x4 e4; e4[0] = __expf(tot[0]); e4[1] = __expf(tot[1]); e4[2] = __expf(tot[2]); e4[3] = __expf(tot[3]); *(f32x4*)(EGL + ((size_t)d * (TT / 64) + rc) * 512 + ch0) = e4; }
            bf16_t* EGd = QK + (size_t)d * TT * 512;
#pragma unroll 4
            for (int i = 0; i < 16; ++i) { const int p = 16 * qtr + i, tok = d ? 63 - p : p; const size_t row = (size_t)(64 * rc + tok);
                const f32x4 G = *(const LAS f32x4*)(gcs + p * 512 + ch0) + off;
                u32x2 we; we.x = pk2(__expf(G[0]), __expf(G[1])); we.y = pk2(__expf(G[2]), __expf(G[3]));
                *(u32x2*)(EGd + row * 512 + ch0) = we; }
            __syncthreads();
        }
    }
}
typedef short s16x4 __attribute__((ext_vector_type(4)));
constexpr int SC_PITCH = 272, SC_QS = 0, SC_KS = 17408, SC_VS = 34816, SC_SB = 52224, SC_AS = 87040, SC_APITCH = 144, SC_OS = SC_AS + 9216;
__device__ __forceinline__ bf16x8 tr_frag(LAS unsigned char* base, int pitch, int k0, int c0, int lane) {
    const int q = (lane & 15) >> 2, p = lane & 3;
    LAS unsigned char* a = base + (k0 + q) * pitch + (c0 + 4 * p) * 2;
    const s16x4 lo = __builtin_amdgcn_ds_read_tr16_b64_v4i16((LAS s16x4*)a);
    const s16x4 hi = __builtin_amdgcn_ds_read_tr16_b64_v4i16((LAS s16x4*)(a + 4 * pitch));
    return (bf16x8){lo[0], lo[1], lo[2], lo[3], hi[0], hi[1], hi[2], hi[3]};
}
#define MFMA16(a, b, c) __builtin_amdgcn_mfma_f32_16x16x32_bf16((a), (b), (c), 0, 0, 0)
__device__ __forceinline__ int chunk_rc(int d, int b, int chn) { return chn < 4 ? (TLAT / 64) + 4 * b + (d ? 3 - chn : chn) : 64 * b + (d ? 63 - (chn - 4) : (chn - 4)); }
struct ScanSet { u32x4 q[2], k[2], v[2], e[2]; float gl[2]; };
#define GST16(ptr, val) asm volatile("global_store_dwordx4 %0, %1, off\n\ts_nop 1" :: "v"(ptr), "v"(val) : "memory")
template <int MX> __device__ __forceinline__ void scan_unit(const Frame& F, int u) {
    LAS unsigned char* L = F.lds;
    const int tid = F.tid, lane = F.lane, w = F.wave, fr = lane & 15, fq = lane >> 4, tt = tid >> 4, part = tid & 15;
    const int js = u & 1, h = (u >> 1) & 3, b = (u >> 3) & 7, d = (u >> 6) & 1;
    const bf16_t* Pq = (const bf16_t*)(F.ws + WS_P) + (MX ? C_RQ : C_GQ) + 128 * h + 8 * part; const bf16_t* Pk = Pq + 512;
    const bf16_t* Pv = (const bf16_t*)(F.ws + WS_P) + (MX ? C_RV : C_GV) + 256 * h + 128 * js + 8 * part;
    const bf16_t* EGp = (const bf16_t*)(F.ws + WS_C) + (size_t)d * TT * 512 + 128 * h + 8 * part;
    const int tmA = w >> 1, tnA = 2 * (w & 1), tmB = w & 1, tnB = w >> 1, tmS = w & 3, tnS = w >> 2;
    const float* EGLp = (const float*)(F.ws + WS_MODP) + (size_t)d * (TT / 64) * 512 + 128 * h + 32 * tmS + fr;
    bf16_t* O = (bf16_t*)(F.ws + WS_B) + (size_t)(MX * 2 + d) * TT * 1024 + 256 * h + 128 * js + 8 * part;
    float er[2] = {1.f, 1.f}, nr[2] = {1.f, 1.f}, egr = 1.0f;
    if (MX == 1) { const float x = exp2f(-5.0f - (float)h), lg = -(x + x * x * 0.5f + x * x * x * (1.0f / 3.0f) + x * x * x * x * 0.25f);
        egr = __expf(64.0f * lg); er[0] = __expf((float)(tt + 1) * lg); nr[0] = __expf(-(float)(tt + 1) * lg); er[1] = __expf((float)(tt + 33) * lg); nr[1] = __expf(-(float)(tt + 33) * lg); }
    f32x4 S[2][4];
#pragma unroll
    for (int i = 0; i < 2; ++i)
#pragma unroll
        for (int j = 0; j < 4; ++j) S[i][j] = (f32x4){0.f, 0.f, 0.f, 0.f};
    for (int i = tid; i < (128 * SC_PITCH) / 16; i += NTHR) *(LAS u32x4*)(L + SC_SB + i * 16) = (u32x4){0u, 0u, 0u, 0u};
    constexpr int NCH = (CTXL + SEQ) / 64;
    ScanSet sA, sB;
#define SC_LOAD(chn, st) do { const int rc_ = chunk_rc(d, b, (chn)); _Pragma("unroll") for (int ps = 0; ps < 2; ++ps) { const int c_ = tt + 32 * ps; const size_t row_ = (size_t)(64 * rc_ + (d ? 63 - c_ : c_)); \
        st.q[ps] = *(const u32x4*)(Pq + row_ * LDP); st.k[ps] = *(const u32x4*)(Pk + row_ * LDP); st.v[ps] = *(const u32x4*)(Pv + row_ * LDP); if (MX == 0) st.e[ps] = *(const u32x4*)(EGp + row_ * 512); } \
        if (MX == 0) { st.gl[0] = EGLp[(size_t)rc_ * 512]; st.gl[1] = EGLp[(size_t)rc_ * 512 + 16]; } } while (0)
#define SC_PUT(st) do { _Pragma("unroll") for (int ps = 0; ps < 2; ++ps) { const int c_ = tt + 32 * ps; u32x4 qo, ko; \
        _Pragma("unroll") for (int e2 = 0; e2 < 4; ++e2) { float ea, eb, na, nb; \
            if (MX == 0) { ea = bflo(st.e[ps][e2]); eb = bfhi(st.e[ps][e2]); na = __builtin_amdgcn_rcpf(ea); nb = __builtin_amdgcn_rcpf(eb); } else { ea = eb = er[ps]; na = nb = nr[ps]; } \
            qo[e2] = pk2(bflo(st.q[ps][e2]) * ea, bfhi(st.q[ps][e2]) * eb); ko[e2] = pk2(bflo(st.k[ps][e2]) * na, bfhi(st.k[ps][e2]) * nb); } \
        *(LAS u32x4*)(L + SC_QS + c_ * SC_PITCH + part * 16) = qo; *(LAS u32x4*)(L + SC_KS + c_ * SC_PITCH + part * 16) = ko; *(LAS u32x4*)(L + SC_VS + c_ * SC_PITCH + part * 16) = st.v[ps]; } } while (0)
    float eg[2] = {egr, egr}, egn[2] = {egr, egr};
    SC_LOAD(0, sA); SC_PUT(sA); if (MX == 0) { eg[0] = sA.gl[0]; eg[1] = sA.gl[1]; }
    SC_LOAD(1, sA);
    __syncthreads();
#define SC_CHUNK(ch, LS, PS) do { \
        const int rc = chunk_rc(d, b, ch); \
        SC_LOAD(((ch) + 2 < NCH ? (ch) + 2 : NCH - 1), LS); \
        {   f32x4 a[2] = {(f32x4){0.f, 0.f, 0.f, 0.f}, (f32x4){0.f, 0.f, 0.f, 0.f}}; \
        _Pragma("unroll") \
            for (int ks = 0; ks < 4; ++ks) { const bf16x8 xq = *(const LAS bf16x8*)(L + SC_QS + (16 * tmA + fr) * SC_PITCH + (32 * ks + 8 * fq) * 2); \
        _Pragma("unroll") \
                for (int j = 0; j < 2; ++j) { const bf16x8 yk = *(const LAS bf16x8*)(L + SC_KS + (16 * (tnA + j) + fr) * SC_PITCH + (32 * ks + 8 * fq) * 2); a[j] = MFMA16(yk, xq, a[j]); } } \
            const int c = 16 * tmA + fr; \
        _Pragma("unroll") \
            for (int j = 0; j < 2; ++j) { const int s0 = 16 * (tnA + j) + 4 * fq; float m[4]; \
        _Pragma("unroll") \
                for (int e = 0; e < 4; ++e) { const int s = s0 + e; const bool keep = d ? (s < c) : (s <= c); m[e] = keep ? a[j][e] : 0.f; } \
                u32x2 wv; wv.x = pk2(m[0], m[1]); wv.y = pk2(m[2], m[3]); *(LAS u32x2*)(L + SC_AS + c * SC_APITCH + s0 * 2) = wv; } } \
        __syncthreads(); \
        f32x4 o[2][2]; \
        _Pragma("unroll") \
        for (int i = 0; i < 2; ++i) \
        _Pragma("unroll") \
            for (int j = 0; j < 2; ++j) o[i][j] = (f32x4){0.f, 0.f, 0.f, 0.f}; \
        _Pragma("unroll") \
        for (int ks = 0; ks < 2; ++ks) { bf16x8 xa[2], yv[2]; \
        _Pragma("unroll") \
            for (int i = 0; i < 2; ++i) xa[i] = *(const LAS bf16x8*)(L + SC_AS + (32 * tmB + 16 * i + fr) * SC_APITCH + (32 * ks + 8 * fq) * 2); \
        _Pragma("unroll") \
            for (int j = 0; j < 2; ++j) yv[j] = tr_frag(L + SC_VS, SC_PITCH, 32 * ks + 8 * fq, 32 * tnB + 16 * j, lane); \
        _Pragma("unroll") \
            for (int i = 0; i < 2; ++i) \
        _Pragma("unroll") \
                for (int j = 0; j < 2; ++j) o[i][j] = MFMA16(yv[j], xa[i], o[i][j]); } \
        _Pragma("unroll") \
        for (int ks = 0; ks < 4; ++ks) { bf16x8 xq[2], ys[2]; \
        _Pragma("unroll") \
            for (int i = 0; i < 2; ++i) xq[i] = *(const LAS bf16x8*)(L + SC_QS + (32 * tmB + 16 * i + fr) * SC_PITCH + (32 * ks + 8 * fq) * 2); \
        _Pragma("unroll") \
            for (int j = 0; j < 2; ++j) ys[j] = tr_frag(L + SC_SB, SC_PITCH, 32 * ks + 8 * fq, 32 * tnB + 16 * j, lane); \
        _Pragma("unroll") \
            for (int i = 0; i < 2; ++i) \
        _Pragma("unroll") \
                for (int j = 0; j < 2; ++j) o[i][j] = MFMA16(ys[j], xq[i], o[i][j]); } \
        _Pragma("unroll") \
        for (int ks = 0; ks < 2; ++ks) { bf16x8 xk[2], yv[4]; \
        _Pragma("unroll") \
            for (int i = 0; i < 2; ++i) xk[i] = tr_frag(L + SC_KS, SC_PITCH, 32 * ks + 8 * fq, 32 * tmS + 16 * i, lane); \
        _Pragma("unroll") \
            for (int j = 0; j < 4; ++j) yv[j] = tr_frag(L + SC_VS, SC_PITCH, 32 * ks + 8 * fq, 64 * tnS + 16 * j, lane); \
        _Pragma("unroll") \
            for (int i = 0; i < 2; ++i) \
        _Pragma("unroll") \
                for (int j = 0; j < 4; ++j) S[i][j] = MFMA16(yv[j], xk[i], S[i][j]); } \
        __syncthreads(); \
        _Pragma("unroll") \
        for (int i = 0; i < 2; ++i) \
        _Pragma("unroll") \
            for (int j = 0; j < 2; ++j) { u32x2 wv; wv.x = pk2(o[i][j][0], o[i][j][1]); wv.y = pk2(o[i][j][2], o[i][j][3]); \
                *(LAS u32x2*)(L + SC_OS + (32 * tmB + 16 * i + fr) * SC_PITCH + (32 * tnB + 16 * j + 4 * fq) * 2) = wv; } \
        _Pragma("unroll") \
        for (int i = 0; i < 2; ++i) { const int row = 32 * tmS + 16 * i + fr; \
            _Pragma("unroll") \
            for (int j = 0; j < 4; ++j) { S[i][j] = S[i][j] * eg[i]; u32x2 wv; wv.x = pk2(S[i][j][0], S[i][j][1]); wv.y = pk2(S[i][j][2], S[i][j][3]); \
                *(LAS u32x2*)(L + SC_SB + row * SC_PITCH + (64 * tnS + 16 * j + 4 * fq) * 2) = wv; } } \
        SC_PUT(PS); if (MX == 0) { eg[0] = PS.gl[0]; eg[1] = PS.gl[1]; } \
        __syncthreads(); \
        _Pragma("unroll") \
        for (int ps = 0; ps < 2; ++ps) { const int c = tt + 32 * ps; const u32x4 v = *(const LAS u32x4*)(L + SC_OS + c * SC_PITCH + part * 16); \
            GST16(O + (size_t)(64 * rc + (d ? 63 - c : c)) * 1024, v); } \
    } while (0)
    for (int ch2 = 0; ch2 < NCH; ch2 += 2) { SC_CHUNK(ch2, sB, sA); SC_CHUNK(ch2 + 1, sA, sB); }
    (void)egn;
#undef SC_CHUNK
#undef SC_LOAD
#undef SC_PUT
    __syncthreads();
}
__device__ __forceinline__ void phase_scan_mfma(const Frame& F, int li) {
    for (int u = F.bx; u < 256; u += F.G) { if (u < 128) scan_unit<0>(F, u); else scan_unit<1>(F, u - 128); }
}


__device__ __forceinline__ void phase_finish(const Frame& F, int li, int nrows) {
    const bf16_t* P = (const bf16_t*)(F.ws + WS_P); const bf16_t* OB = (const bf16_t*)(F.ws + WS_B); const bf16_t* HB = (const bf16_t*)(F.ws + WS_E); bf16_t* A3 = (bf16_t*)(F.ws + WS_C);
    const float* gnorm = inptr<11>() + (size_t)li * 1024; const float* rnorm = inptr<19>() + (size_t)li * 1024;
    const size_t RS = (size_t)TT * 1024;
    for (int row = F.gw; row < nrows; row += F.NGW) {
        const bf16_t* pr = P + (size_t)row * LDP; const size_t ro = (size_t)row * 1024;
#pragma unroll
        for (int j = 0; j < 4; ++j) {
            const int c = 4 * F.lane + 256 * j;
            {
                const f32x4 o = ld4bf(OB + ro + c) + ld4bf(OB + RS + ro + c);
                const float ss = wave_sum((o[0] * o[0] + o[1] * o[1]) + (o[2] * o[2] + o[3] * o[3])); const float rs = rsqrtf(ss * (1.0f / 256.0f) + EPS);
                const f32x4 g = ld4bf(pr + C_GG + c), gn = *(const f32x4*)(gnorm + c); u32x2 w;
                w.x = pk2(o[0] * rs * gn[0] * siluf_(g[0]), o[1] * rs * gn[1] * siluf_(g[1])); w.y = pk2(o[2] * rs * gn[2] * siluf_(g[2]), o[3] * rs * gn[3] * siluf_(g[3]));
                *(u32x2*)(A3 + ro + c) = w; }
            {
                const f32x4 hh = ld4bf(HB + ro + c) + ld4bf(HB + RS + ro + c), g = ld4bf(pr + C_LG + c); u32x2 w;
                w.x = pk2(hh[0] * gelu_tanh_(g[0]), hh[1] * gelu_tanh_(g[1])); w.y = pk2(hh[2] * gelu_tanh_(g[2]), hh[3] * gelu_tanh_(g[3]));
                *(u32x2*)(A3 + RS + ro + c) = w; }
            {
                f32x4 o = ld4bf(OB + 2 * RS + ro + c) + ld4bf(OB + 3 * RS + ro + c);
                const float mean = wave_sum((o[0] + o[1]) + (o[2] + o[3])) * (1.0f / 256.0f); o = o - mean;
                const float ss = wave_sum((o[0] * o[0] + o[1] * o[1]) + (o[2] * o[2] + o[3] * o[3])); const float rs = rsqrtf(ss * (1.0f / 256.0f) + EPS);
                const f32x4 g = ld4bf(pr + C_RG + c), gn = *(const f32x4*)(rnorm + c); u32x2 w;
                w.x = pk2(o[0] * rs * gn[0] * siluf_(g[0]), o[1] * rs * gn[1] * siluf_(g[1])); w.y = pk2(o[2] * rs * gn[2] * siluf_(g[2]), o[3] * rs * gn[3] * siluf_(g[3]));
                *(u32x2*)(A3 + 2 * RS + ro + c) = w; }
        }
    }
}

constexpr int RT_PITCH = 2064, RT_XH = 0, RT_XL = 16 * RT_PITCH, RT_PART = 2 * 16 * RT_PITCH, RT_PP = 33, RT_HIST = RT_PART + 8 * 16 * RT_PP * 4;
__device__ __forceinline__ void phase_norm2_router(const Frame& F, int li, int ntok) {
    LAS unsigned char* L = F.lds; LAS float* part = (LAS float*)(L + RT_PART); LAS unsigned* hist = (LAS unsigned*)(L + RT_HIST); LAS unsigned* hbase = hist + 32;
    const int lane = F.lane, w = F.wave, fr = lane & 15, fq = lane >> 4;
    const float* wr = inptr<22>() + (size_t)li * 1024 * 32; const float* br = inptr<23>() + li * 32;
    bf16x8 Bh[2][4], Bl[2][4];
#pragma unroll
    for (int nt = 0; nt < 2; ++nt)
#pragma unroll
        for (int ks = 0; ks < 4; ++ks) { u32x4 hw, lw;
#pragma unroll
            for (int i2 = 0; i2 < 4; ++i2) { const float a = wr[(size_t)(128 * w + 32 * ks + 8 * fq + 2 * i2) * 32 + 16 * nt + fr], b = wr[(size_t)(128 * w + 32 * ks + 8 * fq + 2 * i2 + 1) * 32 + 16 * nt + fr];
                hw[i2] = pk2(a, b); lw[i2] = pk2(a - bflo(hw[i2]), b - bfhi(hw[i2])); }
            Bh[nt][ks] = __builtin_bit_cast(bf16x8, hw); Bl[nt][ks] = __builtin_bit_cast(bf16x8, lw); }
    if (F.tid < 32) hist[F.tid] = 0u;
    __syncthreads();
    const bf16_t* xs = (const bf16_t*)(F.ws + WS_XS); const float* mods = (const float*)(F.ws + WS_MODS) + (size_t)li * 9 * 6144;
    bf16_t* xn2 = (bf16_t*)(F.ws + WS_D); int* tok_e = (int*)(F.ws + WS_TOKE); float* tok_w = (float*)(F.ws + WS_TOKW); int* tok_p = (int*)(F.ws + WS_TOKP);
    unsigned* cnt = (unsigned*)(F.ws + WS_CTL) + CW_CNT + li * 32;
    const int ntile = ntok / 16;
    for (int t = F.bx; t < ntile; t += F.G) {
#pragma unroll
        for (int rr = 0; rr < 2; ++rr) { const int lr = 2 * w + rr, row = 16 * t + lr; const float* mp = mods + mrow_of(row) * 6144;
            const RowV y = norm_mod(load_row_bf16(xs + (size_t)row * D, lane), inptr<7>() + (size_t)li * 1024, mp + 3 * 1024, mp + 4 * 1024, lane);
#pragma unroll
            for (int j = 0; j < 4; ++j) { u32x2 h, l2; h.x = pk2(y.v[j][0], y.v[j][1]); h.y = pk2(y.v[j][2], y.v[j][3]);
                l2.x = pk2(y.v[j][0] - bflo(h.x), y.v[j][1] - bfhi(h.x)); l2.y = pk2(y.v[j][2] - bflo(h.y), y.v[j][3] - bfhi(h.y));
                *(u32x2*)(xn2 + (size_t)row * D + 4 * lane + 256 * j) = h;
                *(LAS u32x2*)(L + RT_XH + lr * RT_PITCH + (4 * lane + 256 * j) * 2) = h; *(LAS u32x2*)(L + RT_XL + lr * RT_PITCH + (4 * lane + 256 * j) * 2) = l2; } }
        __syncthreads();
        {   f32x4 acc[2] = {(f32x4){0.f, 0.f, 0.f, 0.f}, (f32x4){0.f, 0.f, 0.f, 0.f}};
#pragma unroll
            for (int ks = 0; ks < 4; ++ks) { const int co = (128 * w + 32 * ks + 8 * fq) * 2;
                const bf16x8 ah = *(const LAS bf16x8*)(L + RT_XH + fr * RT_PITCH + co), al = *(const LAS bf16x8*)(L + RT_XL + fr * RT_PITCH + co);
#pragma unroll
                for (int nt = 0; nt < 2; ++nt) { acc[nt] = __builtin_amdgcn_mfma_f32_16x16x32_bf16(Bh[nt][ks], ah, acc[nt], 0, 0, 0); acc[nt] = __builtin_amdgcn_mfma_f32_16x16x32_bf16(Bl[nt][ks], ah, acc[nt], 0, 0, 0);
                    acc[nt] = __builtin_amdgcn_mfma_f32_16x16x32_bf16(Bh[nt][ks], al, acc[nt], 0, 0, 0); } }
#pragma unroll
            for (int nt = 0; nt < 2; ++nt)
#pragma unroll
                for (int j = 0; j < 4; ++j) part[(w * 16 + fr) * RT_PP + 16 * nt + 4 * fq + j] = acc[nt][j]; }
        __syncthreads();
        {
            const int e = lane & 31, tk = 2 * w + (lane >> 5), row = 16 * t + tk; float v = br[e];
#pragma unroll
            for (int w2 = 0; w2 < 8; ++w2) v += part[(w2 * 16 + tk) * RT_PP + e];
            float tl0, tl1, tl2, tl3; int te0, te1, te2, te3;
#define RT_ARGMAX(TL, TE) do { float bv = v; int bi = e; _Pragma("unroll") for (int o = 16; o >= 1; o >>= 1) { const float ov = __shfl_xor(bv, o); const int oi = __shfl_xor(bi, o); \
                const bool tk_ = (ov > bv) || (ov == bv && oi < bi); bv = tk_ ? ov : bv; bi = tk_ ? oi : bi; } TL = bv; TE = bi; v = (e == bi) ? -3.0e38f : v; } while (0)
            RT_ARGMAX(tl0, te0); RT_ARGMAX(tl1, te1); RT_ARGMAX(tl2, te2); RT_ARGMAX(tl3, te3);
#undef RT_ARGMAX
            const float e1 = __expf(tl1 - tl0), e2 = __expf(tl2 - tl0), e3 = __expf(tl3 - tl0); const float inv = 1.0f / (1.0f + e1 + e2 + e3);
            if (e < 4) { const int ek = e == 0 ? te0 : e == 1 ? te1 : e == 2 ? te2 : te3; const float wk = (e == 0 ? 1.0f : e == 1 ? e1 : e == 2 ? e2 : e3) * inv;
                const unsigned lp = atomicAdd((unsigned*)&hist[ek], 1u); tok_e[row * 4 + e] = ek; tok_w[row * 4 + e] = wk; tok_p[row * 4 + e] = (int)lp; } }
        __syncthreads();
    }
    if (F.tid < 32) hbase[F.tid] = __hip_atomic_fetch_add(cnt + F.tid, hist[F.tid], __ATOMIC_RELAXED, __HIP_MEMORY_SCOPE_AGENT);
    __syncthreads();
    for (int t = F.bx; t < ntile; t += F.G) if (F.tid < 64) { const int i = 16 * t * 4 + F.tid; tok_p[i] += (int)hbase[tok_e[i]]; }
    __syncthreads();
}
__device__ __forceinline__ void phase_dispatch(const Frame& F, int li, int ntok) {
    LAS unsigned* pstart = (LAS unsigned*)F.lds;
    unsigned* ctl = (unsigned*)(F.ws + WS_CTL); unsigned* cnt = ctl + CW_CNT + li * 32; unsigned* tile_e = ctl + CW_TILE + li * 1024;
    if (F.tid == 0) { unsigned ps = 0;
        for (int e = 0; e < 32; ++e) { const unsigned c = __hip_atomic_load(cnt + e, __ATOMIC_RELAXED, __HIP_MEMORY_SCOPE_AGENT), nt = (c + 255u) >> 8; pstart[e] = ps;
            if (F.bx == 0) for (unsigned j = 0; j < nt; ++j) tile_e[(ps >> 8) + j] = (unsigned)e;
            ps += nt << 8; }
        if (F.bx == 0) ctl[CW_NT + li] = ps >> 8; }
    __syncthreads();
    const int* tok_e = (const int*)(F.ws + WS_TOKE); const int* tok_p = (const int*)(F.ws + WS_TOKP); int* tok_s = (int*)(F.ws + WS_TOKS); int* slot_tok = (int*)(F.ws + WS_SLOTTOK);
    for (int it = F.gtid; it < ntok * 4; it += F.NGT) { const int slot = (int)pstart[tok_e[it]] + tok_p[it]; tok_s[it] = slot; slot_tok[slot] = it >> 2; }
    if (F.bx < 32) { const unsigned c = __hip_atomic_load(cnt + F.bx, __ATOMIC_RELAXED, __HIP_MEMORY_SCOPE_AGENT), pe = ((c + 255u) >> 8) << 8;
        for (unsigned s = c + F.tid; s < pe; s += NTHR) slot_tok[pstart[F.bx] + s] = 0; }
    __syncthreads();
}
__device__ __forceinline__ void phase_combine(const Frame& F, int li, int ntok, bool last) {
    bf16_t* xs = (bf16_t*)(F.ws + WS_XS); const bf16_t* Y = (const bf16_t*)(F.ws + WS_B); bf16_t* xn = (bf16_t*)(F.ws + WS_D);
    const float* mods = (const float*)(F.ws + WS_MODS); const float* tok_w = (const float*)(F.ws + WS_TOKW); const int* tok_s = (const int*)(F.ws + WS_TOKS);
    for (int row = F.gw; row < ntok; row += F.NGW) {
        const int mr = mrow_of(row); const float* gp = mods + ((size_t)li * 9 + mr) * 6144 + 5 * 1024;
        RowV x = load_row_bf16(xs + (size_t)row * D, F.lane);
        const int s0 = tok_s[row * 4], s1 = tok_s[row * 4 + 1], s2 = tok_s[row * 4 + 2], s3 = tok_s[row * 4 + 3];
        const float w0 = tok_w[row * 4], w1 = tok_w[row * 4 + 1], w2 = tok_w[row * 4 + 2], w3 = tok_w[row * 4 + 3];
#pragma unroll
        for (int j = 0; j < 4; ++j) { const int c = 4 * F.lane + 256 * j;
            const f32x4 y = ld4bf(Y + (size_t)s0 * 1024 + c) * w0 + ld4bf(Y + (size_t)s1 * 1024 + c) * w1 + ld4bf(Y + (size_t)s2 * 1024 + c) * w2 + ld4bf(Y + (size_t)s3 * 1024 + c) * w3;
            x.v[j] = x.v[j] + *(const f32x4*)(gp + c) * y; }
        if (!last) {
            store_row_bf16(xs + (size_t)row * D, x, F.lane);
            const float* mp = mods + ((size_t)(li + 1) * 9 + mr) * 6144;
            const RowV y = norm_mod(x, inptr<6>() + (size_t)(li + 1) * 1024, mp, mp + 1024, F.lane);
            store_row_bf16(xn + (size_t)row * D, y, F.lane);
        } else {
            const float rs = rsqrtf(row_sumsq(x) * (1.0f / D) + EPS);
#pragma unroll
            for (int j = 0; j < 4; ++j) { const int c = 4 * F.lane + 256 * j; *(f32x4*)(F.out + (size_t)row * D + c) = (x.v[j] * rs) * *(const f32x4*)(inptr<28>() + c); }
        }
    }
}

#ifndef MK_SCAN_REF
#define MK_SCAN_REF 0
#endif
#ifndef MK_ONE_LAUNCH
#define MK_ONE_LAUNCH 1
#endif
constexpr int NPH_LAYER = 15, NPHASES = 2 + 2 * NPH_LAYER;
struct Args { const float* in[29]; float* out; unsigned char* ws; int ph_lo, ph_hi, region, pad; };
#ifndef MK_PHMASK
#define MK_PHMASK 0x7fff
#endif
#define IN(k) (lo <= (k) && (k) < hi)
#define EN(j) ((MK_PHMASK >> (j)) & 1)
#define SEAM(k) do { if (IN(k) && IN((k) + 1)) xcd_barrier(bar); } while (0)
#define MKF() Frame F; { GAS unsigned char* ws_ = (GAS unsigned char*)args.ws; asm volatile("" : "+s"(ws_)); F.ws = ws_; F.lds = (LAS unsigned char*)lds_raw; F.out = args.out; \
        int tid_ = threadIdx.x, bx_ = blockIdx.x; asm volatile("" : "+v"(tid_), "+s"(bx_)); F.tid = tid_; F.bx = bx_; F.lane = F.tid & 63; F.wave = __builtin_amdgcn_readfirstlane(F.tid >> 6); F.G = gridDim.x; \
        F.gw = F.bx * NWAVES + F.wave; F.NGW = F.G * NWAVES; F.gtid = F.bx * NTHR + F.tid; F.NGT = F.G * NTHR; }
template <int li> __device__ __forceinline__ void run_layer(const Args& args, unsigned char* lds_raw, const XcdBarrier& bar, const int lo, const int hi) {
        const int pb = 2 + NPH_LAYER * li; const bool last = (li == 1); const int nrows = last ? TLAT : TT, nMt = nrows / 256;
        if (EN(0) && IN(pb + 0)) { MKF(); phase_W(F, li); if (li == 0) phase_norm_in(F); __syncthreads(); }
        SEAM(pb + 0);
        if (EN(1) && IN(pb + 1)) { MKF(); unsigned* ctl = (unsigned*)(F.ws + WS_CTL); (void)ctl;
            pg8::Gemm g{1024, 1024, 1024}; PlainOrder S; S.A = (const char*)(F.ws + WS_D); S.B = (const char*)(F.ws + WS_WIN); S.astep = 256 * 1024 * 2; S.bstep = 256 * 1024 * 2; S.nM = TT / 256; S.nN = LDP / 256; S.G = F.G; S.c = F.bx;
            EpiProj E{(bf16_t*)(F.ws + WS_P), (const float*)(F.ws + WS_COS), (const float*)(F.ws + WS_SIN)};
            pg8::gemm_phase<EpiProj, PlainOrder, true, true>(F.lds, g, S, E);
        }
        SEAM(pb + 1);
        if (EN(2) && IN(pb + 2)) { MKF(); phase_conv(F, li); phase_scanprep(F, li); }
        SEAM(pb + 2);
        if (EN(3) && IN(pb + 3)) { MKF(); phase_scan_mfma(F, li); }
        SEAM(pb + 3);
        if (EN(4) && IN(pb + 4)) { MKF(); unsigned* ctl = (unsigned*)(F.ws + WS_CTL); (void)ctl;
            pg8::Gemm g{1024, 256, 256}; LruOrder S; S.A = (const char*)(F.ws + WS_D); S.B = (const char*)(F.ws + WS_WLRU); S.nM = TT / 256; S.G = F.G; S.c = F.bx;
            EpiLru E{(const bf16_t*)(F.ws + WS_D), (bf16_t*)(F.ws + WS_C), (bf16_t*)(F.ws + WS_C + 2 * ROWB), inptr<15>() + (size_t)li * 2048, inptr<17>() + (size_t)li * 2048, (const float*)(F.ws + WS_LSL)};
            pg8::gemm_phase<EpiLru, LruOrder, true, true>(F.lds, g, S, E);
        }
        SEAM(pb + 4);
        if (EN(5) && IN(pb + 5)) { MKF(); phase_lru_scan<false>(F); }
        SEAM(pb + 5);
        if (EN(6) && IN(pb + 6)) { MKF(); phase_lru_scan<true>(F); }
        SEAM(pb + 6);
        if (EN(7) && IN(pb + 7)) { MKF(); phase_finish(F, li, nrows); }
        SEAM(pb + 7);
        if (EN(8) && IN(pb + 8)) { MKF(); unsigned* ctl = (unsigned*)(F.ws + WS_CTL); (void)ctl;
            pg8::Gemm g{1024, 1024, 1024}; BranchOrder S; S.A = (const char*)(F.ws + WS_C); S.B = (const char*)(F.ws + WS_WBR); S.nM = nMt; S.G = F.G; S.c = F.bx;
            EpiBranch E{(const bf16_t*)(F.ws + WS_P), (bf16_t*)(F.ws + WS_B)};
            pg8::gemm_phase<EpiBranch, BranchOrder, true, true>(F.lds, g, S, E);
        }
        SEAM(pb + 8);
        if (EN(9) && IN(pb + 9)) { MKF(); unsigned* ctl = (unsigned*)(F.ws + WS_CTL); (void)ctl;
            pg8::Gemm g{1024, 1024, 1024}; PlainOrder S; S.A = (const char*)(F.ws + WS_B + 2 * ROWB); S.B = (const char*)(F.ws + WS_WOUT); S.astep = 256 * 1024 * 2; S.bstep = 256 * 1024 * 2; S.nM = nMt; S.nN = 4; S.G = F.G; S.c = F.bx;
            bf16_t* xs = (bf16_t*)(F.ws + WS_XS);
            EpiOut<li == 0> E{inptr<0>(), inptr<2>(), xs, (const float*)(F.ws + WS_MODS) + (size_t)li * 9 * 6144 + 2 * 1024};
            pg8::gemm_phase<EpiOut<li == 0>, PlainOrder, true, true>(F.lds, g, S, E);
        }
        SEAM(pb + 9);
        if (EN(10) && IN(pb + 10)) { MKF(); phase_norm2_router(F, li, nrows); }
        SEAM(pb + 10);
        if (EN(11) && IN(pb + 11)) { MKF(); phase_dispatch(F, li, nrows); }
        SEAM(pb + 11);
        if (EN(12) && IN(pb + 12)) { MKF(); unsigned* ctl = (unsigned*)(F.ws + WS_CTL); (void)ctl;
            pg8::Gemm g{1024, 1024, 1024}; MoeOrder S; S.A = (const char*)(F.ws + WS_D); S.rowidx = (const int*)(F.ws + WS_SLOTTOK); S.B = (const char*)(F.ws + WS_WGU); S.tile_e = ctl + CW_TILE + li * 1024; S.estep = (size_t)2048 * 1024 * 2;
            S.nM = (int)ctl[CW_NT + li]; S.nN = 8; S.G = F.G; S.c = F.bx; S.ga = 1;
            EpiSwiglu E{(bf16_t*)(F.ws + WS_P + 288 * MiB), inptr<25>() + (size_t)li * 32 * 2048};
            pg8::gemm_phase<EpiSwiglu, MoeOrder, true, true, true>(F.lds, g, S, E);
        }
        SEAM(pb + 12);
        if (EN(13) && IN(pb + 13)) { MKF(); unsigned* ctl = (unsigned*)(F.ws + WS_CTL); (void)ctl;
            pg8::Gemm g{1024, 1024, 1024}; MoeOrder S; S.A = (const char*)(F.ws + WS_P + 288 * MiB); S.B = (const char*)(F.ws + WS_WDN); S.tile_e = ctl + CW_TILE + li * 1024; S.estep = (size_t)1024 * 1024 * 2;
            S.nM = (int)ctl[CW_NT + li]; S.nN = 4; S.G = F.G; S.c = F.bx; S.ga = 0; S.rowidx = nullptr;
            EpiBf16Bias E{(bf16_t*)(F.ws + WS_B), 1024, inptr<27>() + (size_t)li * 32 * 1024, 1024};
            pg8::gemm_phase<EpiBf16Bias, MoeOrder, true, true>(F.lds, g, S, E);
        }
        SEAM(pb + 13);
        if (EN(14) && IN(pb + 14)) { MKF(); phase_combine(F, li, nrows, last); }
        SEAM(pb + 14);
    }
__global__ void __launch_bounds__(NTHR, 2) mk_fwd(Args args) {
    extern __shared__ __attribute__((aligned(16))) unsigned char lds_raw[];
    const int tid0 = threadIdx.x;
    volatile LAS unsigned* MISC = (volatile LAS unsigned*)((LAS unsigned char*)lds_raw + MISC_OFF);
    if (tid0 < 32) MISC[tid0] = 0u;
    __syncthreads();
    unsigned* ctl0 = (unsigned*)(args.ws + WS_CTL);
    const int lo = args.ph_lo, hi = args.ph_hi;
    XcdBarrier bar; bar.bar = ctl0 + CW_BAR + args.region * 4096; bar.x = 0; bar.st = MISC + 8;
    if (hi - lo > 1) bar = xcd_barrier_post(ctl0 + CW_BAR + args.region * 4096, MISC + 8);

    if (IN(0)) { MKF(); phase_proA(F); }
    SEAM(0);
    if (IN(1)) { MKF(); phase_proB(F); }
    SEAM(1);
    run_layer<0>(args, lds_raw, bar, lo, hi);
    run_layer<1>(args, lds_raw, bar, lo, hi);
}

extern "C" void kernel_launch(void* const* d_in, const int* in_sizes, int n_in, void* d_out, int out_size, void* d_ws, size_t ws_size, hipStream_t stream) {
    static int grid = 0;
    if (grid == 0) {
        if (n_in != 29 || ws_size < WS_END || out_size != TLAT * D) { fprintf(stderr, "kernel_launch: unexpected problem: n_in %d ws %zu out %d\n", n_in, ws_size, out_size); grid = -1; return; }
        int dev = 0, cus = 0;
        if (hipGetDevice(&dev) != hipSuccess || hipDeviceGetAttribute(&cus, hipDeviceAttributeMultiprocessorCount, dev) != hipSuccess) { grid = -1; return; }
        if (hipFuncSetAttribute((const void*)mk_fwd, hipFuncAttributeMaxDynamicSharedMemorySize, LDS_BYTES) != hipSuccess) { fprintf(stderr, "kernel_launch: hipFuncSetAttribute failed\n"); grid = -1; return; }
        int per_cu = 0;
        if (hipOccupancyMaxActiveBlocksPerMultiprocessor(&per_cu, (const void*)mk_fwd, NTHR, LDS_BYTES) != hipSuccess || per_cu < 1) fprintf(stderr, "kernel_launch: occupancy query reports %d\n", per_cu);
        (void)hipGetLastError();
        grid = cus;
    }
    if (grid < 0) return;
    (void)hipMemsetAsync((char*)d_ws + WS_CTL, 0, CTL_BYTES, stream);
    Args a{};
    for (int i = 0; i < 29; ++i) a.in[i] = (const float*)d_in[i];
    a.out = (float*)d_out; a.ws = (unsigned char*)d_ws;
#if MK_ONE_LAUNCH
    a.ph_lo = 0; a.ph_hi = NPHASES; a.region = 0;
    hipLaunchKernelGGL(mk_fwd, dim3(grid), dim3(NTHR), LDS_BYTES, stream, a);
#else
    for (int p = 0; p < NPHASES; ++p) { a.ph_lo = p; a.ph_hi = p + 1; a.region = 0; hipLaunchKernelGGL(mk_fwd, dim3(grid), dim3(NTHR), LDS_BYTES, stream, a); }
#endif
}
```

```cpp
#include <hip/hip_runtime.h>
#include <cstdio>
#include <cstdint>

#define LAS __attribute__((address_space(3)))
typedef unsigned short bf16_t;
typedef short bf16x8 __attribute__((ext_vector_type(8)));
typedef float f32x4 __attribute__((ext_vector_type(4)));
typedef float f32x2 __attribute__((ext_vector_type(2)));
typedef unsigned u32x4 __attribute__((ext_vector_type(4)));
typedef unsigned u32x2 __attribute__((ext_vector_type(2)));

constexpr int D = 1024, NBATCH = 8, SEQ = 4096, CTXL = 256;
constexpr int TLAT = NBATCH * SEQ, TCTX = NBATCH * CTXL, TT = TLAT + TCTX;
constexpr int LDP = 11520;
constexpr int C_GQ = 0, C_GK = 512, C_GV = 1024, C_GG = 2048, C_LX = 3072, C_LG = 4096, C_RQ = 5120, C_RK = 5632, C_RV = 6144, C_RG = 7168, C_MG = 8192, C_LR = 11264;
constexpr int IN_TOTAL = 11296, NE = 32;
constexpr int SLOT_TILES_MAX = 576;
constexpr float EPS = 1e-6f;

constexpr size_t MiB = (size_t)1 << 20;
constexpr size_t WS_CTL = 0, CTL_BYTES = 1 * MiB;
constexpr size_t WS_MODP = 1 * MiB, WS_MODS = 5 * MiB, WS_COS = 6 * MiB, WS_SIN = 7 * MiB, WS_LSL = 8 * MiB, WS_CARA = 9 * MiB, WS_CARH = 11 * MiB;
constexpr size_t WS_SLOTTOK = 8 * MiB + 256 * 1024;
constexpr size_t WS_TOKE = 13 * MiB, WS_TOKW = WS_TOKE + 768 * 1024, WS_TOKP = WS_TOKW + 768 * 1024, WS_TOKS = WS_TOKP + 768 * 1024;
constexpr size_t WS_WIN = 16 * MiB, WS_WLRU = 39 * MiB, WS_WBR = 41 * MiB, WS_WOUT = 47 * MiB, WS_WGU = 49 * MiB, WS_WDN = 177 * MiB;
constexpr size_t WS_XS = 241 * MiB, WS_P = 377 * MiB, WS_B = 1142 * MiB, WS_C = 1430 * MiB, WS_D = 1702 * MiB, WS_E = 1770 * MiB, WS_END = 1906 * MiB;
constexpr size_t ROWB = (size_t)TT * D * 2;
static_assert(ROWB == 68 * MiB, "row buffer");
constexpr int CW_CNT = 1024, CW_NT = 1024 + 128, CW_TILE = 2048, CW_BAR = 8192;

__device__ __forceinline__ float bflo(unsigned w) { return __uint_as_float(w << 16); }
__device__ __forceinline__ float bfhi(unsigned w) { return __uint_as_float(w & 0xffff0000u); }
typedef __bf16 bf16x2_t __attribute__((ext_vector_type(2)));
__device__ __forceinline__ unsigned pk2(float lo, float hi) { const bf16x2_t v = __builtin_convertvector((f32x2){lo, hi}, bf16x2_t); return __builtin_bit_cast(unsigned, v); }
__device__ __forceinline__ float sigmoidf_(float x) { return __builtin_amdgcn_rcpf(1.0f + __expf(-x)); }
__device__ __forceinline__ float siluf_(float x) { return x * sigmoidf_(x); }
__device__ __forceinline__ float logsigmoidf_(float z) { return fminf(z, 0.f) - 0.6931471805599453f * __builtin_amdgcn_logf(1.0f + __builtin_amdgcn_exp2f(-1.4426950408889634f * fabsf(z))); }
__device__ __forceinline__ float gelu_tanh_(float x) { const float u = 0.7978845608028654f * (x + 0.044715f * x * x * x); const float t = 1.0f - 2.0f * __builtin_amdgcn_rcpf(__expf(2.0f * u) + 1.0f); return 0.5f * x * (1.0f + t); }
template <int CTRL> __device__ __forceinline__ float dpp_mov(float v) { return __builtin_bit_cast(float, __builtin_amdgcn_update_dpp(0, __builtin_bit_cast(int, v), CTRL, 0xf, 0xf, true)); }
__device__ __forceinline__ float wave_sum(float v) {
    v += dpp_mov<0xB1>(v);
    v += dpp_mov<0x4E>(v);
    v += dpp_mov<0x141>(v);
    v += dpp_mov<0x140>(v);
    const int iv = __builtin_bit_cast(int, v);
    const float r0 = __builtin_bit_cast(float, __builtin_amdgcn_readlane(iv, 0)), r1 = __builtin_bit_cast(float, __builtin_amdgcn_readlane(iv, 16));
    const float r2 = __builtin_bit_cast(float, __builtin_amdgcn_readlane(iv, 32)), r3 = __builtin_bit_cast(float, __builtin_amdgcn_readlane(iv, 48));
    return (r0 + r1) + (r2 + r3);
}
#define LDS_WAIT() asm volatile("s_waitcnt lgkmcnt(0)" ::: "memory")

namespace pg8 {
#define PG8_LAS __attribute__((address_space(3)))
constexpr int BM = 256, BK = 64, HALF = 128, HTB = HALF * BK * 2, STAGE_BYTES = 8 * HTB, NXCD = 8, WGM = 8;
__host__ __device__ __forceinline__ int lds_byte(int r, int c) { const int st = (r >> 4) * 2 + (c >> 5), rr = r & 15, cc = c & 31, ob = rr * 64 + cc * 2; return st * 1024 + (ob ^ (((ob >> 9) & 1) << 5)); }
__host__ __device__ __forceinline__ void stage_rc(int b, int& R, int& C) { const int st = b / 1024, sb = b % 1024, swz = sb ^ (((sb >> 9) & 1) << 5); R = (st >> 1) * 16 + swz / 64; C = (st & 1) * 32 + (swz % 64) / 2; }
__host__ __device__ __forceinline__ int perm32(int rho) { const int n = rho >> 4, i = rho & 15; return 8 * (i >> 2) + 4 * n + (i & 3); }
struct Unit { int pm, pn, aux; const char* a; const char* b; };
struct Gemm { int lda, ldb, K; };
__device__ __forceinline__ void tile_of(int L, int nM, int nN, int& pm, int& pn) {
    const int nwg = nM * nN; int wgid = L; { const int q = nwg / NXCD, r = nwg % NXCD, xcd = wgid % NXCD, off = wgid / NXCD; wgid = (xcd < r ? xcd * (q + 1) : r * (q + 1) + (xcd - r) * q) + off; }
    const int nig = WGM * nN, gid = wgid / nig, fm = gid * WGM, gsz = (nM - fm) < WGM ? (nM - fm) : WGM;
    pm = fm + ((wgid % nig) % gsz); pn = (wgid % nig) / gsz;
}
__device__ __forceinline__ unsigned cvt_pk_bf16(float lo, float hi) { unsigned r; asm volatile("v_cvt_pk_bf16_f32 %0, %1, %2" : "=v"(r) : "v"(lo), "v"(hi)); return r; }
template <class Epi, class Sched, bool ALIGN_EPI = false, bool SP2 = false, bool GATHER = false, bool RELAX = false>
__device__ __forceinline__ void gemm_phase(PG8_LAS unsigned char* lds, const Gemm g, const Sched& S, const Epi& E, const int tid_in) {
    int tid_o = tid_in; asm volatile("" : "+v"(tid_o));
    const int tid = tid_o, wid = __builtin_amdgcn_readfirstlane(tid >> 6), lane = tid & 63, wr = wid >> 2, wc = wid & 3, fr = lane & 15, fq = lane >> 4;
    const int K = g.K, nt = K / BK;
    unsigned voffA[2], voffB[2];
#pragma unroll
    for (int i = 0; i < 2; ++i) { int R, C; stage_rc(tid * 16 + i * 8192, R, C); const int Rb = Epi::PERM ? ((R & ~31) + perm32(R & 31)) : R;
        voffA[i] = (unsigned)(R * g.lda + C) * 2u; voffB[i] = (unsigned)(Rb * g.ldb + C) * 2u; }
    unsigned gA[2][2] = {{0u, 0u}, {0u, 0u}}, gN[2][2] = {{0u, 0u}, {0u, 0u}}; int gR[2], gC[2];
#pragma unroll
    for (int i = 0; i < 2; ++i) stage_rc(tid * 16 + i * 8192, gR[i], gC[i]);
#define PG8_GOFF(dst, u_) do { if constexpr (GATHER) { _Pragma("unroll") for (int h_ = 0; h_ < 2; ++h_) _Pragma("unroll") for (int i_ = 0; i_ < 2; ++i_) \
        dst[h_][i_] = (unsigned)S.rowidx[(u_).pm * BM + h_ * HALF + gR[i_]] * (unsigned)(g.lda * 2) + (unsigned)(gC[i_] * 2); } } while (0)
    const size_t kstep = (size_t)(BK * 2);
    const size_t hstepA = (size_t)HALF * g.lda * 2, hstepB = (size_t)HALF * g.ldb * 2;
    const unsigned ldsw = (unsigned)wid * 1024u;
    const int aoff = lds_byte(wr * 64 + fr, fq * 8), boff = lds_byte(wc * 32 + fr, fq * 8);
#define PG8_SA(b, h) (((b) * 2 + (h)) * HTB)
#define PG8_SB(b, h) ((4 + (b) * 2 + (h)) * HTB)
#define PG8_STAGE(bufoff, gbase, voff) do { _Pragma("unroll") for (int _i = 0; _i < 2; ++_i) \
        __builtin_amdgcn_global_load_lds((const unsigned*)((const char*)(gbase) + (voff)[_i]), (PG8_LAS unsigned*)(lds + (bufoff) + ldsw + _i * 8192), 16, 0, 0); } while (0)
#define PG8_STAGE_A(bufoff, gbase, H, NX) do { if constexpr (GATHER) { _Pragma("unroll") for (int _i = 0; _i < 2; ++_i) { const unsigned o_ = (NX) ? gN[H][_i] : gA[H][_i]; \
        __builtin_amdgcn_global_load_lds((const unsigned*)((const char*)(gbase) + o_), (PG8_LAS unsigned*)(lds + (bufoff) + ldsw + _i * 8192), 16, 0, 0); } } \
        else { PG8_STAGE(bufoff, (gbase) + (H) * hstepA, voffA); } } while (0)
#define PG8_LDA(dst, b, h) do { _Pragma("unroll") for (int m = 0; m < 4; ++m) _Pragma("unroll") for (int k = 0; k < 2; ++k) dst[m][k] = *(const PG8_LAS bf16x8*)(lds + PG8_SA(b, h) + aoff + m * 2048 + k * 1024); } while (0)
#define PG8_LDB(dst, b, h) do { _Pragma("unroll") for (int n = 0; n < 2; ++n) _Pragma("unroll") for (int k = 0; k < 2; ++k) dst[n][k] = *(const PG8_LAS bf16x8*)(lds + PG8_SB(b, h) + boff + n * 2048 + k * 1024); } while (0)
#define PG8_MMA(ai, bj, At, Bt) do { __builtin_amdgcn_s_setprio(1); _Pragma("unroll") for (int m = 0; m < 4; ++m) _Pragma("unroll") for (int n = 0; n < 2; ++n) _Pragma("unroll") for (int k = 0; k < 2; ++k) \
        acc[ai][bj][m][n] = __builtin_amdgcn_mfma_f32_16x16x32_bf16(Bt[n][k], At[m][k], acc[ai][bj][m][n], 0, 0, 0); __builtin_amdgcn_s_setprio(0); } while (0)
#define PG8_WAIT_V(n) asm volatile("s_waitcnt vmcnt(" #n ")" ::: "memory")
#define PG8_WAIT_VN(n) asm volatile("s_waitcnt vmcnt(%0)" :: "n"(n) : "memory")
#define PG8_WAIT_L(n) asm volatile("s_waitcnt lgkmcnt(" #n ")" ::: "memory")
#define PG8_BAR __builtin_amdgcn_s_barrier()
#define PG8_SCHED __builtin_amdgcn_sched_barrier(0)
    Unit cur, nxt; int ui = 0;
    if (!S.next(0, cur)) return;
    f32x4 acc[2][2][4][2];
#pragma unroll
    for (int a = 0; a < 2; ++a)
#pragma unroll
        for (int b = 0; b < 2; ++b)
#pragma unroll
            for (int m = 0; m < 4; ++m)
#pragma unroll
                for (int n = 0; n < 2; ++n) acc[a][b][m][n] = (f32x4){0.f, 0.f, 0.f, 0.f};
    bf16x8 At[4][2], B0[2][2], B1[2][2];
    const char* cA = cur.a; const char* cB = cur.b;
    S.a_ready(cur);
    PG8_GOFF(gA, cur);
    if constexpr (SP2) {
        PG8_STAGE(PG8_SB(0, 0), cB, voffB); PG8_STAGE(PG8_SB(0, 1), cB + hstepB, voffB); PG8_STAGE_A(PG8_SA(0, 0), cA, 0, false); PG8_STAGE_A(PG8_SA(0, 1), cA, 1, false);
        if (wr == 1) PG8_BAR;
        PG8_WAIT_V(2); PG8_BAR;
        PG8_STAGE(PG8_SB(1, 0), cB + kstep, voffB); PG8_STAGE_A(PG8_SA(1, 0), cA + kstep, 0, false); PG8_STAGE(PG8_SB(1, 1), cB + hstepB + kstep, voffB);
        if constexpr (RELAX) PG8_WAIT_V(0); else PG8_WAIT_V(6);
        PG8_BAR;
    } else {
        PG8_STAGE(PG8_SB(0, 0), cB, voffB); PG8_STAGE_A(PG8_SA(0, 0), cA, 0, false); PG8_STAGE(PG8_SB(0, 1), cB + hstepB, voffB); PG8_STAGE_A(PG8_SA(0, 1), cA, 1, false);
        if (wr == 1) PG8_BAR;
        PG8_WAIT_V(4); PG8_BAR;
        PG8_STAGE(PG8_SB(1, 0), cB + kstep, voffB); PG8_STAGE_A(PG8_SA(1, 0), cA + kstep, 0, false); PG8_STAGE(PG8_SB(1, 1), cB + hstepB + kstep, voffB);
        PG8_WAIT_V(6); PG8_BAR;
    }
    for (;;) {
        const bool has_next = S.next(ui + 1, nxt);
        if (has_next) PG8_GOFF(gN, nxt);
        const char* nA = has_next ? nxt.a : cA; const char* nB = has_next ? nxt.b : cB;
        if constexpr (SP2 && RELAX) {
            const char* a1 = cA + kstep; const char* a2 = cA + 2 * kstep; const char* b2 = cB + 2 * kstep; const char* a3 = a2 + kstep; const char* b3 = b2 + kstep;
            PG8_SCHED;
            PG8_LDB(B0, 0, 0); PG8_LDB(B1, 0, 1); PG8_SCHED; PG8_LDA(At, 0, 0); PG8_STAGE_A(PG8_SA(1, 1), a1, 1, false);
            PG8_WAIT_VN(8 + Epi::NST); PG8_WAIT_L(0); PG8_BAR; PG8_MMA(0, 0, At, B0); PG8_MMA(0, 1, At, B1); PG8_BAR; PG8_SCHED;
            PG8_LDA(At, 0, 1); PG8_STAGE(PG8_SB(0, 0), b2, voffB); PG8_STAGE(PG8_SB(0, 1), b2 + hstepB, voffB); PG8_STAGE_A(PG8_SA(0, 0), a2, 0, false);
            PG8_WAIT_VN(8 + Epi::NST); PG8_WAIT_L(0); PG8_BAR; PG8_MMA(1, 0, At, B0); PG8_MMA(1, 1, At, B1); PG8_BAR; PG8_SCHED;
            PG8_LDB(B0, 1, 0); PG8_LDB(B1, 1, 1); PG8_SCHED; PG8_LDA(At, 1, 0); PG8_STAGE_A(PG8_SA(0, 1), a2, 1, false);
            PG8_WAIT_V(8); PG8_WAIT_L(0); PG8_BAR; PG8_MMA(0, 0, At, B0); PG8_MMA(0, 1, At, B1); PG8_BAR; PG8_SCHED;
            PG8_LDA(At, 1, 1); PG8_STAGE(PG8_SB(1, 0), b3, voffB); PG8_STAGE(PG8_SB(1, 1), b3 + hstepB, voffB); PG8_STAGE_A(PG8_SA(1, 0), a3, 0, false);
            PG8_WAIT_V(8); PG8_WAIT_L(0); PG8_BAR; PG8_MMA(1, 0, At, B0); PG8_MMA(1, 1, At, B1); PG8_BAR; PG8_SCHED;
        }
        for (int t = (SP2 && RELAX) ? 2 : 0; t < nt; t += 2) {
            const bool last = (t == nt - 2); const bool nx_ = last && has_next;
            const char* a1 = cA + (size_t)(t + 1) * kstep;
            const char* a2 = last ? nA : cA + (size_t)(t + 2) * kstep; const char* b2 = last ? nB : cB + (size_t)(t + 2) * kstep;
            const char* a3 = a2 + kstep; const char* b3 = b2 + kstep;
            if (last && has_next) S.a_ready(nxt);
            if constexpr (SP2) {
            PG8_LDB(B0, 0, 0); PG8_LDB(B1, 0, 1); PG8_SCHED; PG8_LDA(At, 0, 0); PG8_STAGE_A(PG8_SA(1, 1), a1, 1, false);
            PG8_WAIT_V(8); PG8_WAIT_L(0); PG8_BAR; PG8_MMA(0, 0, At, B0); PG8_MMA(0, 1, At, B1); PG8_BAR; PG8_SCHED;
            PG8_LDA(At, 0, 1); PG8_STAGE(PG8_SB(0, 0), b2, voffB); PG8_STAGE(PG8_SB(0, 1), b2 + hstepB, voffB); PG8_STAGE_A(PG8_SA(0, 0), a2, 0, nx_);
            PG8_WAIT_V(8); PG8_WAIT_L(0); PG8_BAR; PG8_MMA(1, 0, At, B0); PG8_MMA(1, 1, At, B1); PG8_BAR; PG8_SCHED;
            PG8_LDB(B0, 1, 0); PG8_LDB(B1, 1, 1); PG8_SCHED; PG8_LDA(At, 1, 0); PG8_STAGE_A(PG8_SA(0, 1), a2, 1, nx_);
            PG8_WAIT_V(8); PG8_WAIT_L(0); PG8_BAR; PG8_MMA(0, 0, At, B0); PG8_MMA(0, 1, At, B1); PG8_BAR; PG8_SCHED;
            PG8_LDA(At, 1, 1); PG8_STAGE(PG8_SB(1, 0), b3, voffB); PG8_STAGE(PG8_SB(1, 1), b3 + hstepB, voffB); PG8_STAGE_A(PG8_SA(1, 0), a3, 0, nx_);
            PG8_WAIT_V(8); PG8_WAIT_L(0); PG8_BAR; PG8_MMA(1, 0, At, B0); PG8_MMA(1, 1, At, B1); PG8_BAR; PG8_SCHED;
            } else {
            PG8_LDB(B0, 0, 0); PG8_SCHED; PG8_LDA(At, 0, 0); PG8_STAGE_A(PG8_SA(1, 1), a1, 1, false);
            PG8_WAIT_L(8); PG8_BAR; PG8_WAIT_L(0); PG8_MMA(0, 0, At, B0); PG8_BAR; PG8_SCHED;
            PG8_LDB(B1, 0, 1); PG8_STAGE(PG8_SB(0, 0), b2, voffB);
            PG8_BAR; PG8_WAIT_L(0); PG8_MMA(0, 1, At, B1); PG8_BAR;
            PG8_LDA(At, 0, 1); PG8_STAGE_A(PG8_SA(0, 0), a2, 0, nx_);
            PG8_BAR; PG8_WAIT_L(0); PG8_MMA(1, 0, At, B0); PG8_BAR; PG8_SCHED;
            PG8_STAGE(PG8_SB(0, 1), b2 + hstepB, voffB);
            PG8_WAIT_V(6); PG8_BAR; PG8_MMA(1, 1, At, B1); PG8_BAR;
            PG8_LDB(B0, 1, 0); PG8_SCHED; PG8_LDA(At, 1, 0); PG8_STAGE_A(PG8_SA(0, 1), a2, 1, nx_);
            PG8_WAIT_L(8); PG8_BAR; PG8_WAIT_L(0); PG8_MMA(0, 0, At, B0); PG8_BAR; PG8_SCHED;
            PG8_LDB(B1, 1, 1); PG8_STAGE(PG8_SB(1, 0), b3, voffB);
            PG8_BAR; PG8_WAIT_L(0); PG8_MMA(0, 1, At, B1); PG8_BAR;
            PG8_LDA(At, 1, 1); PG8_STAGE_A(PG8_SA(1, 0), a3, 0, nx_);
            PG8_BAR; PG8_WAIT_L(0); PG8_MMA(1, 0, At, B0); PG8_BAR; PG8_SCHED;
            PG8_STAGE(PG8_SB(1, 1), b3 + hstepB, voffB);
            PG8_WAIT_V(6); PG8_BAR; PG8_MMA(1, 1, At, B1); PG8_BAR;
            }
        }
        if constexpr (ALIGN_EPI) { if (wr == 0) PG8_BAR; }
        if constexpr (!Epi::AFTER_DRAIN) { const int ln_ = (int)__builtin_amdgcn_mbcnt_hi(~0u, __builtin_amdgcn_mbcnt_lo(~0u, 0u));
            E(acc, cur, wr, wc, ln_ & 15, ln_ >> 4); S.done(cur); }
        if (!has_next) break;
#pragma unroll
        for (int a = 0; a < 2; ++a)
#pragma unroll
            for (int b = 0; b < 2; ++b)
#pragma unroll
                for (int m = 0; m < 4; ++m)
#pragma unroll
                    for (int n = 0; n < 2; ++n) acc[a][b][m][n] = (f32x4){0.f, 0.f, 0.f, 0.f};
        cur = nxt; cA = nA; cB = nB; ++ui;
        if constexpr (GATHER) { _Pragma("unroll") for (int h_ = 0; h_ < 2; ++h_) _Pragma("unroll") for (int i_ = 0; i_ < 2; ++i_) gA[h_][i_] = gN[h_][i_]; }
        if constexpr (ALIGN_EPI) { if (wr == 1) PG8_BAR; }
    }
    PG8_WAIT_V(0);
    if constexpr (!ALIGN_EPI) { if (wr == 0) PG8_BAR; }
    PG8_BAR;
    if constexpr (Epi::AFTER_DRAIN) { E.fused(acc, cur, wr, wc, fr, fq, lds, wid, lane); S.done(cur); }
#undef PG8_SA
#undef PG8_SB
#undef PG8_STAGE
#undef PG8_STAGE_A
#undef PG8_GOFF
#undef PG8_LDA
#undef PG8_LDB
#undef PG8_MMA
#undef PG8_WAIT_V
#undef PG8_WAIT_VN
#undef PG8_WAIT_L
#undef PG8_BAR
#undef PG8_SCHED
}
}

#define GAS __attribute__((address_space(1)))
typedef GAS unsigned gu32;
#define RLX_AGENT __ATOMIC_RELAXED, __HIP_MEMORY_SCOPE_AGENT
#define XB_TMO      128
#define XB_XCNT(j)  (256  + 64 * (j))
#define XB_XSUB(j)  (1280 + 64 * (j))
#define XB_XGEN(j)  (2304 + 64 * (j))
#define XB_TOP      3328
#define XB_TOPGEN   3392
#define XCD_BAR_WORDS 3456
#define XB_SPIN_CAP (1u << 18)

__device__ __forceinline__ unsigned xb_ld(unsigned* p)              { return __hip_atomic_load(p, __ATOMIC_RELAXED, __HIP_MEMORY_SCOPE_AGENT); }
__device__ __forceinline__ unsigned xb_add(unsigned* p, unsigned v) { return __hip_atomic_fetch_add(p, v, __ATOMIC_RELAXED, __HIP_MEMORY_SCOPE_AGENT); }
__device__ __forceinline__ unsigned xb_xcc_id() { return (unsigned)__builtin_amdgcn_s_getreg((3 << 11) | 20) & 0xFu; }
#define XB_SPIN(cond, bar) do { unsigned _sp = 0; while (cond) { __builtin_amdgcn_s_sleep(1); \
    if ((++_sp & 255u) == 0u) { if (xb_ld(&(bar)[XB_TMO])) break; if (_sp > XB_SPIN_CAP) { atomicAdd(&(bar)[XB_TMO], 1u); break; } } } } while (0)

struct XcdBarrier {
    unsigned* bar; unsigned x; unsigned w0;
    volatile LAS unsigned* st;
};

__device__ __forceinline__ unsigned xb_lane() { return __builtin_amdgcn_mbcnt_hi(~0u, __builtin_amdgcn_mbcnt_lo(~0u, 0u)); }
__device__ __forceinline__ XcdBarrier xcd_barrier_post(unsigned* bar, volatile LAS unsigned* st, unsigned w0) {
    XcdBarrier b; b.bar = bar; b.x = xb_xcc_id(); b.st = st; b.w0 = w0;
    if (w0 == 0u && xb_lane() == 0u) (void)xb_add(&bar[XB_XCNT(b.x)], 1u);
    return b;
}
__device__ __forceinline__ void xcd_barrier_complete(unsigned* bar, unsigned x, unsigned& nloc, unsigned& nx) {
    const unsigned G = gridDim.x * gridDim.y * gridDim.z;
    unsigned sum, cnt, mine, sp = 0u;
    for (;;) {
        sum = 0u; cnt = 0u; mine = 0u;
#pragma unroll
        for (unsigned j = 0; j < 16; ++j) { const unsigned c = xb_ld(&bar[XB_XCNT(j)]); sum += c; cnt += (c > 0u) ? 1u : 0u; mine = (j == x) ? c : mine; }
        if (sum == G) break;
        __builtin_amdgcn_s_sleep(1);
        if ((++sp & 255u) == 0u) { if (xb_ld(&bar[XB_TMO])) break; if (sp > XB_SPIN_CAP) { atomicAdd(&bar[XB_TMO], 1u); break; } }
    }
    nloc = mine > 0u ? mine : 1u; nx = cnt > 0u ? cnt : 1u;
}

__device__ __forceinline__ void xcd_barrier(const XcdBarrier& b) {
    asm volatile("s_waitcnt vmcnt(0)" ::: "memory");
    __syncthreads();
    if (b.w0 == 0u && xb_lane() == 0u) {
        unsigned* bar = b.bar;
        __builtin_amdgcn_s_waitcnt(0);
        unsigned nloc = b.st[0], nx = b.st[1];
        if (nloc == 0u) { xcd_barrier_complete(bar, b.x, nloc, nx); b.st[0] = nloc; b.st[1] = nx; }
        const unsigned old = xb_add(&bar[XB_XSUB(b.x)], 1u);
        const unsigned gen = old / nloc;
        if (old + 1u == (gen + 1u) * nloc) {
            __builtin_amdgcn_fence(__ATOMIC_RELEASE, "agent");
            asm volatile("s_waitcnt vmcnt(0)" ::: "memory");
            const unsigned og = xb_add(&bar[XB_TOP], 1u);
            const unsigned tg = og / nx;
            if (og + 1u == (tg + 1u) * nx) xb_add(&bar[XB_TOPGEN], 1u);
            else XB_SPIN(xb_ld(&bar[XB_TOPGEN]) == tg, bar);
            __builtin_amdgcn_fence(__ATOMIC_ACQUIRE, "agent");
            xb_add(&bar[XB_XGEN(b.x)], 1u);
            asm volatile("s_waitcnt vmcnt(0)" ::: "memory");
        } else {
            XB_SPIN(xb_ld(&bar[XB_XGEN(b.x)]) == gen, bar);
            __builtin_amdgcn_fence(__ATOMIC_ACQUIRE, "agent");
            asm volatile("s_waitcnt vmcnt(0)" ::: "memory");
        }
    }
    __syncthreads();
}

struct OrderBase {
    const int* rowidx;
    __device__ __forceinline__ void a_ready(const pg8::Unit&) const {}
    __device__ __forceinline__ void done(const pg8::Unit&) const {}
};
struct PlainOrder : OrderBase {
    const char* A; const char* B; size_t astep, bstep; int nM, nN, G, c, pm0;
    __device__ __forceinline__ bool next(int i, pg8::Unit& u) const {
        const long L = (long)i * G + c; if (L >= (long)nM * nN) return false;
        pg8::tile_of((int)L, nM, nN, u.pm, u.pn); u.pm += pm0; u.aux = 0; u.a = A + (size_t)u.pm * astep; u.b = B + (size_t)u.pn * bstep; return true; }
};
__device__ __forceinline__ int full_row_tiles(int nM, int nN, int G) { return ((G % nN) == 0 && (nM * nN) % G != 0) ? ((nM * nN) / G) * (G / nN) : nM; }
struct LruOrder : OrderBase {
    const char* A; const char* B; int nM, G, c;
    __device__ __forceinline__ bool next(int i, pg8::Unit& u) const {
        const long L = (long)i * G + c; if (L >= (long)nM * 16) return false;
        pg8::tile_of((int)L, nM, 16, u.pm, u.pn); u.aux = 0; u.a = A + (size_t)u.pm * (256 * 1024 * 2) + (size_t)(u.pn >> 2) * 512; u.b = B + (size_t)u.pn * (256 * 256 * 2); return true; }
};
struct BranchOrder : OrderBase {
    const char* A; const char* B; int nM, G, c;
    __device__ __forceinline__ int full_rows() const { return ((G & 3) == 0 && (nM * 4) % G != 0) ? ((nM * 4) / G) * (G / 4) : nM; }
    __device__ __forceinline__ bool next(int i, pg8::Unit& u) const {
        const int nMa = full_rows(), rounds = (nMa * 4 + G - 1) / G; int br;
        if (i < 3 * rounds) { const int j = i / 3; br = i - 3 * j; const int L = j * G + c; if (L >= nMa * 4) return false; pg8::tile_of(L, nMa, 4, u.pm, u.pn); u.aux = br; }
        else { const int t = (i - 3 * rounds) * G + c; if (t >= (nM - nMa) * 12) return false; const int tb = t / 3; br = t - 3 * tb; u.pm = nMa + (tb >> 2); u.pn = tb & 3; u.aux = br | 4; }
        u.a = A + (size_t)br * ROWB + (size_t)u.pm * (256 * 1024 * 2); u.b = B + (size_t)br * (1024 * 1024 * 2) + (size_t)u.pn * (256 * 1024 * 2); return true; }
};
struct MoeOrder : OrderBase {
    const char* A; const char* B; const unsigned* tile_e; size_t estep; int nM, nN, G, c, ga;
    __device__ __forceinline__ bool next(int i, pg8::Unit& u) const {
        const long L = (long)i * G + c; if (L >= (long)nM * nN) return false;
        pg8::tile_of((int)L, nM, nN, u.pm, u.pn); const int e = (int)tile_e[u.pm]; u.aux = e;
        u.a = ga ? A : A + (size_t)u.pm * (256 * 1024 * 2); u.b = B + (size_t)e * estep + (size_t)u.pn * (256 * 1024 * 2); return true; }
};

struct EpiBf16Bias {
    static constexpr bool PERM = true, AFTER_DRAIN = false; static constexpr int NST = 16;
    bf16_t* O; int ldc; const float* bias; int bstride;
    __device__ __forceinline__ void operator()(const f32x4 (&acc)[2][2][4][2], const pg8::Unit& u, int wr, int wc, int fr, int fq) const {
        const int row0 = u.pm * 256 + wr * 64 + fr, col0 = u.pn * 256 + wc * 32 + 8 * fq;
        f32x4 bv[2][2];
#pragma unroll
        for (int bj = 0; bj < 2; ++bj)
#pragma unroll
            for (int n = 0; n < 2; ++n) bv[bj][n] = bias ? *(const f32x4*)(bias + (size_t)u.aux * bstride + col0 + bj * 128 + 4 * n) : (f32x4){0.f, 0.f, 0.f, 0.f};
#pragma unroll
        for (int ai = 0; ai < 2; ++ai)
#pragma unroll
            for (int m = 0; m < 4; ++m) { bf16_t* rowp = O + (size_t)(row0 + ai * 128 + m * 16) * ldc + col0;
#pragma unroll
                for (int bj = 0; bj < 2; ++bj) { const f32x4 v0 = acc[ai][bj][m][0] + bv[bj][0], v1 = acc[ai][bj][m][1] + bv[bj][1];
                    u32x4 w; w.x = pg8::cvt_pk_bf16(v0[0], v0[1]); w.y = pg8::cvt_pk_bf16(v0[2], v0[3]); w.z = pg8::cvt_pk_bf16(v1[0], v1[1]); w.w = pg8::cvt_pk_bf16(v1[2], v1[3]);
                    *(u32x4*)(rowp + bj * 128) = w; } }
    }
};
struct EpiProj {
    static constexpr bool PERM = true, AFTER_DRAIN = false; static constexpr int NST = 16;
    bf16_t* O; const float* rcos; const float* rsin;
    __device__ __forceinline__ void operator()(const f32x4 (&acc)[2][2][4][2], const pg8::Unit& u, int wr, int wc, int fr, int fq) const {
        const int row0 = u.pm * 256 + wr * 64 + fr, col0 = u.pn * 256 + wc * 32 + 8 * fq;
        if (u.pn >= 20 && u.pn < 24 && u.pm < 128) {
#pragma unroll
            for (int ai = 0; ai < 2; ++ai)
#pragma unroll
                for (int m = 0; m < 4; ++m) { const int row = row0 + ai * 128 + m * 16, t = row & (SEQ - 1); bf16_t* rowp = (bf16_t*)((char*)O + (unsigned)(row * LDP + col0) * 2u);
                    const f32x4 cs = *(const f32x4*)(rcos + t * 64 + 16 * wc + 4 * fq), sn = *(const f32x4*)(rsin + t * 64 + 16 * wc + 4 * fq);
#pragma unroll
                    for (int bj = 0; bj < 2; ++bj) { const f32x4 x1 = acc[ai][bj][m][0], x2 = acc[ai][bj][m][1]; const f32x4 v0 = x1 * cs - x2 * sn, v1 = x1 * sn + x2 * cs;
                        u32x4 w; w.x = pg8::cvt_pk_bf16(v0[0], v0[1]); w.y = pg8::cvt_pk_bf16(v0[2], v0[3]); w.z = pg8::cvt_pk_bf16(v1[0], v1[1]); w.w = pg8::cvt_pk_bf16(v1[2], v1[3]);
                        *(u32x4*)(rowp + bj * 128) = w; }
                    asm volatile("" ::: "memory"); }
        } else {
#pragma unroll
            for (int ai = 0; ai < 2; ++ai)
#pragma unroll
                for (int m = 0; m < 4; ++m) { bf16_t* rowp = (bf16_t*)((char*)O + (unsigned)((row0 + ai * 128 + m * 16) * LDP + col0) * 2u);
#pragma unroll
                    for (int bj = 0; bj < 2; ++bj) { const f32x4 v0 = acc[ai][bj][m][0], v1 = acc[ai][bj][m][1];
                        u32x4 w; w.x = pg8::cvt_pk_bf16(v0[0], v0[1]); w.y = pg8::cvt_pk_bf16(v0[2], v0[3]); w.z = pg8::cvt_pk_bf16(v1[0], v1[1]); w.w = pg8::cvt_pk_bf16(v1[2], v1[3]);
                        *(u32x4*)(rowp + bj * 128) = w; } }
        }
    }
};
struct EpiLru {
    static constexpr bool PERM = true, AFTER_DRAIN = false; static constexpr int NST = 16;
    const bf16_t* xc; bf16_t* LA; bf16_t* BB; const float* ba; const float* bi; const float* lsl;
    __device__ __forceinline__ void operator()(const f32x4 (&acc)[2][2][4][2], const pg8::Unit& u, int wr, int wc, int fr, int fq) const {
        const int g = u.pn >> 2, d = (u.pn >> 1) & 1, hh = u.pn & 1;
        const int row0 = u.pm * 256 + wr * 64 + fr, ch0 = 256 * g + 128 * hh + wc * 32 + 8 * fq;
        constexpr float NL2E = -1.4426950408889634f;
        f32x4 pbn[2], pin[2], c8[2];
#pragma unroll
        for (int n = 0; n < 2; ++n) { pbn[n] = *(const f32x4*)(ba + d * 1024 + ch0 + 4 * n) * NL2E; pin[n] = *(const f32x4*)(bi + d * 1024 + ch0 + 4 * n) * NL2E; c8[n] = *(const f32x4*)(lsl + d * 1024 + ch0 + 4 * n) * 8.0f; }
        u32x4 xwn = *(const u32x4*)(xc + (size_t)row0 * 1024 + ch0);
#pragma unroll
        for (int ai = 0; ai < 2; ++ai)
#pragma unroll
            for (int m = 0; m < 4; ++m) { const size_t off = (size_t)(row0 + ai * 128 + m * 16) * 1024 + ch0;
                const u32x4 xw = xwn; f32x4 la[2], bb[2];
#pragma unroll
                for (int n = 0; n < 2; ++n) {
                    const f32x4 t1 = acc[ai][0][m][n] * NL2E + pbn[n], t2 = acc[ai][1][m][n] * NL2E + pin[n];
                    f32x4 e1, e2;
#pragma unroll
                    for (int e = 0; e < 4; ++e) { e1[e] = __builtin_amdgcn_exp2f(t1[e]); e2[e] = __builtin_amdgcn_exp2f(t2[e]); }
                    e1 = e1 + 1.0f; e2 = e2 + 1.0f;
                    f32x4 r, ig;
#pragma unroll
                    for (int e = 0; e < 4; ++e) { r[e] = __builtin_amdgcn_rcpf(e1[e]); ig[e] = __builtin_amdgcn_rcpf(e2[e]); }
                    const f32x4 l = r * c8[n], t3 = l * (2.0f * 1.4426950408889634f); f32x4 a2;
#pragma unroll
                    for (int e = 0; e < 4; ++e) a2[e] = __builtin_amdgcn_exp2f(t3[e]);
                    a2 = 1.0f - a2; f32x4 sq;
#pragma unroll
                    for (int e = 0; e < 4; ++e) sq[e] = __builtin_amdgcn_sqrtf(fmaxf(a2[e], 0.f));
                    const f32x4 xv = (f32x4){bflo(xw[2 * n]), bfhi(xw[2 * n]), bflo(xw[2 * n + 1]), bfhi(xw[2 * n + 1])};
                    la[n] = l; bb[n] = sq * ig * xv; }
                u32x4 w1, w2; w1.x = pg8::cvt_pk_bf16(la[0][0], la[0][1]); w1.y = pg8::cvt_pk_bf16(la[0][2], la[0][3]); w1.z = pg8::cvt_pk_bf16(la[1][0], la[1][1]); w1.w = pg8::cvt_pk_bf16(la[1][2], la[1][3]);
                w2.x = pg8::cvt_pk_bf16(bb[0][0], bb[0][1]); w2.y = pg8::cvt_pk_bf16(bb[0][2], bb[0][3]); w2.z = pg8::cvt_pk_bf16(bb[1][0], bb[1][1]); w2.w = pg8::cvt_pk_bf16(bb[1][2], bb[1][3]);
                asm volatile("" ::: "memory");
                if (ai * 4 + m < 7) { const int nx = ai * 4 + m + 1; xwn = *(const u32x4*)(xc + (size_t)(row0 + (nx >> 2) * 128 + (nx & 3) * 16) * 1024 + ch0); }
                asm volatile("" ::: "memory");
                *(u32x4*)(LA + (size_t)d * TT * 1024 + off) = w1; *(u32x4*)(BB + (size_t)d * TT * 1024 + off) = w2; asm volatile("" ::: "memory"); }
    }
};
struct EpiBranch {
    static constexpr bool PERM = true, AFTER_DRAIN = false; static constexpr int NST = 16;
    const bf16_t* P; bf16_t* MB;
    __device__ __forceinline__ void operator()(const f32x4 (&acc)[2][2][4][2], const pg8::Unit& u, int wr, int wc, int fr, int fq) const {
        const int br = u.aux & 3, row0 = u.pm * 256 + wr * 64 + fr, col0 = u.pn * 256 + wc * 32 + 8 * fq; const bool alone = (u.aux & 4) != 0;
        bf16_t* dst = MB + (size_t)br * TT * 1024; const bf16_t* M0 = MB; const bf16_t* M1 = MB + (size_t)TT * 1024;
        u32x4 gw[2][4][2];
#pragma unroll
        for (int ai = 0; ai < 2; ++ai)
#pragma unroll
            for (int m = 0; m < 4; ++m)
#pragma unroll
                for (int bj = 0; bj < 2; ++bj) gw[ai][m][bj] = *(const u32x4*)(P + (size_t)(row0 + ai * 128 + m * 16) * LDP + C_MG + br * 1024 + col0 + bj * 128);
#pragma unroll
        for (int ai = 0; ai < 2; ++ai)
#pragma unroll
            for (int m = 0; m < 4; ++m) { const size_t row = (size_t)(row0 + ai * 128 + m * 16);
#pragma unroll
                for (int bj = 0; bj < 2; ++bj) { const int c = col0 + bj * 128; const u32x4 g = gw[ai][m][bj];
                    f32x4 v0, v1;
                    v0[0] = sigmoidf_(bflo(g.x)) * acc[ai][bj][m][0][0]; v0[1] = sigmoidf_(bfhi(g.x)) * acc[ai][bj][m][0][1]; v0[2] = sigmoidf_(bflo(g.y)) * acc[ai][bj][m][0][2]; v0[3] = sigmoidf_(bfhi(g.y)) * acc[ai][bj][m][0][3];
                    v1[0] = sigmoidf_(bflo(g.z)) * acc[ai][bj][m][1][0]; v1[1] = sigmoidf_(bfhi(g.z)) * acc[ai][bj][m][1][1]; v1[2] = sigmoidf_(bflo(g.w)) * acc[ai][bj][m][1][2]; v1[3] = sigmoidf_(bfhi(g.w)) * acc[ai][bj][m][1][3];
                    if (br == 2 && !alone) { const u32x4 p0 = *(const u32x4*)(M0 + row * 1024 + c), p1 = *(const u32x4*)(M1 + row * 1024 + c);
                        v0[0] += bflo(p0.x) + bflo(p1.x); v0[1] += bfhi(p0.x) + bfhi(p1.x); v0[2] += bflo(p0.y) + bflo(p1.y); v0[3] += bfhi(p0.y) + bfhi(p1.y);
                        v1[0] += bflo(p0.z) + bflo(p1.z); v1[1] += bfhi(p0.z) + bfhi(p1.z); v1[2] += bflo(p0.w) + bflo(p1.w); v1[3] += bfhi(p0.w) + bfhi(p1.w); }
                    u32x4 w; w.x = pg8::cvt_pk_bf16(v0[0], v0[1]); w.y = pg8::cvt_pk_bf16(v0[2], v0[3]); w.z = pg8::cvt_pk_bf16(v1[0], v1[1]); w.w = pg8::cvt_pk_bf16(v1[2], v1[3]);
                    *(u32x4*)(dst + row * 1024 + c) = w; } }
    }
};
template <bool BASE_F32> struct EpiOut {
    static constexpr bool PERM = true, AFTER_DRAIN = false; static constexpr int NST = 16;
    const float* baseLat; const float* baseCtx; bf16_t* xs; const float* gate;
    __device__ __forceinline__ void operator()(const f32x4 (&acc)[2][2][4][2], const pg8::Unit& u, int wr, int wc, int fr, int fq) const {
        const int mrow = u.pm < 128 ? (u.pm >> 4) : 8; const float* gp = gate + mrow * 6144;
        const int row0 = u.pm * 256 + wr * 64 + fr, col0 = u.pn * 256 + wc * 32 + 8 * fq;
        const float* base = u.pm < 128 ? baseLat + (size_t)row0 * 1024 : baseCtx + (size_t)(row0 - TLAT) * 1024;
        f32x4 gv[2][2];
#pragma unroll
        for (int bj = 0; bj < 2; ++bj)
#pragma unroll
            for (int n = 0; n < 2; ++n) gv[bj][n] = *(const f32x4*)(gp + col0 + bj * 128 + 4 * n);
#pragma unroll
        for (int ai = 0; ai < 2; ++ai)
#pragma unroll
            for (int m = 0; m < 4; ++m) { const size_t ro = (size_t)(ai * 128 + m * 16) * 1024 + col0; bf16_t* op = xs + (size_t)row0 * 1024 + ro;
#pragma unroll
                for (int bj = 0; bj < 2; ++bj) { f32x4 b0, b1;
                    if (BASE_F32) { b0 = *(const f32x4*)(base + ro + bj * 128); b1 = *(const f32x4*)(base + ro + bj * 128 + 4); }
                    else { const u32x4 w = *(const u32x4*)(op + bj * 128); b0 = (f32x4){bflo(w.x), bfhi(w.x), bflo(w.y), bfhi(w.y)}; b1 = (f32x4){bflo(w.z), bfhi(w.z), bflo(w.w), bfhi(w.w)}; }
                    const f32x4 v0 = b0 + gv[bj][0] * acc[ai][bj][m][0], v1 = b1 + gv[bj][1] * acc[ai][bj][m][1];
                    u32x4 w; w.x = pg8::cvt_pk_bf16(v0[0], v0[1]); w.y = pg8::cvt_pk_bf16(v0[2], v0[3]); w.z = pg8::cvt_pk_bf16(v1[0], v1[1]); w.w = pg8::cvt_pk_bf16(v1[2], v1[3]);
                    *(u32x4*)(op + bj * 128) = w; } }
    }
};
struct EpiSwiglu {
    static constexpr bool PERM = true, AFTER_DRAIN = false; static constexpr int NST = 8;
    bf16_t* H; const float* bgu;
    __device__ __forceinline__ void operator()(const f32x4 (&acc)[2][2][4][2], const pg8::Unit& u, int wr, int wc, int fr, int fq) const {
        const int row0 = u.pm * 256 + wr * 64 + fr, f0 = u.pn * 128 + wc * 32 + 8 * fq;
        f32x4 bg[2], bu[2];
#pragma unroll
        for (int q = 0; q < 4; ++q) { const f32x4 b = *(const f32x4*)(bgu + (size_t)u.aux * 2048 + 2 * f0 + 4 * q); bg[q >> 1][2 * (q & 1)] = b[0]; bu[q >> 1][2 * (q & 1)] = b[1]; bg[q >> 1][2 * (q & 1) + 1] = b[2]; bu[q >> 1][2 * (q & 1) + 1] = b[3]; }
#pragma unroll
        for (int ai = 0; ai < 2; ++ai)
#pragma unroll
            for (int m = 0; m < 4; ++m) { f32x4 a[2];
#pragma unroll
                for (int n = 0; n < 2; ++n) { f32x4 gt = acc[ai][0][m][n] + bg[n], up = acc[ai][1][m][n] + bu[n];
#pragma unroll
                    for (int e = 0; e < 4; ++e) { gt[e] = fminf(gt[e], 7.0f); up[e] = fminf(fmaxf(up[e], -7.0f), 7.0f); }
                    const f32x4 t = gt * (-1.702f * 1.4426950408889634f); f32x4 ex;
#pragma unroll
                    for (int e = 0; e < 4; ++e) ex[e] = __builtin_amdgcn_exp2f(t[e]);
                    ex = ex + 1.0f; f32x4 sg;
#pragma unroll
                    for (int e = 0; e < 4; ++e) sg[e] = __builtin_amdgcn_rcpf(ex[e]);
                    a[n] = gt * sg * (up + 1.0f); }
                u32x4 w; w.x = pg8::cvt_pk_bf16(a[0][0], a[0][1]); w.y = pg8::cvt_pk_bf16(a[0][2], a[0][3]); w.z = pg8::cvt_pk_bf16(a[1][0], a[1][1]); w.w = pg8::cvt_pk_bf16(a[1][2], a[1][3]);
                *(u32x4*)(H + (size_t)(row0 + ai * 128 + m * 16) * 1024 + f0) = w; }
    }
};

constexpr int NWAVES = 8, NTHR = 512;
constexpr int LDS_BYTES = 163840, MISC_OFF = 163840 - 512;
template <int I> __device__ __forceinline__ const float* inptr() { const GAS float* p;
    asm volatile("s_load_dwordx2 %0, %1, %2\n\ts_waitcnt lgkmcnt(0)" : "=s"(p) : "s"(__builtin_amdgcn_kernarg_segment_ptr()), "n"(I * 8)); return (const float*)p; }
struct Frame {
    LAS unsigned char* lds; GAS unsigned char* ws; float* out;
    int tid, bx, lane, wave, G, gw, NGW, gtid, NGT;
};
__device__ __forceinline__ int mrow_of(int row) { return row < TLAT ? (row >> 12) : 8; }
__device__ __forceinline__ int seqrow(int d, int b, int p) {
    if (p < CTXL) return TLAT + b * CTXL + (d ? CTXL - 1 - p : p);
    const int q = p - CTXL; return b * SEQ + (d ? SEQ - 1 - q : q);
}
struct RowV { f32x4 v[4]; };
__device__ __forceinline__ RowV load_row(const float* p, int lane) { RowV r;
#pragma unroll
    for (int j = 0; j < 4; ++j) r.v[j] = *(const f32x4*)(p + 4 * lane + 256 * j);
    return r; }
__device__ __forceinline__ RowV load_row_bf16(const bf16_t* p, int lane) { RowV r;
#pragma unroll
    for (int j = 0; j < 4; ++j) { const u32x2 w = *(const u32x2*)(p + 4 * lane + 256 * j); r.v[j] = (f32x4){bflo(w.x), bfhi(w.x), bflo(w.y), bfhi(w.y)}; }
    return r; }
__device__ __forceinline__ float row_sumsq(const RowV& r) { float s = 0.f;
#pragma unroll
    for (int j = 0; j < 4; ++j) s += (r.v[j][0] * r.v[j][0] + r.v[j][1] * r.v[j][1]) + (r.v[j][2] * r.v[j][2] + r.v[j][3] * r.v[j][3]);
    return wave_sum(s); }
__device__ __forceinline__ RowV norm_mod(const RowV& x, const float* gain, const float* shift, const float* scale, int lane) {
    const float rs = rsqrtf(row_sumsq(x) * (1.0f / D) + EPS); RowV y;
#pragma unroll
    for (int j = 0; j < 4; ++j) { const int c = 4 * lane + 256 * j; const f32x4 g = *(const f32x4*)(gain + c), sh = *(const f32x4*)(shift + c), sc = *(const f32x4*)(scale + c);
        y.v[j] = (x.v[j] * rs) * g * (sc + 1.0f) + sh; }
    return y; }
__device__ __forceinline__ void store_row_bf16(bf16_t* p, const RowV& y, int lane) {
#pragma unroll
    for (int j = 0; j < 4; ++j) { u32x2 w; w.x = pk2(y.v[j][0], y.v[j][1]); w.y = pk2(y.v[j][2], y.v[j][3]); *(u32x2*)(p + 4 * lane + 256 * j) = w; } }
__device__ __forceinline__ f32x4 ld4bf(const bf16_t* p) { const u32x2 w = *(const u32x2*)p; return (f32x4){bflo(w.x), bfhi(w.x), bflo(w.y), bfhi(w.y)}; }

__device__ __forceinline__ void phase_proA(const Frame& F) {
    const float* c = inptr<1>(); const float* cc = inptr<3>(); const float* w_ada = inptr<4>();
    float* modp = (float*)(F.ws + WS_MODP);
    for (int it = F.gw; it < 2 * 8 * 96; it += F.NGW) {
        const int cg = it % 96, ks = (it / 96) % 8, l = it / 768, col = cg * 64 + F.lane;
        float acc[9];
#pragma unroll
        for (int r = 0; r < 9; ++r) acc[r] = 0.f;
        for (int k = ks * 128; k < ks * 128 + 128; ++k) {
            const float w = w_ada[((size_t)l * 1024 + k) * 6144 + col];
#pragma unroll
            for (int r = 0; r < 8; ++r) acc[r] += siluf_(c[r * 1024 + k]) * w;
            acc[8] += siluf_(cc[k]) * w;
        }
#pragma unroll
        for (int r = 0; r < 9; ++r) modp[((size_t)(ks * 2 + l) * 9 + r) * 6144 + col] = acc[r];
    }
    float* rc = (float*)(F.ws + WS_COS); float* rsn = (float*)(F.ws + WS_SIN);
    for (int i = F.gtid; i < SEQ * 64; i += F.NGT) {
        const int t = i >> 6, j = i & 63, f = j & 31; const float pos = (float)((j < 32) ? (t >> 6) : (t & 63));
        const float inv = exp2f(-(float)f * (13.287712379549449f / 32.0f)); const float ang = pos * inv;
        const float nn = rintf(ang * 0.15915494309189535f); float r = fmaf(-nn, 6.28125f, ang); r = fmaf(-nn, 1.9353071795864769e-3f, r);
        rc[i] = __cosf(r); rsn[i] = __sinf(r);
    }
}
__device__ __forceinline__ void phase_proB(const Frame& F) {
    const float* modp = (const float*)(F.ws + WS_MODP); float* mods = (float*)(F.ws + WS_MODS); const float* b_ada = inptr<5>();
    for (int i = F.gtid; i < 2 * 9 * 6144; i += F.NGT) { const int l = i / (9 * 6144), col = i % 6144; float s = b_ada[l * 6144 + col];
#pragma unroll
        for (int ks = 0; ks < 8; ++ks) s += modp[(size_t)ks * (2 * 9 * 6144) + i];
        mods[i] = s; }
}

template <class RM> __device__ __forceinline__ void tr_item(const float* W, int ldw, int k0, int n0, bf16_t* WT, int ldt, LAS float* scr, int lane, const RM& rm) {
#pragma unroll 8
    for (int i = 0; i < 32; ++i) { const int kk = 2 * i + (lane >> 5); scr[kk * 33 + (lane & 31)] = W[(size_t)(k0 + kk) * ldw + n0 + (lane & 31)]; }
    LDS_WAIT(); asm volatile("" ::: "memory");
    const int c = lane & 7;
#pragma unroll
    for (int j = 0; j < 4; ++j) { const int n = (lane >> 3) + 8 * j; const LAS float* s = scr + (8 * c) * 33 + n; int drow; float sc; rm(n0 + n, drow, sc);
        u32x4 o; o.x = pk2(s[0 * 33] * sc, s[1 * 33] * sc); o.y = pk2(s[2 * 33] * sc, s[3 * 33] * sc); o.z = pk2(s[4 * 33] * sc, s[5 * 33] * sc); o.w = pk2(s[6 * 33] * sc, s[7 * 33] * sc);
        *(u32x4*)(WT + (size_t)drow * ldt + k0 + 8 * c) = o; }
    LDS_WAIT(); asm volatile("" ::: "memory");
}
struct RmIn { __device__ __forceinline__ void operator()(int n, int& drow, float& sc) const {
    drow = n < 3072 ? n : (n < 3104 ? C_LR + (n - 3072) : n - 32); sc = (n < 512 || (n >= 5664 && n < 6176)) ? 0.08838834764831845f : 1.0f;
    if (n >= 5152 && n < 6176) { const int o = (n - 5152) & 127, i = o & 63, x2 = o >> 6; drow = (n - 32) - o + 32 * (i >> 4) + 8 * ((i >> 2) & 3) + 4 * x2 + (i & 3); } } };
struct RmId { __device__ __forceinline__ void operator()(int n, int& drow, float& sc) const { drow = n; sc = 1.0f; } };
struct RmLru { int base; __device__ __forceinline__ void operator()(int n, int& drow, float& sc) const { drow = base + (n & 127); sc = 1.0f; } };
struct RmGu { __device__ __forceinline__ void operator()(int n, int& drow, float& sc) const { const int f = n >> 1, u = n & 1; drow = 256 * (f >> 7) + 128 * u + (f & 127); sc = 1.0f; } };
__device__ __forceinline__ void phase_W(const Frame& F, int li) {
    LAS float* scr = (LAS float*)(F.lds + F.wave * 8704);
    bf16_t* Win_t = (bf16_t*)(F.ws + WS_WIN); bf16_t* Wlru_t = (bf16_t*)(F.ws + WS_WLRU); bf16_t* Wbr_t = (bf16_t*)(F.ws + WS_WBR);
    bf16_t* Wout_t = (bf16_t*)(F.ws + WS_WOUT); bf16_t* Wgu_t = (bf16_t*)(F.ws + WS_WGU); bf16_t* Wdn_t = (bf16_t*)(F.ws + WS_WDN);
    constexpr int I_IN = 16 * 353, I_LRU = 512, I_BR = 1536, I_OUT = 512, I_GU = 32768, I_DN = 16384, NITEMS = I_IN + I_LRU + I_BR + I_OUT + I_GU + I_DN;
    for (int it0 = F.gw; it0 < NITEMS; it0 += F.NGW) {
        int it = it0;
        if (it < I_IN) { const int kb = it / 353, nb = it % 353; tr_item(inptr<8>() + (size_t)li * 1024 * IN_TOTAL, IN_TOTAL, 64 * kb, 32 * nb, Win_t, 1024, scr, F.lane, RmIn{}); continue; } it -= I_IN;
        if (it < I_LRU) { const int mat = it >> 5, r = it & 31, kb = r >> 3, nb = r & 7, ty = mat >> 3, d = (mat >> 2) & 1, g = mat & 3, n0 = 32 * nb, pn = g * 4 + d * 2 + (n0 >> 7);
            const float* src = (ty ? inptr<16>() : inptr<14>()) + (size_t)((li * 2 + d) * 4 + g) * 65536;
            tr_item(src, 256, 64 * kb, n0, Wlru_t, 256, scr, F.lane, RmLru{pn * 256 + ty * 128}); continue; } it -= I_LRU;
        if (it < I_BR) { const int br = it >> 9, r = it & 511, kb = r >> 5, nb = r & 31; tr_item(inptr<20>() + (size_t)(li * 3 + br) * 1048576, 1024, 64 * kb, 32 * nb, Wbr_t + (size_t)br * 1048576, 1024, scr, F.lane, RmId{}); continue; } it -= I_BR;
        if (it < I_OUT) { const int kb = it >> 5, nb = it & 31; tr_item(inptr<21>() + (size_t)li * 1048576, 1024, 64 * kb, 32 * nb, Wout_t, 1024, scr, F.lane, RmId{}); continue; } it -= I_OUT;
        if (it < I_GU) { const int e = it >> 10, r = it & 1023, kb = r >> 6, nb = r & 63; tr_item(inptr<24>() + (size_t)(li * 32 + e) * 2097152, 2048, 64 * kb, 32 * nb, Wgu_t + (size_t)e * 2097152, 1024, scr, F.lane, RmGu{}); continue; } it -= I_GU;
        { const int e = it >> 9, r = it & 511, kb = r >> 5, nb = r & 31; tr_item(inptr<26>() + (size_t)(li * 32 + e) * 1048576, 1024, 64 * kb, 32 * nb, Wdn_t + (size_t)e * 1048576, 1024, scr, F.lane, RmId{}); }
    }
    for (int i = F.gtid; i < (LDP - IN_TOTAL) * 1024 / 8; i += F.NGT) *(u32x4*)(Win_t + (size_t)IN_TOTAL * 1024 + (size_t)i * 8) = (u32x4){0u, 0u, 0u, 0u};
    float* lsl = (float*)(F.ws + WS_LSL);
    for (int i = F.gtid; i < 2048; i += F.NGT) lsl[i] = logsigmoidf_(inptr<18>()[li * 2048 + i]);
}
__device__ __forceinline__ void phase_norm_in(const Frame& F) {
    const float* mods = (const float*)(F.ws + WS_MODS); bf16_t* xn = (bf16_t*)(F.ws + WS_D);
    for (int row = F.gw; row < TT; row += F.NGW) {
        const float* src = row < TLAT ? inptr<0>() + (size_t)row * D : inptr<2>() + (size_t)(row - TLAT) * D;
        const float* mp = mods + mrow_of(row) * 6144;
        const RowV y = norm_mod(load_row(src, F.lane), inptr<6>(), mp, mp + 1024, F.lane);
        store_row_bf16(xn + (size_t)row * D, y, F.lane);
    }
}


__device__ __forceinline__ void phase_conv(const Frame& F, int li) {
    const bf16_t* P = (const bf16_t*)(F.ws + WS_P); bf16_t* xc = (bf16_t*)(F.ws + WS_D);
    const float* cw = inptr<12>() + (size_t)li * 4 * 1024; const float* cb = inptr<13>() + (size_t)li * 1024;
    const int ch = (F.gtid & 127) * 8; float wt[4][8], bs[8];
#pragma unroll
    for (int j = 0; j < 4; ++j) { const f32x4 w0 = *(const f32x4*)(cw + j * 1024 + ch), w1 = *(const f32x4*)(cw + j * 1024 + ch + 4);
#pragma unroll
        for (int e = 0; e < 4; ++e) { wt[j][e] = w0[e]; wt[j][4 + e] = w1[e]; } }
    { const f32x4 b0 = *(const f32x4*)(cb + ch), b1 = *(const f32x4*)(cb + ch + 4);
#pragma unroll
      for (int e = 0; e < 4; ++e) { bs[e] = b0[e]; bs[4 + e] = b1[e]; } }
    u32x4 xw[4];
#define CV_LOAD(row_) do { const int r_ = (row_); int t_, L_; if (r_ < TLAT) { t_ = r_ & (SEQ - 1); L_ = SEQ; } else { t_ = (r_ - TLAT) & (CTXL - 1); L_ = CTXL; } \
        _Pragma("unroll") for (int j = 0; j < 4; ++j) { const int tt_ = t_ - 2 + j; const bool in_ = (tt_ >= 0 && tt_ < L_); xw[j] = *(const u32x4*)(P + (size_t)(in_ ? r_ - 2 + j : r_) * LDP + C_LX + ch); } } while (0)
    const int NR = F.NGT >> 7;
    int row = F.gtid >> 7;
    if (row < TT) CV_LOAD(row);
    for (; row < TT; row += NR) {
        int t, L; if (row < TLAT) { t = row & (SEQ - 1); L = SEQ; } else { t = (row - TLAT) & (CTXL - 1); L = CTXL; }
        float a[8];
#pragma unroll
        for (int e = 0; e < 8; ++e) a[e] = bs[e];
#pragma unroll
        for (int j = 0; j < 4; ++j) { const int tt = t - 2 + j; const float z = (tt >= 0 && tt < L) ? 1.0f : 0.0f;
            a[0] += z * wt[j][0] * bflo(xw[j].x); a[1] += z * wt[j][1] * bfhi(xw[j].x); a[2] += z * wt[j][2] * bflo(xw[j].y); a[3] += z * wt[j][3] * bfhi(xw[j].y);
            a[4] += z * wt[j][4] * bflo(xw[j].z); a[5] += z * wt[j][5] * bfhi(xw[j].z); a[6] += z * wt[j][6] * bflo(xw[j].w); a[7] += z * wt[j][7] * bfhi(xw[j].w); }
        u32x4 o; o.x = pk2(a[0], a[1]); o.y = pk2(a[2], a[3]); o.z = pk2(a[4], a[5]); o.w = pk2(a[6], a[7]);
        asm volatile("" ::: "memory");
        if (row + NR < TT) CV_LOAD(row + NR);
        asm volatile("" ::: "memory");
        *(u32x4*)(xc + (size_t)row * 1024 + ch) = o;
    }
#undef CV_LOAD
}

constexpr int LSEG = 136, LNSEG = (CTXL + SEQ) / LSEG;
template <bool FINAL> __device__ __forceinline__ void phase_lru_scan(const Frame& F) {
    const bf16_t* LA = (const bf16_t*)(F.ws + WS_C); const bf16_t* BB = (const bf16_t*)(F.ws + WS_C + 2 * ROWB);
    float* carA = (float*)(F.ws + WS_CARA); float* carH = (float*)(F.ws + WS_CARH); bf16_t* HO = (bf16_t*)(F.ws + WS_E);
    for (int i = F.gtid; i < 2 * 8 * LNSEG * 256; i += F.NGT) {
        const int cq = i & 255, s = (i >> 8) % LNSEG, db = (i >> 8) / LNSEG, b = db & 7, d = db >> 3;
        f32x4 h = (f32x4){0.f, 0.f, 0.f, 0.f}, As = (f32x4){0.f, 0.f, 0.f, 0.f};
        if (FINAL) {
            for (int s0 = 0; s0 < s; s0 += 8) { f32x4 ca[8], ch[8];
#pragma unroll
                for (int k = 0; k < 8; ++k) { const int s2 = (s0 + k < s) ? s0 + k : s - 1; const size_t o = ((size_t)(db * LNSEG + s2) * 256 + cq) * 4; ca[k] = *(const f32x4*)(carA + o); ch[k] = *(const f32x4*)(carH + o); }
#pragma unroll
                for (int k = 0; k < 8; ++k) if (s0 + k < s) h = ca[k] * h + ch[k]; } }
        const size_t dofs = (size_t)d * TT * 1024;
        u32x2 la8[8], bb8[8];
#define LS_LOAD(blk) do { _Pragma("unroll") for (int q = 0; q < 8; ++q) { const size_t off_ = dofs + (size_t)seqrow(d, b, s * LSEG + (blk) * 8 + q) * 1024 + cq * 4; la8[q] = *(const u32x2*)(LA + off_); bb8[q] = *(const u32x2*)(BB + off_); } } while (0)
        LS_LOAD(0);
        for (int blk = 0; blk < LSEG / 8; ++blk) { u32x2 w8[8];
#pragma unroll
            for (int q = 0; q < 8; ++q) { const f32x4 la = (f32x4){bflo(la8[q].x), bfhi(la8[q].x), bflo(la8[q].y), bfhi(la8[q].y)}, bb = (f32x4){bflo(bb8[q].x), bfhi(bb8[q].x), bflo(bb8[q].y), bfhi(bb8[q].y)};
                f32x4 a; a[0] = __expf(la[0]); a[1] = __expf(la[1]); a[2] = __expf(la[2]); a[3] = __expf(la[3]);
                h = a * h + bb;
                if (FINAL) { w8[q].x = pk2(h[0], h[1]); w8[q].y = pk2(h[2], h[3]); } else As += la; }
            const int blk0 = blk;
            if (blk + 1 < LSEG / 8) { asm volatile("" ::: "memory"); LS_LOAD(blk + 1); asm volatile("" ::: "memory"); }
            if (FINAL) {
#pragma unroll
                for (int q = 0; q < 8; ++q) *(u32x2*)(HO + dofs + (size_t)seqrow(d, b, s * LSEG + blk0 * 8 + q) * 1024 + cq * 4) = w8[q]; } }
#undef LS_LOAD
        if (!FINAL) { const size_t o = (size_t)i * 4; f32x4 A; A[0] = __expf(As[0]); A[1] = __expf(As[1]); A[2] = __expf(As[2]); A[3] = __expf(As[3]);
            *(f32x4*)(carA + o) = A; *(f32x4*)(carH + o) = h; }
    }
}


constexpr size_t QKB = (size_t)TT * 512 * 2;
__device__ __forceinline__ void phase_scanprep(const Frame& F, int li) {
    LAS float* lrs = (LAS float*)F.lds;
    LAS float* qtot = lrs + 64 * 32;
    LAS float* gcs = qtot + 4 * 512;
    bf16_t* Pm = (bf16_t*)(F.ws + WS_P); bf16_t* QK = (bf16_t*)(F.ws + WS_C); float* EGL = (float*)(F.ws + WS_MODP);
    const int qtr = F.tid >> 7, c4 = F.tid & 127, ch0 = 4 * c4;
    for (int rc = F.bx; rc < TT / 64; rc += F.G) {
        if (F.tid < 256) { const int tok = F.tid >> 2, q8 = F.tid & 3; const u32x4 v = *(const u32x4*)(Pm + (size_t)(64 * rc + tok) * LDP + C_LR + 8 * q8);
            LAS float* dst = lrs + tok * 32 + 8 * q8; *(LAS f32x4*)dst = (f32x4){bflo(v.x), bfhi(v.x), bflo(v.y), bfhi(v.y)}; *(LAS f32x4*)(dst + 4) = (f32x4){bflo(v.z), bfhi(v.z), bflo(v.w), bfhi(v.w)}; }
        __syncthreads();
        for (int d = 0; d < 2; ++d) {
            f32x4 wv[16];
#pragma unroll
            for (int r = 0; r < 16; ++r) wv[r] = *(const f32x4*)(inptr<9>() + (size_t)((li * 2 + d) * 16 + r) * 512 + ch0);
            const f32x4 bav = *(const f32x4*)(inptr<10>() + (size_t)(li * 2 + d) * 512 + ch0);
            f32x4 run = (f32x4){0.f, 0.f, 0.f, 0.f};
#pragma unroll 2
            for (int i = 0; i < 16; ++i) { const int p = 16 * qtr + i, tok = d ? 63 - p : p; f32x4 z = bav;
#pragma unroll
                for (int r4 = 0; r4 < 4; ++r4) { const f32x4 l = *(const LAS f32x4*)(lrs + tok * 32 + 16 * d + 4 * r4);
#pragma unroll
                    for (int e = 0; e < 4; ++e) z += wv[4 * r4 + e] * l[e]; }
#pragma unroll
                for (int e = 0; e < 4; ++e) run[e] += logsigmoidf_(z[e]) * 0.0625f;
                *(LAS f32x4*)(gcs + p * 512 + ch0) = run; }
            *(LAS f32x4*)(qtot + qtr * 512 + ch0) = run;
            __syncthreads();
            f32x4 off = (f32x4){0.f, 0.f, 0.f, 0.f}, tot = (f32x4){0.f, 0.f, 0.f, 0.f};
#pragma unroll
            for (int q2 = 0; q2 < 4; ++q2) { const f32x4 t = *(const LAS f32x4*)(qtot + q2 * 512 + ch0); tot += t; if (q2 < qtr) off += t; }
            if (qtr == 0) { f32x4 e4; e4[0] = __expf(tot[0]); e4[1] = __expf(tot[1]); e4[2] = __expf(tot[2]); e4[3] = __expf(tot[3]); *(f32x4*)(EGL + ((size_t)d * (TT / 64) + rc) * 512 + ch0) = e4; }
            bf16_t* EGd = QK + (size_t)d * TT * 512;
#pragma unroll 4
            for (int i = 0; i < 16; ++i) { const int p = 16 * qtr + i, tok = d ? 63 - p : p; const size_t row = (size_t)(64 * rc + tok);
                const f32x4 G = *(const LAS f32x4*)(gcs + p * 512 + ch0) + off;
                u32x2 we; { const f32x4 g2 = G * 1.4426950408889634f; we.x = pk2(__builtin_amdgcn_exp2f(g2[0]), __builtin_amdgcn_exp2f(g2[1])); we.y = pk2(__builtin_amdgcn_exp2f(g2[2]), __builtin_amdgcn_exp2f(g2[3])); }
                *(u32x2*)(EGd + row * 512 + ch0) = we; }
            __syncthreads();
        }
    }
}
typedef short s16x4 __attribute__((ext_vector_type(4)));
constexpr int SC_PITCH = 272, SC_TILE = 64 * SC_PITCH, SC_QS = 0, SC_KS = 2 * SC_TILE, SC_VS = 4 * SC_TILE, SC_AS = 6 * SC_TILE, SC_APITCH = 144, SC_EG = SC_AS + 9216, SC_OS = SC_EG + 1024;
__device__ __forceinline__ bf16x8 tr_frag(LAS unsigned char* base, int pitch, int k0, int c0, int lane) {
    const int q = (lane & 15) >> 2, p = lane & 3;
    LAS unsigned char* a = base + (k0 + q) * pitch + (c0 + 4 * p) * 2;
    const s16x4 lo = __builtin_amdgcn_ds_read_tr16_b64_v4i16((LAS s16x4*)a);
    const s16x4 hi = __builtin_amdgcn_ds_read_tr16_b64_v4i16((LAS s16x4*)(a + 4 * pitch));
    return (bf16x8){lo[0], lo[1], lo[2], lo[3], hi[0], hi[1], hi[2], hi[3]};
}
#define MFMA16(a, b, c) __builtin_amdgcn_mfma_f32_16x16x32_bf16((a), (b), (c), 0, 0, 0)
__device__ __forceinline__ int chunk_rc(int d, int b, int chn) { return chn < 4 ? (TLAT / 64) + 4 * b + (d ? 3 - chn : chn) : 64 * b + (d ? 63 - (chn - 4) : (chn - 4)); }
struct ScanSet { u32x4 q[4], k[4], v[4], e[4]; f32x4 gl; };
#define GST16(ptr, val) asm volatile("global_store_dwordx4 %0, %1, off\n\ts_nop 1" :: "v"(ptr), "v"(val) : "memory")
template <int MX> __device__ __forceinline__ void scan_unit(const Frame& F, int u) {
    LAS unsigned char* L = F.lds;
    const int lane = F.lane, w = F.wave, fr = lane & 15, fq = lane >> 4;
    const int js = u & 1, h = (u >> 1) & 3, b = (u >> 3) & 7, d = (u >> 6) & 1;
    constexpr int NCH = (CTXL + SEQ) / 64;
    float lg = 0.f, egr = 1.f;
    if (MX == 1) { const float x = exp2f(-5.0f - (float)h); lg = -(x + x * x * 0.5f + x * x * x * (1.0f / 3.0f) + x * x * x * x * 0.25f); egr = __expf(64.0f * lg); }
    if (w >= 4) {
        const int ptid = F.tid - 256, tt = ptid >> 4, part = ptid & 15;
        const bf16_t* Pq = (const bf16_t*)(F.ws + WS_P) + (MX ? C_RQ : C_GQ) + 128 * h + 8 * part; const bf16_t* Pk = Pq + 512;
        const bf16_t* Pv = (const bf16_t*)(F.ws + WS_P) + (MX ? C_RV : C_GV) + 256 * h + 128 * js + 8 * part;
        const bf16_t* EGp = (const bf16_t*)(F.ws + WS_C) + (size_t)d * TT * 512 + 128 * h + 8 * part;
        const float* EGLp = (const float*)(F.ws + WS_MODP) + (size_t)d * (TT / 64) * 512 + 128 * h + 4 * (ptid & 31);
        bf16_t* O = (bf16_t*)(F.ws + WS_B) + (size_t)(MX * 2 + d) * TT * 1024 + 256 * h + 128 * js + 8 * part;
        float er[4] = {1.f, 1.f, 1.f, 1.f}, nr[4] = {1.f, 1.f, 1.f, 1.f};
        if (MX == 1) {
#pragma unroll
            for (int ps = 0; ps < 4; ++ps) { er[ps] = __expf((float)(tt + 16 * ps + 1) * lg); nr[ps] = __expf(-(float)(tt + 16 * ps + 1) * lg); } }
        ScanSet sA, sB;
#define SC_LOAD(chn, st) do { const int rc_ = chunk_rc(d, b, (chn)); _Pragma("unroll") for (int ps = 0; ps < 4; ++ps) { const int c_ = tt + 16 * ps; const size_t row_ = (size_t)(64 * rc_ + (d ? 63 - c_ : c_)); \
        st.q[ps] = *(const u32x4*)(Pq + row_ * LDP); st.k[ps] = *(const u32x4*)(Pk + row_ * LDP); st.v[ps] = *(const u32x4*)(Pv + row_ * LDP); if (MX == 0) st.e[ps] = *(const u32x4*)(EGp + row_ * 512); } \
        if (MX == 0) st.gl = *(const f32x4*)(EGLp + (size_t)rc_ * 512); } while (0)
#define SC_PUT(st, nb) do { _Pragma("unroll") for (int ps = 0; ps < 4; ++ps) { const int c_ = tt + 16 * ps; u32x4 qo, ko; \
        _Pragma("unroll") for (int e2 = 0; e2 < 4; ++e2) { float ea, eb, na, nb_; \
            if (MX == 0) { ea = bflo(st.e[ps][e2]); eb = bfhi(st.e[ps][e2]); na = __builtin_amdgcn_rcpf(ea); nb_ = __builtin_amdgcn_rcpf(eb); } else { ea = eb = er[ps]; na = nb_ = nr[ps]; } \
            qo[e2] = pk2(bflo(st.q[ps][e2]) * ea, bfhi(st.q[ps][e2]) * eb); ko[e2] = pk2(bflo(st.k[ps][e2]) * na, bfhi(st.k[ps][e2]) * nb_); } \
        *(LAS u32x4*)(L + SC_QS + (nb) * SC_TILE + c_ * SC_PITCH + part * 16) = qo; *(LAS u32x4*)(L + SC_KS + (nb) * SC_TILE + c_ * SC_PITCH + part * 16) = ko; \
        *(LAS u32x4*)(L + SC_VS + (nb) * SC_TILE + c_ * SC_PITCH + part * 16) = st.v[ps]; } \
        if (MX == 0) *(LAS f32x4*)(L + SC_EG + (nb) * 512 + 16 * (ptid & 31)) = st.gl; } while (0)
#define SC_OUT(chn) do { const int rc_ = chunk_rc(d, b, (chn)); _Pragma("unroll") for (int ps = 0; ps < 4; ++ps) { const int c_ = tt + 16 * ps; const u32x4 v_ = *(const LAS u32x4*)(L + SC_OS + c_ * SC_PITCH + part * 16); \
        GST16(O + (size_t)(64 * rc_ + (d ? 63 - c_ : c_)) * 1024, v_); } } while (0)
#define SC_PCHUNK(ch, ST, nb) do { \
        if ((ch) > 0) SC_OUT((ch) - 1); \
        if ((ch) + 1 < NCH) SC_PUT(ST, nb); \
        __syncthreads(); \
        SC_LOAD(((ch) + 3 < NCH ? (ch) + 3 : NCH - 1), ST); \
        __syncthreads(); \
    } while (0)
        SC_LOAD(0, sA); SC_LOAD(1, sB); SC_PUT(sA, 0); SC_LOAD(2, sA);
        __syncthreads();
        for (int ch2 = 0; ch2 < NCH; ch2 += 2) { SC_PCHUNK(ch2, sB, 1); SC_PCHUNK(ch2 + 1, sA, 0); }
        SC_OUT(NCH - 1);
#undef SC_PCHUNK
#undef SC_OUT
#undef SC_PUT
#undef SC_LOAD
    } else {
        const int cw = w;
        f32x4 S[8][2];
#pragma unroll
        for (int i = 0; i < 8; ++i)
#pragma unroll
            for (int j = 0; j < 2; ++j) S[i][j] = (f32x4){0.f, 0.f, 0.f, 0.f};
        __syncthreads();
#define SC_SB() __builtin_amdgcn_sched_barrier(0)
#define SC_CCHUNK(cur) do { \
        LAS unsigned char* Qc = L + SC_QS + (cur) * SC_TILE; LAS unsigned char* Kc = L + SC_KS + (cur) * SC_TILE; LAS unsigned char* Vc = L + SC_VS + (cur) * SC_TILE; \
        {   bf16x8 xq[4], yk[4][4]; \
            _Pragma("unroll") for (int ks = 0; ks < 4; ++ks) { xq[ks] = *(const LAS bf16x8*)(Qc + (16 * cw + fr) * SC_PITCH + (32 * ks + 8 * fq) * 2); \
                _Pragma("unroll") for (int j = 0; j < 4; ++j) yk[ks][j] = *(const LAS bf16x8*)(Kc + (16 * j + fr) * SC_PITCH + (32 * ks + 8 * fq) * 2); } \
            SC_SB(); \
            f32x4 a[4]; \
            _Pragma("unroll") for (int j = 0; j < 4; ++j) a[j] = (f32x4){0.f, 0.f, 0.f, 0.f}; \
            _Pragma("unroll") for (int ks = 0; ks < 4; ++ks) \
                _Pragma("unroll") for (int j = 0; j < 4; ++j) a[j] = MFMA16(yk[ks][j], xq[ks], a[j]); \
            const int c = 16 * cw + fr; \
            _Pragma("unroll") for (int j = 0; j < 4; ++j) { const int s0 = 16 * j + 4 * fq; float m[4]; \
                _Pragma("unroll") for (int e = 0; e < 4; ++e) { const int s = s0 + e; const bool keep = d ? (s < c) : (s <= c); m[e] = keep ? a[j][e] : 0.f; } \
                u32x2 wv; wv.x = pk2(m[0], m[1]); wv.y = pk2(m[2], m[3]); *(LAS u32x2*)(L + SC_AS + c * SC_APITCH + s0 * 2) = wv; } } \
        SC_SB(); \
        f32x4 o[4][2]; \
        _Pragma("unroll") for (int i = 0; i < 4; ++i) \
            _Pragma("unroll") for (int j = 0; j < 2; ++j) o[i][j] = (f32x4){0.f, 0.f, 0.f, 0.f}; \
        {   u32x2 ql[4][4], qh[4][4]; \
            _Pragma("unroll") for (int kk = 0; kk < 4; ++kk) \
                _Pragma("unroll") for (int i = 0; i < 4; ++i) { LAS unsigned char* qa = Qc + (16 * i + fr) * SC_PITCH + (32 * kk + 4 * fq) * 2; ql[kk][i] = *(const LAS u32x2*)qa; qh[kk][i] = *(const LAS u32x2*)(qa + 32); } \
            SC_SB(); \
            _Pragma("unroll") for (int kk = 0; kk < 4; ++kk) { bf16x8 sop[2]; \
                _Pragma("unroll") for (int j = 0; j < 2; ++j) { u32x4 p_; p_.x = pk2(S[2 * kk][j][0], S[2 * kk][j][1]); p_.y = pk2(S[2 * kk][j][2], S[2 * kk][j][3]); \
                    p_.z = pk2(S[2 * kk + 1][j][0], S[2 * kk + 1][j][1]); p_.w = pk2(S[2 * kk + 1][j][2], S[2 * kk + 1][j][3]); sop[j] = __builtin_bit_cast(bf16x8, p_); } \
                _Pragma("unroll") for (int i = 0; i < 4; ++i) { u32x4 x_; x_.x = ql[kk][i].x; x_.y = ql[kk][i].y; x_.z = qh[kk][i].x; x_.w = qh[kk][i].y; const bf16x8 xq = __builtin_bit_cast(bf16x8, x_); \
                    _Pragma("unroll") for (int j = 0; j < 2; ++j) o[i][j] = MFMA16(sop[j], xq, o[i][j]); } } } \
        SC_SB(); \
        bf16x8 yv[2][2]; \
        {   bf16x8 xk[2][8]; \
            _Pragma("unroll") for (int ks = 0; ks < 2; ++ks) \
                _Pragma("unroll") for (int j = 0; j < 2; ++j) yv[ks][j] = tr_frag(Vc, SC_PITCH, 32 * ks + 8 * fq, 32 * cw + 16 * j, lane); \
            _Pragma("unroll") for (int ks = 0; ks < 2; ++ks) \
                _Pragma("unroll") for (int i = 0; i < 8; ++i) xk[ks][i] = tr_frag(Kc, SC_PITCH, 32 * ks + 8 * fq, 16 * i, lane); \
            SC_SB(); \
            _Pragma("unroll") for (int ks = 0; ks < 2; ++ks) \
                _Pragma("unroll") for (int i = 0; i < 8; ++i) \
                    _Pragma("unroll") for (int j = 0; j < 2; ++j) S[i][j] = MFMA16(xk[ks][i], yv[ks][j], S[i][j]); } \
        __syncthreads(); \
        {   bf16x8 xa[2][4]; f32x4 e4[8]; \
            _Pragma("unroll") for (int ks = 0; ks < 2; ++ks) \
                _Pragma("unroll") for (int i = 0; i < 4; ++i) xa[ks][i] = *(const LAS bf16x8*)(L + SC_AS + (16 * i + fr) * SC_APITCH + (32 * ks + 8 * fq) * 2); \
            _Pragma("unroll") for (int i = 0; i < 8; ++i) { e4[i] = (f32x4){egr, egr, egr, egr}; if (MX == 0) e4[i] = *(const LAS f32x4*)(L + SC_EG + (cur) * 512 + (16 * i + 4 * fq) * 4); } \
            SC_SB(); \
            _Pragma("unroll") for (int ks = 0; ks < 2; ++ks) \
                _Pragma("unroll") for (int i = 0; i < 4; ++i) \
                    _Pragma("unroll") for (int j = 0; j < 2; ++j) o[i][j] = MFMA16(yv[ks][j], xa[ks][i], o[i][j]); \
            _Pragma("unroll") for (int i = 0; i < 8; ++i) \
                _Pragma("unroll") for (int j = 0; j < 2; ++j) S[i][j] = S[i][j] * e4[i]; } \
        _Pragma("unroll") for (int i = 0; i < 4; ++i) \
            _Pragma("unroll") for (int j = 0; j < 2; ++j) { u32x2 wv; wv.x = pk2(o[i][j][0], o[i][j][1]); wv.y = pk2(o[i][j][2], o[i][j][3]); \
                *(LAS u32x2*)(L + SC_OS + (16 * i + fr) * SC_PITCH + (32 * cw + 16 * j + 4 * fq) * 2) = wv; } \
        __syncthreads(); \
    } while (0)
        for (int ch2 = 0; ch2 < NCH; ch2 += 2) { SC_CCHUNK(0); SC_CCHUNK(1); }
#undef SC_CCHUNK
#undef SC_SB
    }
    __syncthreads();
}
__device__ __forceinline__ void phase_scan_mfma(const Frame& F, int li) {
    for (int u = F.bx; u < 256; u += F.G) { if (u < 128) scan_unit<0>(F, u); else scan_unit<1>(F, u - 128); }
}


__device__ __forceinline__ void phase_finish(const Frame& F, int li, int nrows) {
    const bf16_t* P = (const bf16_t*)(F.ws + WS_P); const bf16_t* OB = (const bf16_t*)(F.ws + WS_B); const bf16_t* HB = (const bf16_t*)(F.ws + WS_E); bf16_t* A3 = (bf16_t*)(F.ws + WS_C);
    const float* gnorm = inptr<11>() + (size_t)li * 1024; const float* rnorm = inptr<19>() + (size_t)li * 1024;
    const size_t RS = (size_t)TT * 1024;
    struct RowIn { u32x2 v[4][9]; };
#define FIN_LOAD(dst, row_) do { const bf16_t* pr_ = P + (size_t)(row_) * LDP; const size_t ro_ = (size_t)(row_) * 1024; _Pragma("unroll") for (int j = 0; j < 4; ++j) { const int c_ = 4 * F.lane + 256 * j; \
        dst.v[j][0] = *(const u32x2*)(OB + ro_ + c_); dst.v[j][1] = *(const u32x2*)(OB + RS + ro_ + c_); dst.v[j][2] = *(const u32x2*)(pr_ + C_GG + c_); \
        dst.v[j][3] = *(const u32x2*)(HB + ro_ + c_); dst.v[j][4] = *(const u32x2*)(HB + RS + ro_ + c_); dst.v[j][5] = *(const u32x2*)(pr_ + C_LG + c_); \
        dst.v[j][6] = *(const u32x2*)(OB + 2 * RS + ro_ + c_); dst.v[j][7] = *(const u32x2*)(OB + 3 * RS + ro_ + c_); dst.v[j][8] = *(const u32x2*)(pr_ + C_RG + c_); } } while (0)
#define BF4(w) ((f32x4){bflo((w).x), bfhi((w).x), bflo((w).y), bfhi((w).y)})
    RowIn cur;
    if (F.gw < nrows) FIN_LOAD(cur, F.gw);
    for (int row = F.gw; row < nrows; row += F.NGW) {
        const size_t ro = (size_t)row * 1024; u32x2 wo[4][3];
#pragma unroll
        for (int j = 0; j < 4; ++j) {
            const int c = 4 * F.lane + 256 * j;
            {
                const f32x4 o = BF4(cur.v[j][0]) + BF4(cur.v[j][1]);
                const float ss = wave_sum((o[0] * o[0] + o[1] * o[1]) + (o[2] * o[2] + o[3] * o[3])); const float rs = rsqrtf(ss * (1.0f / 256.0f) + EPS);
                const f32x4 g = BF4(cur.v[j][2]), gn = *(const f32x4*)(gnorm + c);
                wo[j][0].x = pk2(o[0] * rs * gn[0] * siluf_(g[0]), o[1] * rs * gn[1] * siluf_(g[1])); wo[j][0].y = pk2(o[2] * rs * gn[2] * siluf_(g[2]), o[3] * rs * gn[3] * siluf_(g[3])); }
            {
                const f32x4 hh = BF4(cur.v[j][3]) + BF4(cur.v[j][4]), g = BF4(cur.v[j][5]);
                wo[j][1].x = pk2(hh[0] * gelu_tanh_(g[0]), hh[1] * gelu_tanh_(g[1])); wo[j][1].y = pk2(hh[2] * gelu_tanh_(g[2]), hh[3] * gelu_tanh_(g[3])); }
            {
                f32x4 o = BF4(cur.v[j][6]) + BF4(cur.v[j][7]);
                const float mean = wave_sum((o[0] + o[1]) + (o[2] + o[3])) * (1.0f / 256.0f); o = o - mean;
                const float ss = wave_sum((o[0] * o[0] + o[1] * o[1]) + (o[2] * o[2] + o[3] * o[3])); const float rs = rsqrtf(ss * (1.0f / 256.0f) + EPS);
                const f32x4 g = BF4(cur.v[j][8]), gn = *(const f32x4*)(rnorm + c);
                wo[j][2].x = pk2(o[0] * rs * gn[0] * siluf_(g[0]), o[1] * rs * gn[1] * siluf_(g[1])); wo[j][2].y = pk2(o[2] * rs * gn[2] * siluf_(g[2]), o[3] * rs * gn[3] * siluf_(g[3])); }
        }
        asm volatile("" ::: "memory");
        if (row + F.NGW < nrows) FIN_LOAD(cur, row + F.NGW);
        asm volatile("" ::: "memory");
#pragma unroll
        for (int j = 0; j < 4; ++j) { const int c = 4 * F.lane + 256 * j; *(u32x2*)(A3 + ro + c) = wo[j][0]; *(u32x2*)(A3 + RS + ro + c) = wo[j][1]; *(u32x2*)(A3 + 2 * RS + ro + c) = wo[j][2]; }
    }
#undef FIN_LOAD
#undef BF4
}

constexpr int RT_PITCH = 2064, RT_XH = 0, RT_XL = 16 * RT_PITCH, RT_PART = 2 * 16 * RT_PITCH, RT_PP = 33, RT_HIST = RT_PART + 8 * 16 * RT_PP * 4;
__device__ __forceinline__ void phase_norm2_router(const Frame& F, int li, int tile0, int ntile) {
    LAS unsigned char* L = F.lds; LAS float* part = (LAS float*)(L + RT_PART); LAS unsigned* hist = (LAS unsigned*)(L + RT_HIST); LAS unsigned* hbase = hist + 32;
    const int lane = F.lane, w = F.wave, fr = lane & 15, fq = lane >> 4;
    const float* wr = inptr<22>() + (size_t)li * 1024 * 32; const float* br = inptr<23>() + li * 32;
    bf16x8 Bh[2][4], Bl[2][4];
#pragma unroll
    for (int nt = 0; nt < 2; ++nt)
#pragma unroll
        for (int ks = 0; ks < 4; ++ks) { u32x4 hw, lw;
#pragma unroll
            for (int i2 = 0; i2 < 4; ++i2) { const float a = wr[(size_t)(128 * w + 32 * ks + 8 * fq + 2 * i2) * 32 + 16 * nt + fr], b = wr[(size_t)(128 * w + 32 * ks + 8 * fq + 2 * i2 + 1) * 32 + 16 * nt + fr];
                hw[i2] = pk2(a, b); lw[i2] = pk2(a - bflo(hw[i2]), b - bfhi(hw[i2])); }
            Bh[nt][ks] = __builtin_bit_cast(bf16x8, hw); Bl[nt][ks] = __builtin_bit_cast(bf16x8, lw); }
    if (F.tid < 32) hist[F.tid] = 0u;
    __syncthreads();
    const bf16_t* xs = (const bf16_t*)(F.ws + WS_XS); const float* mods = (const float*)(F.ws + WS_MODS) + (size_t)li * 9 * 6144;
    bf16_t* xn2 = (bf16_t*)(F.ws + WS_D); int* tok_e = (int*)(F.ws + WS_TOKE); float* tok_w = (float*)(F.ws + WS_TOKW); int* tok_p = (int*)(F.ws + WS_TOKP);
    unsigned* cnt = (unsigned*)(F.ws + WS_CTL) + CW_CNT + li * 32;
    RowV xr[2];
    if (F.bx < ntile) {
#pragma unroll
        for (int rr = 0; rr < 2; ++rr) xr[rr] = load_row_bf16(xs + (size_t)(16 * (tile0 + F.bx) + 2 * w + rr) * D, lane); }
    for (int t = F.bx; t < ntile; t += F.G) {
        u32x2 hs[2][4];
#pragma unroll
        for (int rr = 0; rr < 2; ++rr) { const int lr = 2 * w + rr, row = 16 * (tile0 + t) + lr; const float* mp = mods + mrow_of(row) * 6144;
            const RowV y = norm_mod(xr[rr], inptr<7>() + (size_t)li * 1024, mp + 3 * 1024, mp + 4 * 1024, lane);
#pragma unroll
            for (int j = 0; j < 4; ++j) { u32x2 h, l2; h.x = pk2(y.v[j][0], y.v[j][1]); h.y = pk2(y.v[j][2], y.v[j][3]);
                l2.x = pk2(y.v[j][0] - bflo(h.x), y.v[j][1] - bfhi(h.x)); l2.y = pk2(y.v[j][2] - bflo(h.y), y.v[j][3] - bfhi(h.y)); hs[rr][j] = h;
                *(LAS u32x2*)(L + RT_XH + lr * RT_PITCH + (4 * lane + 256 * j) * 2) = h; *(LAS u32x2*)(L + RT_XL + lr * RT_PITCH + (4 * lane + 256 * j) * 2) = l2; } }
        asm volatile("" ::: "memory");
        if (t + F.G < ntile) {
#pragma unroll
            for (int rr = 0; rr < 2; ++rr) xr[rr] = load_row_bf16(xs + (size_t)(16 * (tile0 + t + F.G) + 2 * w + rr) * D, lane); }
        asm volatile("" ::: "memory");
#pragma unroll
        for (int rr = 0; rr < 2; ++rr)
#pragma unroll
            for (int j = 0; j < 4; ++j) *(u32x2*)(xn2 + (size_t)(16 * (tile0 + t) + 2 * w + rr) * D + 4 * lane + 256 * j) = hs[rr][j];
        __syncthreads();
        {   f32x4 acc[2] = {(f32x4){0.f, 0.f, 0.f, 0.f}, (f32x4){0.f, 0.f, 0.f, 0.f}};
#pragma unroll
            for (int ks = 0; ks < 4; ++ks) { const int co = (128 * w + 32 * ks + 8 * fq) * 2;
                const bf16x8 ah = *(const LAS bf16x8*)(L + RT_XH + fr * RT_PITCH + co), al = *(const LAS bf16x8*)(L + RT_XL + fr * RT_PITCH + co);
#pragma unroll
                for (int nt = 0; nt < 2; ++nt) { acc[nt] = __builtin_amdgcn_mfma_f32_16x16x32_bf16(Bh[nt][ks], ah, acc[nt], 0, 0, 0); acc[nt] = __builtin_amdgcn_mfma_f32_16x16x32_bf16(Bl[nt][ks], ah, acc[nt], 0, 0, 0);
                    acc[nt] = __builtin_amdgcn_mfma_f32_16x16x32_bf16(Bh[nt][ks], al, acc[nt], 0, 0, 0); } }
#pragma unroll
            for (int nt = 0; nt < 2; ++nt)
#pragma unroll
                for (int j = 0; j < 4; ++j) part[(w * 16 + fr) * RT_PP + 16 * nt + 4 * fq + j] = acc[nt][j]; }
        __syncthreads();
        {
            const int e = lane & 31, tk = 2 * w + (lane >> 5), row = 16 * (tile0 + t) + tk; float v = br[e];
#pragma unroll
            for (int w2 = 0; w2 < 8; ++w2) v += part[(w2 * 16 + tk) * RT_PP + e];
            float tl0, tl1, tl2, tl3; int te0, te1, te2, te3;
#define RT_ARGMAX(TL, TE) do { float bv = v; int bi = e; _Pragma("unroll") for (int o = 16; o >= 1; o >>= 1) { const float ov = __shfl_xor(bv, o); const int oi = __shfl_xor(bi, o); \
                const bool tk_ = (ov > bv) || (ov == bv && oi < bi); bv = tk_ ? ov : bv; bi = tk_ ? oi : bi; } TL = bv; TE = bi; v = (e == bi) ? -3.0e38f : v; } while (0)
            RT_ARGMAX(tl0, te0); RT_ARGMAX(tl1, te1); RT_ARGMAX(tl2, te2); RT_ARGMAX(tl3, te3);
#undef RT_ARGMAX
            const float e1 = __expf(tl1 - tl0), e2 = __expf(tl2 - tl0), e3 = __expf(tl3 - tl0); const float inv = 1.0f / (1.0f + e1 + e2 + e3);
            if (e < 4) { const int ek = e == 0 ? te0 : e == 1 ? te1 : e == 2 ? te2 : te3; const float wk = (e == 0 ? 1.0f : e == 1 ? e1 : e == 2 ? e2 : e3) * inv;
                const unsigned lp = atomicAdd((unsigned*)&hist[ek], 1u); tok_e[row * 4 + e] = ek; tok_w[row * 4 + e] = wk; tok_p[row * 4 + e] = (int)lp; } }
        __syncthreads();
    }
    if (F.tid < 32) hbase[F.tid] = __hip_atomic_fetch_add(cnt + F.tid, hist[F.tid], __ATOMIC_RELAXED, __HIP_MEMORY_SCOPE_AGENT);
    __syncthreads();
    for (int t = F.bx; t < ntile; t += F.G) if (F.tid < 64) { const int i = 16 * (tile0 + t) * 4 + F.tid; tok_p[i] += (int)hbase[tok_e[i]]; }
    __syncthreads();
}
__device__ __forceinline__ void phase_dispatch(const Frame& F, int li, int ntok) {
    LAS unsigned* pstart = (LAS unsigned*)F.lds;
    unsigned* ctl = (unsigned*)(F.ws + WS_CTL); unsigned* cnt = ctl + CW_CNT + li * 32; unsigned* tile_e = ctl + CW_TILE + li * 1024;
    if (F.tid == 0) { unsigned ps = 0;
        for (int e = 0; e < 32; ++e) { const unsigned c = __hip_atomic_load(cnt + e, __ATOMIC_RELAXED, __HIP_MEMORY_SCOPE_AGENT), nt = (c + 255u) >> 8; pstart[e] = ps;
            if (F.bx == 0) for (unsigned j = 0; j < nt; ++j) tile_e[(ps >> 8) + j] = (unsigned)e;
            ps += nt << 8; }
        if (F.bx == 0) ctl[CW_NT + li] = ps >> 8; }
    __syncthreads();
    const int* tok_e = (const int*)(F.ws + WS_TOKE); const int* tok_p = (const int*)(F.ws + WS_TOKP); int* tok_s = (int*)(F.ws + WS_TOKS); int* slot_tok = (int*)(F.ws + WS_SLOTTOK);
    for (int it = F.gtid; it < ntok * 4; it += F.NGT) { const int slot = (int)pstart[tok_e[it]] + tok_p[it]; tok_s[it] = slot; slot_tok[slot] = it >> 2; }
    if (F.bx < 32) { const unsigned c = __hip_atomic_load(cnt + F.bx, __ATOMIC_RELAXED, __HIP_MEMORY_SCOPE_AGENT), pe = ((c + 255u) >> 8) << 8;
        for (unsigned s = c + F.tid; s < pe; s += NTHR) slot_tok[pstart[F.bx] + s] = 0; }
    __syncthreads();
}
__device__ __forceinline__ void phase_combine(const Frame& F, int li, int ntok, bool last) {
    bf16_t* xs = (bf16_t*)(F.ws + WS_XS); const bf16_t* Y = (const bf16_t*)(F.ws + WS_B); bf16_t* xn = (bf16_t*)(F.ws + WS_D);
    const float* mods = (const float*)(F.ws + WS_MODS); const float* tok_w = (const float*)(F.ws + WS_TOKW); const int* tok_s = (const int*)(F.ws + WS_TOKS);
    for (int row = F.gw; row < ntok; row += F.NGW) {
        const int mr = mrow_of(row); const float* gp = mods + ((size_t)li * 9 + mr) * 6144 + 5 * 1024;
        RowV x = load_row_bf16(xs + (size_t)row * D, F.lane);
        const int s0 = tok_s[row * 4], s1 = tok_s[row * 4 + 1], s2 = tok_s[row * 4 + 2], s3 = tok_s[row * 4 + 3];
        const float w0 = tok_w[row * 4], w1 = tok_w[row * 4 + 1], w2 = tok_w[row * 4 + 2], w3 = tok_w[row * 4 + 3];
#pragma unroll
        for (int j = 0; j < 4; ++j) { const int c = 4 * F.lane + 256 * j;
            const f32x4 y = ld4bf(Y + (size_t)s0 * 1024 + c) * w0 + ld4bf(Y + (size_t)s1 * 1024 + c) * w1 + ld4bf(Y + (size_t)s2 * 1024 + c) * w2 + ld4bf(Y + (size_t)s3 * 1024 + c) * w3;
            x.v[j] = x.v[j] + *(const f32x4*)(gp + c) * y; }
        if (!last) {
            store_row_bf16(xs + (size_t)row * D, x, F.lane);
            const float* mp = mods + ((size_t)(li + 1) * 9 + mr) * 6144;
            const RowV y = norm_mod(x, inptr<6>() + (size_t)(li + 1) * 1024, mp, mp + 1024, F.lane);
            store_row_bf16(xn + (size_t)row * D, y, F.lane);
        } else {
            const float rs = rsqrtf(row_sumsq(x) * (1.0f / D) + EPS);
#pragma unroll
            for (int j = 0; j < 4; ++j) { const int c = 4 * F.lane + 256 * j; *(f32x4*)(F.out + (size_t)row * D + c) = (x.v[j] * rs) * *(const f32x4*)(inptr<28>() + c); }
        }
    }
}


__device__ __forceinline__ void phase_branch_tail(const Frame& F, int r0, int r1) {
    bf16_t* MB = (bf16_t*)(F.ws + WS_B);
    for (int row = r0 + F.gw; row < r1; row += F.NGW) { const size_t o = (size_t)row * 1024 + 16 * F.lane;
        u32x4 s[2][3];
#pragma unroll
        for (int hlf = 0; hlf < 2; ++hlf)
#pragma unroll
            for (int k = 0; k < 3; ++k) s[hlf][k] = *(const u32x4*)(MB + (size_t)k * TT * 1024 + o + 8 * hlf);
#pragma unroll
        for (int hlf = 0; hlf < 2; ++hlf) { u32x4 w;
#pragma unroll
            for (int e = 0; e < 4; ++e) w[e] = pk2(bflo(s[hlf][2][e]) + bflo(s[hlf][0][e]) + bflo(s[hlf][1][e]), bfhi(s[hlf][2][e]) + bfhi(s[hlf][0][e]) + bfhi(s[hlf][1][e]));
            *(u32x4*)(MB + (size_t)2 * TT * 1024 + o + 8 * hlf) = w; } }
}

#ifndef MK_RLXMASK
#define MK_RLXMASK 1
#endif
#define MK_RLX(i) (((MK_RLXMASK) >> (i)) & 1)
#ifndef MK_SCAN_REF
#define MK_SCAN_REF 0
#endif
#ifndef MK_ONE_LAUNCH
#define MK_ONE_LAUNCH 1
#endif
constexpr int NPH_LAYER = 15, NPHASES = 2 + 2 * NPH_LAYER;
struct Args { const float* in[29]; float* out; unsigned char* ws; int ph_lo, ph_hi, region, pad; };
#ifndef MK_PHMASK
#define MK_PHMASK 0x7fff
#endif
#define IN(k) (lo <= (k) && (k) < hi)
#define EN(j) ((MK_PHMASK >> (j)) & 1)
#define SEAM(k) do { if (IN(k) && IN((k) + 1)) xcd_barrier(bar); } while (0)
#define MKF() Frame F; { GAS unsigned char* ws_ = (GAS unsigned char*)args.ws; asm volatile("" : "+s"(ws_)); F.ws = ws_; F.lds = (LAS unsigned char*)lds_raw; F.out = args.out; \
        int tid_ = (wave0 << 6) | (int)xb_lane(), bx_ = blockIdx.x; asm volatile("" : "+v"(tid_), "+s"(bx_)); F.tid = tid_; F.bx = bx_; F.lane = F.tid & 63; F.wave = __builtin_amdgcn_readfirstlane(F.tid >> 6); F.G = gridDim.x; \
        F.gw = F.bx * NWAVES + F.wave; F.NGW = F.G * NWAVES; F.gtid = F.bx * NTHR + F.tid; F.NGT = F.G * NTHR; }
template <int li> __device__ __forceinline__ void run_layer(const Args& args, unsigned char* lds_raw, const XcdBarrier& bar, const int lo, const int hi, const int wave0) {
        const int pb = 2 + NPH_LAYER * li; const bool last = (li == 1); const int nrows = last ? TLAT : TT, nMt = nrows / 256;
        if (EN(0) && IN(pb + 0)) { MKF(); phase_W(F, li); if (li == 0) phase_norm_in(F); __syncthreads(); }
        SEAM(pb + 0);
        if (EN(1) && IN(pb + 1)) { MKF(); unsigned* ctl = (unsigned*)(F.ws + WS_CTL); (void)ctl;
            pg8::Gemm g{1024, 1024, 1024}; PlainOrder S; S.pm0 = 0; S.A = (const char*)(F.ws + WS_D); S.B = (const char*)(F.ws + WS_WIN); S.astep = 256 * 1024 * 2; S.bstep = 256 * 1024 * 2; S.nM = TT / 256; S.nN = LDP / 256; S.G = F.G; S.c = F.bx;
            EpiProj E{(bf16_t*)(F.ws + WS_P), (const float*)(F.ws + WS_COS), (const float*)(F.ws + WS_SIN)};
            pg8::gemm_phase<EpiProj, PlainOrder, true, true, false, MK_RLX(0)>(F.lds, g, S, E, F.tid);
        }
        SEAM(pb + 1);
        if (EN(2) && IN(pb + 2)) { MKF(); phase_conv(F, li); phase_scanprep(F, li); }
        SEAM(pb + 2);
        if (EN(3) && IN(pb + 3)) { MKF(); phase_scan_mfma(F, li); }
        SEAM(pb + 3);
        if (EN(4) && IN(pb + 4)) { MKF(); unsigned* ctl = (unsigned*)(F.ws + WS_CTL); (void)ctl;
            pg8::Gemm g{1024, 256, 256}; LruOrder S; S.A = (const char*)(F.ws + WS_D); S.B = (const char*)(F.ws + WS_WLRU); S.nM = TT / 256; S.G = F.G; S.c = F.bx;
            EpiLru E{(const bf16_t*)(F.ws + WS_D), (bf16_t*)(F.ws + WS_C), (bf16_t*)(F.ws + WS_C + 2 * ROWB), inptr<15>() + (size_t)li * 2048, inptr<17>() + (size_t)li * 2048, (const float*)(F.ws + WS_LSL)};
            pg8::gemm_phase<EpiLru, LruOrder, true, true, false, MK_RLX(1)>(F.lds, g, S, E, F.tid);
        }
        SEAM(pb + 4);
        if (EN(5) && IN(pb + 5)) { MKF(); phase_lru_scan<false>(F); }
        SEAM(pb + 5);
        if (EN(6) && IN(pb + 6)) { MKF(); phase_lru_scan<true>(F); }
        SEAM(pb + 6);
        if (EN(7) && IN(pb + 7)) { MKF(); phase_finish(F, li, nrows); }
        SEAM(pb + 7);
        if (EN(8) && IN(pb + 8)) { MKF(); unsigned* ctl = (unsigned*)(F.ws + WS_CTL); (void)ctl;
            pg8::Gemm g{1024, 1024, 1024}; BranchOrder S; S.A = (const char*)(F.ws + WS_C); S.B = (const char*)(F.ws + WS_WBR); S.nM = nMt; S.G = F.G; S.c = F.bx;
            EpiBranch E{(const bf16_t*)(F.ws + WS_P), (bf16_t*)(F.ws + WS_B)};
            pg8::gemm_phase<EpiBranch, BranchOrder, true, true, false, MK_RLX(2)>(F.lds, g, S, E, F.tid);
            if (S.full_rows() < nMt) { xcd_barrier(bar); phase_branch_tail(F, S.full_rows() * 256, nMt * 256); }
        }
        SEAM(pb + 8);
        if (EN(9) && IN(pb + 9)) { MKF(); unsigned* ctl = (unsigned*)(F.ws + WS_CTL); (void)ctl;
            pg8::Gemm g{1024, 1024, 1024}; PlainOrder S; S.pm0 = 0; S.A = (const char*)(F.ws + WS_B + 2 * ROWB); S.B = (const char*)(F.ws + WS_WOUT); S.astep = 256 * 1024 * 2; S.bstep = 256 * 1024 * 2; S.nM = nMt; S.nN = 4; S.G = F.G; S.c = F.bx;
            bf16_t* xs = (bf16_t*)(F.ws + WS_XS);
            EpiOut<li == 0> E{inptr<0>(), inptr<2>(), xs, (const float*)(F.ws + WS_MODS) + (size_t)li * 9 * 6144 + 2 * 1024};
            const int nMa = full_row_tiles(nMt, 4, F.G); S.nM = nMa;
            pg8::gemm_phase<EpiOut<li == 0>, PlainOrder, true, true, false, MK_RLX(3)>(F.lds, g, S, E, F.tid);
            if (nMa < nMt) { const int ntw = (nMt - nMa) * 4; xcd_barrier(bar);
                if (F.bx < ntw) { PlainOrder T = S; T.nM = nMt - nMa; T.pm0 = nMa; T.G = ntw; T.c = F.bx; pg8::gemm_phase<EpiOut<li == 0>, PlainOrder, true, true, false, MK_RLX(3)>(F.lds, g, T, E, F.tid); }
                else { Frame F2 = F; F2.bx = F.bx - ntw; F2.G = F.G - ntw; phase_norm2_router(F2, li, 0, nMa * 16); } }
        }
        SEAM(pb + 9);
        if (EN(10) && IN(pb + 10)) { MKF(); const int nMa = full_row_tiles(nMt, 4, F.G); if (nMa < nMt) phase_norm2_router(F, li, nMa * 16, (nMt - nMa) * 16); else phase_norm2_router(F, li, 0, nrows / 16); }
        SEAM(pb + 10);
        if (EN(11) && IN(pb + 11)) { MKF(); phase_dispatch(F, li, nrows); }
        SEAM(pb + 11);
        if (EN(12) && IN(pb + 12)) { MKF(); unsigned* ctl = (unsigned*)(F.ws + WS_CTL); (void)ctl;
            pg8::Gemm g{1024, 1024, 1024}; MoeOrder S; S.A = (const char*)(F.ws + WS_D); S.rowidx = (const int*)(F.ws + WS_SLOTTOK); S.B = (const char*)(F.ws + WS_WGU); S.tile_e = ctl + CW_TILE + li * 1024; S.estep = (size_t)2048 * 1024 * 2;
            S.nM = __builtin_amdgcn_readfirstlane((int)ctl[CW_NT + li]); S.nN = 8; S.G = F.G; S.c = F.bx; S.ga = 1;
            EpiSwiglu E{(bf16_t*)(F.ws + WS_P + 288 * MiB), inptr<25>() + (size_t)li * 32 * 2048};
            pg8::gemm_phase<EpiSwiglu, MoeOrder, true, true, true, MK_RLX(4)>(F.lds, g, S, E, F.tid);
        }
        SEAM(pb + 12);
        if (EN(13) && IN(pb + 13)) { MKF(); unsigned* ctl = (unsigned*)(F.ws + WS_CTL); (void)ctl;
            pg8::Gemm g{1024, 1024, 1024}; MoeOrder S; S.A = (const char*)(F.ws + WS_P + 288 * MiB); S.B = (const char*)(F.ws + WS_WDN); S.tile_e = ctl + CW_TILE + li * 1024; S.estep = (size_t)1024 * 1024 * 2;
            S.nM = __builtin_amdgcn_readfirstlane((int)ctl[CW_NT + li]); S.nN = 4; S.G = F.G; S.c = F.bx; S.ga = 0; S.rowidx = nullptr;
            EpiBf16Bias E{(bf16_t*)(F.ws + WS_B), 1024, inptr<27>() + (size_t)li * 32 * 1024, 1024};
            pg8::gemm_phase<EpiBf16Bias, MoeOrder, true, true, false, MK_RLX(5)>(F.lds, g, S, E, F.tid);
        }
        SEAM(pb + 13);
        if (EN(14) && IN(pb + 14)) { MKF(); phase_combine(F, li, nrows, last); }
        SEAM(pb + 14);
    }
__global__ void __launch_bounds__(NTHR, 2) mk_fwd(Args args) {
    extern __shared__ __attribute__((aligned(16))) unsigned char lds_raw[];
    const int tid0 = threadIdx.x; int wave0 = __builtin_amdgcn_readfirstlane(tid0 >> 6); asm volatile("" : "+s"(wave0));
    volatile LAS unsigned* MISC = (volatile LAS unsigned*)((LAS unsigned char*)lds_raw + MISC_OFF);
    if (tid0 < 32) MISC[tid0] = 0u;
    __syncthreads();
    unsigned* ctl0 = (unsigned*)(args.ws + WS_CTL);
    const int lo = args.ph_lo, hi = args.ph_hi;
    XcdBarrier bar; bar.bar = ctl0 + CW_BAR + args.region * 4096; bar.x = 0; bar.st = MISC + 8; bar.w0 = (unsigned)wave0;
    if (hi - lo > 1) bar = xcd_barrier_post(ctl0 + CW_BAR + args.region * 4096, MISC + 8, (unsigned)wave0);

    if (IN(0)) { MKF(); phase_proA(F); }
    SEAM(0);
    if (IN(1)) { MKF(); phase_proB(F); }
    SEAM(1);
    run_layer<0>(args, lds_raw, bar, lo, hi, wave0);
    run_layer<1>(args, lds_raw, bar, lo, hi, wave0);
}

extern "C" void kernel_launch(void* const* d_in, const int* in_sizes, int n_in, void* d_out, int out_size, void* d_ws, size_t ws_size, hipStream_t stream) {
    static int grid = 0;
    if (grid == 0) {
        if (n_in != 29 || ws_size < WS_END || out_size != TLAT * D) { fprintf(stderr, "kernel_launch: unexpected problem: n_in %d ws %zu out %d\n", n_in, ws_size, out_size); grid = -1; return; }
        int dev = 0, cus = 0;
        if (hipGetDevice(&dev) != hipSuccess || hipDeviceGetAttribute(&cus, hipDeviceAttributeMultiprocessorCount, dev) != hipSuccess) { grid = -1; return; }
        if (hipFuncSetAttribute((const void*)mk_fwd, hipFuncAttributeMaxDynamicSharedMemorySize, LDS_BYTES) != hipSuccess) { fprintf(stderr, "kernel_launch: hipFuncSetAttribute failed\n"); grid = -1; return; }
        int per_cu = 0;
        if (hipOccupancyMaxActiveBlocksPerMultiprocessor(&per_cu, (const void*)mk_fwd, NTHR, LDS_BYTES) != hipSuccess || per_cu < 1) fprintf(stderr, "kernel_launch: occupancy query reports %d\n", per_cu);
        (void)hipGetLastError();
        grid = cus;
    }
    if (grid < 0) return;
    (void)hipMemsetAsync((char*)d_ws + WS_CTL, 0, CTL_BYTES, stream);
    Args a{};
    for (int i = 0; i < 29; ++i) a.in[i] = (const float*)d_in[i];
    a.out = (float*)d_out; a.ws = (unsigned char*)d_ws;
#if MK_ONE_LAUNCH
    a.ph_lo = 0; a.ph_hi = NPHASES; a.region = 0;
    hipLaunchKernelGGL(mk_fwd, dim3(grid), dim3(NTHR), LDS_BYTES, stream, a);
#else
    for (int p = 0; p < NPHASES; ++p) { a.ph_lo = p; a.ph_hi = p + 1; a.region = 0; hipLaunchKernelGGL(mk_fwd, dim3(grid), dim3(NTHR), LDS_BYTES, stream, a); }
#endif
}
```

```cpp
#include <hip/hip_runtime.h>
#include <cstdio>
#include <cstdint>

#define LAS __attribute__((address_space(3)))
typedef unsigned short bf16_t;
typedef short bf16x8 __attribute__((ext_vector_type(8)));
typedef float f32x4 __attribute__((ext_vector_type(4)));
typedef float f32x2 __attribute__((ext_vector_type(2)));
typedef unsigned u32x4 __attribute__((ext_vector_type(4)));
typedef unsigned u32x2 __attribute__((ext_vector_type(2)));

constexpr int D = 1024, NBATCH = 8, SEQ = 4096, CTXL = 256;
constexpr int TLAT = NBATCH * SEQ, TCTX = NBATCH * CTXL, TT = TLAT + TCTX;
constexpr int LDP = 11520;
constexpr int C_GQ = 0, C_GK = 512, C_GV = 1024, C_GG = 2048, C_LX = 3072, C_LG = 4096, C_RQ = 5120, C_RK = 5632, C_RV = 6144, C_RG = 7168, C_MG = 8192, C_LR = 11264;
constexpr int IN_TOTAL = 11296, NE = 32;
constexpr int SLOT_TILES_MAX = 576;
constexpr float EPS = 1e-6f;

constexpr size_t MiB = (size_t)1 << 20;
constexpr size_t WS_CTL = 0, CTL_BYTES = 1 * MiB;
constexpr size_t WS_MODP = 1 * MiB, WS_MODS = 5 * MiB, WS_COS = 6 * MiB, WS_SIN = 7 * MiB, WS_LSL = 8 * MiB, WS_CARA = 9 * MiB, WS_CARH = 11 * MiB;
constexpr size_t WS_SLOTTOK = 8 * MiB + 256 * 1024;
constexpr size_t WS_TOKE = 13 * MiB, WS_TOKW = WS_TOKE + 768 * 1024, WS_TOKP = WS_TOKW + 768 * 1024, WS_TOKS = WS_TOKP + 768 * 1024;
constexpr size_t WS_WIN = 16 * MiB, WS_WLRU = 39 * MiB, WS_WBR = 41 * MiB, WS_WOUT = 47 * MiB, WS_WGU = 49 * MiB, WS_WDN = 177 * MiB;
constexpr size_t WS_XS = 241 * MiB, WS_P = 377 * MiB, WS_B = 1142 * MiB, WS_C = 1430 * MiB, WS_D = 1702 * MiB, WS_E = 1770 * MiB, WS_END = 1906 * MiB;
constexpr size_t ROWB = (size_t)TT * D * 2;
static_assert(ROWB == 68 * MiB, "row buffer");
constexpr int CW_CNT = 1024, CW_NT = 1024 + 128, CW_TILE = 2048, CW_BAR = 8192;

__device__ __forceinline__ float bflo(unsigned w) { return __uint_as_float(w << 16); }
__device__ __forceinline__ float bfhi(unsigned w) { return __uint_as_float(w & 0xffff0000u); }
typedef __bf16 bf16x2_t __attribute__((ext_vector_type(2)));
__device__ __forceinline__ unsigned pk2(float lo, float hi) { const bf16x2_t v = __builtin_convertvector((f32x2){lo, hi}, bf16x2_t); return __builtin_bit_cast(unsigned, v); }
__device__ __forceinline__ float sigmoidf_(float x) { return __builtin_amdgcn_rcpf(1.0f + __expf(-x)); }
__device__ __forceinline__ float siluf_(float x) { return x * sigmoidf_(x); }
__device__ __forceinline__ float logsigmoidf_(float z) { return fminf(z, 0.f) - 0.6931471805599453f * __builtin_amdgcn_logf(1.0f + __builtin_amdgcn_exp2f(-1.4426950408889634f * fabsf(z))); }
__device__ __forceinline__ float gelu_tanh_(float x) { const float u = 0.7978845608028654f * (x + 0.044715f * x * x * x); const float t = 1.0f - 2.0f * __builtin_amdgcn_rcpf(__expf(2.0f * u) + 1.0f); return 0.5f * x * (1.0f + t); }
__device__ __forceinline__ float wave_sum(float v) {
#pragma unroll
    for (int o = 1; o < 64; o <<= 1) v += __shfl_xor(v, o);
    return v;
}
#define LDS_WAIT() asm volatile("s_waitcnt lgkmcnt(0)" ::: "memory")

namespace pg8 {
#define PG8_LAS __attribute__((address_space(3)))
constexpr int BM = 256, BK = 64, HALF = 128, HTB = HALF * BK * 2, STAGE_BYTES = 8 * HTB, NXCD = 8, WGM = 8;
__host__ __device__ __forceinline__ int lds_byte(int r, int c) { const int st = (r >> 4) * 2 + (c >> 5), rr = r & 15, cc = c & 31, ob = rr * 64 + cc * 2; return st * 1024 + (ob ^ (((ob >> 9) & 1) << 5)); }
__host__ __device__ __forceinline__ void stage_rc(int b, int& R, int& C) { const int st = b / 1024, sb = b % 1024, swz = sb ^ (((sb >> 9) & 1) << 5); R = (st >> 1) * 16 + swz / 64; C = (st & 1) * 32 + (swz % 64) / 2; }
__host__ __device__ __forceinline__ int perm32(int rho) { const int n = rho >> 4, i = rho & 15; return 8 * (i >> 2) + 4 * n + (i & 3); }
struct Unit { int pm, pn, aux; const char* a; const char* b; };
struct Gemm { int lda, ldb, K; };
__device__ __forceinline__ void tile_of(int L, int nM, int nN, int& pm, int& pn) {
    const int nwg = nM * nN; int wgid = L; { const int q = nwg / NXCD, r = nwg % NXCD, xcd = wgid % NXCD, off = wgid / NXCD; wgid = (xcd < r ? xcd * (q + 1) : r * (q + 1) + (xcd - r) * q) + off; }
    const int nig = WGM * nN, gid = wgid / nig, fm = gid * WGM, gsz = (nM - fm) < WGM ? (nM - fm) : WGM;
    pm = fm + ((wgid % nig) % gsz); pn = (wgid % nig) / gsz;
}
__device__ __forceinline__ unsigned cvt_pk_bf16(float lo, float hi) { unsigned r; asm volatile("v_cvt_pk_bf16_f32 %0, %1, %2" : "=v"(r) : "v"(lo), "v"(hi)); return r; }
template <class Epi, class Sched, bool ALIGN_EPI = false, bool SP2 = false, bool GATHER = false, bool RELAX = false>
__device__ __forceinline__ void gemm_phase(PG8_LAS unsigned char* lds, const Gemm g, const Sched& S, const Epi& E, const int tid_in) {
    int tid_o = tid_in; asm volatile("" : "+v"(tid_o));
    const int tid = tid_o, wid = __builtin_amdgcn_readfirstlane(tid >> 6), lane = tid & 63, wr = wid >> 2, wc = wid & 3, fr = lane & 15, fq = lane >> 4;
    const int K = g.K, nt = K / BK;
    unsigned voffA[2], voffB[2];
#pragma unroll
    for (int i = 0; i < 2; ++i) { int R, C; stage_rc(tid * 16 + i * 8192, R, C); const int Rb = Epi::PERM ? ((R & ~31) + perm32(R & 31)) : R;
        voffA[i] = (unsigned)(R * g.lda + C) * 2u; voffB[i] = (unsigned)(Rb * g.ldb + C) * 2u; }
    unsigned gA[2][2] = {{0u, 0u}, {0u, 0u}}, gN[2][2] = {{0u, 0u}, {0u, 0u}}; int gR[2], gC[2];
#pragma unroll
    for (int i = 0; i < 2; ++i) stage_rc(tid * 16 + i * 8192, gR[i], gC[i]);
#define PG8_GOFF(dst, u_) do { if constexpr (GATHER) { _Pragma("unroll") for (int h_ = 0; h_ < 2; ++h_) _Pragma("unroll") for (int i_ = 0; i_ < 2; ++i_) \
        dst[h_][i_] = (unsigned)S.rowidx[(u_).pm * BM + h_ * HALF + gR[i_]] * (unsigned)(g.lda * 2) + (unsigned)(gC[i_] * 2); } } while (0)
    const size_t kstep = (size_t)(BK * 2);
    const size_t hstepA = (size_t)HALF * g.lda * 2, hstepB = (size_t)HALF * g.ldb * 2;
    const unsigned ldsw = (unsigned)wid * 1024u;
    const int aoff = lds_byte(wr * 64 + fr, fq * 8), boff = lds_byte(wc * 32 + fr, fq * 8);
#define PG8_SA(b, h) (((b) * 2 + (h)) * HTB)
#define PG8_SB(b, h) ((4 + (b) * 2 + (h)) * HTB)
#define PG8_STAGE(bufoff, gbase, voff) do { _Pragma("unroll") for (int _i = 0; _i < 2; ++_i) \
        __builtin_amdgcn_global_load_lds((const unsigned*)((const char*)(gbase) + (voff)[_i]), (PG8_LAS unsigned*)(lds + (bufoff) + ldsw + _i * 8192), 16, 0, 0); } while (0)
#define PG8_STAGE_A(bufoff, gbase, H, NX) do { if constexpr (GATHER) { _Pragma("unroll") for (int _i = 0; _i < 2; ++_i) { const unsigned o_ = (NX) ? gN[H][_i] : gA[H][_i]; \
        __builtin_amdgcn_global_load_lds((const unsigned*)((const char*)(gbase) + o_), (PG8_LAS unsigned*)(lds + (bufoff) + ldsw + _i * 8192), 16, 0, 0); } } \
        else { PG8_STAGE(bufoff, (gbase) + (H) * hstepA, voffA); } } while (0)
#define PG8_LDA(dst, b, h) do { _Pragma("unroll") for (int m = 0; m < 4; ++m) _Pragma("unroll") for (int k = 0; k < 2; ++k) dst[m][k] = *(const PG8_LAS bf16x8*)(lds + PG8_SA(b, h) + aoff + m * 2048 + k * 1024); } while (0)
#define PG8_LDB(dst, b, h) do { _Pragma("unroll") for (int n = 0; n < 2; ++n) _Pragma("unroll") for (int k = 0; k < 2; ++k) dst[n][k] = *(const PG8_LAS bf16x8*)(lds + PG8_SB(b, h) + boff + n * 2048 + k * 1024); } while (0)
#define PG8_MMA(ai, bj, At, Bt) do { __builtin_amdgcn_s_setprio(1); _Pragma("unroll") for (int m = 0; m < 4; ++m) _Pragma("unroll") for (int n = 0; n < 2; ++n) _Pragma("unroll") for (int k = 0; k < 2; ++k) \
        acc[ai][bj][m][n] = __builtin_amdgcn_mfma_f32_16x16x32_bf16(Bt[n][k], At[m][k], acc[ai][bj][m][n], 0, 0, 0); __builtin_amdgcn_s_setprio(0); } while (0)
#define PG8_WAIT_V(n) asm volatile("s_waitcnt vmcnt(" #n ")" ::: "memory")
#define PG8_WAIT_VN(n) asm volatile("s_waitcnt vmcnt(%0)" :: "n"(n) : "memory")
#define PG8_WAIT_L(n) asm volatile("s_waitcnt lgkmcnt(" #n ")" ::: "memory")
#define PG8_BAR __builtin_amdgcn_s_barrier()
#define PG8_SCHED __builtin_amdgcn_sched_barrier(0)
    Unit cur, nxt; int ui = 0;
    if (!S.next(0, cur)) return;
    f32x4 acc[2][2][4][2];
#pragma unroll
    for (int a = 0; a < 2; ++a)
#pragma unroll
        for (int b = 0; b < 2; ++b)
#pragma unroll
            for (int m = 0; m < 4; ++m)
#pragma unroll
                for (int n = 0; n < 2; ++n) acc[a][b][m][n] = (f32x4){0.f, 0.f, 0.f, 0.f};
    bf16x8 At[4][2], B0[2][2], B1[2][2];
    const char* cA = cur.a; const char* cB = cur.b;
    S.a_ready(cur);
    PG8_GOFF(gA, cur);
    if constexpr (SP2) {
        PG8_STAGE(PG8_SB(0, 0), cB, voffB); PG8_STAGE(PG8_SB(0, 1), cB + hstepB, voffB); PG8_STAGE_A(PG8_SA(0, 0), cA, 0, false); PG8_STAGE_A(PG8_SA(0, 1), cA, 1, false);
        if (wr == 1) PG8_BAR;
        PG8_WAIT_V(2); PG8_BAR;
        PG8_STAGE(PG8_SB(1, 0), cB + kstep, voffB); PG8_STAGE_A(PG8_SA(1, 0), cA + kstep, 0, false); PG8_STAGE(PG8_SB(1, 1), cB + hstepB + kstep, voffB);
        if constexpr (RELAX) PG8_WAIT_V(0); else PG8_WAIT_V(6);
        PG8_BAR;
    } else {
        PG8_STAGE(PG8_SB(0, 0), cB, voffB); PG8_STAGE_A(PG8_SA(0, 0), cA, 0, false); PG8_STAGE(PG8_SB(0, 1), cB + hstepB, voffB); PG8_STAGE_A(PG8_SA(0, 1), cA, 1, false);
        if (wr == 1) PG8_BAR;
        PG8_WAIT_V(4); PG8_BAR;
        PG8_STAGE(PG8_SB(1, 0), cB + kstep, voffB); PG8_STAGE_A(PG8_SA(1, 0), cA + kstep, 0, false); PG8_STAGE(PG8_SB(1, 1), cB + hstepB + kstep, voffB);
        PG8_WAIT_V(6); PG8_BAR;
    }
    for (;;) {
        const bool has_next = S.next(ui + 1, nxt);
        if (has_next) PG8_GOFF(gN, nxt);
        const char* nA = has_next ? nxt.a : cA; const char* nB = has_next ? nxt.b : cB;
        if constexpr (SP2 && RELAX) {
            const char* a1 = cA + kstep; const char* a2 = cA + 2 * kstep; const char* b2 = cB + 2 * kstep; const char* a3 = a2 + kstep; const char* b3 = b2 + kstep;
            PG8_SCHED;
            PG8_LDB(B0, 0, 0); PG8_LDB(B1, 0, 1); PG8_SCHED; PG8_LDA(At, 0, 0); PG8_STAGE_A(PG8_SA(1, 1), a1, 1, false);
            PG8_WAIT_VN(8 + Epi::NST); PG8_WAIT_L(0); PG8_BAR; PG8_MMA(0, 0, At, B0); PG8_MMA(0, 1, At, B1); PG8_BAR; PG8_SCHED;
            PG8_LDA(At, 0, 1); PG8_STAGE(PG8_SB(0, 0), b2, voffB); PG8_STAGE(PG8_SB(0, 1), b2 + hstepB, voffB); PG8_STAGE_A(PG8_SA(0, 0), a2, 0, false);
            PG8_WAIT_VN(8 + Epi::NST); PG8_WAIT_L(0); PG8_BAR; PG8_MMA(1, 0, At, B0); PG8_MMA(1, 1, At, B1); PG8_BAR; PG8_SCHED;
            PG8_LDB(B0, 1, 0); PG8_LDB(B1, 1, 1); PG8_SCHED; PG8_LDA(At, 1, 0); PG8_STAGE_A(PG8_SA(0, 1), a2, 1, false);
            PG8_WAIT_V(8); PG8_WAIT_L(0); PG8_BAR; PG8_MMA(0, 0, At, B0); PG8_MMA(0, 1, At, B1); PG8_BAR; PG8_SCHED;
            PG8_LDA(At, 1, 1); PG8_STAGE(PG8_SB(1, 0), b3, voffB); PG8_STAGE(PG8_SB(1, 1), b3 + hstepB, voffB); PG8_STAGE_A(PG8_SA(1, 0), a3, 0, false);
            PG8_WAIT_V(8); PG8_WAIT_L(0); PG8_BAR; PG8_MMA(1, 0, At, B0); PG8_MMA(1, 1, At, B1); PG8_BAR; PG8_SCHED;
        }
        for (int t = (SP2 && RELAX) ? 2 : 0; t < nt; t += 2) {
            const bool last = (t == nt - 2); const bool nx_ = last && has_next;
            const char* a1 = cA + (size_t)(t + 1) * kstep;
            const char* a2 = last ? nA : cA + (size_t)(t + 2) * kstep; const char* b2 = last ? nB : cB + (size_t)(t + 2) * kstep;
            const char* a3 = a2 + kstep; const char* b3 = b2 + kstep;
            if (last && has_next) S.a_ready(nxt);
            if constexpr (SP2) {
            PG8_LDB(B0, 0, 0); PG8_LDB(B1, 0, 1); PG8_SCHED; PG8_LDA(At, 0, 0); PG8_STAGE_A(PG8_SA(1, 1), a1, 1, false);
            PG8_WAIT_V(8); PG8_WAIT_L(0); PG8_BAR; PG8_MMA(0, 0, At, B0); PG8_MMA(0, 1, At, B1); PG8_BAR; PG8_SCHED;
            PG8_LDA(At, 0, 1); PG8_STAGE(PG8_SB(0, 0), b2, voffB); PG8_STAGE(PG8_SB(0, 1), b2 + hstepB, voffB); PG8_STAGE_A(PG8_SA(0, 0), a2, 0, nx_);
            PG8_WAIT_V(8); PG8_WAIT_L(0); PG8_BAR; PG8_MMA(1, 0, At, B0); PG8_MMA(1, 1, At, B1); PG8_BAR; PG8_SCHED;
            PG8_LDB(B0, 1, 0); PG8_LDB(B1, 1, 1); PG8_SCHED; PG8_LDA(At, 1, 0); PG8_STAGE_A(PG8_SA(0, 1), a2, 1, nx_);
            PG8_WAIT_V(8); PG8_WAIT_L(0); PG8_BAR; PG8_MMA(0, 0, At, B0); PG8_MMA(0, 1, At, B1); PG8_BAR; PG8_SCHED;
            PG8_LDA(At, 1, 1); PG8_STAGE(PG8_SB(1, 0), b3, voffB); PG8_STAGE(PG8_SB(1, 1), b3 + hstepB, voffB); PG8_STAGE_A(PG8_SA(1, 0), a3, 0, nx_);
            PG8_WAIT_V(8); PG8_WAIT_L(0); PG8_BAR; PG8_MMA(1, 0, At, B0); PG8_MMA(1, 1, At, B1); PG8_BAR; PG8_SCHED;
            } else {
            PG8_LDB(B0, 0, 0); PG8_SCHED; PG8_LDA(At, 0, 0); PG8_STAGE_A(PG8_SA(1, 1), a1, 1, false);
            PG8_WAIT_L(8); PG8_BAR; PG8_WAIT_L(0); PG8_MMA(0, 0, At, B0); PG8_BAR; PG8_SCHED;
            PG8_LDB(B1, 0, 1); PG8_STAGE(PG8_SB(0, 0), b2, voffB);
            PG8_BAR; PG8_WAIT_L(0); PG8_MMA(0, 1, At, B1); PG8_BAR;
            PG8_LDA(At, 0, 1); PG8_STAGE_A(PG8_SA(0, 0), a2, 0, nx_);
            PG8_BAR; PG8_WAIT_L(0); PG8_MMA(1, 0, At, B0); PG8_BAR; PG8_SCHED;
            PG8_STAGE(PG8_SB(0, 1), b2 + hstepB, voffB);
            PG8_WAIT_V(6); PG8_BAR; PG8_MMA(1, 1, At, B1); PG8_BAR;
            PG8_LDB(B0, 1, 0); PG8_SCHED; PG8_LDA(At, 1, 0); PG8_STAGE_A(PG8_SA(0, 1), a2, 1, nx_);
            PG8_WAIT_L(8); PG8_BAR; PG8_WAIT_L(0); PG8_MMA(0, 0, At, B0); PG8_BAR; PG8_SCHED;
            PG8_LDB(B1, 1, 1); PG8_STAGE(PG8_SB(1, 0), b3, voffB);
            PG8_BAR; PG8_WAIT_L(0); PG8_MMA(0, 1, At, B1); PG8_BAR;
            PG8_LDA(At, 1, 1); PG8_STAGE_A(PG8_SA(1, 0), a3, 0, nx_);
            PG8_BAR; PG8_WAIT_L(0); PG8_MMA(1, 0, At, B0); PG8_BAR; PG8_SCHED;
            PG8_STAGE(PG8_SB(1, 1), b3 + hstepB, voffB);
            PG8_WAIT_V(6); PG8_BAR; PG8_MMA(1, 1, At, B1); PG8_BAR;
            }
        }
        if constexpr (ALIGN_EPI) { if (wr == 0) PG8_BAR; }
        if constexpr (!Epi::AFTER_DRAIN) { const int ln_ = (int)__builtin_amdgcn_mbcnt_hi(~0u, __builtin_amdgcn_mbcnt_lo(~0u, 0u));
            E(acc, cur, wr, wc, ln_ & 15, ln_ >> 4); S.done(cur); }
        if (!has_next) break;
#pragma unroll
        for (int a = 0; a < 2; ++a)
#pragma unroll
            for (int b = 0; b < 2; ++b)
#pragma unroll
                for (int m = 0; m < 4; ++m)
#pragma unroll
                    for (int n = 0; n < 2; ++n) acc[a][b][m][n] = (f32x4){0.f, 0.f, 0.f, 0.f};
        cur = nxt; cA = nA; cB = nB; ++ui;
        if constexpr (GATHER) { _Pragma("unroll") for (int h_ = 0; h_ < 2; ++h_) _Pragma("unroll") for (int i_ = 0; i_ < 2; ++i_) gA[h_][i_] = gN[h_][i_]; }
        if constexpr (ALIGN_EPI) { if (wr == 1) PG8_BAR; }
    }
    PG8_WAIT_V(0);
    if constexpr (!ALIGN_EPI) { if (wr == 0) PG8_BAR; }
    PG8_BAR;
    if constexpr (Epi::AFTER_DRAIN) { E.fused(acc, cur, wr, wc, fr, fq, lds, wid, lane); S.done(cur); }
#undef PG8_SA
#undef PG8_SB
#undef PG8_STAGE
#undef PG8_STAGE_A
#undef PG8_GOFF
#undef PG8_LDA
#undef PG8_LDB
#undef PG8_MMA
#undef PG8_WAIT_V
#undef PG8_WAIT_VN
#undef PG8_WAIT_L
#undef PG8_BAR
#undef PG8_SCHED
}
}

#define GAS __attribute__((address_space(1)))
typedef GAS unsigned gu32;
#define RLX_AGENT __ATOMIC_RELAXED, __HIP_MEMORY_SCOPE_AGENT
#define XB_TMO      128
#define XB_XCNT(j)  (256  + 64 * (j))
#define XB_XSUB(j)  (1280 + 64 * (j))
#define XB_XGEN(j)  (2304 + 64 * (j))
#define XB_TOP      3328
#define XB_TOPGEN   3392
#define XCD_BAR_WORDS 3456
#define XB_SPIN_CAP (1u << 18)

__device__ __forceinline__ unsigned xb_ld(unsigned* p)              { return __hip_atomic_load(p, __ATOMIC_RELAXED, __HIP_MEMORY_SCOPE_AGENT); }
__device__ __forceinline__ unsigned xb_add(unsigned* p, unsigned v) { return __hip_atomic_fetch_add(p, v, __ATOMIC_RELAXED, __HIP_MEMORY_SCOPE_AGENT); }
__device__ __forceinline__ unsigned xb_xcc_id() { return (unsigned)__builtin_amdgcn_s_getreg((3 << 11) | 20) & 0xFu; }
#define XB_SPIN(cond, bar) do { unsigned _sp = 0; while (cond) { __builtin_amdgcn_s_sleep(1); \
    if ((++_sp & 255u) == 0u) { if (xb_ld(&(bar)[XB_TMO])) break; if (_sp > XB_SPIN_CAP) { atomicAdd(&(bar)[XB_TMO], 1u); break; } } } } while (0)

struct XcdBarrier {
    unsigned* bar; unsigned x; unsigned w0;
    volatile LAS unsigned* st;
};

__device__ __forceinline__ unsigned xb_lane() { return __builtin_amdgcn_mbcnt_hi(~0u, __builtin_amdgcn_mbcnt_lo(~0u, 0u)); }
__device__ __forceinline__ XcdBarrier xcd_barrier_post(unsigned* bar, volatile LAS unsigned* st, unsigned w0) {
    XcdBarrier b; b.bar = bar; b.x = xb_xcc_id(); b.st = st; b.w0 = w0;
    if (w0 == 0u && xb_lane() == 0u) (void)xb_add(&bar[XB_XCNT(b.x)], 1u);
    return b;
}
__device__ __forceinline__ void xcd_barrier_complete(unsigned* bar, unsigned x, unsigned& nloc, unsigned& nx) {
    const unsigned G = gridDim.x * gridDim.y * gridDim.z;
    unsigned sum, cnt, mine, sp = 0u;
    for (;;) {
        sum = 0u; cnt = 0u; mine = 0u;
#pragma unroll
        for (unsigned j = 0; j < 16; ++j) { const unsigned c = xb_ld(&bar[XB_XCNT(j)]); sum += c; cnt += (c > 0u) ? 1u : 0u; mine = (j == x) ? c : mine; }
        if (sum == G) break;
        __builtin_amdgcn_s_sleep(1);
        if ((++sp & 255u) == 0u) { if (xb_ld(&bar[XB_TMO])) break; if (sp > XB_SPIN_CAP) { atomicAdd(&bar[XB_TMO], 1u); break; } }
    }
    nloc = mine > 0u ? mine : 1u; nx = cnt > 0u ? cnt : 1u;
}

__device__ __forceinline__ void xcd_barrier(const XcdBarrier& b) {
    asm volatile("s_waitcnt vmcnt(0)" ::: "memory");
    __syncthreads();
    if (b.w0 == 0u && xb_lane() == 0u) {
        unsigned* bar = b.bar;
        __builtin_amdgcn_s_waitcnt(0);
        unsigned nloc = b.st[0], nx = b.st[1];
        if (nloc == 0u) { xcd_barrier_complete(bar, b.x, nloc, nx); b.st[0] = nloc; b.st[1] = nx; }
        const unsigned old = xb_add(&bar[XB_XSUB(b.x)], 1u);
        const unsigned gen = old / nloc;
        if (old + 1u == (gen + 1u) * nloc) {
            __builtin_amdgcn_fence(__ATOMIC_RELEASE, "agent");
            asm volatile("s_waitcnt vmcnt(0)" ::: "memory");
            const unsigned og = xb_add(&bar[XB_TOP], 1u);
            const unsigned tg = og / nx;
            if (og + 1u == (tg + 1u) * nx) xb_add(&bar[XB_TOPGEN], 1u);
            else XB_SPIN(xb_ld(&bar[XB_TOPGEN]) == tg, bar);
            __builtin_amdgcn_fence(__ATOMIC_ACQUIRE, "agent");
            xb_add(&bar[XB_XGEN(b.x)], 1u);
            asm volatile("s_waitcnt vmcnt(0)" ::: "memory");
        } else {
            XB_SPIN(xb_ld(&bar[XB_XGEN(b.x)]) == gen, bar);
            __builtin_amdgcn_fence(__ATOMIC_ACQUIRE, "agent");
            asm volatile("s_waitcnt vmcnt(0)" ::: "memory");
        }
    }
    __syncthreads();
}

struct OrderBase {
    const int* rowidx;
    __device__ __forceinline__ void a_ready(const pg8::Unit&) const {}
    __device__ __forceinline__ void done(const pg8::Unit&) const {}
};
struct PlainOrder : OrderBase {
    const char* A; const char* B; size_t astep, bstep; int nM, nN, G, c, pm0;
    __device__ __forceinline__ bool next(int i, pg8::Unit& u) const {
        const long L = (long)i * G + c; if (L >= (long)nM * nN) return false;
        pg8::tile_of((int)L, nM, nN, u.pm, u.pn); u.pm += pm0; u.aux = 0; u.a = A + (size_t)u.pm * astep; u.b = B + (size_t)u.pn * bstep; return true; }
};
__device__ __forceinline__ int full_row_tiles(int nM, int nN, int G) { return ((G % nN) == 0 && (nM * nN) % G != 0) ? ((nM * nN) / G) * (G / nN) : nM; }
struct LruOrder : OrderBase {
    const char* A; const char* B; int nM, G, c;
    __device__ __forceinline__ bool next(int i, pg8::Unit& u) const {
        const long L = (long)i * G + c; if (L >= (long)nM * 16) return false;
        pg8::tile_of((int)L, nM, 16, u.pm, u.pn); u.aux = 0; u.a = A + (size_t)u.pm * (256 * 1024 * 2) + (size_t)(u.pn >> 2) * 512; u.b = B + (size_t)u.pn * (256 * 256 * 2); return true; }
};
struct BranchOrder : OrderBase {
    const char* A; const char* B; int nM, G, c;
    __device__ __forceinline__ int full_rows() const { return ((G & 3) == 0 && (nM * 4) % G != 0) ? ((nM * 4) / G) * (G / 4) : nM; }
    __device__ __forceinline__ bool next(int i, pg8::Unit& u) const {
        const int nMa = full_rows(), rounds = (nMa * 4 + G - 1) / G; int br;
        if (i < 3 * rounds) { const int j = i / 3; br = i - 3 * j; const int L = j * G + c; if (L >= nMa * 4) return false; pg8::tile_of(L, nMa, 4, u.pm, u.pn); u.aux = br; }
        else { const int t = (i - 3 * rounds) * G + c; if (t >= (nM - nMa) * 12) return false; const int tb = t / 3; br = t - 3 * tb; u.pm = nMa + (tb >> 2); u.pn = tb & 3; u.aux = br | 4; }
        u.a = A + (size_t)br * ROWB + (size_t)u.pm * (256 * 1024 * 2); u.b = B + (size_t)br * (1024 * 1024 * 2) + (size_t)u.pn * (256 * 1024 * 2); return true; }
};
struct MoeOrder : OrderBase {
    const char* A; const char* B; const unsigned* tile_e; size_t estep; int nM, nN, G, c, ga;
    __device__ __forceinline__ bool next(int i, pg8::Unit& u) const {
        const long L = (long)i * G + c; if (L >= (long)nM * nN) return false;
        pg8::tile_of((int)L, nM, nN, u.pm, u.pn); const int e = (int)tile_e[u.pm]; u.aux = e;
        u.a = ga ? A : A + (size_t)u.pm * (256 * 1024 * 2); u.b = B + (size_t)e * estep + (size_t)u.pn * (256 * 1024 * 2); return true; }
};

struct EpiBf16Bias {
    static constexpr bool PERM = true, AFTER_DRAIN = false; static constexpr int NST = 16;
    bf16_t* O; int ldc; const float* bias; int bstride;
    __device__ __forceinline__ void operator()(const f32x4 (&acc)[2][2][4][2], const pg8::Unit& u, int wr, int wc, int fr, int fq) const {
        const int row0 = u.pm * 256 + wr * 64 + fr, col0 = u.pn * 256 + wc * 32 + 8 * fq;
        f32x4 bv[2][2];
#pragma unroll
        for (int bj = 0; bj < 2; ++bj)
#pragma unroll
            for (int n = 0; n < 2; ++n) bv[bj][n] = bias ? *(const f32x4*)(bias + (size_t)u.aux * bstride + col0 + bj * 128 + 4 * n) : (f32x4){0.f, 0.f, 0.f, 0.f};
#pragma unroll
        for (int ai = 0; ai < 2; ++ai)
#pragma unroll
            for (int m = 0; m < 4; ++m) { bf16_t* rowp = O + (size_t)(row0 + ai * 128 + m * 16) * ldc + col0;
#pragma unroll
                for (int bj = 0; bj < 2; ++bj) { const f32x4 v0 = acc[ai][bj][m][0] + bv[bj][0], v1 = acc[ai][bj][m][1] + bv[bj][1];
                    u32x4 w; w.x = pg8::cvt_pk_bf16(v0[0], v0[1]); w.y = pg8::cvt_pk_bf16(v0[2], v0[3]); w.z = pg8::cvt_pk_bf16(v1[0], v1[1]); w.w = pg8::cvt_pk_bf16(v1[2], v1[3]);
                    *(u32x4*)(rowp + bj * 128) = w; } }
    }
};
struct EpiProj {
    static constexpr bool PERM = true, AFTER_DRAIN = false; static constexpr int NST = 16;
    bf16_t* O; const float* rcos; const float* rsin;
    __device__ __forceinline__ void operator()(const f32x4 (&acc)[2][2][4][2], const pg8::Unit& u, int wr, int wc, int fr, int fq) const {
        const int row0 = u.pm * 256 + wr * 64 + fr, col0 = u.pn * 256 + wc * 32 + 8 * fq;
        if (u.pn >= 20 && u.pn < 24 && u.pm < 128) {
#pragma unroll
            for (int ai = 0; ai < 2; ++ai)
#pragma unroll
                for (int m = 0; m < 4; ++m) { const int row = row0 + ai * 128 + m * 16, t = row & (SEQ - 1); bf16_t* rowp = (bf16_t*)((char*)O + (unsigned)(row * LDP + col0) * 2u);
                    const f32x4 cs = *(const f32x4*)(rcos + t * 64 + 16 * wc + 4 * fq), sn = *(const f32x4*)(rsin + t * 64 + 16 * wc + 4 * fq);
#pragma unroll
                    for (int bj = 0; bj < 2; ++bj) { const f32x4 x1 = acc[ai][bj][m][0], x2 = acc[ai][bj][m][1]; const f32x4 v0 = x1 * cs - x2 * sn, v1 = x1 * sn + x2 * cs;
                        u32x4 w; w.x = pg8::cvt_pk_bf16(v0[0], v0[1]); w.y = pg8::cvt_pk_bf16(v0[2], v0[3]); w.z = pg8::cvt_pk_bf16(v1[0], v1[1]); w.w = pg8::cvt_pk_bf16(v1[2], v1[3]);
                        *(u32x4*)(rowp + bj * 128) = w; }
                    asm volatile("" ::: "memory"); }
        } else {
#pragma unroll
            for (int ai = 0; ai < 2; ++ai)
#pragma unroll
                for (int m = 0; m < 4; ++m) { bf16_t* rowp = (bf16_t*)((char*)O + (unsigned)((row0 + ai * 128 + m * 16) * LDP + col0) * 2u);
#pragma unroll
                    for (int bj = 0; bj < 2; ++bj) { const f32x4 v0 = acc[ai][bj][m][0], v1 = acc[ai][bj][m][1];
                        u32x4 w; w.x = pg8::cvt_pk_bf16(v0[0], v0[1]); w.y = pg8::cvt_pk_bf16(v0[2], v0[3]); w.z = pg8::cvt_pk_bf16(v1[0], v1[1]); w.w = pg8::cvt_pk_bf16(v1[2], v1[3]);
                        *(u32x4*)(rowp + bj * 128) = w; } }
        }
    }
};
struct EpiLru {
    static constexpr bool PERM = true, AFTER_DRAIN = false; static constexpr int NST = 16;
    const bf16_t* xc; bf16_t* LA; bf16_t* BB; const float* ba; const float* bi; const float* lsl;
    __device__ __forceinline__ void operator()(const f32x4 (&acc)[2][2][4][2], const pg8::Unit& u, int wr, int wc, int fr, int fq) const {
        const int g = u.pn >> 2, d = (u.pn >> 1) & 1, hh = u.pn & 1;
        const int row0 = u.pm * 256 + wr * 64 + fr, ch0 = 256 * g + 128 * hh + wc * 32 + 8 * fq;
        constexpr float NL2E = -1.4426950408889634f;
        f32x4 pbn[2], pin[2], c8[2];
#pragma unroll
        for (int n = 0; n < 2; ++n) { pbn[n] = *(const f32x4*)(ba + d * 1024 + ch0 + 4 * n) * NL2E; pin[n] = *(const f32x4*)(bi + d * 1024 + ch0 + 4 * n) * NL2E; c8[n] = *(const f32x4*)(lsl + d * 1024 + ch0 + 4 * n) * 8.0f; }
        u32x4 xwn = *(const u32x4*)(xc + (size_t)row0 * 1024 + ch0);
#pragma unroll
        for (int ai = 0; ai < 2; ++ai)
#pragma unroll
            for (int m = 0; m < 4; ++m) { const size_t off = (size_t)(row0 + ai * 128 + m * 16) * 1024 + ch0;
                const u32x4 xw = xwn; f32x4 la[2], bb[2];
#pragma unroll
                for (int n = 0; n < 2; ++n) {
                    const f32x4 t1 = acc[ai][0][m][n] * NL2E + pbn[n], t2 = acc[ai][1][m][n] * NL2E + pin[n];
                    f32x4 e1, e2;
#pragma unroll
                    for (int e = 0; e < 4; ++e) { e1[e] = __builtin_amdgcn_exp2f(t1[e]); e2[e] = __builtin_amdgcn_exp2f(t2[e]); }
                    e1 = e1 + 1.0f; e2 = e2 + 1.0f;
                    f32x4 r, ig;
#pragma unroll
                    for (int e = 0; e < 4; ++e) { r[e] = __builtin_amdgcn_rcpf(e1[e]); ig[e] = __builtin_amdgcn_rcpf(e2[e]); }
                    const f32x4 l = r * c8[n], t3 = l * (2.0f * 1.4426950408889634f); f32x4 a2;
#pragma unroll
                    for (int e = 0; e < 4; ++e) a2[e] = __builtin_amdgcn_exp2f(t3[e]);
                    a2 = 1.0f - a2; f32x4 sq;
#pragma unroll
                    for (int e = 0; e < 4; ++e) sq[e] = __builtin_amdgcn_sqrtf(fmaxf(a2[e], 0.f));
                    const f32x4 xv = (f32x4){bflo(xw[2 * n]), bfhi(xw[2 * n]), bflo(xw[2 * n + 1]), bfhi(xw[2 * n + 1])};
                    la[n] = l; bb[n] = sq * ig * xv; }
                u32x4 w1, w2; w1.x = pg8::cvt_pk_bf16(la[0][0], la[0][1]); w1.y = pg8::cvt_pk_bf16(la[0][2], la[0][3]); w1.z = pg8::cvt_pk_bf16(la[1][0], la[1][1]); w1.w = pg8::cvt_pk_bf16(la[1][2], la[1][3]);
                w2.x = pg8::cvt_pk_bf16(bb[0][0], bb[0][1]); w2.y = pg8::cvt_pk_bf16(bb[0][2], bb[0][3]); w2.z = pg8::cvt_pk_bf16(bb[1][0], bb[1][1]); w2.w = pg8::cvt_pk_bf16(bb[1][2], bb[1][3]);
                asm volatile("" ::: "memory");
                if (ai * 4 + m < 7) { const int nx = ai * 4 + m + 1; xwn = *(const u32x4*)(xc + (size_t)(row0 + (nx >> 2) * 128 + (nx & 3) * 16) * 1024 + ch0); }
                asm volatile("" ::: "memory");
                *(u32x4*)(LA + (size_t)d * TT * 1024 + off) = w1; *(u32x4*)(BB + (size_t)d * TT * 1024 + off) = w2; asm volatile("" ::: "memory"); }
    }
};
struct EpiBranch {
    static constexpr bool PERM = true, AFTER_DRAIN = false; static constexpr int NST = 16;
    const bf16_t* P; bf16_t* MB;
    __device__ __forceinline__ void operator()(const f32x4 (&acc)[2][2][4][2], const pg8::Unit& u, int wr, int wc, int fr, int fq) const {
        const int br = u.aux & 3, row0 = u.pm * 256 + wr * 64 + fr, col0 = u.pn * 256 + wc * 32 + 8 * fq; const bool alone = (u.aux & 4) != 0;
        bf16_t* dst = MB + (size_t)br * TT * 1024; const bf16_t* M0 = MB; const bf16_t* M1 = MB + (size_t)TT * 1024;
        u32x4 gw[2][4][2];
#pragma unroll
        for (int ai = 0; ai < 2; ++ai)
#pragma unroll
            for (int m = 0; m < 4; ++m)
#pragma unroll
                for (int bj = 0; bj < 2; ++bj) gw[ai][m][bj] = *(const u32x4*)(P + (size_t)(row0 + ai * 128 + m * 16) * LDP + C_MG + br * 1024 + col0 + bj * 128);
#pragma unroll
        for (int ai = 0; ai < 2; ++ai)
#pragma unroll
            for (int m = 0; m < 4; ++m) { const size_t row = (size_t)(row0 + ai * 128 + m * 16);
#pragma unroll
                for (int bj = 0; bj < 2; ++bj) { const int c = col0 + bj * 128; const u32x4 g = gw[ai][m][bj];
                    f32x4 v0, v1;
                    v0[0] = sigmoidf_(bflo(g.x)) * acc[ai][bj][m][0][0]; v0[1] = sigmoidf_(bfhi(g.x)) * acc[ai][bj][m][0][1]; v0[2] = sigmoidf_(bflo(g.y)) * acc[ai][bj][m][0][2]; v0[3] = sigmoidf_(bfhi(g.y)) * acc[ai][bj][m][0][3];
                    v1[0] = sigmoidf_(bflo(g.z)) * acc[ai][bj][m][1][0]; v1[1] = sigmoidf_(bfhi(g.z)) * acc[ai][bj][m][1][1]; v1[2] = sigmoidf_(bflo(g.w)) * acc[ai][bj][m][1][2]; v1[3] = sigmoidf_(bfhi(g.w)) * acc[ai][bj][m][1][3];
                    if (br == 2 && !alone) { const u32x4 p0 = *(const u32x4*)(M0 + row * 1024 + c), p1 = *(const u32x4*)(M1 + row * 1024 + c);
                        v0[0] += bflo(p0.x) + bflo(p1.x); v0[1] += bfhi(p0.x) + bfhi(p1.x); v0[2] += bflo(p0.y) + bflo(p1.y); v0[3] += bfhi(p0.y) + bfhi(p1.y);
                        v1[0] += bflo(p0.z) + bflo(p1.z); v1[1] += bfhi(p0.z) + bfhi(p1.z); v1[2] += bflo(p0.w) + bflo(p1.w); v1[3] += bfhi(p0.w) + bfhi(p1.w); }
                    u32x4 w; w.x = pg8::cvt_pk_bf16(v0[0], v0[1]); w.y = pg8::cvt_pk_bf16(v0[2], v0[3]); w.z = pg8::cvt_pk_bf16(v1[0], v1[1]); w.w = pg8::cvt_pk_bf16(v1[2], v1[3]);
                    *(u32x4*)(dst + row * 1024 + c) = w; } }
    }
};
template <bool BASE_F32> struct EpiOut {
    static constexpr bool PERM = true, AFTER_DRAIN = false; static constexpr int NST = 16;
    const float* baseLat; const float* baseCtx; bf16_t* xs; const float* gate;
    __device__ __forceinline__ void operator()(const f32x4 (&acc)[2][2][4][2], const pg8::Unit& u, int wr, int wc, int fr, int fq) const {
        const int mrow = u.pm < 128 ? (u.pm >> 4) : 8; const float* gp = gate + mrow * 6144;
        const int row0 = u.pm * 256 + wr * 64 + fr, col0 = u.pn * 256 + wc * 32 + 8 * fq;
        const float* base = u.pm < 128 ? baseLat + (size_t)row0 * 1024 : baseCtx + (size_t)(row0 - TLAT) * 1024;
        f32x4 gv[2][2];
#pragma unroll
        for (int bj = 0; bj < 2; ++bj)
#pragma unroll
            for (int n = 0; n < 2; ++n) gv[bj][n] = *(const f32x4*)(gp + col0 + bj * 128 + 4 * n);
#pragma unroll
        for (int ai = 0; ai < 2; ++ai)
#pragma unroll
            for (int m = 0; m < 4; ++m) { const size_t ro = (size_t)(ai * 128 + m * 16) * 1024 + col0; bf16_t* op = xs + (size_t)row0 * 1024 + ro;
#pragma unroll
                for (int bj = 0; bj < 2; ++bj) { f32x4 b0, b1;
                    if (BASE_F32) { b0 = *(const f32x4*)(base + ro + bj * 128); b1 = *(const f32x4*)(base + ro + bj * 128 + 4); }
                    else { const u32x4 w = *(const u32x4*)(op + bj * 128); b0 = (f32x4){bflo(w.x), bfhi(w.x), bflo(w.y), bfhi(w.y)}; b1 = (f32x4){bflo(w.z), bfhi(w.z), bflo(w.w), bfhi(w.w)}; }
                    const f32x4 v0 = b0 + gv[bj][0] * acc[ai][bj][m][0], v1 = b1 + gv[bj][1] * acc[ai][bj][m][1];
                    u32x4 w; w.x = pg8::cvt_pk_bf16(v0[0], v0[1]); w.y = pg8::cvt_pk_bf16(v0[2], v0[3]); w.z = pg8::cvt_pk_bf16(v1[0], v1[1]); w.w = pg8::cvt_pk_bf16(v1[2], v1[3]);
                    *(u32x4*)(op + bj * 128) = w; } }
    }
};
struct EpiSwiglu {
    static constexpr bool PERM = true, AFTER_DRAIN = false; static constexpr int NST = 8;
    bf16_t* H; const float* bgu;
    __device__ __forceinline__ void operator()(const f32x4 (&acc)[2][2][4][2], const pg8::Unit& u, int wr, int wc, int fr, int fq) const {
        const int row0 = u.pm * 256 + wr * 64 + fr, f0 = u.pn * 128 + wc * 32 + 8 * fq;
        f32x4 bg[2], bu[2];
#pragma unroll
        for (int q = 0; q < 4; ++q) { const f32x4 b = *(const f32x4*)(bgu + (size_t)u.aux * 2048 + 2 * f0 + 4 * q); bg[q >> 1][2 * (q & 1)] = b[0]; bu[q >> 1][2 * (q & 1)] = b[1]; bg[q >> 1][2 * (q & 1) + 1] = b[2]; bu[q >> 1][2 * (q & 1) + 1] = b[3]; }
#pragma unroll
        for (int ai = 0; ai < 2; ++ai)
#pragma unroll
            for (int m = 0; m < 4; ++m) { f32x4 a[2];
#pragma unroll
                for (int n = 0; n < 2; ++n) { f32x4 gt = acc[ai][0][m][n] + bg[n], up = acc[ai][1][m][n] + bu[n];
#pragma unroll
                    for (int e = 0; e < 4; ++e) { gt[e] = fminf(gt[e], 7.0f); up[e] = fminf(fmaxf(up[e], -7.0f), 7.0f); }
                    const f32x4 t = gt * (-1.702f * 1.4426950408889634f); f32x4 ex;
#pragma unroll
                    for (int e = 0; e < 4; ++e) ex[e] = __builtin_amdgcn_exp2f(t[e]);
                    ex = ex + 1.0f; f32x4 sg;
#pragma unroll
                    for (int e = 0; e < 4; ++e) sg[e] = __builtin_amdgcn_rcpf(ex[e]);
                    a[n] = gt * sg * (up + 1.0f); }
                u32x4 w; w.x = pg8::cvt_pk_bf16(a[0][0], a[0][1]); w.y = pg8::cvt_pk_bf16(a[0][2], a[0][3]); w.z = pg8::cvt_pk_bf16(a[1][0], a[1][1]); w.w = pg8::cvt_pk_bf16(a[1][2], a[1][3]);
                *(u32x4*)(H + (size_t)(row0 + ai * 128 + m * 16) * 1024 + f0) = w; }
    }
};

constexpr int NWAVES = 8, NTHR = 512;
constexpr int LDS_BYTES = 163840, MISC_OFF = 163840 - 512;
template <int I> __device__ __forceinline__ const float* inptr() { const GAS float* p;
    asm volatile("s_load_dwordx2 %0, %1, %2\n\ts_waitcnt lgkmcnt(0)" : "=s"(p) : "s"(__builtin_amdgcn_kernarg_segment_ptr()), "n"(I * 8)); return (const float*)p; }
struct Frame {
    LAS unsigned char* lds; GAS unsigned char* ws; float* out;
    int tid, bx, lane, wave, G, gw, NGW, gtid, NGT;
};
__device__ __forceinline__ int mrow_of(int row) { return row < TLAT ? (row >> 12) : 8; }
__device__ __forceinline__ int seqrow(int d, int b, int p) {
    if (p < CTXL) return TLAT + b * CTXL + (d ? CTXL - 1 - p : p);
    const int q = p - CTXL; return b * SEQ + (d ? SEQ - 1 - q : q);
}
struct RowV { f32x4 v[4]; };
__device__ __forceinline__ RowV load_row(const float* p, int lane) { RowV r;
#pragma unroll
    for (int j = 0; j < 4; ++j) r.v[j] = *(const f32x4*)(p + 4 * lane + 256 * j);
    return r; }
__device__ __forceinline__ RowV load_row_bf16(const bf16_t* p, int lane) { RowV r;
#pragma unroll
    for (int j = 0; j < 4; ++j) { const u32x2 w = *(const u32x2*)(p + 4 * lane + 256 * j); r.v[j] = (f32x4){bflo(w.x), bfhi(w.x), bflo(w.y), bfhi(w.y)}; }
    return r; }
__device__ __forceinline__ float row_sumsq(const RowV& r) { float s = 0.f;
#pragma unroll
    for (int j = 0; j < 4; ++j) s += (r.v[j][0] * r.v[j][0] + r.v[j][1] * r.v[j][1]) + (r.v[j][2] * r.v[j][2] + r.v[j][3] * r.v[j][3]);
    return wave_sum(s); }
__device__ __forceinline__ RowV norm_mod(const RowV& x, const float* gain, const float* shift, const float* scale, int lane) {
    const float rs = rsqrtf(row_sumsq(x) * (1.0f / D) + EPS); RowV y;
#pragma unroll
    for (int j = 0; j < 4; ++j) { const int c = 4 * lane + 256 * j; const f32x4 g = *(const f32x4*)(gain + c), sh = *(const f32x4*)(shift + c), sc = *(const f32x4*)(scale + c);
        y.v[j] = (x.v[j] * rs) * g * (sc + 1.0f) + sh; }
    return y; }
__device__ __forceinline__ void store_row_bf16(bf16_t* p, const RowV& y, int lane) {
#pragma unroll
    for (int j = 0; j < 4; ++j) { u32x2 w; w.x = pk2(y.v[j][0], y.v[j][1]); w.y = pk2(y.v[j][2], y.v[j][3]); *(u32x2*)(p + 4 * lane + 256 * j) = w; } }
__device__ __forceinline__ f32x4 ld4bf(const bf16_t* p) { const u32x2 w = *(const u32x2*)p; return (f32x4){bflo(w.x), bfhi(w.x), bflo(w.y), bfhi(w.y)}; }

__device__ __forceinline__ void phase_proA(const Frame& F) {
    const float* c = inptr<1>(); const float* cc = inptr<3>(); const float* w_ada = inptr<4>();
    float* modp = (float*)(F.ws + WS_MODP);
    for (int it = F.gw; it < 2 * 8 * 96; it += F.NGW) {
        const int cg = it % 96, ks = (it / 96) % 8, l = it / 768, col = cg * 64 + F.lane;
        float acc[9];
#pragma unroll
        for (int r = 0; r < 9; ++r) acc[r] = 0.f;
        for (int k = ks * 128; k < ks * 128 + 128; ++k) {
            const float w = w_ada[((size_t)l * 1024 + k) * 6144 + col];
#pragma unroll
            for (int r = 0; r < 8; ++r) acc[r] += siluf_(c[r * 1024 + k]) * w;
            acc[8] += siluf_(cc[k]) * w;
        }
#pragma unroll
        for (int r = 0; r < 9; ++r) modp[((size_t)(ks * 2 + l) * 9 + r) * 6144 + col] = acc[r];
    }
    float* rc = (float*)(F.ws + WS_COS); float* rsn = (float*)(F.ws + WS_SIN);
    for (int i = F.gtid; i < SEQ * 64; i += F.NGT) {
        const int t = i >> 6, j = i & 63, f = j & 31; const float pos = (float)((j < 32) ? (t >> 6) : (t & 63));
        const float inv = exp2f(-(float)f * (13.287712379549449f / 32.0f)); const float ang = pos * inv;
        const float nn = rintf(ang * 0.15915494309189535f); float r = fmaf(-nn, 6.28125f, ang); r = fmaf(-nn, 1.9353071795864769e-3f, r);
        rc[i] = __cosf(r); rsn[i] = __sinf(r);
    }
}
__device__ __forceinline__ void phase_proB(const Frame& F) {
    const float* modp = (const float*)(F.ws + WS_MODP); float* mods = (float*)(F.ws + WS_MODS); const float* b_ada = inptr<5>();
    for (int i = F.gtid; i < 2 * 9 * 6144; i += F.NGT) { const int l = i / (9 * 6144), col = i % 6144; float s = b_ada[l * 6144 + col];
#pragma unroll
        for (int ks = 0; ks < 8; ++ks) s += modp[(size_t)ks * (2 * 9 * 6144) + i];
        mods[i] = s; }
}

template <class RM> __device__ __forceinline__ void tr_item(const float* W, int ldw, int k0, int n0, bf16_t* WT, int ldt, LAS float* scr, int lane, const RM& rm) {
#pragma unroll 8
    for (int i = 0; i < 32; ++i) { const int kk = 2 * i + (lane >> 5); scr[kk * 33 + (lane & 31)] = W[(size_t)(k0 + kk) * ldw + n0 + (lane & 31)]; }
    LDS_WAIT(); asm volatile("" ::: "memory");
    const int c = lane & 7;
#pragma unroll
    for (int j = 0; j < 4; ++j) { const int n = (lane >> 3) + 8 * j; const LAS float* s = scr + (8 * c) * 33 + n; int drow; float sc; rm(n0 + n, drow, sc);
        u32x4 o; o.x = pk2(s[0 * 33] * sc, s[1 * 33] * sc); o.y = pk2(s[2 * 33] * sc, s[3 * 33] * sc); o.z = pk2(s[4 * 33] * sc, s[5 * 33] * sc); o.w = pk2(s[6 * 33] * sc, s[7 * 33] * sc);
        *(u32x4*)(WT + (size_t)drow * ldt + k0 + 8 * c) = o; }
    LDS_WAIT(); asm volatile("" ::: "memory");
}
struct RmIn { __device__ __forceinline__ void operator()(int n, int& drow, float& sc) const {
    drow = n < 3072 ? n : (n < 3104 ? C_LR + (n - 3072) : n - 32); sc = (n < 512 || (n >= 5664 && n < 6176)) ? 0.08838834764831845f : 1.0f;
    if (n >= 5152 && n < 6176) { const int o = (n - 5152) & 127, i = o & 63, x2 = o >> 6; drow = (n - 32) - o + 32 * (i >> 4) + 8 * ((i >> 2) & 3) + 4 * x2 + (i & 3); } } };
struct RmId { __device__ __forceinline__ void operator()(int n, int& drow, float& sc) const { drow = n; sc = 1.0f; } };
struct RmLru { int base; __device__ __forceinline__ void operator()(int n, int& drow, float& sc) const { drow = base + (n & 127); sc = 1.0f; } };
struct RmGu { __device__ __forceinline__ void operator()(int n, int& drow, float& sc) const { const int f = n >> 1, u = n & 1; drow = 256 * (f >> 7) + 128 * u + (f & 127); sc = 1.0f; } };
__device__ __forceinline__ void phase_W(const Frame& F, int li) {
    LAS float* scr = (LAS float*)(F.lds + F.wave * 8704);
    bf16_t* Win_t = (bf16_t*)(F.ws + WS_WIN); bf16_t* Wlru_t = (bf16_t*)(F.ws + WS_WLRU); bf16_t* Wbr_t = (bf16_t*)(F.ws + WS_WBR);
    bf16_t* Wout_t = (bf16_t*)(F.ws + WS_WOUT); bf16_t* Wgu_t = (bf16_t*)(F.ws + WS_WGU); bf16_t* Wdn_t = (bf16_t*)(F.ws + WS_WDN);
    constexpr int I_IN = 16 * 353, I_LRU = 512, I_BR = 1536, I_OUT = 512, I_GU = 32768, I_DN = 16384, NITEMS = I_IN + I_LRU + I_BR + I_OUT + I_GU + I_DN;
    for (int it0 = F.gw; it0 < NITEMS; it0 += F.NGW) {
        int it = it0;
        if (it < I_IN) { const int kb = it / 353, nb = it % 353; tr_item(inptr<8>() + (size_t)li * 1024 * IN_TOTAL, IN_TOTAL, 64 * kb, 32 * nb, Win_t, 1024, scr, F.lane, RmIn{}); continue; } it -= I_IN;
        if (it < I_LRU) { const int mat = it >> 5, r = it & 31, kb = r >> 3, nb = r & 7, ty = mat >> 3, d = (mat >> 2) & 1, g = mat & 3, n0 = 32 * nb, pn = g * 4 + d * 2 + (n0 >> 7);
            const float* src = (ty ? inptr<16>() : inptr<14>()) + (size_t)((li * 2 + d) * 4 + g) * 65536;
            tr_item(src, 256, 64 * kb, n0, Wlru_t, 256, scr, F.lane, RmLru{pn * 256 + ty * 128}); continue; } it -= I_LRU;
        if (it < I_BR) { const int br = it >> 9, r = it & 511, kb = r >> 5, nb = r & 31; tr_item(inptr<20>() + (size_t)(li * 3 + br) * 1048576, 1024, 64 * kb, 32 * nb, Wbr_t + (size_t)br * 1048576, 1024, scr, F.lane, RmId{}); continue; } it -= I_BR;
        if (it < I_OUT) { const int kb = it >> 5, nb = it & 31; tr_item(inptr<21>() + (size_t)li * 1048576, 1024, 64 * kb, 32 * nb, Wout_t, 1024, scr, F.lane, RmId{}); continue; } it -= I_OUT;
        if (it < I_GU) { const int e = it >> 10, r = it & 1023, kb = r >> 6, nb = r & 63; tr_item(inptr<24>() + (size_t)(li * 32 + e) * 2097152, 2048, 64 * kb, 32 * nb, Wgu_t + (size_t)e * 2097152, 1024, scr, F.lane, RmGu{}); continue; } it -= I_GU;
        { const int e = it >> 9, r = it & 511, kb = r >> 5, nb = r & 31; tr_item(inptr<26>() + (size_t)(li * 32 + e) * 1048576, 1024, 64 * kb, 32 * nb, Wdn_t + (size_t)e * 1048576, 1024, scr, F.lane, RmId{}); }
    }
    for (int i = F.gtid; i < (LDP - IN_TOTAL) * 1024 / 8; i += F.NGT) *(u32x4*)(Win_t + (size_t)IN_TOTAL * 1024 + (size_t)i * 8) = (u32x4){0u, 0u, 0u, 0u};
    float* lsl = (float*)(F.ws + WS_LSL);
    for (int i = F.gtid; i < 2048; i += F.NGT) lsl[i] = logsigmoidf_(inptr<18>()[li * 2048 + i]);
}
__device__ __forceinline__ void phase_norm_in(const Frame& F) {
    const float* mods = (const float*)(F.ws + WS_MODS); bf16_t* xn = (bf16_t*)(F.ws + WS_D);
    for (int row = F.gw; row < TT; row += F.NGW) {
        const float* src = row < TLAT ? inptr<0>() + (size_t)row * D : inptr<2>() + (size_t)(row - TLAT) * D;
        const float* mp = mods + mrow_of(row) * 6144;
        const RowV y = norm_mod(load_row(src, F.lane), inptr<6>(), mp, mp + 1024, F.lane);
        store_row_bf16(xn + (size_t)row * D, y, F.lane);
    }
}


__device__ __forceinline__ void phase_conv(const Frame& F, int li) {
    const bf16_t* P = (const bf16_t*)(F.ws + WS_P); bf16_t* xc = (bf16_t*)(F.ws + WS_D);
    const float* cw = inptr<12>() + (size_t)li * 4 * 1024; const float* cb = inptr<13>() + (size_t)li * 1024;
    const int ch = (F.gtid & 127) * 8; float wt[4][8], bs[8];
#pragma unroll
    for (int j = 0; j < 4; ++j) { const f32x4 w0 = *(const f32x4*)(cw + j * 1024 + ch), w1 = *(const f32x4*)(cw + j * 1024 + ch + 4);
#pragma unroll
        for (int e = 0; e < 4; ++e) { wt[j][e] = w0[e]; wt[j][4 + e] = w1[e]; } }
    { const f32x4 b0 = *(const f32x4*)(cb + ch), b1 = *(const f32x4*)(cb + ch + 4);
#pragma unroll
      for (int e = 0; e < 4; ++e) { bs[e] = b0[e]; bs[4 + e] = b1[e]; } }
    u32x4 xw[4];
#define CV_LOAD(row_) do { const int r_ = (row_); int t_, L_; if (r_ < TLAT) { t_ = r_ & (SEQ - 1); L_ = SEQ; } else { t_ = (r_ - TLAT) & (CTXL - 1); L_ = CTXL; } \
        _Pragma("unroll") for (int j = 0; j < 4; ++j) { const int tt_ = t_ - 2 + j; const bool in_ = (tt_ >= 0 && tt_ < L_); xw[j] = *(const u32x4*)(P + (size_t)(in_ ? r_ - 2 + j : r_) * LDP + C_LX + ch); } } while (0)
    const int NR = F.NGT >> 7;
    int row = F.gtid >> 7;
    if (row < TT) CV_LOAD(row);
    for (; row < TT; row += NR) {
        int t, L; if (row < TLAT) { t = row & (SEQ - 1); L = SEQ; } else { t = (row - TLAT) & (CTXL - 1); L = CTXL; }
        float a[8];
#pragma unroll
        for (int e = 0; e < 8; ++e) a[e] = bs[e];
#pragma unroll
        for (int j = 0; j < 4; ++j) { const int tt = t - 2 + j; const float z = (tt >= 0 && tt < L) ? 1.0f : 0.0f;
            a[0] += z * wt[j][0] * bflo(xw[j].x); a[1] += z * wt[j][1] * bfhi(xw[j].x); a[2] += z * wt[j][2] * bflo(xw[j].y); a[3] += z * wt[j][3] * bfhi(xw[j].y);
            a[4] += z * wt[j][4] * bflo(xw[j].z); a[5] += z * wt[j][5] * bfhi(xw[j].z); a[6] += z * wt[j][6] * bflo(xw[j].w); a[7] += z * wt[j][7] * bfhi(xw[j].w); }
        u32x4 o; o.x = pk2(a[0], a[1]); o.y = pk2(a[2], a[3]); o.z = pk2(a[4], a[5]); o.w = pk2(a[6], a[7]);
        asm volatile("" ::: "memory");
        if (row + NR < TT) CV_LOAD(row + NR);
        asm volatile("" ::: "memory");
        *(u32x4*)(xc + (size_t)row * 1024 + ch) = o;
    }
#undef CV_LOAD
}

constexpr int LSEG = 136, LNSEG = (CTXL + SEQ) / LSEG;
template <bool FINAL> __device__ __forceinline__ void phase_lru_scan(const Frame& F) {
    const bf16_t* LA = (const bf16_t*)(F.ws + WS_C); const bf16_t* BB = (const bf16_t*)(F.ws + WS_C + 2 * ROWB);
    float* carA = (float*)(F.ws + WS_CARA); float* carH = (float*)(F.ws + WS_CARH); bf16_t* HO = (bf16_t*)(F.ws + WS_E);
    for (int i = F.gtid; i < 2 * 8 * LNSEG * 256; i += F.NGT) {
        const int sg = __builtin_amdgcn_readfirstlane(i >> 8);
        const int cq = i & 255, s = sg % LNSEG, db = sg / LNSEG, b = db & 7, d = db >> 3;
        f32x4 h = (f32x4){0.f, 0.f, 0.f, 0.f}, As = (f32x4){0.f, 0.f, 0.f, 0.f};
        if (FINAL) {
            for (int s0 = 0; s0 < s; s0 += 8) { f32x4 ca[8], ch[8];
#pragma unroll
                for (int k = 0; k < 8; ++k) { const int s2 = (s0 + k < s) ? s0 + k : s - 1; const size_t o = ((size_t)(db * LNSEG + s2) * 256 + cq) * 4; ca[k] = *(const f32x4*)(carA + o); ch[k] = *(const f32x4*)(carH + o); }
#pragma unroll
                for (int k = 0; k < 8; ++k) if (s0 + k < s) h = ca[k] * h + ch[k]; } }
        const size_t dofs = (size_t)d * TT * 1024;
        const char* LAd = (const char*)(LA + dofs); const char* BBd = (const char*)(BB + dofs); char* HOd = (char*)(HO + dofs);
        const int st = d ? -2048 : 2048;
        u32x2 la8[8], bb8[8];
#define LS_OFF(blk) ((unsigned)(seqrow(d, b, s * LSEG + (blk) * 8) * 2048 + cq * 8))
#define LS_LOAD(blk) do { const unsigned o0_ = LS_OFF(blk); _Pragma("unroll") for (int q = 0; q < 8; ++q) { const unsigned o_ = o0_ + (unsigned)(q * st); la8[q] = *(const u32x2*)(LAd + o_); bb8[q] = *(const u32x2*)(BBd + o_); } } while (0)
        LS_LOAD(0);
        for (int blk = 0; blk < LSEG / 8; ++blk) { u32x2 w8[8];
#pragma unroll
            for (int q = 0; q < 8; ++q) { const f32x4 la = (f32x4){bflo(la8[q].x), bfhi(la8[q].x), bflo(la8[q].y), bfhi(la8[q].y)}, bb = (f32x4){bflo(bb8[q].x), bfhi(bb8[q].x), bflo(bb8[q].y), bfhi(bb8[q].y)};
                f32x4 a; a[0] = __expf(la[0]); a[1] = __expf(la[1]); a[2] = __expf(la[2]); a[3] = __expf(la[3]);
                h = a * h + bb;
                if (FINAL) { w8[q].x = pk2(h[0], h[1]); w8[q].y = pk2(h[2], h[3]); } else As += la; }
            const unsigned oc = LS_OFF(blk);
            if (blk + 1 < LSEG / 8) { asm volatile("" ::: "memory"); LS_LOAD(blk + 1); asm volatile("" ::: "memory"); }
            if (FINAL) {
#pragma unroll
                for (int q = 0; q < 8; ++q) *(u32x2*)(HOd + (oc + (unsigned)(q * st))) = w8[q]; } }
#undef LS_OFF
#undef LS_LOAD
        if (!FINAL) { const size_t o = (size_t)i * 4; f32x4 A; A[0] = __expf(As[0]); A[1] = __expf(As[1]); A[2] = __expf(As[2]); A[3] = __expf(As[3]);
            *(f32x4*)(carA + o) = A; *(f32x4*)(carH + o) = h; }
    }
}


constexpr size_t QKB = (size_t)TT * 512 * 2;
__device__ __forceinline__ void phase_scanprep(const Frame& F, int li) {
    LAS float* lrs = (LAS float*)F.lds;
    LAS float* qtot = lrs + 64 * 32;
    LAS float* gcs = qtot + 4 * 512;
    bf16_t* Pm = (bf16_t*)(F.ws + WS_P); bf16_t* QK = (bf16_t*)(F.ws + WS_C); float* EGL = (float*)(F.ws + WS_MODP);
    const int qtr = F.tid >> 7, c4 = F.tid & 127, ch0 = 4 * c4;
    for (int rc = F.bx; rc < TT / 64; rc += F.G) {
        if (F.tid < 256) { const int tok = F.tid >> 2, q8 = F.tid & 3; const u32x4 v = *(const u32x4*)(Pm + (size_t)(64 * rc + tok) * LDP + C_LR + 8 * q8);
            LAS float* dst = lrs + tok * 32 + 8 * q8; *(LAS f32x4*)dst = (f32x4){bflo(v.x), bfhi(v.x), bflo(v.y), bfhi(v.y)}; *(LAS f32x4*)(dst + 4) = (f32x4){bflo(v.z), bfhi(v.z), bflo(v.w), bfhi(v.w)}; }
        __syncthreads();
        for (int d = 0; d < 2; ++d) {
            f32x4 wv[16];
#pragma unroll
            for (int r = 0; r < 16; ++r) wv[r] = *(const f32x4*)(inptr<9>() + (size_t)((li * 2 + d) * 16 + r) * 512 + ch0);
            const f32x4 bav = *(const f32x4*)(inptr<10>() + (size_t)(li * 2 + d) * 512 + ch0);
            f32x4 run = (f32x4){0.f, 0.f, 0.f, 0.f};
#pragma unroll 2
            for (int i = 0; i < 16; ++i) { const int p = 16 * qtr + i, tok = d ? 63 - p : p; f32x4 z = bav;
#pragma unroll
                for (int r4 = 0; r4 < 4; ++r4) { const f32x4 l = *(const LAS f32x4*)(lrs + tok * 32 + 16 * d + 4 * r4);
#pragma unroll
                    for (int e = 0; e < 4; ++e) z += wv[4 * r4 + e] * l[e]; }
#pragma unroll
                for (int e = 0; e < 4; ++e) run[e] += logsigmoidf_(z[e]) * 0.0625f;
                *(LAS f32x4*)(gcs + p * 512 + ch0) = run; }
            *(LAS f32x4*)(qtot + qtr * 512 + ch0) = run;
            __syncthreads();
            f32x4 off = (f32x4){0.f, 0.f, 0.f, 0.f}, tot = (f32x4){0.f, 0.f, 0.f, 0.f};
#pragma unroll
            for (int q2 = 0; q2 < 4; ++q2) { const f32x4 t = *(const LAS f32x4*)(qtot + q2 * 512 + ch0); tot += t; if (q2 < qtr) off += t; }
            if (qtr == 0) { f32x4 e4; e4[0] = __expf(tot[0]); e4[1] = __expf(tot[1]); e4[2] = __expf(tot[2]); e4[3] = __expf(tot[3]); *(f32x4*)(EGL + ((size_t)d * (TT / 64) + rc) * 512 + ch0) = e4; }
            bf16_t* EGd = QK + (size_t)d * TT * 512;
#pragma unroll 4
            for (int i = 0; i < 16; ++i) { const int p = 16 * qtr + i, tok = d ? 63 - p : p; const size_t row = (size_t)(64 * rc + tok);
                const f32x4 G = *(const LAS f32x4*)(gcs + p * 512 + ch0) + off;
                u32x2 we; { const f32x4 g2 = G * 1.4426950408889634f; we.x = pk2(__builtin_amdgcn_exp2f(g2[0]), __builtin_amdgcn_exp2f(g2[1])); we.y = pk2(__builtin_amdgcn_exp2f(g2[2]), __builtin_amdgcn_exp2f(g2[3])); }
                *(u32x2*)(EGd + row * 512 + ch0) = we; }
            __syncthreads();
        }
    }
}
typedef short s16x4 __attribute__((ext_vector_type(4)));
constexpr int SC_PITCH = 272, SC_TILE = 64 * SC_PITCH, SC_QS = 0, SC_KS = 2 * SC_TILE, SC_VS = 4 * SC_TILE, SC_AS = 6 * SC_TILE, SC_APITCH = 144, SC_EG = SC_AS + 9216, SC_OS = SC_EG + 1024;
__device__ __forceinline__ bf16x8 tr_frag(LAS unsigned char* base, int pitch, int k0, int c0, int lane) {
    const int q = (lane & 15) >> 2, p = lane & 3;
    LAS unsigned char* a = base + (k0 + q) * pitch + (c0 + 4 * p) * 2;
    const s16x4 lo = __builtin_amdgcn_ds_read_tr16_b64_v4i16((LAS s16x4*)a);
    const s16x4 hi = __builtin_amdgcn_ds_read_tr16_b64_v4i16((LAS s16x4*)(a + 4 * pitch));
    return (bf16x8){lo[0], lo[1], lo[2], lo[3], hi[0], hi[1], hi[2], hi[3]};
}
#define MFMA16(a, b, c) __builtin_amdgcn_mfma_f32_16x16x32_bf16((a), (b), (c), 0, 0, 0)
__device__ __forceinline__ int chunk_rc(int d, int b, int chn) { return chn < 4 ? (TLAT / 64) + 4 * b + (d ? 3 - chn : chn) : 64 * b + (d ? 63 - (chn - 4) : (chn - 4)); }
struct ScanSet { u32x4 q[4], k[4], v[4], e[4]; f32x4 gl; };
#define GST16(ptr, val) asm volatile("global_store_dwordx4 %0, %1, off\n\ts_nop 1" :: "v"(ptr), "v"(val) : "memory")
template <int MX> __device__ __forceinline__ void scan_unit(const Frame& F, int u) {
    LAS unsigned char* L = F.lds;
    const int lane = F.lane, w = F.wave, fr = lane & 15, fq = lane >> 4;
    const int js = u & 1, h = (u >> 1) & 3, b = (u >> 3) & 7, d = (u >> 6) & 1;
    constexpr int NCH = (CTXL + SEQ) / 64;
    float lg = 0.f, egr = 1.f;
    if (MX == 1) { const float x = exp2f(-5.0f - (float)h); lg = -(x + x * x * 0.5f + x * x * x * (1.0f / 3.0f) + x * x * x * x * 0.25f); egr = __expf(64.0f * lg); }
    if (w >= 4) {
        const int ptid = F.tid - 256, tt = ptid >> 4, part = ptid & 15;
        const bf16_t* Pq = (const bf16_t*)(F.ws + WS_P) + (MX ? C_RQ : C_GQ) + 128 * h + 8 * part; const bf16_t* Pk = Pq + 512;
        const bf16_t* Pv = (const bf16_t*)(F.ws + WS_P) + (MX ? C_RV : C_GV) + 256 * h + 128 * js + 8 * part;
        const bf16_t* EGp = (const bf16_t*)(F.ws + WS_C) + (size_t)d * TT * 512 + 128 * h + 8 * part;
        const float* EGLp = (const float*)(F.ws + WS_MODP) + (size_t)d * (TT / 64) * 512 + 128 * h + 4 * (ptid & 31);
        bf16_t* O = (bf16_t*)(F.ws + WS_B) + (size_t)(MX * 2 + d) * TT * 1024 + 256 * h + 128 * js + 8 * part;
        float er[4] = {1.f, 1.f, 1.f, 1.f}, nr[4] = {1.f, 1.f, 1.f, 1.f};
        if (MX == 1) {
#pragma unroll
            for (int ps = 0; ps < 4; ++ps) { er[ps] = __expf((float)(tt + 16 * ps + 1) * lg); nr[ps] = __expf(-(float)(tt + 16 * ps + 1) * lg); } }
        ScanSet sA, sB;
#define SC_LOAD(chn, st) do { const int rc_ = chunk_rc(d, b, (chn)); _Pragma("unroll") for (int ps = 0; ps < 4; ++ps) { const int c_ = tt + 16 * ps; const size_t row_ = (size_t)(64 * rc_ + (d ? 63 - c_ : c_)); \
        st.q[ps] = *(const u32x4*)(Pq + row_ * LDP); st.k[ps] = *(const u32x4*)(Pk + row_ * LDP); st.v[ps] = *(const u32x4*)(Pv + row_ * LDP); if (MX == 0) st.e[ps] = *(const u32x4*)(EGp + row_ * 512); } \
        if (MX == 0) st.gl = *(const f32x4*)(EGLp + (size_t)rc_ * 512); } while (0)
#define SC_PUT(st, nb) do { _Pragma("unroll") for (int ps = 0; ps < 4; ++ps) { const int c_ = tt + 16 * ps; u32x4 qo, ko; \
        _Pragma("unroll") for (int e2 = 0; e2 < 4; ++e2) { float ea, eb, na, nb_; \
            if (MX == 0) { ea = bflo(st.e[ps][e2]); eb = bfhi(st.e[ps][e2]); na = __builtin_amdgcn_rcpf(ea); nb_ = __builtin_amdgcn_rcpf(eb); } else { ea = eb = er[ps]; na = nb_ = nr[ps]; } \
            qo[e2] = pk2(bflo(st.q[ps][e2]) * ea, bfhi(st.q[ps][e2]) * eb); ko[e2] = pk2(bflo(st.k[ps][e2]) * na, bfhi(st.k[ps][e2]) * nb_); } \
        *(LAS u32x4*)(L + SC_QS + (nb) * SC_TILE + c_ * SC_PITCH + part * 16) = qo; *(LAS u32x4*)(L + SC_KS + (nb) * SC_TILE + c_ * SC_PITCH + part * 16) = ko; \
        *(LAS u32x4*)(L + SC_VS + (nb) * SC_TILE + c_ * SC_PITCH + part * 16) = st.v[ps]; } \
        if (MX == 0) *(LAS f32x4*)(L + SC_EG + (nb) * 512 + 16 * (ptid & 31)) = st.gl; } while (0)
#define SC_OUT(chn) do { const int rc_ = chunk_rc(d, b, (chn)); _Pragma("unroll") for (int ps = 0; ps < 4; ++ps) { const int c_ = tt + 16 * ps; const u32x4 v_ = *(const LAS u32x4*)(L + SC_OS + c_ * SC_PITCH + part * 16); \
        GST16(O + (size_t)(64 * rc_ + (d ? 63 - c_ : c_)) * 1024, v_); } } while (0)
#define SC_PCHUNK(ch, ST, nb) do { \
        if ((ch) > 0) SC_OUT((ch) - 1); \
        if ((ch) + 1 < NCH) SC_PUT(ST, nb); \
        __syncthreads(); \
        SC_LOAD(((ch) + 3 < NCH ? (ch) + 3 : NCH - 1), ST); \
        __syncthreads(); \
    } while (0)
        SC_LOAD(0, sA); SC_LOAD(1, sB); SC_PUT(sA, 0); SC_LOAD(2, sA);
        __syncthreads();
        for (int ch2 = 0; ch2 < NCH; ch2 += 2) { SC_PCHUNK(ch2, sB, 1); SC_PCHUNK(ch2 + 1, sA, 0); }
        SC_OUT(NCH - 1);
#undef SC_PCHUNK
#undef SC_OUT
#undef SC_PUT
#undef SC_LOAD
    } else {
        const int cw = w;
        f32x4 S[8][2];
#pragma unroll
        for (int i = 0; i < 8; ++i)
#pragma unroll
            for (int j = 0; j < 2; ++j) S[i][j] = (f32x4){0.f, 0.f, 0.f, 0.f};
        __syncthreads();
#define SC_SB() __builtin_amdgcn_sched_barrier(0)
#define SC_CCHUNK(cur) do { \
        LAS unsigned char* Qc = L + SC_QS + (cur) * SC_TILE; LAS unsigned char* Kc = L + SC_KS + (cur) * SC_TILE; LAS unsigned char* Vc = L + SC_VS + (cur) * SC_TILE; \
        {   bf16x8 xq[4], yk[4][4]; \
            _Pragma("unroll") for (int ks = 0; ks < 4; ++ks) { xq[ks] = *(const LAS bf16x8*)(Qc + (16 * cw + fr) * SC_PITCH + (32 * ks + 8 * fq) * 2); \
                _Pragma("unroll") for (int j = 0; j < 4; ++j) yk[ks][j] = *(const LAS bf16x8*)(Kc + (16 * j + fr) * SC_PITCH + (32 * ks + 8 * fq) * 2); } \
            SC_SB(); \
            f32x4 a[4]; \
            _Pragma("unroll") for (int j = 0; j < 4; ++j) a[j] = (f32x4){0.f, 0.f, 0.f, 0.f}; \
            _Pragma("unroll") for (int ks = 0; ks < 4; ++ks) \
                _Pragma("unroll") for (int j = 0; j < 4; ++j) a[j] = MFMA16(yk[ks][j], xq[ks], a[j]); \
            const int c = 16 * cw + fr; \
            _Pragma("unroll") for (int j = 0; j < 4; ++j) { const int s0 = 16 * j + 4 * fq; float m[4]; \
                _Pragma("unroll") for (int e = 0; e < 4; ++e) { const int s = s0 + e; const bool keep = d ? (s < c) : (s <= c); m[e] = keep ? a[j][e] : 0.f; } \
                u32x2 wv; wv.x = pk2(m[0], m[1]); wv.y = pk2(m[2], m[3]); *(LAS u32x2*)(L + SC_AS + c * SC_APITCH + s0 * 2) = wv; } } \
        SC_SB(); \
        f32x4 o[4][2]; \
        _Pragma("unroll") for (int i = 0; i < 4; ++i) \
            _Pragma("unroll") for (int j = 0; j < 2; ++j) o[i][j] = (f32x4){0.f, 0.f, 0.f, 0.f}; \
        {   u32x2 ql[4][4], qh[4][4]; \
            _Pragma("unroll") for (int kk = 0; kk < 4; ++kk) \
                _Pragma("unroll") for (int i = 0; i < 4; ++i) { LAS unsigned char* qa = Qc + (16 * i + fr) * SC_PITCH + (32 * kk + 4 * fq) * 2; ql[kk][i] = *(const LAS u32x2*)qa; qh[kk][i] = *(const LAS u32x2*)(qa + 32); } \
            SC_SB(); \
            _Pragma("unroll") for (int kk = 0; kk < 4; ++kk) { bf16x8 sop[2]; \
                _Pragma("unroll") for (int j = 0; j < 2; ++j) { u32x4 p_; p_.x = pk2(S[2 * kk][j][0], S[2 * kk][j][1]); p_.y = pk2(S[2 * kk][j][2], S[2 * kk][j][3]); \
                    p_.z = pk2(S[2 * kk + 1][j][0], S[2 * kk + 1][j][1]); p_.w = pk2(S[2 * kk + 1][j][2], S[2 * kk + 1][j][3]); sop[j] = __builtin_bit_cast(bf16x8, p_); } \
                _Pragma("unroll") for (int i = 0; i < 4; ++i) { u32x4 x_; x_.x = ql[kk][i].x; x_.y = ql[kk][i].y; x_.z = qh[kk][i].x; x_.w = qh[kk][i].y; const bf16x8 xq = __builtin_bit_cast(bf16x8, x_); \
                    _Pragma("unroll") for (int j = 0; j < 2; ++j) o[i][j] = MFMA16(sop[j], xq, o[i][j]); } } } \
        SC_SB(); \
        bf16x8 yv[2][2]; \
        {   bf16x8 xk[2][8]; \
            _Pragma("unroll") for (int ks = 0; ks < 2; ++ks) \
                _Pragma("unroll") for (int j = 0; j < 2; ++j) yv[ks][j] = tr_frag(Vc, SC_PITCH, 32 * ks + 8 * fq, 32 * cw + 16 * j, lane); \
            _Pragma("unroll") for (int ks = 0; ks < 2; ++ks) \
                _Pragma("unroll") for (int i = 0; i < 8; ++i) xk[ks][i] = tr_frag(Kc, SC_PITCH, 32 * ks + 8 * fq, 16 * i, lane); \
            SC_SB(); \
            _Pragma("unroll") for (int ks = 0; ks < 2; ++ks) \
                _Pragma("unroll") for (int i = 0; i < 8; ++i) \
                    _Pragma("unroll") for (int j = 0; j < 2; ++j) S[i][j] = MFMA16(xk[ks][i], yv[ks][j], S[i][j]); } \
        __syncthreads(); \
        {   bf16x8 xa[2][4]; f32x4 e4[8]; \
            _Pragma("unroll") for (int ks = 0; ks < 2; ++ks) \
                _Pragma("unroll") for (int i = 0; i < 4; ++i) xa[ks][i] = *(const LAS bf16x8*)(L + SC_AS + (16 * i + fr) * SC_APITCH + (32 * ks + 8 * fq) * 2); \
            _Pragma("unroll") for (int i = 0; i < 8; ++i) { e4[i] = (f32x4){egr, egr, egr, egr}; if (MX == 0) e4[i] = *(const LAS f32x4*)(L + SC_EG + (cur) * 512 + (16 * i + 4 * fq) * 4); } \
            SC_SB(); \
            _Pragma("unroll") for (int ks = 0; ks < 2; ++ks) \
                _Pragma("unroll") for (int i = 0; i < 4; ++i) \
                    _Pragma("unroll") for (int j = 0; j < 2; ++j) o[i][j] = MFMA16(yv[ks][j], xa[ks][i], o[i][j]); \
            _Pragma("unroll") for (int i = 0; i < 8; ++i) \
                _Pragma("unroll") for (int j = 0; j < 2; ++j) S[i][j] = S[i][j] * e4[i]; } \
        _Pragma("unroll") for (int i = 0; i < 4; ++i) \
            _Pragma("unroll") for (int j = 0; j < 2; ++j) { u32x2 wv; wv.x = pk2(o[i][j][0], o[i][j][1]); wv.y = pk2(o[i][j][2], o[i][j][3]); \
                *(LAS u32x2*)(L + SC_OS + (16 * i + fr) * SC_PITCH + (32 * cw + 16 * j + 4 * fq) * 2) = wv; } \
        __syncthreads(); \
    } while (0)
        for (int ch2 = 0; ch2 < NCH; ch2 += 2) { SC_CCHUNK(0); SC_CCHUNK(1); }
#undef SC_CCHUNK
#undef SC_SB
    }
    __syncthreads();
}
__device__ __forceinline__ void phase_scan_mfma(const Frame& F, int li) {
    for (int u = F.bx; u < 256; u += F.G) { if (u < 128) scan_unit<0>(F, u); else scan_unit<1>(F, u - 128); }
}


__device__ __forceinline__ void phase_finish(const Frame& F, int li, int nrows) {
    const bf16_t* P = (const bf16_t*)(F.ws + WS_P); const bf16_t* OB = (const bf16_t*)(F.ws + WS_B); const bf16_t* HB = (const bf16_t*)(F.ws + WS_E); bf16_t* A3 = (bf16_t*)(F.ws + WS_C);
    const float* gnorm = inptr<11>() + (size_t)li * 1024; const float* rnorm = inptr<19>() + (size_t)li * 1024;
    const size_t RS = (size_t)TT * 1024;
    struct RowIn { u32x2 v[4][9]; };
#define FIN_LOAD(dst, row_) do { const bf16_t* pr_ = P + (size_t)(row_) * LDP; const size_t ro_ = (size_t)(row_) * 1024; _Pragma("unroll") for (int j = 0; j < 4; ++j) { const int c_ = 4 * F.lane + 256 * j; \
        dst.v[j][0] = *(const u32x2*)(OB + ro_ + c_); dst.v[j][1] = *(const u32x2*)(OB + RS + ro_ + c_); dst.v[j][2] = *(const u32x2*)(pr_ + C_GG + c_); \
        dst.v[j][3] = *(const u32x2*)(HB + ro_ + c_); dst.v[j][4] = *(const u32x2*)(HB + RS + ro_ + c_); dst.v[j][5] = *(const u32x2*)(pr_ + C_LG + c_); \
        dst.v[j][6] = *(const u32x2*)(OB + 2 * RS + ro_ + c_); dst.v[j][7] = *(const u32x2*)(OB + 3 * RS + ro_ + c_); dst.v[j][8] = *(const u32x2*)(pr_ + C_RG + c_); } } while (0)
#define BF4(w) ((f32x4){bflo((w).x), bfhi((w).x), bflo((w).y), bfhi((w).y)})
    RowIn cur;
    if (F.gw < nrows) FIN_LOAD(cur, F.gw);
    for (int row = F.gw; row < nrows; row += F.NGW) {
        const size_t ro = (size_t)row * 1024; u32x2 wo[4][3];
#pragma unroll
        for (int j = 0; j < 4; ++j) {
            const int c = 4 * F.lane + 256 * j;
            {
                const f32x4 o = BF4(cur.v[j][0]) + BF4(cur.v[j][1]);
                const float ss = wave_sum((o[0] * o[0] + o[1] * o[1]) + (o[2] * o[2] + o[3] * o[3])); const float rs = rsqrtf(ss * (1.0f / 256.0f) + EPS);
                const f32x4 g = BF4(cur.v[j][2]), gn = *(const f32x4*)(gnorm + c);
                wo[j][0].x = pk2(o[0] * rs * gn[0] * siluf_(g[0]), o[1] * rs * gn[1] * siluf_(g[1])); wo[j][0].y = pk2(o[2] * rs * gn[2] * siluf_(g[2]), o[3] * rs * gn[3] * siluf_(g[3])); }
            {
                const f32x4 hh = BF4(cur.v[j][3]) + BF4(cur.v[j][4]), g = BF4(cur.v[j][5]);
                wo[j][1].x = pk2(hh[0] * gelu_tanh_(g[0]), hh[1] * gelu_tanh_(g[1])); wo[j][1].y = pk2(hh[2] * gelu_tanh_(g[2]), hh[3] * gelu_tanh_(g[3])); }
            {
                f32x4 o = BF4(cur.v[j][6]) + BF4(cur.v[j][7]);
                const float mean = wave_sum((o[0] + o[1]) + (o[2] + o[3])) * (1.0f / 256.0f); o = o - mean;
                const float ss = wave_sum((o[0] * o[0] + o[1] * o[1]) + (o[2] * o[2] + o[3] * o[3])); const float rs = rsqrtf(ss * (1.0f / 256.0f) + EPS);
                const f32x4 g = BF4(cur.v[j][8]), gn = *(const f32x4*)(rnorm + c);
                wo[j][2].x = pk2(o[0] * rs * gn[0] * siluf_(g[0]), o[1] * rs * gn[1] * siluf_(g[1])); wo[j][2].y = pk2(o[2] * rs * gn[2] * siluf_(g[2]), o[3] * rs * gn[3] * siluf_(g[3])); }
        }
        asm volatile("" ::: "memory");
        if (row + F.NGW < nrows) FIN_LOAD(cur, row + F.NGW);
        asm volatile("" ::: "memory");
#pragma unroll
        for (int j = 0; j < 4; ++j) { const int c = 4 * F.lane + 256 * j; *(u32x2*)(A3 + ro + c) = wo[j][0]; *(u32x2*)(A3 + RS + ro + c) = wo[j][1]; *(u32x2*)(A3 + 2 * RS + ro + c) = wo[j][2]; }
    }
#undef FIN_LOAD
#undef BF4
}

constexpr int RT_PITCH = 2064, RT_XH = 0, RT_XL = 16 * RT_PITCH, RT_PART = 2 * 16 * RT_PITCH, RT_PP = 33, RT_HIST = RT_PART + 8 * 16 * RT_PP * 4;
__device__ __forceinline__ void phase_norm2_router(const Frame& F, int li, int tile0, int ntile) {
    LAS unsigned char* L = F.lds; LAS float* part = (LAS float*)(L + RT_PART); LAS unsigned* hist = (LAS unsigned*)(L + RT_HIST); LAS unsigned* hbase = hist + 32;
    const int lane = F.lane, w = F.wave, fr = lane & 15, fq = lane >> 4;
    const float* wr = inptr<22>() + (size_t)li * 1024 * 32; const float* br = inptr<23>() + li * 32;
    bf16x8 Bh[2][4], Bl[2][4];
#pragma unroll
    for (int nt = 0; nt < 2; ++nt)
#pragma unroll
        for (int ks = 0; ks < 4; ++ks) { u32x4 hw, lw;
#pragma unroll
            for (int i2 = 0; i2 < 4; ++i2) { const float a = wr[(size_t)(128 * w + 32 * ks + 8 * fq + 2 * i2) * 32 + 16 * nt + fr], b = wr[(size_t)(128 * w + 32 * ks + 8 * fq + 2 * i2 + 1) * 32 + 16 * nt + fr];
                hw[i2] = pk2(a, b); lw[i2] = pk2(a - bflo(hw[i2]), b - bfhi(hw[i2])); }
            Bh[nt][ks] = __builtin_bit_cast(bf16x8, hw); Bl[nt][ks] = __builtin_bit_cast(bf16x8, lw); }
    if (F.tid < 32) hist[F.tid] = 0u;
    __syncthreads();
    const bf16_t* xs = (const bf16_t*)(F.ws + WS_XS); const float* mods = (const float*)(F.ws + WS_MODS) + (size_t)li * 9 * 6144;
    bf16_t* xn2 = (bf16_t*)(F.ws + WS_D); int* tok_e = (int*)(F.ws + WS_TOKE); float* tok_w = (float*)(F.ws + WS_TOKW); int* tok_p = (int*)(F.ws + WS_TOKP);
    unsigned* cnt = (unsigned*)(F.ws + WS_CTL) + CW_CNT + li * 32;
    RowV xr[2];
    if (F.bx < ntile) {
#pragma unroll
        for (int rr = 0; rr < 2; ++rr) xr[rr] = load_row_bf16(xs + (size_t)(16 * (tile0 + F.bx) + 2 * w + rr) * D, lane); }
    for (int t = F.bx; t < ntile; t += F.G) {
        u32x2 hs[2][4];
#pragma unroll
        for (int rr = 0; rr < 2; ++rr) { const int lr = 2 * w + rr, row = 16 * (tile0 + t) + lr; const float* mp = mods + mrow_of(row) * 6144;
            const RowV y = norm_mod(xr[rr], inptr<7>() + (size_t)li * 1024, mp + 3 * 1024, mp + 4 * 1024, lane);
#pragma unroll
            for (int j = 0; j < 4; ++j) { u32x2 h, l2; h.x = pk2(y.v[j][0], y.v[j][1]); h.y = pk2(y.v[j][2], y.v[j][3]);
                l2.x = pk2(y.v[j][0] - bflo(h.x), y.v[j][1] - bfhi(h.x)); l2.y = pk2(y.v[j][2] - bflo(h.y), y.v[j][3] - bfhi(h.y)); hs[rr][j] = h;
                *(LAS u32x2*)(L + RT_XH + lr * RT_PITCH + (4 * lane + 256 * j) * 2) = h; *(LAS u32x2*)(L + RT_XL + lr * RT_PITCH + (4 * lane + 256 * j) * 2) = l2; } }
        asm volatile("" ::: "memory");
        if (t + F.G < ntile) {
#pragma unroll
            for (int rr = 0; rr < 2; ++rr) xr[rr] = load_row_bf16(xs + (size_t)(16 * (tile0 + t + F.G) + 2 * w + rr) * D, lane); }
        asm volatile("" ::: "memory");
#pragma unroll
        for (int rr = 0; rr < 2; ++rr)
#pragma unroll
            for (int j = 0; j < 4; ++j) *(u32x2*)(xn2 + (size_t)(16 * (tile0 + t) + 2 * w + rr) * D + 4 * lane + 256 * j) = hs[rr][j];
        __syncthreads();
        {   f32x4 acc[2] = {(f32x4){0.f, 0.f, 0.f, 0.f}, (f32x4){0.f, 0.f, 0.f, 0.f}};
#pragma unroll
            for (int ks = 0; ks < 4; ++ks) { const int co = (128 * w + 32 * ks + 8 * fq) * 2;
                const bf16x8 ah = *(const LAS bf16x8*)(L + RT_XH + fr * RT_PITCH + co), al = *(const LAS bf16x8*)(L + RT_XL + fr * RT_PITCH + co);
#pragma unroll
                for (int nt = 0; nt < 2; ++nt) { acc[nt] = __builtin_amdgcn_mfma_f32_16x16x32_bf16(Bh[nt][ks], ah, acc[nt], 0, 0, 0); acc[nt] = __builtin_amdgcn_mfma_f32_16x16x32_bf16(Bl[nt][ks], ah, acc[nt], 0, 0, 0);
                    acc[nt] = __builtin_amdgcn_mfma_f32_16x16x32_bf16(Bh[nt][ks], al, acc[nt], 0, 0, 0); } }
#pragma unroll
            for (int nt = 0; nt < 2; ++nt)
#pragma unroll
                for (int j = 0; j < 4; ++j) part[(w * 16 + fr) * RT_PP + 16 * nt + 4 * fq + j] = acc[nt][j]; }
        __syncthreads();
        {
            const int e = lane & 31, tk = 2 * w + (lane >> 5), row = 16 * (tile0 + t) + tk; float v = br[e];
#pragma unroll
            for (int w2 = 0; w2 < 8; ++w2) v += part[(w2 * 16 + tk) * RT_PP + e];
            float tl0, tl1, tl2, tl3; int te0, te1, te2, te3;
#define RT_ARGMAX(TL, TE) do { float bv = v; int bi = e; _Pragma("unroll") for (int o = 16; o >= 1; o >>= 1) { const float ov = __shfl_xor(bv, o); const int oi = __shfl_xor(bi, o); \
                const bool tk_ = (ov > bv) || (ov == bv && oi < bi); bv = tk_ ? ov : bv; bi = tk_ ? oi : bi; } TL = bv; TE = bi; v = (e == bi) ? -3.0e38f : v; } while (0)
            RT_ARGMAX(tl0, te0); RT_ARGMAX(tl1, te1); RT_ARGMAX(tl2, te2); RT_ARGMAX(tl3, te3);
#undef RT_ARGMAX
            const float e1 = __expf(tl1 - tl0), e2 = __expf(tl2 - tl0), e3 = __expf(tl3 - tl0); const float inv = 1.0f / (1.0f + e1 + e2 + e3);
            if (e < 4) { const int ek = e == 0 ? te0 : e == 1 ? te1 : e == 2 ? te2 : te3; const float wk = (e == 0 ? 1.0f : e == 1 ? e1 : e == 2 ? e2 : e3) * inv;
                const unsigned lp = atomicAdd((unsigned*)&hist[ek], 1u); tok_e[row * 4 + e] = ek; tok_w[row * 4 + e] = wk; tok_p[row * 4 + e] = (int)lp; } }
        __syncthreads();
    }
    if (F.tid < 32) hbase[F.tid] = __hip_atomic_fetch_add(cnt + F.tid, hist[F.tid], __ATOMIC_RELAXED, __HIP_MEMORY_SCOPE_AGENT);
    __syncthreads();
    for (int t = F.bx; t < ntile; t += F.G) if (F.tid < 64) { const int i = 16 * (tile0 + t) * 4 + F.tid; tok_p[i] += (int)hbase[tok_e[i]]; }
    __syncthreads();
}
__device__ __forceinline__ void phase_dispatch(const Frame& F, int li, int ntok) {
    LAS unsigned* pstart = (LAS unsigned*)F.lds;
    unsigned* ctl = (unsigned*)(F.ws + WS_CTL); unsigned* cnt = ctl + CW_CNT + li * 32; unsigned* tile_e = ctl + CW_TILE + li * 1024;
    if (F.tid == 0) { unsigned ps = 0;
        for (int e = 0; e < 32; ++e) { const unsigned c = __hip_atomic_load(cnt + e, __ATOMIC_RELAXED, __HIP_MEMORY_SCOPE_AGENT), nt = (c + 255u) >> 8; pstart[e] = ps;
            if (F.bx == 0) for (unsigned j = 0; j < nt; ++j) tile_e[(ps >> 8) + j] = (unsigned)e;
            ps += nt << 8; }
        if (F.bx == 0) ctl[CW_NT + li] = ps >> 8; }
    __syncthreads();
    const int* tok_e = (const int*)(F.ws + WS_TOKE); const int* tok_p = (const int*)(F.ws + WS_TOKP); int* tok_s = (int*)(F.ws + WS_TOKS); int* slot_tok = (int*)(F.ws + WS_SLOTTOK);
    for (int it = F.gtid; it < ntok * 4; it += F.NGT) { const int slot = (int)pstart[tok_e[it]] + tok_p[it]; tok_s[it] = slot; slot_tok[slot] = it >> 2; }
    if (F.bx < 32) { const unsigned c = __hip_atomic_load(cnt + F.bx, __ATOMIC_RELAXED, __HIP_MEMORY_SCOPE_AGENT), pe = ((c + 255u) >> 8) << 8;
        for (unsigned s = c + F.tid; s < pe; s += NTHR) slot_tok[pstart[F.bx] + s] = 0; }
    __syncthreads();
}
__device__ __forceinline__ void phase_combine(const Frame& F, int li, int ntok, bool last) {
    bf16_t* xs = (bf16_t*)(F.ws + WS_XS); const bf16_t* Y = (const bf16_t*)(F.ws + WS_B); bf16_t* xn = (bf16_t*)(F.ws + WS_D);
    const float* mods = (const float*)(F.ws + WS_MODS); const float* tok_w = (const float*)(F.ws + WS_TOKW); const int* tok_s = (const int*)(F.ws + WS_TOKS);
    for (int row = F.gw; row < ntok; row += F.NGW) {
        const int mr = mrow_of(row); const float* gp = mods + ((size_t)li * 9 + mr) * 6144 + 5 * 1024;
        RowV x = load_row_bf16(xs + (size_t)row * D, F.lane);
        const int s0 = tok_s[row * 4], s1 = tok_s[row * 4 + 1], s2 = tok_s[row * 4 + 2], s3 = tok_s[row * 4 + 3];
        const float w0 = tok_w[row * 4], w1 = tok_w[row * 4 + 1], w2 = tok_w[row * 4 + 2], w3 = tok_w[row * 4 + 3];
#pragma unroll
        for (int j = 0; j < 4; ++j) { const int c = 4 * F.lane + 256 * j;
            const f32x4 y = ld4bf(Y + (size_t)s0 * 1024 + c) * w0 + ld4bf(Y + (size_t)s1 * 1024 + c) * w1 + ld4bf(Y + (size_t)s2 * 1024 + c) * w2 + ld4bf(Y + (size_t)s3 * 1024 + c) * w3;
            x.v[j] = x.v[j] + *(const f32x4*)(gp + c) * y; }
        if (!last) {
            store_row_bf16(xs + (size_t)row * D, x, F.lane);
            const float* mp = mods + ((size_t)(li + 1) * 9 + mr) * 6144;
            const RowV y = norm_mod(x, inptr<6>() + (size_t)(li + 1) * 1024, mp, mp + 1024, F.lane);
            store_row_bf16(xn + (size_t)row * D, y, F.lane);
        } else {
            const float rs = rsqrtf(row_sumsq(x) * (1.0f / D) + EPS);
#pragma unroll
            for (int j = 0; j < 4; ++j) { const int c = 4 * F.lane + 256 * j; *(f32x4*)(F.out + (size_t)row * D + c) = (x.v[j] * rs) * *(const f32x4*)(inptr<28>() + c); }
        }
    }
}


__device__ __forceinline__ void phase_branch_tail(const Frame& F, int r0, int r1) {
    bf16_t* MB = (bf16_t*)(F.ws + WS_B);
    for (int row = r0 + F.gw; row < r1; row += F.NGW) { const size_t o = (size_t)row * 1024 + 16 * F.lane;
        u32x4 s[2][3];
#pragma unroll
        for (int hlf = 0; hlf < 2; ++hlf)
#pragma unroll
            for (int k = 0; k < 3; ++k) s[hlf][k] = *(const u32x4*)(MB + (size_t)k * TT * 1024 + o + 8 * hlf);
#pragma unroll
        for (int hlf = 0; hlf < 2; ++hlf) { u32x4 w;
#pragma unroll
            for (int e = 0; e < 4; ++e) w[e] = pk2(bflo(s[hlf][2][e]) + bflo(s[hlf][0][e]) + bflo(s[hlf][1][e]), bfhi(s[hlf][2][e]) + bfhi(s[hlf][0][e]) + bfhi(s[hlf][1][e]));
            *(u32x4*)(MB + (size_t)2 * TT * 1024 + o + 8 * hlf) = w; } }
}

#ifndef MK_RLXMASK
#define MK_RLXMASK 1
#endif
#define MK_RLX(i) (((MK_RLXMASK) >> (i)) & 1)
#ifndef MK_SCAN_REF
#define MK_SCAN_REF 0
#endif
#ifndef MK_ONE_LAUNCH
#define MK_ONE_LAUNCH 1
#endif
constexpr int NPH_LAYER = 15, NPHASES = 2 + 2 * NPH_LAYER;
struct Args { const float* in[29]; float* out; unsigned char* ws; int ph_lo, ph_hi, region, pad; };
#ifndef MK_PHMASK
#define MK_PHMASK 0x7fff
#endif
#define IN(k) (lo <= (k) && (k) < hi)
#define EN(j) ((MK_PHMASK >> (j)) & 1)
#define SEAM(k) do { if (IN(k) && IN((k) + 1)) xcd_barrier(bar); } while (0)
#define MKF() Frame F; { GAS unsigned char* ws_ = (GAS unsigned char*)args.ws; asm volatile("" : "+s"(ws_)); F.ws = ws_; F.lds = (LAS unsigned char*)lds_raw; F.out = args.out; \
        int tid_ = (wave0 << 6) | (int)xb_lane(), bx_ = blockIdx.x; asm volatile("" : "+v"(tid_), "+s"(bx_)); F.tid = tid_; F.bx = bx_; F.lane = F.tid & 63; F.wave = __builtin_amdgcn_readfirstlane(F.tid >> 6); F.G = gridDim.x; \
        F.gw = F.bx * NWAVES + F.wave; F.NGW = F.G * NWAVES; F.gtid = F.bx * NTHR + F.tid; F.NGT = F.G * NTHR; }
template <int li> __device__ __forceinline__ void run_layer(const Args& args, unsigned char* lds_raw, const XcdBarrier& bar, const int lo, const int hi, const int wave0) {
        const int pb = 2 + NPH_LAYER * li; const bool last = (li == 1); const int nrows = last ? TLAT : TT, nMt = nrows / 256;
        if (EN(0) && IN(pb + 0)) { MKF(); phase_W(F, li); if (li == 0) phase_norm_in(F); __syncthreads(); }
        SEAM(pb + 0);
        if (EN(1) && IN(pb + 1)) { MKF(); unsigned* ctl = (unsigned*)(F.ws + WS_CTL); (void)ctl;
            pg8::Gemm g{1024, 1024, 1024}; PlainOrder S; S.pm0 = 0; S.A = (const char*)(F.ws + WS_D); S.B = (const char*)(F.ws + WS_WIN); S.astep = 256 * 1024 * 2; S.bstep = 256 * 1024 * 2; S.nM = TT / 256; S.nN = LDP / 256; S.G = F.G; S.c = F.bx;
            EpiProj E{(bf16_t*)(F.ws + WS_P), (const float*)(F.ws + WS_COS), (const float*)(F.ws + WS_SIN)};
            pg8::gemm_phase<EpiProj, PlainOrder, true, true, false, MK_RLX(0)>(F.lds, g, S, E, F.tid);
        }
        SEAM(pb + 1);
        if (EN(2) && IN(pb + 2)) { MKF(); phase_conv(F, li); phase_scanprep(F, li); }
        SEAM(pb + 2);
        if (EN(3) && IN(pb + 3)) { MKF(); phase_scan_mfma(F, li); }
        SEAM(pb + 3);
        if (EN(4) && IN(pb + 4)) { MKF(); unsigned* ctl = (unsigned*)(F.ws + WS_CTL); (void)ctl;
            pg8::Gemm g{1024, 256, 256}; LruOrder S; S.A = (const char*)(F.ws + WS_D); S.B = (const char*)(F.ws + WS_WLRU); S.nM = TT / 256; S.G = F.G; S.c = F.bx;
            EpiLru E{(const bf16_t*)(F.ws + WS_D), (bf16_t*)(F.ws + WS_C), (bf16_t*)(F.ws + WS_C + 2 * ROWB), inptr<15>() + (size_t)li * 2048, inptr<17>() + (size_t)li * 2048, (const float*)(F.ws + WS_LSL)};
            pg8::gemm_phase<EpiLru, LruOrder, true, true, false, MK_RLX(1)>(F.lds, g, S, E, F.tid);
        }
        SEAM(pb + 4);
        if (EN(5) && IN(pb + 5)) { MKF(); phase_lru_scan<false>(F); }
        SEAM(pb + 5);
        if (EN(6) && IN(pb + 6)) { MKF(); phase_lru_scan<true>(F); }
        SEAM(pb + 6);
        if (EN(7) && IN(pb + 7)) { MKF(); phase_finish(F, li, nrows); }
        SEAM(pb + 7);
        if (EN(8) && IN(pb + 8)) { MKF(); unsigned* ctl = (unsigned*)(F.ws + WS_CTL); (void)ctl;
            pg8::Gemm g{1024, 1024, 1024}; BranchOrder S; S.A = (const char*)(F.ws + WS_C); S.B = (const char*)(F.ws + WS_WBR); S.nM = nMt; S.G = F.G; S.c = F.bx;
            EpiBranch E{(const bf16_t*)(F.ws + WS_P), (bf16_t*)(F.ws + WS_B)};
            pg8::gemm_phase<EpiBranch, BranchOrder, true, true, false, MK_RLX(2)>(F.lds, g, S, E, F.tid);
            if (S.full_rows() < nMt) { xcd_barrier(bar); phase_branch_tail(F, S.full_rows() * 256, nMt * 256); }
        }
        SEAM(pb + 8);
        if (EN(9) && IN(pb + 9)) { MKF(); unsigned* ctl = (unsigned*)(F.ws + WS_CTL); (void)ctl;
            pg8::Gemm g{1024, 1024, 1024}; PlainOrder S; S.pm0 = 0; S.A = (const char*)(F.ws + WS_B + 2 * ROWB); S.B = (const char*)(F.ws + WS_WOUT); S.astep = 256 * 1024 * 2; S.bstep = 256 * 1024 * 2; S.nM = nMt; S.nN = 4; S.G = F.G; S.c = F.bx;
            bf16_t* xs = (bf16_t*)(F.ws + WS_XS);
            EpiOut<li == 0> E{inptr<0>(), inptr<2>(), xs, (const float*)(F.ws + WS_MODS) + (size_t)li * 9 * 6144 + 2 * 1024};
            const int nMa = full_row_tiles(nMt, 4, F.G); S.nM = nMa;
            pg8::gemm_phase<EpiOut<li == 0>, PlainOrder, true, true, false, MK_RLX(3)>(F.lds, g, S, E, F.tid);
            if (nMa < nMt) { const int ntw = (nMt - nMa) * 4; xcd_barrier(bar);
                if (F.bx < ntw) { PlainOrder T = S; T.nM = nMt - nMa; T.pm0 = nMa; T.G = ntw; T.c = F.bx; pg8::gemm_phase<EpiOut<li == 0>, PlainOrder, true, true, false, MK_RLX(3)>(F.lds, g, T, E, F.tid); }
                else { Frame F2 = F; F2.bx = F.bx - ntw; F2.G = F.G - ntw; phase_norm2_router(F2, li, 0, nMa * 16); } }
        }
        SEAM(pb + 9);
        if (EN(10) && IN(pb + 10)) { MKF(); const int nMa = full_row_tiles(nMt, 4, F.G); if (nMa < nMt) phase_norm2_router(F, li, nMa * 16, (nMt - nMa) * 16); else phase_norm2_router(F, li, 0, nrows / 16); }
        SEAM(pb + 10);
        if (EN(11) && IN(pb + 11)) { MKF(); phase_dispatch(F, li, nrows); }
        SEAM(pb + 11);
        if (EN(12) && IN(pb + 12)) { MKF(); unsigned* ctl = (unsigned*)(F.ws + WS_CTL); (void)ctl;
            pg8::Gemm g{1024, 1024, 1024}; MoeOrder S; S.A = (const char*)(F.ws + WS_D); S.rowidx = (const int*)(F.ws + WS_SLOTTOK); S.B = (const char*)(F.ws + WS_WGU); S.tile_e = ctl + CW_TILE + li * 1024; S.estep = (size_t)2048 * 1024 * 2;
            S.nM = __builtin_amdgcn_readfirstlane((int)ctl[CW_NT + li]); S.nN = 8; S.G = F.G; S.c = F.bx; S.ga = 1;
            EpiSwiglu E{(bf16_t*)(F.ws + WS_P + 288 * MiB), inptr<25>() + (size_t)li * 32 * 2048};
            pg8::gemm_phase<EpiSwiglu, MoeOrder, true, true, true, MK_RLX(4)>(F.lds, g, S, E, F.tid);
        }
        SEAM(pb + 12);
        if (EN(13) && IN(pb + 13)) { MKF(); unsigned* ctl = (unsigned*)(F.ws + WS_CTL); (void)ctl;
            pg8::Gemm g{1024, 1024, 1024}; MoeOrder S; S.A = (const char*)(F.ws + WS_P + 288 * MiB); S.B = (const char*)(F.ws + WS_WDN); S.tile_e = ctl + CW_TILE + li * 1024; S.estep = (size_t)1024 * 1024 * 2;
            S.nM = __builtin_amdgcn_readfirstlane((int)ctl[CW_NT + li]); S.nN = 4; S.G = F.G; S.c = F.bx; S.ga = 0; S.rowidx = nullptr;
            EpiBf16Bias E{(bf16_t*)(F.ws + WS_B), 1024, inptr<27>() + (size_t)li * 32 * 1024, 1024};
            pg8::gemm_phase<EpiBf16Bias, MoeOrder, true, true, false, MK_RLX(5)>(F.lds, g, S, E, F.tid);
        }
        SEAM(pb + 13);
        if (EN(14) && IN(pb + 14)) { MKF(); phase_combine(F, li, nrows, last); }
        SEAM(pb + 14);
    }
__global__ void __launch_bounds__(NTHR, 2) mk_fwd(Args args) {
    extern __shared__ __attribute__((aligned(16))) unsigned char lds_raw[];
    const int tid0 = threadIdx.x; int wave0 = __builtin_amdgcn_readfirstlane(tid0 >> 6); asm volatile("" : "+s"(wave0));
    volatile LAS unsigned* MISC = (volatile LAS unsigned*)((LAS unsigned char*)lds_raw + MISC_OFF);
    if (tid0 < 32) MISC[tid0] = 0u;
    __syncthreads();
    unsigned* ctl0 = (unsigned*)(args.ws + WS_CTL);
    const int lo = args.ph_lo, hi = args.ph_hi;
    XcdBarrier bar; bar.bar = ctl0 + CW_BAR + args.region * 4096; bar.x = 0; bar.st = MISC + 8; bar.w0 = (unsigned)wave0;
    if (hi - lo > 1) bar = xcd_barrier_post(ctl0 + CW_BAR + args.region * 4096, MISC + 8, (unsigned)wave0);

    if (IN(0)) { MKF(); phase_proA(F); }
    SEAM(0);
    if (IN(1)) { MKF(); phase_proB(F); }
    SEAM(1);
    run_layer<0>(args, lds_raw, bar, lo, hi, wave0);
    run_layer<1>(args, lds_raw, bar, lo, hi, wave0);
}

extern "C" void kernel_launch(void* const* d_in, const int* in_sizes, int n_in, void* d_out, int out_size, void* d_ws, size_t ws_size, hipStream_t stream) {
    static int grid = 0;
    if (grid == 0) {
        if (n_in != 29 || ws_size < WS_END || out_size != TLAT * D) { fprintf(stderr, "kernel_launch: unexpected problem: n_in %d ws %zu out %d\n", n_in, ws_size, out_size); grid = -1; return; }
        int dev = 0, cus = 0;
        if (hipGetDevice(&dev) != hipSuccess || hipDeviceGetAttribute(&cus, hipDeviceAttributeMultiprocessorCount, dev) != hipSuccess) { grid = -1; return; }
        if (hipFuncSetAttribute((const void*)mk_fwd, hipFuncAttributeMaxDynamicSharedMemorySize, LDS_BYTES) != hipSuccess) { fprintf(stderr, "kernel_launch: hipFuncSetAttribute failed\n"); grid = -1; return; }
        int per_cu = 0;
        if (hipOccupancyMaxActiveBlocksPerMultiprocessor(&per_cu, (const void*)mk_fwd, NTHR, LDS_BYTES) != hipSuccess || per_cu < 1) fprintf(stderr, "kernel_launch: occupancy query reports %d\n", per_cu);
        (void)hipGetLastError();
        grid = cus;
    }
    if (grid < 0) return;
    (void)hipMemsetAsync((char*)d_ws + WS_CTL, 0, CTL_BYTES, stream);
    Args a{};
    for (int i = 0; i < 29; ++i) a.in[i] = (const float*)d_in[i];
    a.out = (float*)d_out; a.ws = (unsigned char*)d_ws;
#if MK_ONE_LAUNCH
    a.ph_lo = 0; a.ph_hi = NPHASES; a.region = 0;
    hipLaunchKernelGGL(mk_fwd, dim3(grid), dim3(NTHR), LDS_BYTES, stream, a);
#else
    for (int p = 0; p < NPHASES; ++p) { a.ph_lo = p; a.ph_hi = p + 1; a.region = 0; hipLaunchKernelGGL(mk_fwd, dim3(grid), dim3(NTHR), LDS_BYTES, stream, a); }
#endif
}
```
